# Optimizing an MI355X kernel written in HIP

```python
import jax
import jax.numpy as jnp
from jax import lax
import numpy as np

D_MODEL = 2048
BATCH = 2
SEQ = 8192
DEPTH = 2

GRID_W = 64
CTX_LEN = 256
HEAD_DIM = 64
GROUP_W = D_MODEL // 4
NA_HEADS = GROUP_W // HEAD_DIM
NA_KH = 8
NA_KW = 16
NA_KBW = 2 * NA_KW
SC_W = GROUP_W
SC_KSIZE = 3
GLA_HEADS = 4
GLA_DK = GROUP_W // (2 * GLA_HEADS)
GLA_DV = GROUP_W // GLA_HEADS
GLA_RANK = 16
GLA_TAU = 16.0
GLA_CHUNK = 32
SWA_HEADS = GROUP_W // HEAD_DIM
SWA_KV_HEADS = 2
SWA_WINDOW = 128
SWA_BLOCK = 128
ROPE_BASE = 10000.0
N_EXPERTS = 64
TOP_K = 8
N_GROUPS = 8
TOPK_GROUPS = 4
D_EXPERT = D_MODEL // 4
D_SHARED = D_EXPERT
ROUTED_SCALE = 2.5
MOE_BLOCK = 256
DN_ALPHA = (2 * DEPTH) ** 0.25
DN_BETA = (8 * DEPTH) ** -0.25
LN_EPS = 1e-6
PROJ_SPLITS = (GROUP_W, GROUP_W, GROUP_W,
               SC_W, SC_W, SC_W,
               GLA_HEADS * GLA_DK, GLA_HEADS * GLA_DK, GLA_HEADS * GLA_DV, GLA_HEADS * GLA_DV, 2 * GLA_RANK,
               SWA_HEADS * HEAD_DIM, SWA_KV_HEADS * HEAD_DIM, SWA_KV_HEADS * HEAD_DIM)
PROJ_W = sum(PROJ_SPLITS)

kernel_name = 'hybrid_diffusion_na_conv_gla_swa_moe'


def _layer_norm(x, gain=None, bias=None):
    xf = x.astype(jnp.float32)
    mu = jnp.mean(xf, axis=-1, keepdims=True)
    var = jnp.mean(jnp.square(xf - mu), axis=-1, keepdims=True)
    y = (xf - mu) * lax.rsqrt(var + LN_EPS)
    if gain is not None:
        y = y * gain.astype(jnp.float32) + bias.astype(jnp.float32)
    return y.astype(x.dtype)


def _modulate(h, shift, scale):
    return _layer_norm(h) * (1 + scale) + shift


def _heads(t, n):
    return t.reshape(*t.shape[:-1], n, t.shape[-1] // n)


def _split_proj(p):
    cuts = np.cumsum(PROJ_SPLITS)[:-1].tolist()
    return jnp.split(p, cuts, axis=-1)


def _rope_1d(x, pos):
    half = x.shape[-1] // 2
    inv = ROPE_BASE ** (-2.0 * jnp.arange(half, dtype=jnp.float32) / x.shape[-1])
    ang = pos[:, None] * inv[None, :]
    cos = jnp.cos(ang)[None, :, None, :].astype(x.dtype)
    sin = jnp.sin(ang)[None, :, None, :].astype(x.dtype)
    x1, x2 = x[..., :half], x[..., half:]
    return jnp.concatenate([x1 * cos - x2 * sin, x2 * cos + x1 * sin], axis=-1)


def _axial_rope(x, row, col):
    half = x.shape[-1] // 2
    return jnp.concatenate([_rope_1d(x[..., :half], row), _rope_1d(x[..., half:], col)], axis=-1)


def _context_attention(q, k, v, sink=None):
    bsz, n, hq, dh = q.shape
    hkv = k.shape[2]
    grp = hq // hkv
    qg = q.reshape(bsz, n, hkv, grp, dh)
    s = jnp.einsum('bnkgd,bmkd->bkgnm', qg, k).astype(jnp.float32) * dh ** -0.5
    if sink is not None:
        sk = jnp.broadcast_to(sink.astype(jnp.float32).reshape(1, hkv, grp, 1, 1), (*s.shape[:-1], 1))
        p = jax.nn.softmax(jnp.concatenate([s, sk], axis=-1), axis=-1)[..., :-1]
    else:
        p = jax.nn.softmax(s, axis=-1)
    o = jnp.einsum('bkgnm,bmkd->bnkgd', p.astype(v.dtype), v)
    return o.reshape(bsz, n, hq * dh)


def _neighbourhood_attention(q, k, v, kc, vc, rpb):
    bsz, seq, nh, dh = q.shape
    rows = seq // GRID_W
    kh = min(NA_KH, rows)
    ncb = GRID_W // NA_KW
    scale = dh ** -0.5
    r = jnp.arange(rows)
    row_idx = jnp.clip(r - kh // 2, 0, rows - kh)[:, None] + jnp.arange(kh)[None, :]
    qcol = jnp.arange(ncb)[:, None] * NA_KW + jnp.arange(NA_KW)[None, :]
    kcol = jnp.clip(jnp.arange(ncb) * NA_KW - NA_KW // 2, 0, GRID_W - NA_KBW)[:, None] + jnp.arange(NA_KBW)[None, :]
    cstart = jnp.clip(qcol - NA_KW // 2, 0, GRID_W - NA_KW)
    valid = (kcol[:, None, :] >= cstart[:, :, None]) & (kcol[:, None, :] < cstart[:, :, None] + NA_KW)
    coff = jnp.clip(kcol[:, None, :] - qcol[:, :, None], 1 - NA_KW, NA_KW - 1) + NA_KW - 1
    roff = row_idx - r[:, None] + NA_KH - 1
    bias = rpb[:, roff[:, None, None, :, None], coff[None, :, :, None, :]].astype(jnp.float32)
    bias = jnp.where(valid[None, None, :, :, None, :], bias, -jnp.inf).transpose(1, 2, 3, 0, 4, 5)
    ri = row_idx[:, :, None, None]
    ci = kcol[None, None]
    kg = k.reshape(bsz, rows, GRID_W, nh, dh)[:, ri, ci]
    vg = v.reshape(bsz, rows, GRID_W, nh, dh)[:, ri, ci]
    qg = q.reshape(bsz, rows, ncb, NA_KW, nh, dh)
    s_nb = jnp.einsum('brmqhd,brimjhd->brmqhij', qg, kg).astype(jnp.float32) * scale + bias
    s_ctx = jnp.einsum('brmqhd,bnhd->brmqhn', qg, kc).astype(jnp.float32) * scale
    nb = kh * NA_KBW
    logits = jnp.concatenate([s_nb.reshape(*s_nb.shape[:5], nb), s_ctx], axis=-1)
    p = jax.nn.softmax(logits, axis=-1).astype(v.dtype)
    o = (jnp.einsum('brmqhij,brimjhd->brmqhd', p[..., :nb].reshape(s_nb.shape), vg)
         + jnp.einsum('brmqhn,bnhd->brmqhd', p[..., nb:], vc))
    return o.reshape(bsz, seq, nh * dh)


def _window_attention(q, k, v, kc, vc, sink):
    bsz, seq, hq, dh = q.shape
    hkv = k.shape[2]
    grp = hq // hkv
    nblk = seq // SWA_BLOCK
    qb = q.reshape(bsz, nblk, SWA_BLOCK, hkv, grp, dh)

    def band(t):
        tb = jnp.pad(t.reshape(bsz, nblk, SWA_BLOCK, hkv, dh), ((0, 0), (1, 1), (0, 0), (0, 0), (0, 0)))
        return jnp.concatenate([tb[:, :-2], tb[:, 1:-1], tb[:, 2:]], axis=2)

    kb, vb = band(k), band(v)
    qpos = jnp.arange(nblk)[:, None] * SWA_BLOCK + jnp.arange(SWA_BLOCK)[None, :]
    kpos = (jnp.arange(nblk)[:, None] - 1) * SWA_BLOCK + jnp.arange(3 * SWA_BLOCK)[None, :]
    valid = ((jnp.abs(qpos[:, :, None] - kpos[:, None, :]) <= SWA_WINDOW)
             & (kpos[:, None, :] >= 0) & (kpos[:, None, :] < seq))
    scale = dh ** -0.5
    s_win = jnp.einsum('bnqkgd,bnjkd->bnkgqj', qb, kb).astype(jnp.float32) * scale
    s_win = jnp.where(valid[None, :, None, None], s_win, -jnp.inf)
    s_ctx = jnp.einsum('bnqkgd,bmkd->bnkgqm', qb, kc).astype(jnp.float32) * scale
    s_sink = jnp.broadcast_to(sink.astype(jnp.float32).reshape(1, 1, hkv, grp, 1, 1), (*s_win.shape[:-1], 1))
    p = jax.nn.softmax(jnp.concatenate([s_win, s_ctx, s_sink], axis=-1), axis=-1).astype(v.dtype)
    nw = 3 * SWA_BLOCK
    nc = kc.shape[1]
    o = (jnp.einsum('bnkgqj,bnjkd->bnqkgd', p[..., :nw], vb)
         + jnp.einsum('bnkgqm,bmkd->bnqkgd', p[..., nw:nw + nc], vc))
    return o.reshape(bsz, seq, hq * dh)


def _short_conv(u, gate_b, gate_c, w):
    ch = u.shape[-1]
    z = lax.conv_general_dilated(gate_c * u, w[:, None, :], window_strides=(1,),
                                 padding=((SC_KSIZE // 2, SC_KSIZE // 2),),
                                 dimension_numbers=('NWC', 'WIO', 'NWC'), feature_group_count=ch)
    return gate_b * z


def _gla_log_decay(z, w2, b):
    zf, zb = jnp.split(z, 2, axis=-1)
    lf = jax.nn.log_sigmoid((zf @ w2[0] + b[0]).astype(jnp.float32)) / GLA_TAU
    lb = jax.nn.log_sigmoid((zb @ w2[1] + b[1]).astype(jnp.float32)) / GLA_TAU
    return _heads(lf, GLA_HEADS), _heads(lb, GLA_HEADS)


def _gla_scan(q, k, v, log_a, s0):
    bsz, seq, nh, dk = q.shape
    dv = v.shape[-1]
    nc = seq // GLA_CHUNK

    def chunks(t):
        return t.astype(jnp.float32).reshape(bsz, nc, GLA_CHUNK, nh, t.shape[-1])

    qf = chunks(q) * dk ** -0.5
    kf = chunks(k)
    vf = chunks(v)
    cum = jnp.cumsum(chunks(log_a), axis=2)
    last = cum[:, :, -1:]
    lower = jnp.tril(jnp.ones((GLA_CHUNK, GLA_CHUNK), dtype=bool))
    decay = jnp.exp(jnp.where(lower[:, :, None, None], cum[:, :, :, None] - cum[:, :, None, :], -jnp.inf))
    attn = jnp.einsum('bcthd,bcshd,bctshd->bchts', qf, kf, decay)
    o_intra = jnp.einsum('bchts,bcshv->bcthv', attn, vf)
    upd = jnp.einsum('bcshk,bcshv->bchkv', kf * jnp.exp(last - cum), vf)
    gdec = jnp.exp(last[:, :, 0])

    def step(state, inp):
        g, u = inp
        return g[..., None] * state + u, state

    s_fin, s_in = lax.scan(step, s0, (jnp.moveaxis(gdec, 1, 0), jnp.moveaxis(upd, 1, 0)))
    o_inter = jnp.einsum('bcthk,cbhkv->bcthv', qf * jnp.exp(cum), s_in)
    return (o_intra + o_inter).reshape(bsz, seq, nh, dv), s_fin


def _gla_bidirectional(q, k, v, la_f, la_b, qc, kc, vc, lac_f, lac_b):
    bsz, _, nh, dk = q.shape
    s0 = jnp.zeros((bsz, nh, dk, v.shape[-1]), jnp.float32)

    def flip(t):
        return jnp.flip(t, axis=1)

    oc_f, sc_f = _gla_scan(qc, kc, vc, lac_f, s0)
    oc_b, sc_b = _gla_scan(flip(qc), flip(kc), flip(vc), flip(lac_b), s0)
    o_f, _ = _gla_scan(q, k, v, la_f, sc_f)
    o_b, _ = _gla_scan(flip(q), flip(k), flip(v), flip(la_b), sc_b)
    return o_f + flip(o_b), oc_f + flip(oc_b)


def _gla_out(o, g, gain):
    on = o * lax.rsqrt(jnp.mean(jnp.square(o), axis=-1, keepdims=True) + LN_EPS) * gain.astype(jnp.float32)
    return (on.astype(g.dtype) * jax.nn.silu(g.reshape(o.shape))).reshape(g.shape)


def _token_mixers(p_lat, p_ctx, rpb, conv_w, gla_w2, gla_b, gla_norm_g, sink, with_ctx_out):
    seq = p_lat.shape[1]
    na_q, na_k, na_v, sc_u, sc_b, sc_c, gl_q, gl_k, gl_v, gl_g, gl_z, sw_q, sw_k, sw_v = _split_proj(p_lat)
    cna_q, cna_k, cna_v, csc_u, csc_b, csc_c, cgl_q, cgl_k, cgl_v, cgl_g, cgl_z, csw_q, csw_k, csw_v = _split_proj(p_ctx)
    y_na = _neighbourhood_attention(_heads(na_q, NA_HEADS), _heads(na_k, NA_HEADS), _heads(na_v, NA_HEADS),
                                    _heads(cna_k, NA_HEADS), _heads(cna_v, NA_HEADS), rpb)
    y_sc = _short_conv(sc_u, sc_b, sc_c, conv_w)
    la_f, la_b = _gla_log_decay(gl_z, gla_w2, gla_b)
    lac_f, lac_b = _gla_log_decay(cgl_z, gla_w2, gla_b)
    o_gl, oc_gl = _gla_bidirectional(_heads(gl_q, GLA_HEADS), _heads(gl_k, GLA_HEADS), _heads(gl_v, GLA_HEADS), la_f, la_b,
                                     _heads(cgl_q, GLA_HEADS), _heads(cgl_k, GLA_HEADS), _heads(cgl_v, GLA_HEADS), lac_f, lac_b)
    y_gl = _gla_out(o_gl, gl_g, gla_norm_g)
    t = jnp.arange(seq)
    row = (t // GRID_W).astype(jnp.float32)
    col = (t % GRID_W).astype(jnp.float32)
    y_sw = _window_attention(_axial_rope(_heads(sw_q, SWA_HEADS), row, col),
                             _axial_rope(_heads(sw_k, SWA_KV_HEADS), row, col),
                             _heads(sw_v, SWA_KV_HEADS), _heads(csw_k, SWA_KV_HEADS), _heads(csw_v, SWA_KV_HEADS), sink)
    y_lat = jnp.concatenate([y_na, y_sc, y_gl, y_sw], axis=-1)
    if not with_ctx_out:
        return y_lat, None
    y_ctx = jnp.concatenate([
        _context_attention(_heads(cna_q, NA_HEADS), _heads(cna_k, NA_HEADS), _heads(cna_v, NA_HEADS)),
        _short_conv(csc_u, csc_b, csc_c, conv_w),
        _gla_out(oc_gl, cgl_g, gla_norm_g),
        _context_attention(_heads(csw_q, SWA_HEADS), _heads(csw_k, SWA_KV_HEADS), _heads(csw_v, SWA_KV_HEADS), sink),
    ], axis=-1)
    return y_lat, y_ctx


def _swiglu(h, wg, wu, wd):
    return (jax.nn.silu(h @ wg) * (h @ wu)) @ wd


def _routed_experts(h, eidx, wts, w_eg, w_eu, w_ed):
    n, d = h.shape
    nk = n * TOP_K
    flat_e = eidx.reshape(-1)
    flat_tok = jnp.repeat(jnp.arange(n, dtype=jnp.int32), TOP_K)
    flat_w = wts.reshape(-1)
    order = jnp.argsort(flat_e)
    sorted_e = flat_e[order]
    counts = jnp.bincount(flat_e, length=N_EXPERTS)
    padded = (counts + MOE_BLOCK - 1) // MOE_BLOCK * MOE_BLOCK
    pad_end = jnp.cumsum(padded)
    pad_start = pad_end - padded
    start = jnp.cumsum(counts) - counts
    dest = pad_start[sorted_e] + jnp.arange(nk) - start[sorted_e]
    n_blocks = (nk + N_EXPERTS * (MOE_BLOCK - 1) + MOE_BLOCK - 1) // MOE_BLOCK
    n_rows = n_blocks * MOE_BLOCK
    tok_buf = jnp.full((n_rows,), n, jnp.int32).at[dest].set(flat_tok[order])
    gate_buf = jnp.zeros((n_rows,), h.dtype).at[dest].set(flat_w[order])
    block_e = jnp.minimum(jnp.searchsorted(pad_end, jnp.arange(n_blocks) * MOE_BLOCK, side='right'), N_EXPERTS - 1)
    hp = jnp.concatenate([h, jnp.zeros((1, d), h.dtype)], axis=0)

    def expert_block(args):
        ids, e = args
        xb = hp[ids]
        return (jax.nn.silu(xb @ w_eg[e]) * (xb @ w_eu[e])) @ w_ed[e]

    y = lax.map(expert_block, (tok_buf.reshape(n_blocks, MOE_BLOCK), block_e)).reshape(n_rows, d)
    return jax.ops.segment_sum(y * gate_buf[:, None], tok_buf, num_segments=n + 1)[:n]


def _moe(h, w_router, router_bias, w_eg, w_eu, w_ed, w_sg, w_su, w_sd):
    n, _ = h.shape
    scores = jax.nn.sigmoid((h @ w_router).astype(jnp.float32))
    sel = scores + router_bias.astype(jnp.float32)
    grp = sel.reshape(n, N_GROUPS, N_EXPERTS // N_GROUPS)
    grp_score = jnp.sum(lax.top_k(grp, 2)[0], axis=-1)
    _, gidx = lax.top_k(grp_score, TOPK_GROUPS)
    gmask = jnp.sum(jax.nn.one_hot(gidx, N_GROUPS, dtype=jnp.float32), axis=-2) > 0
    emask = jnp.repeat(gmask, N_EXPERTS // N_GROUPS, axis=-1)
    _, eidx = lax.top_k(jnp.where(emask, sel, -jnp.inf), TOP_K)
    wts = jnp.take_along_axis(scores, eidx, axis=-1)
    wts = wts / jnp.sum(wts, axis=-1, keepdims=True) * ROUTED_SCALE
    routed = _routed_experts(h, eidx, wts.astype(h.dtype), w_eg, w_eu, w_ed)
    return routed + _swiglu(h, w_sg, w_su, w_sd)


def setup_inputs(seed: int = 0) -> dict:
    key = jax.random.key(seed)
    ks = jax.random.split(key, 26)
    f32 = jnp.float32
    D = D_MODEL

    def nrm(k, shape, s):
        return jax.random.normal(k, shape, f32) * s

    return {
        'x': nrm(ks[0], (BATCH, SEQ, D), 1.0),
        'c': nrm(ks[1], (BATCH, D), 1.0),
        'ctx': nrm(ks[2], (BATCH, CTX_LEN, D), 1.0),
        'c_ctx': nrm(ks[3], (D,), 1.0),
        'w_ada': nrm(ks[4], (DEPTH, D, 6 * D), 0.5 * D ** -0.5),
        'b_ada': nrm(ks[5], (DEPTH, 6 * D), 0.02),
        'w_in': nrm(ks[6], (DEPTH, D, PROJ_W), D ** -0.5),
        'na_rpb': nrm(ks[7], (DEPTH, NA_HEADS, 2 * NA_KH - 1, 2 * NA_KW - 1), 0.1),
        'conv_w': nrm(ks[8], (DEPTH, SC_KSIZE, SC_W), SC_KSIZE ** -0.5),
        'gla_w2': nrm(ks[9], (DEPTH, 2, GLA_RANK, GLA_HEADS * GLA_DK), GLA_RANK ** -0.5),
        'gla_b': nrm(ks[10], (DEPTH, 2, GLA_HEADS * GLA_DK), 0.1),
        'gla_norm_g': 1.0 + nrm(ks[11], (DEPTH, GLA_DV), 0.01),
        'swa_sink': nrm(ks[12], (DEPTH, SWA_HEADS), 0.5),
        'w_out': nrm(ks[13], (DEPTH, D, D), DN_BETA * D ** -0.5),
        'ln1_g': 1.0 + nrm(ks[14], (DEPTH, D), 0.01),
        'ln1_b': nrm(ks[15], (DEPTH, D), 0.01),
        'w_router': nrm(ks[16], (DEPTH, D, N_EXPERTS), D ** -0.5),
        'router_bias': nrm(ks[17], (DEPTH, N_EXPERTS), 0.01),
        'w_exp_gate': nrm(ks[18], (DEPTH, N_EXPERTS, D, D_EXPERT), D ** -0.5),
        'w_exp_up': nrm(ks[19], (DEPTH, N_EXPERTS, D, D_EXPERT), D ** -0.5),
        'w_exp_down': nrm(ks[20], (DEPTH, N_EXPERTS, D_EXPERT, D), DN_BETA * D_EXPERT ** -0.5),
        'w_sh_gate': nrm(ks[21], (DEPTH, D, D_SHARED), D ** -0.5),
        'w_sh_up': nrm(ks[22], (DEPTH, D, D_SHARED), D ** -0.5),
        'w_sh_down': nrm(ks[23], (DEPTH, D_SHARED, D), DN_BETA * D_SHARED ** -0.5),
        'ln2_g': 1.0 + nrm(ks[24], (DEPTH, D), 0.01),
        'ln2_b': nrm(ks[25], (DEPTH, D), 0.01),
    }


def reference(x, c, ctx, c_ctx, w_ada, b_ada, w_in, na_rpb, conv_w, gla_w2, gla_b, gla_norm_g, swa_sink, w_out,
              ln1_g, ln1_b, w_router, router_bias, w_exp_gate, w_exp_up, w_exp_down, w_sh_gate, w_sh_up, w_sh_down,
              ln2_g, ln2_b):
    bsz, seq, d = x.shape
    h_ctx = ctx
    for layer in range(DEPTH):
        last = layer == DEPTH - 1
        mod = jax.nn.silu(c) @ w_ada[layer] + b_ada[layer]
        mod_c = jax.nn.silu(c_ctx) @ w_ada[layer] + b_ada[layer]
        sh1, sc1, g1, sh2, sc2, g2 = [t[:, None, :] for t in jnp.split(mod, 6, axis=-1)]
        sh1c, sc1c, g1c, sh2c, sc2c, g2c = jnp.split(mod_c, 6, axis=-1)
        p_lat = _modulate(x, sh1, sc1) @ w_in[layer]
        p_ctx = _modulate(h_ctx, sh1c, sc1c) @ w_in[layer]
        y_lat, y_ctx = _token_mixers(p_lat, p_ctx, na_rpb[layer], conv_w[layer], gla_w2[layer], gla_b[layer],
                                     gla_norm_g[layer], swa_sink[layer], not last)
        x = _layer_norm(DN_ALPHA * x + g1 * (y_lat @ w_out[layer]), ln1_g[layer], ln1_b[layer])
        moe_w = (w_router[layer], router_bias[layer], w_exp_gate[layer], w_exp_up[layer], w_exp_down[layer],
                 w_sh_gate[layer], w_sh_up[layer], w_sh_down[layer])
        f_in = _modulate(x, sh2, sc2).reshape(-1, d)
        if last:
            f_lat = _moe(f_in, *moe_w).reshape(bsz, seq, d)
        else:
            h_ctx = _layer_norm(DN_ALPHA * h_ctx + g1c * (y_ctx @ w_out[layer]), ln1_g[layer], ln1_b[layer])
            n_ctx = bsz * h_ctx.shape[1]
            fc_in = _modulate(h_ctx, sh2c, sc2c).reshape(-1, d)
            f_all = _moe(jnp.concatenate([fc_in, f_in], axis=0), *moe_w)
            h_ctx = _layer_norm(DN_ALPHA * h_ctx + g2c * f_all[:n_ctx].reshape(h_ctx.shape), ln2_g[layer], ln2_b[layer])
            f_lat = f_all[n_ctx:].reshape(bsz, seq, d)
        x = _layer_norm(DN_ALPHA * x + g2 * f_lat, ln2_g[layer], ln2_b[layer])
    return x
```

```cpp
#include <hip/hip_runtime.h>
#include <cstdio>

#define DI __device__ __forceinline__
#define LAS __attribute__((address_space(3)))
#if defined(__HIP_DEVICE_COMPILE__)
#define GAS __attribute__((address_space(1)))
#else
#define GAS
#endif
typedef unsigned short bf16;
typedef short bf16x8 __attribute__((ext_vector_type(8)));
typedef short s16x4 __attribute__((ext_vector_type(4)));
typedef float f32x2 __attribute__((ext_vector_type(2)));
typedef float f32x4 __attribute__((ext_vector_type(4)));
typedef float f32x8 __attribute__((ext_vector_type(8)));
typedef float f32x16 __attribute__((ext_vector_type(16)));
typedef unsigned u32x2 __attribute__((ext_vector_type(2)));
typedef unsigned u32x4 __attribute__((ext_vector_type(4)));
typedef __bf16 hbf16x2 __attribute__((ext_vector_type(2)));

constexpr int D = 2048, SEQ = 8192, CTXL = 256, NB = 2;
constexpr int NLAT = NB * SEQ, NCTX = NB * CTXL, NTOK = NLAT + NCTX;
constexpr int PW = 5408, PWP = 5632;
constexpr int NA_Q = 0, NA_K = 512, NA_V = 1024, SC_U = 1536, SC_B = 2048, SC_C = 2560, GL_Q = 3072, GL_K = 3328, GL_V = 3584, GL_G = 4096, GL_Z = 4608, SW_Q = 4640, SW_K = 5152, SW_V = 5280;
constexpr int NEXP = 64, DEXP = 512, NCH = 264;
constexpr int MAXTILES = 658;
constexpr float LN_EPS = 1e-6f, DN_ALPHA = 1.41421356237f;

constexpr size_t MiB = 1u << 20;
constexpr size_t WS_CTL = 0, CTL_BYTES = MiB;
constexpr size_t WS_MOD = 1 * MiB, WS_ROPE = 1 * MiB + 512 * 1024, WS_STATS = 2 * MiB, WS_ROUTW = 3 * MiB, WS_EIDX = 4 * MiB, WS_RANK = 5 * MiB, WS_WTS = 6 * MiB, WS_POS = 7 * MiB,
                 WS_TOKS = 8 * MiB, WS_TILEE = 9 * MiB, WS_GDEC = 10 * MiB, WS_HCTX = 12 * MiB, WS_WIN = 16 * MiB, WS_WOUT = 38 * MiB, WS_WGU = 46 * MiB, WS_WD = 306 * MiB,
                 WS_X1 = 436 * MiB, WS_XN = 568 * MiB, WS_YMIX = 634 * MiB, WS_H = 700 * MiB, WS_UT = WS_H, WS_SIN = WS_H + 66 * MiB, WS_Y = 865 * MiB, WS_P = WS_Y, WS_T = WS_Y + 192 * MiB,
                 WS_END = 1523 * MiB;
constexpr int CW_CNT = 1024, CW_NT = 2048, CW_BAR = 4096;

DI float bf2f(unsigned v) { return __uint_as_float(v << 16); }
DI unsigned pk2(float a, float b) { hbf16x2 v = __builtin_convertvector((f32x2){a, b}, hbf16x2); return __builtin_bit_cast(unsigned, v); }
DI bf16 f2bf(float a) { return (bf16)(pk2(a, 0.f) & 0xffffu); }
DI float lo16(unsigned u) { return __uint_as_float(u << 16); }
DI float hi16(unsigned u) { return __uint_as_float(u & 0xffff0000u); }
DI bf16x8 pack8(float a0, float a1, float a2, float a3, float a4, float a5, float a6, float a7) {
    u32x4 p; p.x = pk2(a0, a1); p.y = pk2(a2, a3); p.z = pk2(a4, a5); p.w = pk2(a6, a7); return __builtin_bit_cast(bf16x8, p); }
DI void unpack8(bf16x8 v, float (&f)[8]) { u32x4 p = __builtin_bit_cast(u32x4, v); f[0] = lo16(p.x); f[1] = hi16(p.x); f[2] = lo16(p.y); f[3] = hi16(p.y); f[4] = lo16(p.z); f[5] = hi16(p.z); f[6] = lo16(p.w); f[7] = hi16(p.w); }
DI float wave_sum(float v) {
#pragma unroll
    for (int o = 1; o < 64; o <<= 1) v += __shfl_xor(v, o);
    return v; }
DI int crow(int reg, int h) { return (reg & 3) + 8 * (reg >> 2) + 4 * h; }
#define MFMA32(a, b, c) __builtin_amdgcn_mfma_f32_32x32x16_bf16((a), (b), (c), 0, 0, 0)
#define MFMA16(a, b, c) __builtin_amdgcn_mfma_f32_16x16x32_bf16((a), (b), (c), 0, 0, 0)
DI s16x4 tr_read(LAS unsigned char* p) { return __builtin_amdgcn_ds_read_tr16_b64_v4i16((LAS s16x4*)p); }
DI bf16x8 cat4(s16x4 lo, s16x4 hi) { return __builtin_shufflevector(lo, hi, 0, 1, 2, 3, 4, 5, 6, 7); }
DI f32x16 zero16() { f32x16 z;
#pragma unroll
    for (int i = 0; i < 16; ++i) z[i] = 0.f; return z; }
#define XB_TMO      128
#define XB_XCNT(j)  (256  + 64 * (j))
#define XB_XSUB(j)  (1280 + 64 * (j))
#define XB_XGEN(j)  (2304 + 64 * (j))
#define XB_TOP      3328
#define XB_TOPGEN   3392
#define XCD_BAR_WORDS 3456
#define XB_SPIN_CAP (1u << 18)

__device__ __forceinline__ unsigned xb_ld(unsigned* p)              { return __hip_atomic_load(p, __ATOMIC_RELAXED, __HIP_MEMORY_SCOPE_AGENT); }
__device__ __forceinline__ unsigned xb_add(unsigned* p, unsigned v) { return __hip_atomic_fetch_add(p, v, __ATOMIC_RELAXED, __HIP_MEMORY_SCOPE_AGENT); }
__device__ __forceinline__ unsigned xb_xcc_id() { return (unsigned)__builtin_amdgcn_s_getreg((3 << 11) | 20) & 0xFu; }
#define XB_SPIN(cond, bar) do { unsigned _sp = 0; while (cond) { __builtin_amdgcn_s_sleep(1); \
    if ((++_sp & 255u) == 0u) { if (xb_ld(&(bar)[XB_TMO])) break; if (_sp > XB_SPIN_CAP) { atomicAdd(&(bar)[XB_TMO], 1u); break; } } } } while (0)

struct XcdBarrier { unsigned* bar; unsigned x; volatile LAS unsigned* st; };

__device__ __forceinline__ XcdBarrier xcd_barrier_post(unsigned* bar, volatile LAS unsigned* st) {
    XcdBarrier b; b.bar = bar; b.x = xb_xcc_id(); b.st = st;
    if (threadIdx.x == 0) (void)xb_add(&bar[XB_XCNT(b.x)], 1u);
    return b;
}
__device__ __forceinline__ void xcd_barrier_complete(unsigned* bar, unsigned x, unsigned& nloc, unsigned& nx) {
    const unsigned G = gridDim.x * gridDim.y * gridDim.z;
    unsigned sum, cnt, mine, sp = 0u;
    for (;;) {
        sum = 0u; cnt = 0u; mine = 0u;
#pragma unroll
        for (unsigned j = 0; j < 16; ++j) { const unsigned c = xb_ld(&bar[XB_XCNT(j)]); sum += c; cnt += (c > 0u) ? 1u : 0u; mine = (j == x) ? c : mine; }
        if (sum == G) break;
        __builtin_amdgcn_s_sleep(1);
        if ((++sp & 255u) == 0u) { if (xb_ld(&bar[XB_TMO])) break; if (sp > XB_SPIN_CAP) { atomicAdd(&bar[XB_TMO], 1u); break; } }
    }
    nloc = mine > 0u ? mine : 1u; nx = cnt > 0u ? cnt : 1u;
}
__device__ __forceinline__ void xcd_barrier(const XcdBarrier& b) {
    asm volatile("s_waitcnt vmcnt(0)" ::: "memory");
    __syncthreads();
    if (threadIdx.x == 0) {
        unsigned* bar = b.bar;
        __builtin_amdgcn_s_waitcnt(0);
        unsigned nloc = b.st[0], nx = b.st[1];
        if (nloc == 0u) { xcd_barrier_complete(bar, b.x, nloc, nx); b.st[0] = nloc; b.st[1] = nx; }
        const unsigned old = xb_add(&bar[XB_XSUB(b.x)], 1u);
        const unsigned gen = old / nloc;
        if (old + 1u == (gen + 1u) * nloc) {
            __builtin_amdgcn_fence(__ATOMIC_RELEASE, "agent");
            asm volatile("s_waitcnt vmcnt(0)" ::: "memory");
            const unsigned og = xb_add(&bar[XB_TOP], 1u);
            const unsigned tg = og / nx;
            if (og + 1u == (tg + 1u) * nx) xb_add(&bar[XB_TOPGEN], 1u);
            else XB_SPIN(xb_ld(&bar[XB_TOPGEN]) == tg, bar);
            __builtin_amdgcn_fence(__ATOMIC_ACQUIRE, "agent");
            xb_add(&bar[XB_XGEN(b.x)], 1u);
            asm volatile("s_waitcnt vmcnt(0)" ::: "memory");
        } else {
            XB_SPIN(xb_ld(&bar[XB_XGEN(b.x)]) == gen, bar);
            __builtin_amdgcn_fence(__ATOMIC_ACQUIRE, "agent");
            asm volatile("s_waitcnt vmcnt(0)" ::: "memory");
        }
    }
    __syncthreads();
}

namespace pg8 {
constexpr int BM = 256, BK = 64, HALF = 128, HTB = HALF * BK * 2, STAGE_BYTES = 8 * HTB, NXCD = 8, WGM = 8;
__host__ __device__ __forceinline__ int lds_byte(int r, int c) { const int st = (r >> 4) * 2 + (c >> 5), rr = r & 15, cc = c & 31, ob = rr * 64 + cc * 2; return st * 1024 + (ob ^ (((ob >> 9) & 1) << 5)); }
__host__ __device__ __forceinline__ void stage_rc(int b, int& R, int& C) { const int st = b / 1024, sb = b % 1024, swz = sb ^ (((sb >> 9) & 1) << 5); R = (st >> 1) * 16 + swz / 64; C = (st & 1) * 32 + (swz % 64) / 2; }
__host__ __device__ __forceinline__ int perm32(int rho) { const int n = rho >> 4, i = rho & 15; return 8 * (i >> 2) + 4 * n + (i & 3); }

struct Unit { int pm, pn, pc; };
struct Gemm { const bf16* A; const bf16* Bt; int K; };

struct StaticOrder {
    int nM, nN, nwg, G, c;
    __device__ void init(int M, int N, int G_, int c_) { nM = M / BM; nN = N / BM; nwg = nM * nN; G = G_; c = c_; }
    __device__ bool next(int i, Unit& u) const {
        const long L = (long)i * G + c; if (L >= nwg) return false;
        int wgid = (int)L; { const int q = nwg / NXCD, r = nwg % NXCD, xcd = wgid % NXCD, off = wgid / NXCD; wgid = (xcd < r ? xcd * (q + 1) : r * (q + 1) + (xcd - r) * q) + off; }
        const int nig = WGM * nN, gid = wgid / nig, fm = gid * WGM, gsz = (nM - fm) < WGM ? (nM - fm) : WGM;
        u.pm = fm + ((wgid % nig) % gsz); u.pn = (wgid % nig) / gsz; u.pc = u.pn; return true;
    }
};
struct GroupOrder {
    const int* tile_e; int ntiles, nN, G, c;
    __device__ bool next(int i, Unit& u) const {
        const long L = (long)i * G + c; if (L >= (long)ntiles * nN) return false;
        const int tile = (int)(L / nN), j = (int)(L % nN);
        u.pm = tile; u.pc = j; u.pn = tile_e[tile] * nN + j; return true;
    }
};

struct EpiBf16 {
    bf16* O; int ldc;
    __device__ __forceinline__ void operator()(const f32x4 (&acc)[2][2][4][2], const Unit& u, int wr, int wc, int fr, int fq) const {
        const int row0 = u.pm * BM + wr * 64 + fr, col0 = u.pc * BM + wc * 32 + 8 * fq;
#pragma unroll
        for (int ai = 0; ai < 2; ++ai)
#pragma unroll
            for (int m = 0; m < 4; ++m) { bf16* rowp = O + (size_t)(row0 + ai * HALF + m * 16) * ldc + col0;
#pragma unroll
                for (int bj = 0; bj < 2; ++bj) { const f32x4 v0 = acc[ai][bj][m][0], v1 = acc[ai][bj][m][1];
                    u32x4 w; w.x = pk2(v0[0], v0[1]); w.y = pk2(v0[2], v0[3]); w.z = pk2(v1[0], v1[1]); w.w = pk2(v1[2], v1[3]);
                    *(u32x4*)(rowp + bj * HALF) = w; } }
    }
};
struct EpiSwiglu {
    bf16* O;
    __device__ __forceinline__ void operator()(const f32x4 (&acc)[2][2][4][2], const Unit& u, int wr, int wc, int fr, int fq) const {
        const int row0 = u.pm * BM + wr * 64 + fr, col0 = u.pc * HALF + wc * 32 + 8 * fq;
#pragma unroll
        for (int ai = 0; ai < 2; ++ai)
#pragma unroll
            for (int m = 0; m < 4; ++m) { bf16* rowp = O + (size_t)(row0 + ai * HALF + m * 16) * DEXP + col0;
                float h[8];
#pragma unroll
                for (int n = 0; n < 2; ++n)
#pragma unroll
                    for (int j = 0; j < 4; ++j) { const float g = acc[ai][0][m][n][j], up = acc[ai][1][m][n][j]; h[n * 4 + j] = g / (1.f + __expf(-g)) * up; }
                u32x4 w; w.x = pk2(h[0], h[1]); w.y = pk2(h[2], h[3]); w.z = pk2(h[4], h[5]); w.w = pk2(h[6], h[7]);
                *(u32x4*)rowp = w; }
    }
};

template <class Epi, class Sched, bool GATHER>
__device__ __forceinline__ void gemm_phase(LAS unsigned char* lds, const Gemm g, const Sched& S, const Epi& E, const int* toks) {
    int tid_ = threadIdx.x; asm volatile("" : "+v"(tid_));
    const int tid = tid_, wid = __builtin_amdgcn_readfirstlane(tid >> 6), lane = tid & 63, wr = wid >> 2, wc = wid & 3, fr = lane & 15, fq = lane >> 4;
    const int K = g.K, nt = K / BK;
    int RA[2], CA[2]; unsigned voffA[2], voffB[2];
#pragma unroll
    for (int i = 0; i < 2; ++i) { int R, C; stage_rc(tid * 16 + i * 8192, R, C); const int Rb = (R & ~31) + perm32(R & 31); RA[i] = R; CA[i] = C; voffA[i] = (unsigned)(R * K + C) * 2u; voffB[i] = (unsigned)(Rb * K + C) * 2u; }
    const size_t kstep = (size_t)(BK * 2);
    const size_t hstep = (size_t)HALF * K * 2;
    const size_t tstep = 2 * hstep;
    const unsigned ldsw = (unsigned)wid * 1024u;
    const int aoff = lds_byte(wr * 64 + fr, fq * 8), boff = lds_byte(wc * 32 + fr, fq * 8);
#define PG8_SA(b, h) (((b) * 2 + (h)) * HTB)
#define PG8_SB(b, h) ((4 + (b) * 2 + (h)) * HTB)
#define PG8_STAGE(bufoff, gbase, voff) do { _Pragma("unroll") for (int _i = 0; _i < 2; ++_i) \
        __builtin_amdgcn_global_load_lds((const unsigned*)((const char*)(gbase) + (voff)[_i]), (LAS unsigned*)(lds + (bufoff) + ldsw + _i * 8192), 16, 0, 0); } while (0)
#define PG8_STAGEA(bufoff, kb, vo, ub, h) do { _Pragma("unroll") for (int _i = 0; _i < 2; ++_i) \
        __builtin_amdgcn_global_load_lds((const unsigned*)(GATHER ? (const char*)g.A + (kb) + (vo)[h][_i] : (ub) + (kb) + (h) * hstep + voffA[_i]), (LAS unsigned*)(lds + (bufoff) + ldsw + _i * 8192), 16, 0, 0); } while (0)
#define PG8_LDA(dst, b, h) do { _Pragma("unroll") for (int m = 0; m < 4; ++m) _Pragma("unroll") for (int k = 0; k < 2; ++k) dst[m][k] = *(const LAS bf16x8*)(lds + PG8_SA(b, h) + aoff + m * 2048 + k * 1024); } while (0)
#define PG8_LDB(dst, b, h) do { _Pragma("unroll") for (int n = 0; n < 2; ++n) _Pragma("unroll") for (int k = 0; k < 2; ++k) dst[n][k] = *(const LAS bf16x8*)(lds + PG8_SB(b, h) + boff + n * 2048 + k * 1024); } while (0)
#define PG8_MMA(ai, bj, At, Bt) do { __builtin_amdgcn_s_setprio(1); _Pragma("unroll") for (int m = 0; m < 4; ++m) _Pragma("unroll") for (int n = 0; n < 2; ++n) _Pragma("unroll") for (int k = 0; k < 2; ++k) \
        acc[ai][bj][m][n] = __builtin_amdgcn_mfma_f32_16x16x32_bf16(Bt[n][k], At[m][k], acc[ai][bj][m][n], 0, 0, 0); __builtin_amdgcn_s_setprio(0); } while (0)
#define PG8_WAIT_V(n) asm volatile("s_waitcnt vmcnt(" #n ")" ::: "memory")
#define PG8_WAIT_L(n) asm volatile("s_waitcnt lgkmcnt(" #n ")" ::: "memory")
#define PG8_BAR __builtin_amdgcn_s_barrier()
#define PG8_SCHED __builtin_amdgcn_sched_barrier(0)
#define PG8_VOA(dst, un) do { if (GATHER) { _Pragma("unroll") for (int _h = 0; _h < 2; ++_h) _Pragma("unroll") for (int _i = 0; _i < 2; ++_i) { \
        const int _lr = (un).pm * BM + _h * HALF + RA[_i]; const int _row = toks[_lr]; dst[_h][_i] = (unsigned)(_row * K + CA[_i]) * 2u; } \
        asm volatile("" : "+v"(dst[0][0]), "+v"(dst[0][1]), "+v"(dst[1][0]), "+v"(dst[1][1])); } } while (0)
    Unit cur, nxt; int ui = 0;
    if (!S.next(0, cur)) return;
    f32x4 acc[2][2][4][2];
#pragma unroll
    for (int a = 0; a < 2; ++a)
#pragma unroll
        for (int b = 0; b < 2; ++b)
#pragma unroll
            for (int m = 0; m < 4; ++m)
#pragma unroll
                for (int n = 0; n < 2; ++n) acc[a][b][m][n] = (f32x4){0.f, 0.f, 0.f, 0.f};
    bf16x8 At[4][2], B0[2][2], B1[2][2];
    unsigned voA[2][2] = {{0u, 0u}, {0u, 0u}}, voN[2][2] = {{0u, 0u}, {0u, 0u}};
    PG8_VOA(voA, cur);
    const char* cA = (const char*)g.A + (size_t)cur.pm * tstep;
    const char* cB = (const char*)g.Bt + (size_t)cur.pn * tstep;
    PG8_STAGE(PG8_SB(0, 0), cB, voffB); PG8_STAGEA(PG8_SA(0, 0), 0, voA, cA, 0); PG8_STAGE(PG8_SB(0, 1), cB + hstep, voffB); PG8_STAGEA(PG8_SA(0, 1), 0, voA, cA, 1);
    if (wr == 1) PG8_BAR;
    PG8_WAIT_V(4); PG8_BAR;
    PG8_STAGE(PG8_SB(1, 0), cB + kstep, voffB); PG8_STAGEA(PG8_SA(1, 0), kstep, voA, cA, 0); PG8_STAGE(PG8_SB(1, 1), cB + hstep + kstep, voffB);
    PG8_WAIT_V(6); PG8_BAR;
    for (;;) {
        const bool has_next = S.next(ui + 1, nxt);
        if (has_next) { PG8_VOA(voN, nxt); }
        else if (GATHER) {
#pragma unroll
            for (int _h = 0; _h < 2; ++_h)
#pragma unroll
                for (int _i = 0; _i < 2; ++_i) voN[_h][_i] = voA[_h][_i]; }
        const char* nA = has_next ? (const char*)g.A + (size_t)nxt.pm * tstep : cA;
        const char* nB = has_next ? (const char*)g.Bt + (size_t)nxt.pn * tstep : cB;
        for (int t = 0; t < nt; t += 2) {
            const bool last = (t == nt - 2);
            const size_t k1 = (size_t)(t + 1) * kstep;
            const size_t k2 = last ? 0 : (size_t)(t + 2) * kstep, k3 = k2 + kstep;
            const char* b2 = last ? nB : cB + (size_t)(t + 2) * kstep; const char* b3 = b2 + kstep;
            unsigned vo2[2][2] = {{0u, 0u}, {0u, 0u}};
            if (GATHER) {
#pragma unroll
                for (int _h = 0; _h < 2; ++_h)
#pragma unroll
                    for (int _i = 0; _i < 2; ++_i) vo2[_h][_i] = last ? voN[_h][_i] : voA[_h][_i]; }
            const char* a2 = last ? nA : cA;
            PG8_LDB(B0, 0, 0); PG8_SCHED; PG8_LDA(At, 0, 0); PG8_STAGEA(PG8_SA(1, 1), k1, voA, cA, 1);
            PG8_WAIT_L(8); PG8_BAR; PG8_WAIT_L(0); PG8_MMA(0, 0, At, B0); PG8_BAR; PG8_SCHED;
            PG8_LDB(B1, 0, 1); PG8_STAGE(PG8_SB(0, 0), b2, voffB);
            PG8_BAR; PG8_WAIT_L(0); PG8_MMA(0, 1, At, B1); PG8_BAR;
            PG8_LDA(At, 0, 1); PG8_STAGEA(PG8_SA(0, 0), k2, vo2, a2, 0);
            PG8_BAR; PG8_WAIT_L(0); PG8_MMA(1, 0, At, B0); PG8_BAR; PG8_SCHED;
            PG8_STAGE(PG8_SB(0, 1), b2 + hstep, voffB);
            PG8_WAIT_V(6); PG8_BAR; PG8_MMA(1, 1, At, B1); PG8_BAR;
            PG8_LDB(B0, 1, 0); PG8_SCHED; PG8_LDA(At, 1, 0); PG8_STAGEA(PG8_SA(0, 1), k2, vo2, a2, 1);
            PG8_WAIT_L(8); PG8_BAR; PG8_WAIT_L(0); PG8_MMA(0, 0, At, B0); PG8_BAR; PG8_SCHED;
            PG8_LDB(B1, 1, 1); PG8_STAGE(PG8_SB(1, 0), b3, voffB);
            PG8_BAR; PG8_WAIT_L(0); PG8_MMA(0, 1, At, B1); PG8_BAR;
            PG8_LDA(At, 1, 1); PG8_STAGEA(PG8_SA(1, 0), k3, vo2, a2, 0);
            PG8_BAR; PG8_WAIT_L(0); PG8_MMA(1, 0, At, B0); PG8_BAR; PG8_SCHED;
            PG8_STAGE(PG8_SB(1, 1), b3 + hstep, voffB);
            PG8_WAIT_V(6); PG8_BAR; PG8_MMA(1, 1, At, B1); PG8_BAR;
        }
        E(acc, cur, wr, wc, fr, fq);
        if (!has_next) break;
#pragma unroll
        for (int a = 0; a < 2; ++a)
#pragma unroll
            for (int b = 0; b < 2; ++b)
#pragma unroll
                for (int m = 0; m < 4; ++m)
#pragma unroll
                    for (int n = 0; n < 2; ++n) acc[a][b][m][n] = (f32x4){0.f, 0.f, 0.f, 0.f};
        cur = nxt; cA = nA; cB = nB; ++ui;
        if (GATHER) {
#pragma unroll
            for (int _h = 0; _h < 2; ++_h)
#pragma unroll
                for (int _i = 0; _i < 2; ++_i) voA[_h][_i] = voN[_h][_i]; }
    }
    PG8_WAIT_V(0);
    if (wr == 0) PG8_BAR;
    PG8_BAR;
#undef PG8_SA
#undef PG8_SB
#undef PG8_STAGE
#undef PG8_STAGEA
#undef PG8_LDA
#undef PG8_LDB
#undef PG8_MMA
#undef PG8_WAIT_V
#undef PG8_WAIT_L
#undef PG8_BAR
#undef PG8_SCHED
#undef PG8_VOA
}
}
struct Params {
    const GAS float* in[26];
    GAS float* out;
    GAS unsigned char* ws;
    int ph_lo, ph_hi;
};
typedef const Params __attribute__((address_space(4))) CParams;
constexpr int NPH = 13;
constexpr int WAVE_LDS = 18432;
constexpr int LDS_MISC = 8 * WAVE_LDS;
constexpr int LDS_BYTES = LDS_MISC + 1024;

struct Ctx {
    LAS unsigned char* lds; int tid, lane, wave, gw, ngw, L;
    CParams* p;
    unsigned char* ws;
};
DI unsigned char* fresh(GAS unsigned char* q) { asm volatile("" : "+s"(q)); return (unsigned char*)q; }
#define inp(c, k) ((const float*)(c).p->in[k])
#define outp(c) ((float*)(c).p->out)

DI void transpose_item(const float* W, int K, int N, bf16* WT, int drow0, LAS float* scr, int kb, int nb, int lane, bool lo_part) {
    const int k0 = 64 * kb, n0 = 32 * nb;
#pragma unroll 8
    for (int i = 0; i < 32; ++i) { const int kk = 2 * i + (lane >> 5); scr[kk * 33 + (lane & 31)] = W[(size_t)(k0 + kk) * N + n0 + (lane & 31)]; }
    asm volatile("s_waitcnt lgkmcnt(0)" ::: "memory");
    const int c = lane & 7;
#pragma unroll
    for (int j = 0; j < 4; ++j) { const int n = (lane >> 3) + 8 * j; const LAS float* s = scr + (8 * c) * 33 + n;
        float v[8];
#pragma unroll
        for (int q = 0; q < 8; ++q) { v[q] = s[q * 33]; if (lo_part) v[q] = v[q] - bf2f(f2bf(v[q])); }
        u32x4 o; o.x = pk2(v[0], v[1]); o.y = pk2(v[2], v[3]); o.z = pk2(v[4], v[5]); o.w = pk2(v[6], v[7]);
        *(u32x4*)(WT + (size_t)(drow0 + n) * K + k0 + 8 * c) = o; }
    asm volatile("s_waitcnt lgkmcnt(0)" ::: "memory");
}

DI void phase0(const Ctx& c) {
    const int L = c.L;
    unsigned char* ws = c.ws;
    {
        LAS float* sc = (LAS float*)c.lds;
        LAS float* part = (LAS float*)(c.lds + 32768);
        for (int i = c.tid; i < 3 * D; i += 512) { const int r = i / D, k = i % D; const float v = r < 2 ? inp(c, 1)[r * D + k] : inp(c, 3)[k]; sc[i] = v / (1.f + __expf(-v)); }
        __syncthreads();
        const float* wa = inp(c, 4) + (size_t)L * D * 6 * D; const float* ba = inp(c, 5) + (size_t)L * 6 * D;
        float* mod = (float*)(ws + WS_MOD);
        for (int cb = blockIdx.x; cb < 256; cb += gridDim.x) {
            const int n0 = cb * 48;
            float a0 = 0.f, a1 = 0.f, a2 = 0.f;
            if (c.lane < 48) {
                const float* wp = wa + (size_t)(c.wave * 256) * (6 * D) + n0 + c.lane;
#pragma unroll 8
                for (int k = 0; k < 256; ++k) { const float w = wp[(size_t)k * (6 * D)]; const int kk = c.wave * 256 + k; a0 += sc[kk] * w; a1 += sc[D + kk] * w; a2 += sc[2 * D + kk] * w; }
                part[(c.wave * 3 + 0) * 48 + c.lane] = a0; part[(c.wave * 3 + 1) * 48 + c.lane] = a1; part[(c.wave * 3 + 2) * 48 + c.lane] = a2;
            }
            __syncthreads();
            if (c.tid < 144) { const int r = c.tid / 48, j = c.tid % 48; float s = 0.f;
#pragma unroll
                for (int w = 0; w < 8; ++w) s += part[(w * 3 + r) * 48 + j];
                mod[r * 6 * D + n0 + j] = s + ba[n0 + j]; }
            __syncthreads();
        }
    }
    {
        LAS float* scr = (LAS float*)(c.lds + c.wave * WAVE_LDS);
        constexpr int I_IN = 32 * (PW / 32), I_OUT = 32 * 64, I_E = 1536, I_R = 64;
        constexpr int NIT = I_IN + I_OUT + 65 * I_E + 2 * I_R;
        bf16* win = (bf16*)(ws + WS_WIN); bf16* wout = (bf16*)(ws + WS_WOUT); bf16* wgu = (bf16*)(ws + WS_WGU); bf16* wd = (bf16*)(ws + WS_WD); bf16* rw = (bf16*)(ws + WS_ROUTW);
        for (int it = c.gw; it < NIT; it += c.ngw) {
            int r = it;
            if (r < I_IN) { const int nblk = PW / 32; transpose_item(inp(c, 6) + (size_t)L * D * PW, D, PW, win, 32 * (r % nblk), scr, r / nblk, r % nblk, c.lane, false); continue; } r -= I_IN;
            if (r < I_OUT) { transpose_item(inp(c, 13) + (size_t)L * D * D, D, D, wout, 32 * (r % 64), scr, r / 64, r % 64, c.lane, false); continue; } r -= I_OUT;
            if (r < 65 * I_E) {
                const int e = r / I_E, q = r % I_E, which = q / 512, idx = q % 512;
                if (which < 2) {
                    const float* W = e < 64 ? inp(c, which == 0 ? 18 : 19) + ((size_t)(L * 64 + e)) * D * DEXP : inp(c, which == 0 ? 21 : 22) + (size_t)L * D * DEXP;
                    const int kb = idx / 16, nb = idx % 16, n0 = 32 * nb;
                    transpose_item(W, D, DEXP, wgu, e * 1024 + (n0 / 128) * 256 + which * 128 + (n0 % 128), scr, kb, nb, c.lane, false);
                } else {
                    const float* W = e < 64 ? inp(c, 20) + ((size_t)(L * 64 + e)) * DEXP * D : inp(c, 23) + (size_t)L * DEXP * D;
                    const int kb = idx / 64, nb = idx % 64;
                    transpose_item(W, DEXP, D, wd, e * 2048 + 32 * nb, scr, kb, nb, c.lane, false);
                }
                continue; }
            r -= 65 * I_E;
            { const int lo = r / I_R, idx = r % I_R, kb = idx / 2, nb = idx % 2;
              transpose_item(inp(c, 16) + (size_t)L * D * NEXP, D, NEXP, rw, lo * 64 + 32 * nb, scr, kb, nb, c.lane, lo != 0); }
        }
    }
    if (L == 0) {
        float* rope = (float*)(ws + WS_ROPE);
        for (int i = blockIdx.x * 512 + c.tid; i < 128 * 16; i += gridDim.x * 512) {
            const int pos = i / 16, f = i % 16;
            const float inv = exp2f(-(float)f * (13.287712379549449f / 16.f));
            const float ang = (float)pos * inv;
            const float n = rintf(ang * 0.15915494309189535f);
            float rr = fmaf(-n, 6.28125f, ang); rr = fmaf(-n, 1.9353071795864769e-3f, rr);
            rope[2 * i] = __cosf(rr); rope[2 * i + 1] = __sinf(rr);
        }
    }
}

DI void row_stats(const f32x4 (&v)[8], float& mean, float& rstd) {
    float s = 0.f;
#pragma unroll
    for (int j = 0; j < 8; ++j) s += (v[j].x + v[j].y) + (v[j].z + v[j].w);
    mean = wave_sum(s) * (1.f / D);
    float q = 0.f;
#pragma unroll
    for (int j = 0; j < 8; ++j) { const f32x4 d = v[j] - mean; q += (d.x * d.x + d.y * d.y) + (d.z * d.z + d.w * d.w); }
    rstd = 1.f / sqrtf(wave_sum(q) * (1.f / D) + LN_EPS);
}
DI const float* mod_row(const Ctx& c, int row) { return (const float*)(c.ws + WS_MOD) + (size_t)(row < NLAT ? row / SEQ : 2) * 6 * D; }
DI const float* x_in_row(const Ctx& c, int row) {

    if (row < NLAT) return (c.L == 0 ? inp(c, 0) : (const float*)outp(c)) + (size_t)row * D;
    return (c.L == 0 ? inp(c, 2) : (const float*)(c.ws + WS_HCTX)) + (size_t)(row - NLAT) * D;
}

DI void phase1(const Ctx& c) {
    bf16* xn = (bf16*)(c.ws + WS_XN);
    for (int row = c.gw; row < NTOK; row += c.ngw) {
        const float* xr = x_in_row(c, row); const float* mod = mod_row(c, row);
        f32x4 v[8];
#pragma unroll
        for (int j = 0; j < 8; ++j) v[j] = *(const f32x4*)(xr + 4 * c.lane + 256 * j);
        float mean, rstd; row_stats(v, mean, rstd);
#pragma unroll
        for (int j = 0; j < 8; ++j) { const int col = 4 * c.lane + 256 * j;
            const f32x4 sh = *(const f32x4*)(mod + col), sc = *(const f32x4*)(mod + D + col);
            const f32x4 y = (v[j] - mean) * rstd * (sc + 1.f) + sh;
            u32x2 o; o.x = pk2(y.x, y.y); o.y = pk2(y.z, y.w);
            *(u32x2*)(xn + (size_t)row * D + col) = o; }
    }
}

DI void phase7(const Ctx& c) {
    const int L = c.L;
    bf16* xn = (bf16*)(c.ws + WS_XN); const bf16* T = (const bf16*)(c.ws + WS_T); float* x1 = (float*)(c.ws + WS_X1); float* stats = (float*)(c.ws + WS_STATS);
    const float* lg = inp(c, 14) + (size_t)L * D; const float* lb = inp(c, 15) + (size_t)L * D;
    const int nrows = L == 0 ? NTOK : NLAT;
    for (int row = c.gw; row < nrows; row += c.ngw) {
        const float* xr = x_in_row(c, row); const float* mod = mod_row(c, row);
        f32x4 v[8];
#pragma unroll
        for (int j = 0; j < 8; ++j) { const int col = 4 * c.lane + 256 * j;
            const f32x4 x = *(const f32x4*)(xr + col), g = *(const f32x4*)(mod + 2 * D + col);
            const u32x2 t = *(const u32x2*)(T + (size_t)row * D + col);
            const f32x4 tf = (f32x4){lo16(t.x), hi16(t.x), lo16(t.y), hi16(t.y)};
            v[j] = x * DN_ALPHA + g * tf; }
        float mean, rstd; row_stats(v, mean, rstd);
#pragma unroll
        for (int j = 0; j < 8; ++j) { const int col = 4 * c.lane + 256 * j;
            v[j] = (v[j] - mean) * rstd * *(const f32x4*)(lg + col) + *(const f32x4*)(lb + col);
            *(f32x4*)(x1 + (size_t)row * D + col) = v[j]; }
        row_stats(v, mean, rstd);
        if (c.lane == 0) { stats[2 * row] = mean; stats[2 * row + 1] = rstd; }
#pragma unroll
        for (int j = 0; j < 8; ++j) { const int col = 4 * c.lane + 256 * j;
            const f32x4 sh = *(const f32x4*)(mod + 3 * D + col), sc = *(const f32x4*)(mod + 4 * D + col);
            const f32x4 y = (v[j] - mean) * rstd * (sc + 1.f) + sh;
            u32x2 o; o.x = pk2(y.x, y.y); o.y = pk2(y.z, y.w);
            *(u32x2*)(xn + (size_t)row * D + col) = o; }
    }
}
constexpr int VSTR = 144;
struct AttnAcc { f32x16 o0, o1; float m, l; };
DI void attn_init(AttnAcc& a) { a.o0 = zero16(); a.o1 = zero16(); a.m = -INFINITY; a.l = 0.f; }

template <class ScoreF>
DI void attn_tile(AttnAcc& a, const bf16x8 (&qf)[4], const bf16x8 (&kf)[4], const bf16* vsrc, LAS unsigned char* vl, int lane, ScoreF sf) {
    const int half = lane >> 5;
    {
        const u32x4* s = (const u32x4*)vsrc; LAS unsigned char* d = vl + (lane >> 1) * VSTR + (lane & 1) * 64;
        const u32x4 v0 = s[0], v1 = s[1], v2 = s[2], v3 = s[3];
        *(LAS u32x4*)(d) = v0; *(LAS u32x4*)(d + 16) = v1; *(LAS u32x4*)(d + 32) = v2; *(LAS u32x4*)(d + 48) = v3;
    }
    f32x16 st = zero16();
#pragma unroll
    for (int s = 0; s < 4; ++s) st = MFMA32(kf[s], qf[s], st);
    float sc[16]; float mx = -INFINITY;
#pragma unroll
    for (int r = 0; r < 16; ++r) { sc[r] = sf(crow(r, half), st[r]); mx = fmaxf(mx, sc[r]); }
    mx = fmaxf(mx, __shfl_xor(mx, 32));
    const float mnew = fmaxf(a.m, mx);
    const float muse = (mnew == -INFINITY) ? 0.f : mnew;
    const float corr = __expf(a.m - muse);
    float ps = 0.f;
#pragma unroll
    for (int r = 0; r < 16; ++r) { sc[r] = __expf(sc[r] - muse); ps += sc[r]; }
    ps += __shfl_xor(ps, 32);
    a.l = a.l * corr + ps; a.m = mnew;
#pragma unroll
    for (int r = 0; r < 16; ++r) { a.o0[r] *= corr; a.o1[r] *= corr; }
    const bf16x8 pb0 = pack8(sc[0], sc[1], sc[2], sc[3], sc[4], sc[5], sc[6], sc[7]);
    const bf16x8 pb1 = pack8(sc[8], sc[9], sc[10], sc[11], sc[12], sc[13], sc[14], sc[15]);
    const int q = (lane & 15) >> 2, pp = lane & 3, blk = (lane >> 4) & 1;
    LAS unsigned char* vb = vl + (4 * half + q) * VSTR + (16 * blk + 4 * pp) * 2;
    { const bf16x8 A = cat4(tr_read(vb), tr_read(vb + 8 * VSTR)); a.o0 = MFMA32(A, pb0, a.o0); }
    { const bf16x8 A = cat4(tr_read(vb + 64), tr_read(vb + 8 * VSTR + 64)); a.o1 = MFMA32(A, pb0, a.o1); }
    { const bf16x8 A = cat4(tr_read(vb + 16 * VSTR), tr_read(vb + 24 * VSTR)); a.o0 = MFMA32(A, pb1, a.o0); }
    { const bf16x8 A = cat4(tr_read(vb + 16 * VSTR + 64), tr_read(vb + 24 * VSTR + 64)); a.o1 = MFMA32(A, pb1, a.o1); }
}
DI void attn_store(const AttnAcc& a, bf16* orow, int lane) {
    const int half = lane >> 5; const float inv = 1.f / a.l;
#pragma unroll
    for (int g = 0; g < 4; ++g) {
        u32x2 w0; w0.x = pk2(a.o0[4 * g] * inv, a.o0[4 * g + 1] * inv); w0.y = pk2(a.o0[4 * g + 2] * inv, a.o0[4 * g + 3] * inv);
        u32x2 w1; w1.x = pk2(a.o1[4 * g] * inv, a.o1[4 * g + 1] * inv); w1.y = pk2(a.o1[4 * g + 2] * inv, a.o1[4 * g + 3] * inv);
        *(u32x2*)(orow + 8 * g + 4 * half) = w0; *(u32x2*)(orow + 32 + 8 * g + 4 * half) = w1; }
}
DI void load_frags(bf16x8 (&f)[4], const bf16* row, int half) {
#pragma unroll
    for (int s = 0; s < 4; ++s) f[s] = *(const bf16x8*)(row + 16 * s + 8 * half);
}
DI void rope_frags(bf16x8 (&f)[4], int posr, int posc, int half, const float* rope) {
#pragma unroll
    for (int pr = 0; pr < 2; ++pr) {
        const int pos = pr == 0 ? posr : posc;
        const f32x4* t = (const f32x4*)(rope + (size_t)(pos * 16 + 8 * half) * 2);
        const f32x4 t0 = t[0], t1 = t[1], t2 = t[2], t3 = t[3];
        const float cs[16] = {t0.x, t0.y, t0.z, t0.w, t1.x, t1.y, t1.z, t1.w, t2.x, t2.y, t2.z, t2.w, t3.x, t3.y, t3.z, t3.w};
        float x1[8], x2[8]; unpack8(f[2 * pr], x1); unpack8(f[2 * pr + 1], x2);
        float y1[8], y2[8];
#pragma unroll
        for (int e = 0; e < 8; ++e) { const float co = cs[2 * e], si = cs[2 * e + 1]; y1[e] = x1[e] * co - x2[e] * si; y2[e] = x2[e] * co + x1[e] * si; }
        f[2 * pr] = pack8(y1[0], y1[1], y1[2], y1[3], y1[4], y1[5], y1[6], y1[7]);
        f[2 * pr + 1] = pack8(y2[0], y2[1], y2[2], y2[3], y2[4], y2[5], y2[6], y2[7]);
    }
}

DI void na_item(const Ctx& c, int item) {
    const bf16* P = (const bf16*)(c.ws + WS_P); bf16* Y = (bf16*)(c.ws + WS_YMIX);
    const int lane = c.lane, half = lane >> 5, j = lane & 31;
    const int cc = item & 1, h = (item >> 1) & 7, r = (item >> 4) & 127, b = item >> 11;
    const float* rpb = inp(c, 7) + (size_t)(c.L * 8 + h) * 15 * 31;
    LAS unsigned char* vl = c.lds + c.wave * WAVE_LDS;
    const int qrow = b * SEQ + r * 64 + 32 * cc + j;
    bf16x8 qf[4]; load_frags(qf, P + (size_t)qrow * PWP + NA_Q + h * 64, half);
    const int qc = 32 * cc + j;
    const int rs = min(max(r - 4, 0), 120);
    AttnAcc a; attn_init(a);
    for (int kr = 0; kr < 8; ++kr) {
        const float* brow = rpb + (rs + kr - r + 7) * 31;
        for (int ct = 0; ct < 2; ++ct) {
            int qc_ = qc; asm volatile("" : "+v"(qc_));
            const int qc = qc_; const int cstart = min(max(qc - 8, 0), 48);
            const int base = b * SEQ + (rs + kr) * 64 + 32 * ct;
            bf16x8 kf[4]; load_frags(kf, P + (size_t)(base + j) * PWP + NA_K + h * 64, half);
            const bf16* vsrc = P + (size_t)(base + (lane >> 1)) * PWP + NA_V + h * 64 + (lane & 1) * 32;
            attn_tile(a, qf, kf, vsrc, vl, lane, [&](int i, float raw) {
                const int kc = 32 * ct + i; const bool ok = (kc >= cstart) && (kc < cstart + 16);
                const int bi = min(max(kc - qc + 15, 0), 30);
                return ok ? raw * 0.125f + brow[bi] : -INFINITY; });
        }
    }
    for (int ct = 0; ct < 8; ++ct) {
        const int base = NLAT + b * CTXL + 32 * ct;
        bf16x8 kf[4]; load_frags(kf, P + (size_t)(base + j) * PWP + NA_K + h * 64, half);
        const bf16* vsrc = P + (size_t)(base + (lane >> 1)) * PWP + NA_V + h * 64 + (lane & 1) * 32;
        attn_tile(a, qf, kf, vsrc, vl, lane, [&](int, float raw) { return raw * 0.125f; });
    }
    attn_store(a, Y + (size_t)qrow * D + h * 64, lane);
}

DI void swa_item(const Ctx& c, int item) {
    const bf16* P = (const bf16*)(c.ws + WS_P); bf16* Y = (bf16*)(c.ws + WS_YMIX); const float* rope = (const float*)(c.ws + WS_ROPE);
    const int lane = c.lane, half = lane >> 5, j = lane & 31;
    const int hq = item & 7, qb = (item >> 3) & 255, b = item >> 11, kvh = hq >> 2;
    LAS unsigned char* vl = c.lds + c.wave * WAVE_LDS;
    const int i0 = 32 * qb, qi = i0 + j, qrow = b * SEQ + qi;
    bf16x8 qf[4]; load_frags(qf, P + (size_t)qrow * PWP + SW_Q + hq * 64, half);
    rope_frags(qf, qi >> 6, qi & 63, half, rope);
    AttnAcc a; attn_init(a);
    for (int m = 0; m < 9; ++m) {
        const int j0 = i0 - 128 + 32 * m;
        if (j0 < 0 || j0 >= SEQ) continue;
        const int kj = j0 + j;
        bf16x8 kf[4]; load_frags(kf, P + (size_t)(b * SEQ + kj) * PWP + SW_K + kvh * 64, half);
        rope_frags(kf, kj >> 6, kj & 63, half, rope);
        const bf16* vsrc = P + (size_t)(b * SEQ + j0 + (lane >> 1)) * PWP + SW_V + kvh * 64 + (lane & 1) * 32;
        attn_tile(a, qf, kf, vsrc, vl, lane, [&](int i, float raw) {
            const int dlt = j0 + i - qi; const bool ok = (dlt >= -128) && (dlt <= 128);
            return ok ? raw * 0.125f : -INFINITY; });
    }
    for (int ct = 0; ct < 8; ++ct) {
        const int base = NLAT + b * CTXL + 32 * ct;
        bf16x8 kf[4]; load_frags(kf, P + (size_t)(base + j) * PWP + SW_K + kvh * 64, half);
        const bf16* vsrc = P + (size_t)(base + (lane >> 1)) * PWP + SW_V + kvh * 64 + (lane & 1) * 32;
        attn_tile(a, qf, kf, vsrc, vl, lane, [&](int, float raw) { return raw * 0.125f; });
    }
    const float sink = inp(c, 12)[c.L * 8 + hq];
    a.l += __expf(sink - a.m);
    attn_store(a, Y + (size_t)qrow * D + 1536 + hq * 64, lane);
}

DI void ctx_attn_item(const Ctx& c, int item) {
    const bf16* P = (const bf16*)(c.ws + WS_P); bf16* Y = (bf16*)(c.ws + WS_YMIX);
    const int lane = c.lane, half = lane >> 5, j = lane & 31;
    const int h = item & 7, qb = (item >> 3) & 7, b = (item >> 6) & 1, kind = item >> 7;
    LAS unsigned char* vl = c.lds + c.wave * WAVE_LDS;
    const int qcol = kind == 0 ? NA_Q + h * 64 : SW_Q + h * 64;
    const int kcol = kind == 0 ? NA_K + h * 64 : SW_K + (h >> 2) * 64;
    const int vcol = kind == 0 ? NA_V + h * 64 : SW_V + (h >> 2) * 64;
    const int qrow = NLAT + b * CTXL + 32 * qb + j;
    bf16x8 qf[4]; load_frags(qf, P + (size_t)qrow * PWP + qcol, half);
    AttnAcc a; attn_init(a);
    for (int ct = 0; ct < 8; ++ct) {
        const int base = NLAT + b * CTXL + 32 * ct;
        bf16x8 kf[4]; load_frags(kf, P + (size_t)(base + j) * PWP + kcol, half);
        const bf16* vsrc = P + (size_t)(base + (lane >> 1)) * PWP + vcol + (lane & 1) * 32;
        attn_tile(a, qf, kf, vsrc, vl, lane, [&](int, float raw) { return raw * 0.125f; });
    }
    if (kind == 1) a.l += __expf(inp(c, 12)[c.L * 8 + h] - a.m);
    attn_store(a, Y + (size_t)qrow * D + (kind == 0 ? 0 : 1536) + h * 64, lane);
}

DI void conv_row(const Ctx& c, int row) {
    const bf16* P = (const bf16*)(c.ws + WS_P); bf16* Y = (bf16*)(c.ws + WS_YMIX);
    const int lane = c.lane, ch = 8 * lane;
    const float* w = inp(c, 8) + (size_t)c.L * 3 * 512;
    int pos, len; if (row < NLAT) { pos = row % SEQ; len = SEQ; } else { pos = (row - NLAT) % CTXL; len = CTXL; }
    float acc[8];
#pragma unroll
    for (int e = 0; e < 8; ++e) acc[e] = 0.f;
#pragma unroll
    for (int t = 0; t < 3; ++t) {
        const int q = pos + t - 1;
        if (q < 0 || q >= len) continue;
        const bf16* pr = P + (size_t)(row + t - 1) * PWP;
        float u[8], g[8]; unpack8(*(const bf16x8*)(pr + SC_U + ch), u); unpack8(*(const bf16x8*)(pr + SC_C + ch), g);
        const f32x4 w0 = *(const f32x4*)(w + t * 512 + ch), w1 = *(const f32x4*)(w + t * 512 + ch + 4);
        const float wv[8] = {w0.x, w0.y, w0.z, w0.w, w1.x, w1.y, w1.z, w1.w};
#pragma unroll
        for (int e = 0; e < 8; ++e) acc[e] += wv[e] * (g[e] * u[e]);
    }
    float gb[8]; unpack8(*(const bf16x8*)(P + (size_t)row * PWP + SC_B + ch), gb);
    *(bf16x8*)(Y + (size_t)row * D + 512 + ch) = pack8(gb[0] * acc[0], gb[1] * acc[1], gb[2] * acc[2], gb[3] * acc[3], gb[4] * acc[4], gb[5] * acc[5], gb[6] * acc[6], gb[7] * acc[7]);
}
constexpr int KSTR = 144, V2STR = 272;
DI int gla_row0(int b, int ck) { return ck < 8 ? NLAT + b * CTXL + 32 * ck : b * SEQ + 32 * (ck - 8); }
DI int gla_chain_pos(int dir, int ck) { return ck < 8 ? (dir == 0 ? ck : 7 - ck) : (dir == 0 ? ck : 8 + 255 - (ck - 8)); }

struct GlaGate { float w[16]; float bias; };
template <int DIR>
DI void gla_gate_load(const Ctx& c, int h, GlaGate& g) {

    const float* w2 = inp(c, 9) + (size_t)((c.L * 2 + DIR) * 16) * 256 + h * 64 + c.lane;
#pragma unroll
    for (int i = 0; i < 16; ++i) g.w[i] = w2[i * 256];
    g.bias = inp(c, 10)[(c.L * 2 + DIR) * 256 + h * 64 + c.lane];
}
template <int DIR>
DI float gla_la(const GlaGate& g, const bf16* prow) {
    const bf16* zr = prow + GL_Z + DIR * 16;
    float a[8], bq[8]; unpack8(*(const bf16x8*)zr, a); unpack8(*(const bf16x8*)(zr + 8), bq);
    float x = g.bias;
#pragma unroll
    for (int i = 0; i < 8; ++i) x += a[i] * g.w[i];
#pragma unroll
    for (int i = 0; i < 8; ++i) x += bq[i] * g.w[8 + i];
    return (fminf(x, 0.f) - __logf(1.f + __expf(-fabsf(x)))) * (1.f / 16.f);
}
DI void gla_stage_v(const bf16* P, int row0, int h, LAS unsigned char* vl, int lane) {
#pragma unroll
    for (int i = 0; i < 8; ++i) { const int idx = lane + 64 * i, t = idx >> 4, ch = idx & 15;
        *(LAS u32x4*)(vl + t * V2STR + ch * 16) = *(const u32x4*)(P + (size_t)(row0 + t) * PWP + GL_V + h * 128 + ch * 8); }
}

template <int DIR>
DI void gla_g1(const Ctx& c, int b, int h, int ck) {
    const bf16* P = (const bf16*)(c.ws + WS_P);
    const int lane = c.lane, half = lane >> 5;
    LAS unsigned char* kl = c.lds + c.wave * WAVE_LDS; LAS unsigned char* vl = kl + 32 * KSTR;
    const int row0 = gla_row0(b, ck), n = gla_chain_pos(DIR, ck);
    const size_t chain = (size_t)((b * 2 + DIR) * 4 + h) * NCH + n;
    GlaGate gate; gla_gate_load<DIR>(c, h, gate);
    float rev = 0.f;
#pragma unroll 2
    for (int tt = 31; tt >= 0; --tt) {
        const int t = DIR ? 31 - tt : tt;
        const bf16* prow = P + (size_t)(row0 + t) * PWP;
        const float kv = bf2f(prow[GL_K + h * 64 + lane]);
        *(LAS bf16*)(kl + t * KSTR + 2 * lane) = f2bf(kv * __expf(rev));
        rev += gla_la<DIR>(gate, prow);
    }
    ((float*)(c.ws + WS_GDEC))[chain * 64 + lane] = __expf(rev);
    gla_stage_v(P, row0, h, vl, lane);
    const int q = (lane & 15) >> 2, pp = lane & 3, blk = (lane >> 4) & 1;
    bf16* ut = (bf16*)(c.ws + WS_UT) + chain * 8192;
    bf16x8 Bf[2][2];
#pragma unroll
    for (int nt = 0; nt < 2; ++nt)
#pragma unroll
        for (int s = 0; s < 2; ++s) { LAS unsigned char* a = kl + (16 * s + 8 * half + q) * KSTR + (32 * nt + 16 * blk + 4 * pp) * 2; Bf[nt][s] = cat4(tr_read(a), tr_read(a + 4 * KSTR)); }
#pragma unroll
    for (int mt = 0; mt < 4; ++mt) {
        bf16x8 Af[2];
#pragma unroll
        for (int s = 0; s < 2; ++s) { LAS unsigned char* a = vl + (16 * s + 8 * half + q) * V2STR + (32 * mt + 16 * blk + 4 * pp) * 2; Af[s] = cat4(tr_read(a), tr_read(a + 4 * V2STR)); }
#pragma unroll
        for (int nt = 0; nt < 2; ++nt) {
            f32x16 acc = zero16();
            acc = MFMA32(Af[0], Bf[nt][0], acc); acc = MFMA32(Af[1], Bf[nt][1], acc);
#pragma unroll
            for (int r = 0; r < 16; ++r) ut[(32 * mt + crow(r, half)) * 64 + 32 * nt + (lane & 31)] = f2bf(acc[r]);
        }
    }
}

DI void gla_scan(const Ctx& c) {

    const bf16* ut = (const bf16*)(c.ws + WS_UT); bf16* sin = (bf16*)(c.ws + WS_SIN); const float* gd = (const float*)(c.ws + WS_GDEC);
    for (int e = blockIdx.x * 512 + c.tid; e < 16 * 8192; e += gridDim.x * 512) {
        const int chain = e >> 13, el = e & 8191, k = el & 63;
        const size_t base = (size_t)chain * NCH * 8192 + el;
        const float* g = gd + (size_t)chain * NCH * 64 + k;
        float st = 0.f;
        for (int n0 = 0; n0 < NCH; n0 += 8) {
            float u[8], gg[8];
#pragma unroll
            for (int i = 0; i < 8; ++i) { u[i] = bf2f(ut[base + (size_t)(n0 + i) * 8192]); gg[i] = g[(n0 + i) * 64]; }
#pragma unroll
            for (int i = 0; i < 8; ++i) { sin[base + (size_t)(n0 + i) * 8192] = f2bf(st); st = gg[i] * st + u[i]; }
        }
    }
}

template <int DIR>
DI void gla_g3_dir(const Ctx& c, const bf16* P, int b, int h, int ck, int row0, LAS unsigned char* ql, LAS unsigned char* kl, LAS unsigned char* vl, f32x16 (&o)[4]) {
    const int lane = c.lane, half = lane >> 5, j = lane & 31;
    { GlaGate gate; gla_gate_load<DIR>(c, h, gate);
      float cum = 0.f;
#pragma unroll 2
      for (int tt = 0; tt < 32; ++tt) {
        const int t = DIR ? 31 - tt : tt;
        const bf16* prow = P + (size_t)(row0 + t) * PWP;
        cum += gla_la<DIR>(gate, prow);
        const float qv = bf2f(prow[GL_Q + h * 64 + lane]), kv = bf2f(prow[GL_K + h * 64 + lane]);
        *(LAS bf16*)(ql + t * KSTR + 2 * lane) = f2bf(qv * __expf(cum) * 0.125f);
        *(LAS bf16*)(kl + t * KSTR + 2 * lane) = f2bf(kv * __expf(-cum));
      } }
    bf16x8 qf[4], kf[4];
#pragma unroll
    for (int s = 0; s < 4; ++s) { qf[s] = *(const LAS bf16x8*)(ql + j * KSTR + (16 * s + 8 * half) * 2); kf[s] = *(const LAS bf16x8*)(kl + j * KSTR + (16 * s + 8 * half) * 2); }
    f32x16 at = zero16();
#pragma unroll
    for (int s = 0; s < 4; ++s) at = MFMA32(kf[s], qf[s], at);
    float a[16];
#pragma unroll
    for (int r = 0; r < 16; ++r) { const int s = crow(r, half); const bool ok = DIR ? (s >= j) : (s <= j); a[r] = ok ? at[r] : 0.f; }
    const bf16x8 pb0 = pack8(a[0], a[1], a[2], a[3], a[4], a[5], a[6], a[7]), pb1 = pack8(a[8], a[9], a[10], a[11], a[12], a[13], a[14], a[15]);
    const int q = (lane & 15) >> 2, pp = lane & 3, blk = (lane >> 4) & 1;
    const size_t chain = (size_t)((b * 2 + DIR) * 4 + h) * NCH + gla_chain_pos(DIR, ck);
    const bf16* sin = (const bf16*)(c.ws + WS_SIN) + chain * 8192;
#pragma unroll
    for (int mt = 0; mt < 4; ++mt) {
        LAS unsigned char* vb = vl + (4 * half + q) * V2STR + (32 * mt + 16 * blk + 4 * pp) * 2;
        o[mt] = MFMA32(cat4(tr_read(vb), tr_read(vb + 8 * V2STR)), pb0, o[mt]);
        o[mt] = MFMA32(cat4(tr_read(vb + 16 * V2STR), tr_read(vb + 24 * V2STR)), pb1, o[mt]);
#pragma unroll
        for (int s = 0; s < 4; ++s) o[mt] = MFMA32(*(const bf16x8*)(sin + (size_t)(32 * mt + j) * 64 + 16 * s + 8 * half), qf[s], o[mt]);
    }
}
DI void gla_g3(const Ctx& c, int b, int h, int ck) {
    const bf16* P = (const bf16*)(c.ws + WS_P); bf16* Y = (bf16*)(c.ws + WS_YMIX);
    const int lane = c.lane, half = lane >> 5, j = lane & 31;
    LAS unsigned char* ql = c.lds + c.wave * WAVE_LDS; LAS unsigned char* kl = ql + 32 * KSTR; LAS unsigned char* vl = kl + 32 * KSTR;
    const int row0 = gla_row0(b, ck);
    gla_stage_v(P, row0, h, vl, lane);
    f32x16 o[4];
#pragma unroll
    for (int mt = 0; mt < 4; ++mt) o[mt] = zero16();
    gla_g3_dir<0>(c, P, b, h, ck, row0, ql, kl, vl, o);
    gla_g3_dir<1>(c, P, b, h, ck, row0, ql, kl, vl, o);
    float ss = 0.f;
#pragma unroll
    for (int mt = 0; mt < 4; ++mt)
#pragma unroll
        for (int r = 0; r < 16; ++r) ss += o[mt][r] * o[mt][r];
    ss += __shfl_xor(ss, 32);
    const float rstd = 1.f / sqrtf(ss * (1.f / 128.f) + LN_EPS);
    const float* gain = inp(c, 11) + (size_t)c.L * 128;
    const int row = row0 + j;
#pragma unroll
    for (int mt = 0; mt < 4; ++mt)
#pragma unroll
        for (int g4 = 0; g4 < 4; ++g4) {
            const int v0 = 32 * mt + 8 * g4 + 4 * half;
            const u32x2 gr = *(const u32x2*)(P + (size_t)row * PWP + GL_G + h * 128 + v0);
            const float gv[4] = {lo16(gr.x), hi16(gr.x), lo16(gr.y), hi16(gr.y)};
            const f32x4 gn = *(const f32x4*)(gain + v0);
            float y[4];
#pragma unroll
            for (int e = 0; e < 4; ++e) { const float on = o[mt][4 * g4 + e] * rstd * gn[e]; y[e] = on * (gv[e] / (1.f + __expf(-gv[e]))); }
            u32x2 w; w.x = pk2(y[0], y[1]); w.y = pk2(y[2], y[3]);
            *(u32x2*)(Y + (size_t)row * D + 1024 + h * 128 + v0) = w; }
}
DI void router_item(const Ctx& c, int tile) {
    const int L = c.L, lane = c.lane, r16 = lane & 15, q = lane >> 4;
    const float* x1 = (const float*)(c.ws + WS_X1); const float* stats = (const float*)(c.ws + WS_STATS); const bf16* rw = (const bf16*)(c.ws + WS_ROUTW);
    const int row = tile * 16 + r16;
    const float* mod = mod_row(c, tile * 16);
    const float mean = stats[2 * row], rstd = stats[2 * row + 1];
    f32x4 acc[4];
#pragma unroll
    for (int nt = 0; nt < 4; ++nt) acc[nt] = (f32x4){0.f, 0.f, 0.f, 0.f};
    for (int ks = 0; ks < 64; ++ks) {
        const int k0 = 32 * ks + 8 * q;
        const f32x4 xa = *(const f32x4*)(x1 + (size_t)row * D + k0), xb = *(const f32x4*)(x1 + (size_t)row * D + k0 + 4);
        const f32x4 sha = *(const f32x4*)(mod + 3 * D + k0), shb = *(const f32x4*)(mod + 3 * D + k0 + 4), sca = *(const f32x4*)(mod + 4 * D + k0), scb = *(const f32x4*)(mod + 4 * D + k0 + 4);
        const f32x4 ya = (xa - mean) * rstd * (sca + 1.f) + sha, yb = (xb - mean) * rstd * (scb + 1.f) + shb;
        const bf16x8 ah = pack8(ya.x, ya.y, ya.z, ya.w, yb.x, yb.y, yb.z, yb.w);
        float hf[8]; unpack8(ah, hf);
        const bf16x8 al = pack8(ya.x - hf[0], ya.y - hf[1], ya.z - hf[2], ya.w - hf[3], yb.x - hf[4], yb.y - hf[5], yb.z - hf[6], yb.w - hf[7]);
#pragma unroll
        for (int nt = 0; nt < 4; ++nt) {
            const bf16x8 bh = *(const bf16x8*)(rw + (size_t)(16 * nt + r16) * D + k0), bl = *(const bf16x8*)(rw + (size_t)(64 + 16 * nt + r16) * D + k0);
            acc[nt] = MFMA16(ah, bh, acc[nt]); acc[nt] = MFMA16(al, bh, acc[nt]); acc[nt] = MFMA16(ah, bl, acc[nt]);
        }
    }
    LAS float* sc = (LAS float*)(c.lds + c.wave * WAVE_LDS);
    LAS float* sl = sc + 16 * 65;
    const float* rb = inp(c, 17) + (size_t)L * NEXP;
#pragma unroll
    for (int nt = 0; nt < 4; ++nt)
#pragma unroll
        for (int r = 0; r < 4; ++r) { const int e = 16 * nt + r16, t = 4 * q + r; const float s = 1.f / (1.f + __expf(-acc[nt][r])); sc[t * 65 + e] = s; sl[t * 65 + e] = s + rb[e]; }
    asm volatile("s_waitcnt lgkmcnt(0)" ::: "memory");
    if (lane < 16) {
        const int t = lane; const int tok = tile * 16 + t;
        float gs[8];
#pragma unroll
        for (int g = 0; g < 8; ++g) { float m1 = -INFINITY, m2 = -INFINITY;
#pragma unroll
            for (int e = 0; e < 8; ++e) { const float v = sl[t * 65 + 8 * g + e]; if (v > m1) { m2 = m1; m1 = v; } else if (v > m2) m2 = v; }
            gs[g] = m1 + m2; }
        unsigned gmask = 0u;
#pragma unroll
        for (int it = 0; it < 4; ++it) { float best = -INFINITY; int bi = 0;
#pragma unroll
            for (int g = 0; g < 8; ++g) { const bool fr = ((gmask >> g) & 1u) == 0u; if (fr && gs[g] > best) { best = gs[g]; bi = g; } }
            gmask |= 1u << bi; }
        unsigned long long chosen = 0ull; float wsum = 0.f; int ei[8]; float wi[8];
#pragma unroll
        for (int k = 0; k < 8; ++k) { float best = -INFINITY; int bi = 0;
            for (int e = 0; e < 64; ++e) { const bool ok = ((gmask >> (e >> 3)) & 1u) && !((chosen >> e) & 1ull); const float v = sl[t * 65 + e]; if (ok && v > best) { best = v; bi = e; } }
            chosen |= 1ull << bi; ei[k] = bi; wi[k] = sc[t * 65 + bi]; wsum += wi[k]; }
        int* eidx = (int*)(c.ws + WS_EIDX); int* rank = (int*)(c.ws + WS_RANK); float* wts = (float*)(c.ws + WS_WTS);
        unsigned* cnt = (unsigned*)(c.ws + WS_CTL) + CW_CNT + L * 64;
        const float sc25 = 2.5f / wsum;
#pragma unroll
        for (int k = 0; k < 8; ++k) { eidx[tok * 8 + k] = ei[k]; wts[tok * 8 + k] = wi[k] * sc25; rank[tok * 8 + k] = (int)atomicAdd(cnt + ei[k], 1u); }
    }
}

DI void phase9(const Ctx& c) {
    const int L = c.L;
    const int nmoe = L == 0 ? NTOK : NLAT;
    LAS int* ts = (LAS int*)c.lds;
    const unsigned* cnt = (const unsigned*)(c.ws + WS_CTL) + CW_CNT + L * 64;
    if (c.tid == 0) { int acc = 0; for (int e = 0; e < 64; ++e) { ts[e] = acc; acc += ((int)cnt[e] + 255) >> 8; } ts[64] = acc; ts[65] = acc + nmoe / 256; }
    __syncthreads();
    int* toks = (int*)(c.ws + WS_TOKS); int* pos = (int*)(c.ws + WS_POS); int* tile_e = (int*)(c.ws + WS_TILEE);
    const int* eidx = (const int*)(c.ws + WS_EIDX); const int* rank = (const int*)(c.ws + WS_RANK);
    const int gt = blockIdx.x * 512 + c.tid, ngt = gridDim.x * 512;
    for (int i = gt; i < nmoe * 8; i += ngt) { const int e = eidx[i]; const int slot = ts[e] * 256 + rank[i]; toks[slot] = i >> 3; pos[i] = slot; }
    for (int i = gt; i < nmoe; i += ngt) toks[ts[64] * 256 + i] = i;
    for (int e = blockIdx.x; e < 65; e += gridDim.x) {
        for (int t = ts[e] + c.tid; t < ts[e + 1]; t += 512) tile_e[t] = e;
        if (e < 64) { const int n = (int)cnt[e]; for (int s = n + c.tid; s < (ts[e + 1] - ts[e]) * 256; s += 512) toks[ts[e] * 256 + s] = 0; }
    }
    if (blockIdx.x == 0 && c.tid == 0) { int* nt = (int*)(c.ws + WS_CTL) + CW_NT + L * 64; nt[0] = ts[65]; nt[1] = ts[64]; }
    __syncthreads();
}

DI void phase12(const Ctx& c) {
    const int L = c.L;
    const int nmoe = L == 0 ? NTOK : NLAT;
    const bf16* Yb = (const bf16*)(c.ws + WS_Y); const float* x1 = (const float*)(c.ws + WS_X1);
    const int* pos = (const int*)(c.ws + WS_POS); const float* wts = (const float*)(c.ws + WS_WTS);
    const int sh_tile0 = ((const int*)(c.ws + WS_CTL))[CW_NT + L * 64 + 1];
    const float* lg = inp(c, 24) + (size_t)L * D; const float* lb = inp(c, 25) + (size_t)L * D;
    for (int row = c.gw; row < nmoe; row += c.ngw) {
        const float* mod = mod_row(c, row);
        f32x4 f[8];
        { const bf16* yr = Yb + ((size_t)sh_tile0 * 256 + row) * D;
#pragma unroll
          for (int j = 0; j < 8; ++j) { const u32x2 t = *(const u32x2*)(yr + 4 * c.lane + 256 * j); f[j] = (f32x4){lo16(t.x), hi16(t.x), lo16(t.y), hi16(t.y)}; } }
        for (int k = 0; k < 8; ++k) {
            const int slot = pos[row * 8 + k]; const float w = wts[row * 8 + k];
            const bf16* yr = Yb + (size_t)slot * D;
#pragma unroll
            for (int j = 0; j < 8; ++j) { const u32x2 t = *(const u32x2*)(yr + 4 * c.lane + 256 * j); f[j] += (f32x4){lo16(t.x), hi16(t.x), lo16(t.y), hi16(t.y)} * w; }
        }
        f32x4 v[8];
#pragma unroll
        for (int j = 0; j < 8; ++j) { const int col = 4 * c.lane + 256 * j; v[j] = *(const f32x4*)(x1 + (size_t)row * D + col) * DN_ALPHA + *(const f32x4*)(mod + 5 * D + col) * f[j]; }
        float mean, rstd; row_stats(v, mean, rstd);
        float* orow = row < NLAT ? outp(c) + (size_t)row * D : (float*)(c.ws + WS_HCTX) + (size_t)(row - NLAT) * D;
#pragma unroll
        for (int j = 0; j < 8; ++j) { const int col = 4 * c.lane + 256 * j; *(f32x4*)(orow + col) = (v[j] - mean) * rstd * *(const f32x4*)(lg + col) + *(const f32x4*)(lb + col); }
    }
}

__global__ void __launch_bounds__(512, 2) fwd(Params prm) {
    extern __shared__ __attribute__((aligned(16))) unsigned char lds_raw[];
    Ctx c; c.lds = (LAS unsigned char*)lds_raw; c.tid = threadIdx.x; c.lane = c.tid & 63; c.wave = __builtin_amdgcn_readfirstlane(c.tid >> 6);
    c.gw = blockIdx.x * 8 + c.wave; c.ngw = gridDim.x * 8; c.p = (CParams*)__builtin_amdgcn_kernarg_segment_ptr(); c.L = 0;
    volatile LAS unsigned* misc = (volatile LAS unsigned*)(c.lds + LDS_MISC);
    if (c.tid < 64) misc[c.tid] = 0u;
    __syncthreads();
    unsigned char* ws = (unsigned char*)prm.ws; c.ws = ws;
    XcdBarrier bar = xcd_barrier_post((unsigned*)(ws + WS_CTL) + CW_BAR, misc + 8);
    const int lo = prm.ph_lo, hi = prm.ph_hi;
#ifndef ONLY_PH
#define ONLY_PH -1
#endif
#ifndef PHMASK
#define PHMASK 0x1fff
#endif
#define IN(k) (lo <= (k) && (k) < hi && (ONLY_PH < 0 || ((k) % NPH) == ONLY_PH) && ((PHMASK >> ((k) % NPH)) & 1))
#define REFRESH() do { { CParams* kp_ = (CParams*)__builtin_amdgcn_kernarg_segment_ptr(); asm volatile("" : "+s"(kp_)); c.p = kp_; } ws = fresh(c.p->ws); c.ws = ws; int t_ = threadIdx.x; asm volatile("" : "+v"(t_)); c.tid = t_; c.lane = t_ & 63; c.wave = __builtin_amdgcn_readfirstlane(t_ >> 6); c.gw = blockIdx.x * 8 + c.wave; } while (0)
#define SEAM(k) do { if (IN(k) && IN((k) + 1)) xcd_barrier(bar); } while (0)
    for (int L = 0; L < 2; ++L) {
        c.L = L; const int pb = L * NPH;
        if (IN(pb + 0)) { REFRESH(); phase0(c); __syncthreads(); } SEAM(pb + 0);
        if (IN(pb + 1)) { REFRESH(); phase1(c); } SEAM(pb + 1);
        if (IN(pb + 2)) { REFRESH();
            pg8::Gemm g{(const bf16*)(ws + WS_XN), (const bf16*)(ws + WS_WIN), D}; pg8::StaticOrder S; S.init(NTOK, PWP, gridDim.x, blockIdx.x);
            pg8::EpiBf16 E{(bf16*)(ws + WS_P), PWP};
            pg8::gemm_phase<pg8::EpiBf16, pg8::StaticOrder, false>(c.lds, g, S, E, nullptr);
        } SEAM(pb + 2);
        if (IN(pb + 3)) { REFRESH();
            for (int it = c.gw; it < 4096; it += c.ngw) na_item(c, it);
            for (int it = c.gw; it < 4096; it += c.ngw) swa_item(c, it);
            for (int it = c.gw; it < 16 * NCH; it += c.ngw) { const int ck = it % NCH, h = (it / NCH) & 3, dir = (it / (NCH * 4)) & 1, b = it / (NCH * 8);
                if (dir == 0) gla_g1<0>(c, b, h, ck); else gla_g1<1>(c, b, h, ck); }
            if (L == 0) for (int it = c.gw; it < 256; it += c.ngw) ctx_attn_item(c, it);
            for (int row = c.gw; row < (L == 0 ? NTOK : NLAT); row += c.ngw) conv_row(c, row);
        } SEAM(pb + 3);
        if (IN(pb + 4)) { REFRESH(); gla_scan(c); } SEAM(pb + 4);
        if (IN(pb + 5)) { REFRESH();
            for (int it = c.gw; it < 8 * NCH; it += c.ngw) { const int ck = it % NCH, h = (it / NCH) & 3, b = it / (NCH * 4);
                if (ck < 8 && L != 0) continue;
                gla_g3(c, b, h, ck); }
        } SEAM(pb + 5);
        if (IN(pb + 6)) { REFRESH();
            pg8::Gemm g{(const bf16*)(ws + WS_YMIX), (const bf16*)(ws + WS_WOUT), D}; pg8::StaticOrder S; S.init(L == 0 ? NTOK : NLAT, D, gridDim.x, blockIdx.x);
            pg8::EpiBf16 E{(bf16*)(ws + WS_T), D};
            pg8::gemm_phase<pg8::EpiBf16, pg8::StaticOrder, false>(c.lds, g, S, E, nullptr);
        } SEAM(pb + 6);
        if (IN(pb + 7)) { REFRESH(); phase7(c); } SEAM(pb + 7);
        if (IN(pb + 8)) { REFRESH(); for (int it = c.gw; it < (L == 0 ? NTOK : NLAT) / 16; it += c.ngw) router_item(c, it); } SEAM(pb + 8);
        if (IN(pb + 9)) { REFRESH(); phase9(c); } SEAM(pb + 9);
        if (IN(pb + 10)) { REFRESH();
            const int* ntp = (const int*)(ws + WS_CTL) + CW_NT + L * 64;
            pg8::Gemm g{(const bf16*)(ws + WS_XN), (const bf16*)(ws + WS_WGU), D};
            pg8::GroupOrder S{(const int*)(ws + WS_TILEE), ntp[0], 4, (int)gridDim.x, (int)blockIdx.x};
            pg8::EpiSwiglu E{(bf16*)(ws + WS_H)};
            pg8::gemm_phase<pg8::EpiSwiglu, pg8::GroupOrder, true>(c.lds, g, S, E, (const int*)(ws + WS_TOKS));
        } SEAM(pb + 10);
        if (IN(pb + 11)) { REFRESH();
            const int* ntp = (const int*)(ws + WS_CTL) + CW_NT + L * 64;
            pg8::Gemm g{(const bf16*)(ws + WS_H), (const bf16*)(ws + WS_WD), DEXP};
            pg8::GroupOrder S{(const int*)(ws + WS_TILEE), ntp[0], 8, (int)gridDim.x, (int)blockIdx.x};
            pg8::EpiBf16 E{(bf16*)(ws + WS_Y), D};
            pg8::gemm_phase<pg8::EpiBf16, pg8::GroupOrder, false>(c.lds, g, S, E, nullptr);
        } SEAM(pb + 11);
        if (IN(pb + 12)) { REFRESH(); phase12(c); } SEAM(pb + 12);
    }
#undef IN
#undef SEAM
}

#ifndef MK_ONE_LAUNCH
#define MK_ONE_LAUNCH 0
#endif
extern "C" void kernel_launch(void* const* d_in, const int* in_sizes, int n_in, void* d_out, int out_size, void* d_ws, size_t ws_size, hipStream_t stream) {
    static int grid = 0;
    if (grid == 0) {
        if (n_in != 26 || out_size != NLAT * D || ws_size < WS_END) { fprintf(stderr, "kernel_launch: unexpected shapes (n_in %d out %d ws %zu)\n", n_in, out_size, ws_size); grid = -1; return; }
        int dev = 0, cus = 0;
        if (hipGetDevice(&dev) != hipSuccess || hipDeviceGetAttribute(&cus, hipDeviceAttributeMultiprocessorCount, dev) != hipSuccess) { grid = -1; return; }
        if (hipFuncSetAttribute((const void*)fwd, hipFuncAttributeMaxDynamicSharedMemorySize, LDS_BYTES) != hipSuccess) { fprintf(stderr, "kernel_launch: hipFuncSetAttribute failed\n"); grid = -1; return; }
        int per_cu = 0;
        if (hipOccupancyMaxActiveBlocksPerMultiprocessor(&per_cu, (const void*)fwd, 512, LDS_BYTES) != hipSuccess || per_cu < 1) fprintf(stderr, "kernel_launch: occupancy query reports %d\n", per_cu);
        (void)hipGetLastError();
        grid = cus;
    }
    if (grid < 0) return;
    hipMemsetAsync((char*)d_ws + WS_CTL, 0, CTL_BYTES, stream);
    Params prm{};
    for (int i = 0; i < 26; ++i) prm.in[i] = (const GAS float*)d_in[i];
    prm.out = (GAS float*)d_out; prm.ws = (GAS unsigned char*)d_ws;
#if MK_ONE_LAUNCH
    prm.ph_lo = 0; prm.ph_hi = 2 * NPH;
    hipLaunchKernelGGL(fwd, dim3(grid), dim3(512), LDS_BYTES, stream, prm);
#else
    for (int ph = 0; ph < 2 * NPH; ++ph) { prm.ph_lo = ph; prm.ph_hi = ph + 1; hipLaunchKernelGGL(fwd, dim3(grid), dim3(512), LDS_BYTES, stream, prm); }
#endif
}
```

```cpp
#include <hip/hip_runtime.h>
#include <cstdio>

#define DI __device__ __forceinline__
#define LAS __attribute__((address_space(3)))
#if defined(__HIP_DEVICE_COMPILE__)
#define GAS __attribute__((address_space(1)))
#else
#define GAS
#endif
typedef unsigned short bf16;
typedef short bf16x8 __attribute__((ext_vector_type(8)));
typedef short s16x4 __attribute__((ext_vector_type(4)));
typedef float f32x2 __attribute__((ext_vector_type(2)));
typedef float f32x4 __attribute__((ext_vector_type(4)));
typedef float f32x8 __attribute__((ext_vector_type(8)));
typedef float f32x16 __attribute__((ext_vector_type(16)));
typedef unsigned u32x2 __attribute__((ext_vector_type(2)));
typedef unsigned u32x4 __attribute__((ext_vector_type(4)));
typedef __bf16 hbf16x2 __attribute__((ext_vector_type(2)));

constexpr int D = 2048, SEQ = 8192, CTXL = 256, NB = 2;
constexpr int NLAT = NB * SEQ, NCTX = NB * CTXL, NTOK = NLAT + NCTX;
constexpr int PW = 5408, PWP = 5632;
constexpr int NA_Q = 0, NA_K = 512, NA_V = 1024, SC_U = 1536, SC_B = 2048, SC_C = 2560, GL_Q = 3072, GL_K = 3328, GL_V = 3584, GL_G = 4096, GL_Z = 4608, SW_Q = 4640, SW_K = 5152, SW_V = 5280;
constexpr int NEXP = 64, DEXP = 512, NCH = 264;
constexpr int MAXTILES = 658;
constexpr float LN_EPS = 1e-6f, DN_ALPHA = 1.41421356237f;

constexpr size_t MiB = 1u << 20;
constexpr size_t WS_CTL = 0, CTL_BYTES = MiB;
constexpr size_t WS_MOD = 1 * MiB, WS_ROPE = 1 * MiB + 512 * 1024, WS_STATS = 2 * MiB, WS_ROUTW = 3 * MiB, WS_EIDX = 4 * MiB, WS_RANK = 5 * MiB, WS_WTS = 6 * MiB, WS_POS = 7 * MiB,
                 WS_TOKS = 8 * MiB, WS_TILEE = 9 * MiB, WS_GDEC = 10 * MiB, WS_HCTX = 12 * MiB, WS_WIN = 16 * MiB, WS_WOUT = 38 * MiB, WS_WGU = 46 * MiB, WS_WD = 306 * MiB,
                 WS_X1 = 436 * MiB, WS_XN = 568 * MiB, WS_YMIX = 634 * MiB, WS_H = 700 * MiB, WS_UT = WS_H, WS_SIN = WS_H + 66 * MiB, WS_Y = 865 * MiB, WS_P = WS_Y, WS_T = WS_Y + 192 * MiB,
                 WS_END = 1523 * MiB;
constexpr int CW_CNT = 1024, CW_NT = 2048, CW_BAR = 4096;

DI float bf2f(unsigned v) { return __uint_as_float(v << 16); }
DI unsigned pk2(float a, float b) { hbf16x2 v = __builtin_convertvector((f32x2){a, b}, hbf16x2); return __builtin_bit_cast(unsigned, v); }
DI bf16 f2bf(float a) { return (bf16)(pk2(a, 0.f) & 0xffffu); }
DI float lo16(unsigned u) { return __uint_as_float(u << 16); }
DI float hi16(unsigned u) { return __uint_as_float(u & 0xffff0000u); }
DI bf16x8 pack8(float a0, float a1, float a2, float a3, float a4, float a5, float a6, float a7) {
    u32x4 p; p.x = pk2(a0, a1); p.y = pk2(a2, a3); p.z = pk2(a4, a5); p.w = pk2(a6, a7); return __builtin_bit_cast(bf16x8, p); }
DI void unpack8(bf16x8 v, float (&f)[8]) { u32x4 p = __builtin_bit_cast(u32x4, v); f[0] = lo16(p.x); f[1] = hi16(p.x); f[2] = lo16(p.y); f[3] = hi16(p.y); f[4] = lo16(p.z); f[5] = hi16(p.z); f[6] = lo16(p.w); f[7] = hi16(p.w); }
DI float wave_sum(float v) {
#pragma unroll
    for (int o = 1; o < 64; o <<= 1) v += __shfl_xor(v, o);
    return v; }
DI int crow(int reg, int h) { return (reg & 3) + 8 * (reg >> 2) + 4 * h; }
#define MFMA32(a, b, c) __builtin_amdgcn_mfma_f32_32x32x16_bf16((a), (b), (c), 0, 0, 0)
#define MFMA16(a, b, c) __builtin_amdgcn_mfma_f32_16x16x32_bf16((a), (b), (c), 0, 0, 0)
DI s16x4 tr_read(LAS unsigned char* p) { return __builtin_amdgcn_ds_read_tr16_b64_v4i16((LAS s16x4*)p); }
DI bf16x8 cat4(s16x4 lo, s16x4 hi) { return __builtin_shufflevector(lo, hi, 0, 1, 2, 3, 4, 5, 6, 7); }
DI f32x16 zero16() { f32x16 z;
#pragma unroll
    for (int i = 0; i < 16; ++i) z[i] = 0.f; return z; }
#define XB_TMO      128
#define XB_XCNT(j)  (256  + 64 * (j))
#define XB_XSUB(j)  (1280 + 64 * (j))
#define XB_XGEN(j)  (2304 + 64 * (j))
#define XB_TOP      3328
#define XB_TOPGEN   3392
#define XCD_BAR_WORDS 3456
#define XB_SPIN_CAP (1u << 18)

__device__ __forceinline__ unsigned xb_ld(unsigned* p)              { return __hip_atomic_load(p, __ATOMIC_RELAXED, __HIP_MEMORY_SCOPE_AGENT); }
__device__ __forceinline__ unsigned xb_add(unsigned* p, unsigned v) { return __hip_atomic_fetch_add(p, v, __ATOMIC_RELAXED, __HIP_MEMORY_SCOPE_AGENT); }
__device__ __forceinline__ unsigned xb_xcc_id() { return (unsigned)__builtin_amdgcn_s_getreg((3 << 11) | 20) & 0xFu; }
#define XB_SPIN(cond, bar) do { unsigned _sp = 0; while (cond) { __builtin_amdgcn_s_sleep(1); \
    if ((++_sp & 255u) == 0u) { if (xb_ld(&(bar)[XB_TMO])) break; if (_sp > XB_SPIN_CAP) { atomicAdd(&(bar)[XB_TMO], 1u); break; } } } } while (0)

struct XcdBarrier { unsigned* bar; unsigned x; volatile LAS unsigned* st; };

__device__ __forceinline__ XcdBarrier xcd_barrier_post(unsigned* bar, volatile LAS unsigned* st) {
    XcdBarrier b; b.bar = bar; b.x = xb_xcc_id(); b.st = st;
    if (threadIdx.x == 0) (void)xb_add(&bar[XB_XCNT(b.x)], 1u);
    return b;
}
__device__ __forceinline__ void xcd_barrier_complete(unsigned* bar, unsigned x, unsigned& nloc, unsigned& nx) {
    const unsigned G = gridDim.x * gridDim.y * gridDim.z;
    unsigned sum, cnt, mine, sp = 0u;
    for (;;) {
        sum = 0u; cnt = 0u; mine = 0u;
#pragma unroll
        for (unsigned j = 0; j < 16; ++j) { const unsigned c = xb_ld(&bar[XB_XCNT(j)]); sum += c; cnt += (c > 0u) ? 1u : 0u; mine = (j == x) ? c : mine; }
        if (sum == G) break;
        __builtin_amdgcn_s_sleep(1);
        if ((++sp & 255u) == 0u) { if (xb_ld(&bar[XB_TMO])) break; if (sp > XB_SPIN_CAP) { atomicAdd(&bar[XB_TMO], 1u); break; } }
    }
    nloc = mine > 0u ? mine : 1u; nx = cnt > 0u ? cnt : 1u;
}
__device__ __forceinline__ void xcd_barrier(const XcdBarrier& b) {
    asm volatile("s_waitcnt vmcnt(0)" ::: "memory");
    __syncthreads();
    if (threadIdx.x == 0) {
        unsigned* bar = b.bar;
        __builtin_amdgcn_s_waitcnt(0);
        unsigned nloc = b.st[0], nx = b.st[1];
        if (nloc == 0u) { xcd_barrier_complete(bar, b.x, nloc, nx); b.st[0] = nloc; b.st[1] = nx; }
        const unsigned old = xb_add(&bar[XB_XSUB(b.x)], 1u);
        const unsigned gen = old / nloc;
        if (old + 1u == (gen + 1u) * nloc) {
            __builtin_amdgcn_fence(__ATOMIC_RELEASE, "agent");
            asm volatile("s_waitcnt vmcnt(0)" ::: "memory");
            const unsigned og = xb_add(&bar[XB_TOP], 1u);
            const unsigned tg = og / nx;
            if (og + 1u == (tg + 1u) * nx) xb_add(&bar[XB_TOPGEN], 1u);
            else XB_SPIN(xb_ld(&bar[XB_TOPGEN]) == tg, bar);
            __builtin_amdgcn_fence(__ATOMIC_ACQUIRE, "agent");
            xb_add(&bar[XB_XGEN(b.x)], 1u);
            asm volatile("s_waitcnt vmcnt(0)" ::: "memory");
        } else {
            XB_SPIN(xb_ld(&bar[XB_XGEN(b.x)]) == gen, bar);
            __builtin_amdgcn_fence(__ATOMIC_ACQUIRE, "agent");
            asm volatile("s_waitcnt vmcnt(0)" ::: "memory");
        }
    }
    __syncthreads();
}

namespace pg8 {
constexpr int BM = 256, BK = 64, HALF = 128, HTB = HALF * BK * 2, STAGE_BYTES = 8 * HTB, NXCD = 8, WGM = 8;
__host__ __device__ __forceinline__ int lds_byte(int r, int c) { const int st = (r >> 4) * 2 + (c >> 5), rr = r & 15, cc = c & 31, ob = rr * 64 + cc * 2; return st * 1024 + (ob ^ (((ob >> 9) & 1) << 5)); }
__host__ __device__ __forceinline__ void stage_rc(int b, int& R, int& C) { const int st = b / 1024, sb = b % 1024, swz = sb ^ (((sb >> 9) & 1) << 5); R = (st >> 1) * 16 + swz / 64; C = (st & 1) * 32 + (swz % 64) / 2; }
__host__ __device__ __forceinline__ int perm32(int rho) { const int n = rho >> 4, i = rho & 15; return 8 * (i >> 2) + 4 * n + (i & 3); }

struct Unit { int pm, pn, pc; };
struct Gemm { const bf16* A; const bf16* Bt; int K; };

struct StaticOrder {
    int nM, nN, nwg, G, c;
    __device__ void init(int M, int N, int G_, int c_) { nM = M / BM; nN = N / BM; nwg = nM * nN; G = G_; c = c_; }
    __device__ bool next(int i, Unit& u) const {
        const long L = (long)i * G + c; if (L >= nwg) return false;
        int wgid = (int)L; { const int q = nwg / NXCD, r = nwg % NXCD, xcd = wgid % NXCD, off = wgid / NXCD; wgid = (xcd < r ? xcd * (q + 1) : r * (q + 1) + (xcd - r) * q) + off; }
        const int nig = WGM * nN, gid = wgid / nig, fm = gid * WGM, gsz = (nM - fm) < WGM ? (nM - fm) : WGM;
        u.pm = fm + ((wgid % nig) % gsz); u.pn = (wgid % nig) / gsz; u.pc = u.pn; return true;
    }
};
struct GroupOrder {
    const int* tile_e; int ntiles, nN, G, c;
    __device__ bool next(int i, Unit& u) const {
        const long L = (long)i * G + c; if (L >= (long)ntiles * nN) return false;
        const int tile = (int)(L / nN), j = (int)(L % nN);
        u.pm = tile; u.pc = j; u.pn = tile_e[tile] * nN + j; return true;
    }
};

struct EpiBf16 {
    bf16* O; int ldc;
    __device__ __forceinline__ void operator()(const f32x4 (&acc)[2][2][4][2], const Unit& u, int wr, int wc, int fr, int fq) const {
        const int row0 = u.pm * BM + wr * 64 + fr, col0 = u.pc * BM + wc * 32 + 8 * fq;
#pragma unroll
        for (int ai = 0; ai < 2; ++ai)
#pragma unroll
            for (int m = 0; m < 4; ++m) { bf16* rowp = O + (size_t)(row0 + ai * HALF + m * 16) * ldc + col0;
#pragma unroll
                for (int bj = 0; bj < 2; ++bj) { const f32x4 v0 = acc[ai][bj][m][0], v1 = acc[ai][bj][m][1];
                    u32x4 w; w.x = pk2(v0[0], v0[1]); w.y = pk2(v0[2], v0[3]); w.z = pk2(v1[0], v1[1]); w.w = pk2(v1[2], v1[3]);
                    *(u32x4*)(rowp + bj * HALF) = w; } }
    }
};
struct EpiSwiglu {
    bf16* O;
    __device__ __forceinline__ void operator()(const f32x4 (&acc)[2][2][4][2], const Unit& u, int wr, int wc, int fr, int fq) const {
        const int row0 = u.pm * BM + wr * 64 + fr, col0 = u.pc * HALF + wc * 32 + 8 * fq;
#pragma unroll
        for (int ai = 0; ai < 2; ++ai)
#pragma unroll
            for (int m = 0; m < 4; ++m) { bf16* rowp = O + (size_t)(row0 + ai * HALF + m * 16) * DEXP + col0;
                float h[8];
#pragma unroll
                for (int n = 0; n < 2; ++n)
#pragma unroll
                    for (int j = 0; j < 4; ++j) { const float g = acc[ai][0][m][n][j], up = acc[ai][1][m][n][j]; h[n * 4 + j] = g / (1.f + __expf(-g)) * up; }
                u32x4 w; w.x = pk2(h[0], h[1]); w.y = pk2(h[2], h[3]); w.z = pk2(h[4], h[5]); w.w = pk2(h[6], h[7]);
                *(u32x4*)rowp = w; }
    }
};

template <class Epi, class Sched, bool GATHER>
__device__ __forceinline__ void gemm_phase(LAS unsigned char* lds, const Gemm g, const Sched& S, const Epi& E, const int* toks) {
    int tid_ = threadIdx.x; asm volatile("" : "+v"(tid_));
    const int tid = tid_, wid = __builtin_amdgcn_readfirstlane(tid >> 6), lane = tid & 63, wr = wid >> 2, wc = wid & 3, fr = lane & 15, fq = lane >> 4;
    const int K = g.K, nt = K / BK;
    int RA[2], CA[2]; unsigned voffA[2], voffB[2];
#pragma unroll
    for (int i = 0; i < 2; ++i) { int R, C; stage_rc(tid * 16 + i * 8192, R, C); const int Rb = (R & ~31) + perm32(R & 31); RA[i] = R; CA[i] = C; voffA[i] = (unsigned)(R * K + C) * 2u; voffB[i] = (unsigned)(Rb * K + C) * 2u; }
    const size_t kstep = (size_t)(BK * 2);
    const size_t hstep = (size_t)HALF * K * 2;
    const size_t tstep = 2 * hstep;
    const unsigned ldsw = (unsigned)wid * 1024u;
    const int aoff = lds_byte(wr * 64 + fr, fq * 8), boff = lds_byte(wc * 32 + fr, fq * 8);
#define PG8_SA(b, h) (((b) * 2 + (h)) * HTB)
#define PG8_SB(b, h) ((4 + (b) * 2 + (h)) * HTB)
#define PG8_STAGE(bufoff, gbase, voff) do { _Pragma("unroll") for (int _i = 0; _i < 2; ++_i) \
        __builtin_amdgcn_global_load_lds((const unsigned*)((const char*)(gbase) + (voff)[_i]), (LAS unsigned*)(lds + (bufoff) + ldsw + _i * 8192), 16, 0, 0); } while (0)
#define PG8_STAGEA(bufoff, kb, vo, ub, h) do { _Pragma("unroll") for (int _i = 0; _i < 2; ++_i) \
        __builtin_amdgcn_global_load_lds((const unsigned*)(GATHER ? (const char*)g.A + (kb) + (vo)[h][_i] : (ub) + (kb) + (h) * hstep + voffA[_i]), (LAS unsigned*)(lds + (bufoff) + ldsw + _i * 8192), 16, 0, 0); } while (0)
#define PG8_LDA(dst, b, h) do { _Pragma("unroll") for (int m = 0; m < 4; ++m) _Pragma("unroll") for (int k = 0; k < 2; ++k) dst[m][k] = *(const LAS bf16x8*)(lds + PG8_SA(b, h) + aoff + m * 2048 + k * 1024); } while (0)
#define PG8_LDB(dst, b, h) do { _Pragma("unroll") for (int n = 0; n < 2; ++n) _Pragma("unroll") for (int k = 0; k < 2; ++k) dst[n][k] = *(const LAS bf16x8*)(lds + PG8_SB(b, h) + boff + n * 2048 + k * 1024); } while (0)
#define PG8_MMA(ai, bj, At, Bt) do { __builtin_amdgcn_s_setprio(1); _Pragma("unroll") for (int m = 0; m < 4; ++m) _Pragma("unroll") for (int n = 0; n < 2; ++n) _Pragma("unroll") for (int k = 0; k < 2; ++k) \
        acc[ai][bj][m][n] = __builtin_amdgcn_mfma_f32_16x16x32_bf16(Bt[n][k], At[m][k], acc[ai][bj][m][n], 0, 0, 0); __builtin_amdgcn_s_setprio(0); } while (0)
#define PG8_WAIT_V(n) asm volatile("s_waitcnt vmcnt(" #n ")" ::: "memory")
#define PG8_WAIT_L(n) asm volatile("s_waitcnt lgkmcnt(" #n ")" ::: "memory")
#define PG8_BAR __builtin_amdgcn_s_barrier()
#define PG8_SCHED __builtin_amdgcn_sched_barrier(0)
#define PG8_VOA(dst, un) do { if (GATHER) { _Pragma("unroll") for (int _h = 0; _h < 2; ++_h) _Pragma("unroll") for (int _i = 0; _i < 2; ++_i) { \
        const int _lr = (un).pm * BM + _h * HALF + RA[_i]; const int _row = toks[_lr]; dst[_h][_i] = (unsigned)(_row * K + CA[_i]) * 2u; } \
        asm volatile("" : "+v"(dst[0][0]), "+v"(dst[0][1]), "+v"(dst[1][0]), "+v"(dst[1][1])); } } while (0)
    Unit cur, nxt; int ui = 0;
    if (!S.next(0, cur)) return;
    f32x4 acc[2][2][4][2];
#pragma unroll
    for (int a = 0; a < 2; ++a)
#pragma unroll
        for (int b = 0; b < 2; ++b)
#pragma unroll
            for (int m = 0; m < 4; ++m)
#pragma unroll
                for (int n = 0; n < 2; ++n) acc[a][b][m][n] = (f32x4){0.f, 0.f, 0.f, 0.f};
    bf16x8 At[4][2], B0[2][2], B1[2][2];
    unsigned voA[2][2] = {{0u, 0u}, {0u, 0u}}, voN[2][2] = {{0u, 0u}, {0u, 0u}};
    PG8_VOA(voA, cur);
    const char* cA = (const char*)g.A + (size_t)cur.pm * tstep;
    const char* cB = (const char*)g.Bt + (size_t)cur.pn * tstep;
    PG8_STAGE(PG8_SB(0, 0), cB, voffB); PG8_STAGEA(PG8_SA(0, 0), 0, voA, cA, 0); PG8_STAGE(PG8_SB(0, 1), cB + hstep, voffB); PG8_STAGEA(PG8_SA(0, 1), 0, voA, cA, 1);
    if (wr == 1) PG8_BAR;
    PG8_WAIT_V(4); PG8_BAR;
    PG8_STAGE(PG8_SB(1, 0), cB + kstep, voffB); PG8_STAGEA(PG8_SA(1, 0), kstep, voA, cA, 0); PG8_STAGE(PG8_SB(1, 1), cB + hstep + kstep, voffB);
    PG8_WAIT_V(6); PG8_BAR;
    for (;;) {
        const bool has_next = S.next(ui + 1, nxt);
        if (has_next) { PG8_VOA(voN, nxt); }
        else if (GATHER) {
#pragma unroll
            for (int _h = 0; _h < 2; ++_h)
#pragma unroll
                for (int _i = 0; _i < 2; ++_i) voN[_h][_i] = voA[_h][_i]; }
        const char* nA = has_next ? (const char*)g.A + (size_t)nxt.pm * tstep : cA;
        const char* nB = has_next ? (const char*)g.Bt + (size_t)nxt.pn * tstep : cB;
        for (int t = 0; t < nt; t += 2) {
            const bool last = (t == nt - 2);
            const size_t k1 = (size_t)(t + 1) * kstep;
            const size_t k2 = last ? 0 : (size_t)(t + 2) * kstep, k3 = k2 + kstep;
            const char* b2 = last ? nB : cB + (size_t)(t + 2) * kstep; const char* b3 = b2 + kstep;
            unsigned vo2[2][2] = {{0u, 0u}, {0u, 0u}};
            if (GATHER) {
#pragma unroll
                for (int _h = 0; _h < 2; ++_h)
#pragma unroll
                    for (int _i = 0; _i < 2; ++_i) vo2[_h][_i] = last ? voN[_h][_i] : voA[_h][_i]; }
            const char* a2 = last ? nA : cA;
            PG8_LDB(B0, 0, 0); PG8_SCHED; PG8_LDA(At, 0, 0); PG8_STAGEA(PG8_SA(1, 1), k1, voA, cA, 1);
            PG8_WAIT_L(8); PG8_BAR; PG8_WAIT_L(0); PG8_MMA(0, 0, At, B0); PG8_BAR; PG8_SCHED;
            PG8_LDB(B1, 0, 1); PG8_STAGE(PG8_SB(0, 0), b2, voffB);
            PG8_BAR; PG8_WAIT_L(0); PG8_MMA(0, 1, At, B1); PG8_BAR;
            PG8_LDA(At, 0, 1); PG8_STAGEA(PG8_SA(0, 0), k2, vo2, a2, 0);
            PG8_BAR; PG8_WAIT_L(0); PG8_MMA(1, 0, At, B0); PG8_BAR; PG8_SCHED;
            PG8_STAGE(PG8_SB(0, 1), b2 + hstep, voffB);
            PG8_WAIT_V(6); PG8_BAR; PG8_MMA(1, 1, At, B1); PG8_BAR;
            PG8_LDB(B0, 1, 0); PG8_SCHED; PG8_LDA(At, 1, 0); PG8_STAGEA(PG8_SA(0, 1), k2, vo2, a2, 1);
            PG8_WAIT_L(8); PG8_BAR; PG8_WAIT_L(0); PG8_MMA(0, 0, At, B0); PG8_BAR; PG8_SCHED;
            PG8_LDB(B1, 1, 1); PG8_STAGE(PG8_SB(1, 0), b3, voffB);
            PG8_BAR; PG8_WAIT_L(0); PG8_MMA(0, 1, At, B1); PG8_BAR;
            PG8_LDA(At, 1, 1); PG8_STAGEA(PG8_SA(1, 0), k3, vo2, a2, 0);
            PG8_BAR; PG8_WAIT_L(0); PG8_MMA(1, 0, At, B0); PG8_BAR; PG8_SCHED;
            PG8_STAGE(PG8_SB(1, 1), b3 + hstep, voffB);
            PG8_WAIT_V(6); PG8_BAR; PG8_MMA(1, 1, At, B1); PG8_BAR;
        }
        E(acc, cur, wr, wc, fr, fq);
        if (!has_next) break;
#pragma unroll
        for (int a = 0; a < 2; ++a)
#pragma unroll
            for (int b = 0; b < 2; ++b)
#pragma unroll
                for (int m = 0; m < 4; ++m)
#pragma unroll
                    for (int n = 0; n < 2; ++n) acc[a][b][m][n] = (f32x4){0.f, 0.f, 0.f, 0.f};
        cur = nxt; cA = nA; cB = nB; ++ui;
        if (GATHER) {
#pragma unroll
            for (int _h = 0; _h < 2; ++_h)
#pragma unroll
                for (int _i = 0; _i < 2; ++_i) voA[_h][_i] = voN[_h][_i]; }
    }
    PG8_WAIT_V(0);
    if (wr == 0) PG8_BAR;
    PG8_BAR;
#undef PG8_SA
#undef PG8_SB
#undef PG8_STAGE
#undef PG8_STAGEA
#undef PG8_LDA
#undef PG8_LDB
#undef PG8_MMA
#undef PG8_WAIT_V
#undef PG8_WAIT_L
#undef PG8_BAR
#undef PG8_SCHED
#undef PG8_VOA
}
}
struct Params {
    const GAS float* in[26];
    GAS float* out;
    GAS unsigned char* ws;
    int ph_lo, ph_hi;
};
typedef const Params __attribute__((address_space(4))) CParams;
constexpr int NPH = 13;
constexpr int WAVE_LDS = 18432;
constexpr int LDS_MISC = 8 * WAVE_LDS;
constexpr int LDS_BYTES = LDS_MISC + 1024;

struct Ctx {
    LAS unsigned char* lds; int tid, lane, wave, gw, ngw, L;
    CParams* p;
    unsigned char* ws;
};
DI unsigned char* fresh(GAS unsigned char* q) { asm volatile("" : "+s"(q)); return (unsigned char*)q; }
#define inp(c, k) ((const float*)(c).p->in[k])
#define outp(c) ((float*)(c).p->out)

DI void transpose_item(const float* W, int K, int N, bf16* WT, int drow0, LAS float* scr, int kb, int nb, int lane, bool lo_part) {
    const int k0 = 64 * kb, n0 = 32 * nb;
#pragma unroll 8
    for (int i = 0; i < 32; ++i) { const int kk = 2 * i + (lane >> 5); scr[kk * 33 + (lane & 31)] = W[(size_t)(k0 + kk) * N + n0 + (lane & 31)]; }
    asm volatile("s_waitcnt lgkmcnt(0)" ::: "memory");
    const int c = lane & 7;
#pragma unroll
    for (int j = 0; j < 4; ++j) { const int n = (lane >> 3) + 8 * j; const LAS float* s = scr + (8 * c) * 33 + n;
        float v[8];
#pragma unroll
        for (int q = 0; q < 8; ++q) { v[q] = s[q * 33]; if (lo_part) v[q] = v[q] - bf2f(f2bf(v[q])); }
        u32x4 o; o.x = pk2(v[0], v[1]); o.y = pk2(v[2], v[3]); o.z = pk2(v[4], v[5]); o.w = pk2(v[6], v[7]);
        *(u32x4*)(WT + (size_t)(drow0 + n) * K + k0 + 8 * c) = o; }
    asm volatile("s_waitcnt lgkmcnt(0)" ::: "memory");
}

DI void phase0(const Ctx& c) {
    const int L = c.L;
    unsigned char* ws = c.ws;
    {
        LAS float* sc = (LAS float*)c.lds;
        LAS float* part = (LAS float*)(c.lds + 32768);
        for (int i = c.tid; i < 3 * D; i += 512) { const int r = i / D, k = i % D; const float v = r < 2 ? inp(c, 1)[r * D + k] : inp(c, 3)[k]; sc[i] = v / (1.f + __expf(-v)); }
        __syncthreads();
        const float* wa = inp(c, 4) + (size_t)L * D * 6 * D; const float* ba = inp(c, 5) + (size_t)L * 6 * D;
        float* mod = (float*)(ws + WS_MOD);
        for (int cb = blockIdx.x; cb < 256; cb += gridDim.x) {
            const int n0 = cb * 48;
            float a0 = 0.f, a1 = 0.f, a2 = 0.f;
            if (c.lane < 48) {
                const float* wp = wa + (size_t)(c.wave * 256) * (6 * D) + n0 + c.lane;
#pragma unroll 8
                for (int k = 0; k < 256; ++k) { const float w = wp[(size_t)k * (6 * D)]; const int kk = c.wave * 256 + k; a0 += sc[kk] * w; a1 += sc[D + kk] * w; a2 += sc[2 * D + kk] * w; }
                part[(c.wave * 3 + 0) * 48 + c.lane] = a0; part[(c.wave * 3 + 1) * 48 + c.lane] = a1; part[(c.wave * 3 + 2) * 48 + c.lane] = a2;
            }
            __syncthreads();
            if (c.tid < 144) { const int r = c.tid / 48, j = c.tid % 48; float s = 0.f;
#pragma unroll
                for (int w = 0; w < 8; ++w) s += part[(w * 3 + r) * 48 + j];
                mod[r * 6 * D + n0 + j] = s + ba[n0 + j]; }
            __syncthreads();
        }
    }
    {
        LAS float* scr = (LAS float*)(c.lds + c.wave * WAVE_LDS);
        constexpr int I_IN = 32 * (PW / 32), I_OUT = 32 * 64, I_E = 1536, I_R = 64;
        constexpr int NIT = I_IN + I_OUT + 65 * I_E + 2 * I_R;
        bf16* win = (bf16*)(ws + WS_WIN); bf16* wout = (bf16*)(ws + WS_WOUT); bf16* wgu = (bf16*)(ws + WS_WGU); bf16* wd = (bf16*)(ws + WS_WD); bf16* rw = (bf16*)(ws + WS_ROUTW);
        for (int it = c.gw; it < NIT; it += c.ngw) {
            int r = it;
            if (r < I_IN) { const int nblk = PW / 32; transpose_item(inp(c, 6) + (size_t)L * D * PW, D, PW, win, 32 * (r % nblk), scr, r / nblk, r % nblk, c.lane, false); continue; } r -= I_IN;
            if (r < I_OUT) { transpose_item(inp(c, 13) + (size_t)L * D * D, D, D, wout, 32 * (r % 64), scr, r / 64, r % 64, c.lane, false); continue; } r -= I_OUT;
            if (r < 65 * I_E) {
                const int e = r / I_E, q = r % I_E, which = q / 512, idx = q % 512;
                if (which < 2) {
                    const float* W = e < 64 ? inp(c, which == 0 ? 18 : 19) + ((size_t)(L * 64 + e)) * D * DEXP : inp(c, which == 0 ? 21 : 22) + (size_t)L * D * DEXP;
                    const int kb = idx / 16, nb = idx % 16, n0 = 32 * nb;
                    transpose_item(W, D, DEXP, wgu, e * 1024 + (n0 / 128) * 256 + which * 128 + (n0 % 128), scr, kb, nb, c.lane, false);
                } else {
                    const float* W = e < 64 ? inp(c, 20) + ((size_t)(L * 64 + e)) * DEXP * D : inp(c, 23) + (size_t)L * DEXP * D;
                    const int kb = idx / 64, nb = idx % 64;
                    transpose_item(W, DEXP, D, wd, e * 2048 + 32 * nb, scr, kb, nb, c.lane, false);
                }
                continue; }
            r -= 65 * I_E;
            { const int lo = r / I_R, idx = r % I_R, kb = idx / 2, nb = idx % 2;
              transpose_item(inp(c, 16) + (size_t)L * D * NEXP, D, NEXP, rw, lo * 64 + 32 * nb, scr, kb, nb, c.lane, lo != 0); }
        }
    }
    if (L == 0) {
        float* rope = (float*)(ws + WS_ROPE);
        for (int i = blockIdx.x * 512 + c.tid; i < 128 * 16; i += gridDim.x * 512) {
            const int pos = i / 16, f = i % 16;
            const float inv = exp2f(-(float)f * (13.287712379549449f / 16.f));
            const float ang = (float)pos * inv;
            const float n = rintf(ang * 0.15915494309189535f);
            float rr = fmaf(-n, 6.28125f, ang); rr = fmaf(-n, 1.9353071795864769e-3f, rr);
            rope[2 * i] = __cosf(rr); rope[2 * i + 1] = __sinf(rr);
        }
    }
}

DI void row_stats(const f32x4 (&v)[8], float& mean, float& rstd) {
    float s = 0.f;
#pragma unroll
    for (int j = 0; j < 8; ++j) s += (v[j].x + v[j].y) + (v[j].z + v[j].w);
    mean = wave_sum(s) * (1.f / D);
    float q = 0.f;
#pragma unroll
    for (int j = 0; j < 8; ++j) { const f32x4 d = v[j] - mean; q += (d.x * d.x + d.y * d.y) + (d.z * d.z + d.w * d.w); }
    rstd = 1.f / sqrtf(wave_sum(q) * (1.f / D) + LN_EPS);
}
DI const float* mod_row(const Ctx& c, int row) { return (const float*)(c.ws + WS_MOD) + (size_t)(row < NLAT ? row / SEQ : 2) * 6 * D; }
DI const float* x_in_row(const Ctx& c, int row) {

    if (row < NLAT) return (c.L == 0 ? inp(c, 0) : (const float*)outp(c)) + (size_t)row * D;
    return (c.L == 0 ? inp(c, 2) : (const float*)(c.ws + WS_HCTX)) + (size_t)(row - NLAT) * D;
}

DI void phase1(const Ctx& c) {
    bf16* xn = (bf16*)(c.ws + WS_XN);
    for (int row = c.gw; row < NTOK; row += c.ngw) {
        const float* xr = x_in_row(c, row); const float* mod = mod_row(c, row);
        f32x4 v[8];
#pragma unroll
        for (int j = 0; j < 8; ++j) v[j] = *(const f32x4*)(xr + 4 * c.lane + 256 * j);
        float mean, rstd; row_stats(v, mean, rstd);
#pragma unroll
        for (int j = 0; j < 8; ++j) { const int col = 4 * c.lane + 256 * j;
            const f32x4 sh = *(const f32x4*)(mod + col), sc = *(const f32x4*)(mod + D + col);
            const f32x4 y = (v[j] - mean) * rstd * (sc + 1.f) + sh;
            u32x2 o; o.x = pk2(y.x, y.y); o.y = pk2(y.z, y.w);
            *(u32x2*)(xn + (size_t)row * D + col) = o; }
    }
}

DI void phase7(const Ctx& c) {
    const int L = c.L;
    bf16* xn = (bf16*)(c.ws + WS_XN); const bf16* T = (const bf16*)(c.ws + WS_T); float* x1 = (float*)(c.ws + WS_X1); float* stats = (float*)(c.ws + WS_STATS);
    const float* lg = inp(c, 14) + (size_t)L * D; const float* lb = inp(c, 15) + (size_t)L * D;
    const int nrows = L == 0 ? NTOK : NLAT;
    for (int row = c.gw; row < nrows; row += c.ngw) {
        const float* xr = x_in_row(c, row); const float* mod = mod_row(c, row);
        f32x4 v[8];
#pragma unroll
        for (int j = 0; j < 8; ++j) { const int col = 4 * c.lane + 256 * j;
            const f32x4 x = *(const f32x4*)(xr + col), g = *(const f32x4*)(mod + 2 * D + col);
            const u32x2 t = *(const u32x2*)(T + (size_t)row * D + col);
            const f32x4 tf = (f32x4){lo16(t.x), hi16(t.x), lo16(t.y), hi16(t.y)};
            v[j] = x * DN_ALPHA + g * tf; }
        float mean, rstd; row_stats(v, mean, rstd);
#pragma unroll
        for (int j = 0; j < 8; ++j) { const int col = 4 * c.lane + 256 * j;
            v[j] = (v[j] - mean) * rstd * *(const f32x4*)(lg + col) + *(const f32x4*)(lb + col);
            *(f32x4*)(x1 + (size_t)row * D + col) = v[j]; }
        row_stats(v, mean, rstd);
        if (c.lane == 0) { stats[2 * row] = mean; stats[2 * row + 1] = rstd; }
#pragma unroll
        for (int j = 0; j < 8; ++j) { const int col = 4 * c.lane + 256 * j;
            const f32x4 sh = *(const f32x4*)(mod + 3 * D + col), sc = *(const f32x4*)(mod + 4 * D + col);
            const f32x4 y = (v[j] - mean) * rstd * (sc + 1.f) + sh;
            u32x2 o; o.x = pk2(y.x, y.y); o.y = pk2(y.z, y.w);
            *(u32x2*)(xn + (size_t)row * D + col) = o; }
    }
}
constexpr int VSTR = 144;
struct AttnAcc { f32x16 o0, o1; float m, l; };
DI void attn_init(AttnAcc& a) { a.o0 = zero16(); a.o1 = zero16(); a.m = -INFINITY; a.l = 0.f; }

template <class ScoreF>
DI void attn_tile(AttnAcc& a, const bf16x8 (&qf)[4], const bf16x8 (&kf)[4], const bf16* vsrc, LAS unsigned char* vl, int lane, ScoreF sf) {
    const int half = lane >> 5;
    {
        const u32x4* s = (const u32x4*)vsrc; LAS unsigned char* d = vl + (lane >> 1) * VSTR + (lane & 1) * 64;
        const u32x4 v0 = s[0], v1 = s[1], v2 = s[2], v3 = s[3];
        *(LAS u32x4*)(d) = v0; *(LAS u32x4*)(d + 16) = v1; *(LAS u32x4*)(d + 32) = v2; *(LAS u32x4*)(d + 48) = v3;
    }
    f32x16 st = zero16();
#pragma unroll
    for (int s = 0; s < 4; ++s) st = MFMA32(kf[s], qf[s], st);
    float sc[16]; float mx = -INFINITY;
#pragma unroll
    for (int r = 0; r < 16; ++r) { sc[r] = sf(crow(r, half), st[r]); mx = fmaxf(mx, sc[r]); }
    mx = fmaxf(mx, __shfl_xor(mx, 32));
    const float mnew = fmaxf(a.m, mx);
    const float muse = (mnew == -INFINITY) ? 0.f : mnew;
    const float corr = __expf(a.m - muse);
    float ps = 0.f;
#pragma unroll
    for (int r = 0; r < 16; ++r) { sc[r] = __expf(sc[r] - muse); ps += sc[r]; }
    ps += __shfl_xor(ps, 32);
    a.l = a.l * corr + ps; a.m = mnew;
#pragma unroll
    for (int r = 0; r < 16; ++r) { a.o0[r] *= corr; a.o1[r] *= corr; }
    const bf16x8 pb0 = pack8(sc[0], sc[1], sc[2], sc[3], sc[4], sc[5], sc[6], sc[7]);
    const bf16x8 pb1 = pack8(sc[8], sc[9], sc[10], sc[11], sc[12], sc[13], sc[14], sc[15]);
    const int q = (lane & 15) >> 2, pp = lane & 3, blk = (lane >> 4) & 1;
    LAS unsigned char* vb = vl + (4 * half + q) * VSTR + (16 * blk + 4 * pp) * 2;
    { const bf16x8 A = cat4(tr_read(vb), tr_read(vb + 8 * VSTR)); a.o0 = MFMA32(A, pb0, a.o0); }
    { const bf16x8 A = cat4(tr_read(vb + 64), tr_read(vb + 8 * VSTR + 64)); a.o1 = MFMA32(A, pb0, a.o1); }
    { const bf16x8 A = cat4(tr_read(vb + 16 * VSTR), tr_read(vb + 24 * VSTR)); a.o0 = MFMA32(A, pb1, a.o0); }
    { const bf16x8 A = cat4(tr_read(vb + 16 * VSTR + 64), tr_read(vb + 24 * VSTR + 64)); a.o1 = MFMA32(A, pb1, a.o1); }
}
DI void attn_store(const AttnAcc& a, bf16* orow, int lane) {
    const int half = lane >> 5; const float inv = 1.f / a.l;
#pragma unroll
    for (int g = 0; g < 4; ++g) {
        u32x2 w0; w0.x = pk2(a.o0[4 * g] * inv, a.o0[4 * g + 1] * inv); w0.y = pk2(a.o0[4 * g + 2] * inv, a.o0[4 * g + 3] * inv);
        u32x2 w1; w1.x = pk2(a.o1[4 * g] * inv, a.o1[4 * g + 1] * inv); w1.y = pk2(a.o1[4 * g + 2] * inv, a.o1[4 * g + 3] * inv);
        *(u32x2*)(orow + 8 * g + 4 * half) = w0; *(u32x2*)(orow + 32 + 8 * g + 4 * half) = w1; }
}
DI void load_frags(bf16x8 (&f)[4], const bf16* row, int half) {
#pragma unroll
    for (int s = 0; s < 4; ++s) f[s] = *(const bf16x8*)(row + 16 * s + 8 * half);
}
DI void rope_frags(bf16x8 (&f)[4], int posr, int posc, int half, const float* rope) {
#pragma unroll
    for (int pr = 0; pr < 2; ++pr) {
        const int pos = pr == 0 ? posr : posc;
        const f32x4* t = (const f32x4*)(rope + (size_t)(pos * 16 + 8 * half) * 2);
        const f32x4 t0 = t[0], t1 = t[1], t2 = t[2], t3 = t[3];
        const float cs[16] = {t0.x, t0.y, t0.z, t0.w, t1.x, t1.y, t1.z, t1.w, t2.x, t2.y, t2.z, t2.w, t3.x, t3.y, t3.z, t3.w};
        float x1[8], x2[8]; unpack8(f[2 * pr], x1); unpack8(f[2 * pr + 1], x2);
        float y1[8], y2[8];
#pragma unroll
        for (int e = 0; e < 8; ++e) { const float co = cs[2 * e], si = cs[2 * e + 1]; y1[e] = x1[e] * co - x2[e] * si; y2[e] = x2[e] * co + x1[e] * si; }
        f[2 * pr] = pack8(y1[0], y1[1], y1[2], y1[3], y1[4], y1[5], y1[6], y1[7]);
        f[2 * pr + 1] = pack8(y2[0], y2[1], y2[2], y2[3], y2[4], y2[5], y2[6], y2[7]);
    }
}

DI void na_item(const Ctx& c, int item) {
    const bf16* P = (const bf16*)(c.ws + WS_P); bf16* Y = (bf16*)(c.ws + WS_YMIX);
    const int lane = c.lane, half = lane >> 5, j = lane & 31;
    const int cc = item & 1, h = (item >> 1) & 7, r = (item >> 4) & 127, b = item >> 11;
    const float* rpb = inp(c, 7) + (size_t)(c.L * 8 + h) * 15 * 31;
    LAS unsigned char* vl = c.lds + c.wave * WAVE_LDS;
    const int qrow = b * SEQ + r * 64 + 32 * cc + j;
    bf16x8 qf[4]; load_frags(qf, P + (size_t)qrow * PWP + NA_Q + h * 64, half);
    const int qc = 32 * cc + j;
    const int rs = min(max(r - 4, 0), 120);
    AttnAcc a; attn_init(a);
    for (int kr = 0; kr < 8; ++kr) {
        const float* brow = rpb + (rs + kr - r + 7) * 31;
        for (int ct = 0; ct < 2; ++ct) {
            int qc_ = qc; asm volatile("" : "+v"(qc_));
            const int qc = qc_; const int cstart = min(max(qc - 8, 0), 48);
            const int base = b * SEQ + (rs + kr) * 64 + 32 * ct;
            bf16x8 kf[4]; load_frags(kf, P + (size_t)(base + j) * PWP + NA_K + h * 64, half);
            const bf16* vsrc = P + (size_t)(base + (lane >> 1)) * PWP + NA_V + h * 64 + (lane & 1) * 32;
            attn_tile(a, qf, kf, vsrc, vl, lane, [&](int i, float raw) {
                const int kc = 32 * ct + i; const bool ok = (kc >= cstart) && (kc < cstart + 16);
                const int bi = min(max(kc - qc + 15, 0), 30);
                return ok ? raw * 0.125f + brow[bi] : -INFINITY; });
        }
    }
    for (int ct = 0; ct < 8; ++ct) {
        const int base = NLAT + b * CTXL + 32 * ct;
        bf16x8 kf[4]; load_frags(kf, P + (size_t)(base + j) * PWP + NA_K + h * 64, half);
        const bf16* vsrc = P + (size_t)(base + (lane >> 1)) * PWP + NA_V + h * 64 + (lane & 1) * 32;
        attn_tile(a, qf, kf, vsrc, vl, lane, [&](int, float raw) { return raw * 0.125f; });
    }
    attn_store(a, Y + (size_t)qrow * D + h * 64, lane);
}

DI void swa_item(const Ctx& c, int item) {
    const bf16* P = (const bf16*)(c.ws + WS_P); bf16* Y = (bf16*)(c.ws + WS_YMIX); const float* rope = (const float*)(c.ws + WS_ROPE);
    const int lane = c.lane, half = lane >> 5, j = lane & 31;
    const int hq = item & 7, qb = (item >> 3) & 255, b = item >> 11, kvh = hq >> 2;
    LAS unsigned char* vl = c.lds + c.wave * WAVE_LDS;
    const int i0 = 32 * qb, qi = i0 + j, qrow = b * SEQ + qi;
    bf16x8 qf[4]; load_frags(qf, P + (size_t)qrow * PWP + SW_Q + hq * 64, half);
    rope_frags(qf, qi >> 6, qi & 63, half, rope);
    AttnAcc a; attn_init(a);
    for (int m = 0; m < 9; ++m) {
        const int j0 = i0 - 128 + 32 * m;
        if (j0 < 0 || j0 >= SEQ) continue;
        const int kj = j0 + j;
        bf16x8 kf[4]; load_frags(kf, P + (size_t)(b * SEQ + kj) * PWP + SW_K + kvh * 64, half);
        rope_frags(kf, kj >> 6, kj & 63, half, rope);
        const bf16* vsrc = P + (size_t)(b * SEQ + j0 + (lane >> 1)) * PWP + SW_V + kvh * 64 + (lane & 1) * 32;
        attn_tile(a, qf, kf, vsrc, vl, lane, [&](int i, float raw) {
            const int dlt = j0 + i - qi; const bool ok = (dlt >= -128) && (dlt <= 128);
            return ok ? raw * 0.125f : -INFINITY; });
    }
    for (int ct = 0; ct < 8; ++ct) {
        const int base = NLAT + b * CTXL + 32 * ct;
        bf16x8 kf[4]; load_frags(kf, P + (size_t)(base + j) * PWP + SW_K + kvh * 64, half);
        const bf16* vsrc = P + (size_t)(base + (lane >> 1)) * PWP + SW_V + kvh * 64 + (lane & 1) * 32;
        attn_tile(a, qf, kf, vsrc, vl, lane, [&](int, float raw) { return raw * 0.125f; });
    }
    const float sink = inp(c, 12)[c.L * 8 + hq];
    a.l += __expf(sink - a.m);
    attn_store(a, Y + (size_t)qrow * D + 1536 + hq * 64, lane);
}

DI void ctx_attn_item(const Ctx& c, int item) {
    const bf16* P = (const bf16*)(c.ws + WS_P); bf16* Y = (bf16*)(c.ws + WS_YMIX);
    const int lane = c.lane, half = lane >> 5, j = lane & 31;
    const int h = item & 7, qb = (item >> 3) & 7, b = (item >> 6) & 1, kind = item >> 7;
    LAS unsigned char* vl = c.lds + c.wave * WAVE_LDS;
    const int qcol = kind == 0 ? NA_Q + h * 64 : SW_Q + h * 64;
    const int kcol = kind == 0 ? NA_K + h * 64 : SW_K + (h >> 2) * 64;
    const int vcol = kind == 0 ? NA_V + h * 64 : SW_V + (h >> 2) * 64;
    const int qrow = NLAT + b * CTXL + 32 * qb + j;
    bf16x8 qf[4]; load_frags(qf, P + (size_t)qrow * PWP + qcol, half);
    AttnAcc a; attn_init(a);
    for (int ct = 0; ct < 8; ++ct) {
        const int base = NLAT + b * CTXL + 32 * ct;
        bf16x8 kf[4]; load_frags(kf, P + (size_t)(base + j) * PWP + kcol, half);
        const bf16* vsrc = P + (size_t)(base + (lane >> 1)) * PWP + vcol + (lane & 1) * 32;
        attn_tile(a, qf, kf, vsrc, vl, lane, [&](int, float raw) { return raw * 0.125f; });
    }
    if (kind == 1) a.l += __expf(inp(c, 12)[c.L * 8 + h] - a.m);
    attn_store(a, Y + (size_t)qrow * D + (kind == 0 ? 0 : 1536) + h * 64, lane);
}

DI void conv_row(const Ctx& c, int row) {
    const bf16* P = (const bf16*)(c.ws + WS_P); bf16* Y = (bf16*)(c.ws + WS_YMIX);
    const int lane = c.lane, ch = 8 * lane;
    const float* w = inp(c, 8) + (size_t)c.L * 3 * 512;
    int pos, len; if (row < NLAT) { pos = row % SEQ; len = SEQ; } else { pos = (row - NLAT) % CTXL; len = CTXL; }
    float acc[8];
#pragma unroll
    for (int e = 0; e < 8; ++e) acc[e] = 0.f;
#pragma unroll
    for (int t = 0; t < 3; ++t) {
        const int q = pos + t - 1;
        if (q < 0 || q >= len) continue;
        const bf16* pr = P + (size_t)(row + t - 1) * PWP;
        float u[8], g[8]; unpack8(*(const bf16x8*)(pr + SC_U + ch), u); unpack8(*(const bf16x8*)(pr + SC_C + ch), g);
        const f32x4 w0 = *(const f32x4*)(w + t * 512 + ch), w1 = *(const f32x4*)(w + t * 512 + ch + 4);
        const float wv[8] = {w0.x, w0.y, w0.z, w0.w, w1.x, w1.y, w1.z, w1.w};
#pragma unroll
        for (int e = 0; e < 8; ++e) acc[e] += wv[e] * (g[e] * u[e]);
    }
    float gb[8]; unpack8(*(const bf16x8*)(P + (size_t)row * PWP + SC_B + ch), gb);
    *(bf16x8*)(Y + (size_t)row * D + 512 + ch) = pack8(gb[0] * acc[0], gb[1] * acc[1], gb[2] * acc[2], gb[3] * acc[3], gb[4] * acc[4], gb[5] * acc[5], gb[6] * acc[6], gb[7] * acc[7]);
}
constexpr int KSTR = 144, V2STR = 272;
DI int gla_row0(int b, int ck) { return ck < 8 ? NLAT + b * CTXL + 32 * ck : b * SEQ + 32 * (ck - 8); }
DI int gla_chain_pos(int dir, int ck) { return ck < 8 ? (dir == 0 ? ck : 7 - ck) : (dir == 0 ? ck : 8 + 255 - (ck - 8)); }

struct GlaGate { float w[16]; float bias; };
template <int DIR>
DI void gla_gate_load(const Ctx& c, int h, GlaGate& g) {

    const float* w2 = inp(c, 9) + (size_t)((c.L * 2 + DIR) * 16) * 256 + h * 64 + c.lane;
#pragma unroll
    for (int i = 0; i < 16; ++i) g.w[i] = w2[i * 256];
    g.bias = inp(c, 10)[(c.L * 2 + DIR) * 256 + h * 64 + c.lane];
}
template <int DIR>
DI float gla_la(const GlaGate& g, const bf16* prow) {
    const bf16* zr = prow + GL_Z + DIR * 16;
    float a[8], bq[8]; unpack8(*(const bf16x8*)zr, a); unpack8(*(const bf16x8*)(zr + 8), bq);
    float x = g.bias;
#pragma unroll
    for (int i = 0; i < 8; ++i) x += a[i] * g.w[i];
#pragma unroll
    for (int i = 0; i < 8; ++i) x += bq[i] * g.w[8 + i];
    return (fminf(x, 0.f) - __logf(1.f + __expf(-fabsf(x)))) * (1.f / 16.f);
}
DI void gla_stage_v(const bf16* P, int row0, int h, LAS unsigned char* vl, int lane) {
#pragma unroll
    for (int i = 0; i < 8; ++i) { const int idx = lane + 64 * i, t = idx >> 4, ch = idx & 15;
        *(LAS u32x4*)(vl + t * V2STR + ch * 16) = *(const u32x4*)(P + (size_t)(row0 + t) * PWP + GL_V + h * 128 + ch * 8); }
}

template <int DIR>
DI void gla_g1(const Ctx& c, int b, int h, int ck) {
    const bf16* P = (const bf16*)(c.ws + WS_P);
    const int lane = c.lane, half = lane >> 5;
    LAS unsigned char* kl = c.lds + c.wave * WAVE_LDS; LAS unsigned char* vl = kl + 32 * KSTR;
    const int row0 = gla_row0(b, ck), n = gla_chain_pos(DIR, ck);
    const size_t chain = (size_t)((b * 2 + DIR) * 4 + h) * NCH + n;
    GlaGate gate; gla_gate_load<DIR>(c, h, gate);
    float rev = 0.f;
#pragma unroll 2
    for (int tt = 31; tt >= 0; --tt) {
        const int t = DIR ? 31 - tt : tt;
        const bf16* prow = P + (size_t)(row0 + t) * PWP;
        const float kv = bf2f(prow[GL_K + h * 64 + lane]);
        *(LAS bf16*)(kl + t * KSTR + 2 * lane) = f2bf(kv * __expf(rev));
        rev += gla_la<DIR>(gate, prow);
    }
    ((float*)(c.ws + WS_GDEC))[chain * 64 + lane] = __expf(rev);
    gla_stage_v(P, row0, h, vl, lane);
    const int q = (lane & 15) >> 2, pp = lane & 3, blk = (lane >> 4) & 1;
    bf16* ut = (bf16*)(c.ws + WS_UT) + chain * 8192;
    bf16x8 Bf[2][2];
#pragma unroll
    for (int nt = 0; nt < 2; ++nt)
#pragma unroll
        for (int s = 0; s < 2; ++s) { LAS unsigned char* a = kl + (16 * s + 8 * half + q) * KSTR + (32 * nt + 16 * blk + 4 * pp) * 2; Bf[nt][s] = cat4(tr_read(a), tr_read(a + 4 * KSTR)); }
#pragma unroll
    for (int mt = 0; mt < 4; ++mt) {
        bf16x8 Af[2];
#pragma unroll
        for (int s = 0; s < 2; ++s) { LAS unsigned char* a = vl + (16 * s + 8 * half + q) * V2STR + (32 * mt + 16 * blk + 4 * pp) * 2; Af[s] = cat4(tr_read(a), tr_read(a + 4 * V2STR)); }
#pragma unroll
        for (int nt = 0; nt < 2; ++nt) {
            f32x16 acc = zero16();
            acc = MFMA32(Af[0], Bf[nt][0], acc); acc = MFMA32(Af[1], Bf[nt][1], acc);
#pragma unroll
            for (int r = 0; r < 16; ++r) ut[(32 * mt + crow(r, half)) * 64 + 32 * nt + (lane & 31)] = f2bf(acc[r]);
        }
    }
}

DI void gla_scan(const Ctx& c) {

    const bf16* ut = (const bf16*)(c.ws + WS_UT); bf16* sin = (bf16*)(c.ws + WS_SIN); const float* gd = (const float*)(c.ws + WS_GDEC);
    for (int e = blockIdx.x * 512 + c.tid; e < 16 * 8192; e += gridDim.x * 512) {
        const int chain = e >> 13, el = e & 8191, k = el & 63;
        const size_t base = (size_t)chain * NCH * 8192 + el;
        const float* g = gd + (size_t)chain * NCH * 64 + k;
        float st = 0.f;
        for (int n0 = 0; n0 < NCH; n0 += 8) {
            float u[8], gg[8];
#pragma unroll
            for (int i = 0; i < 8; ++i) { u[i] = bf2f(ut[base + (size_t)(n0 + i) * 8192]); gg[i] = g[(n0 + i) * 64]; }
#pragma unroll
            for (int i = 0; i < 8; ++i) { sin[base + (size_t)(n0 + i) * 8192] = f2bf(st); st = gg[i] * st + u[i]; }
        }
    }
}

template <int DIR>
DI void gla_g3_dir(const Ctx& c, const bf16* P, int b, int h, int ck, int row0, LAS unsigned char* ql, LAS unsigned char* kl, LAS unsigned char* vl, f32x16 (&o)[4]) {
    const int lane = c.lane, half = lane >> 5, j = lane & 31;
    { GlaGate gate; gla_gate_load<DIR>(c, h, gate);
      float cum = 0.f;
#pragma unroll 2
      for (int tt = 0; tt < 32; ++tt) {
        const int t = DIR ? 31 - tt : tt;
        const bf16* prow = P + (size_t)(row0 + t) * PWP;
        cum += gla_la<DIR>(gate, prow);
        const float qv = bf2f(prow[GL_Q + h * 64 + lane]), kv = bf2f(prow[GL_K + h * 64 + lane]);
        *(LAS bf16*)(ql + t * KSTR + 2 * lane) = f2bf(qv * __expf(cum) * 0.125f);
        *(LAS bf16*)(kl + t * KSTR + 2 * lane) = f2bf(kv * __expf(-cum));
      } }
    bf16x8 qf[4], kf[4];
#pragma unroll
    for (int s = 0; s < 4; ++s) { qf[s] = *(const LAS bf16x8*)(ql + j * KSTR + (16 * s + 8 * half) * 2); kf[s] = *(const LAS bf16x8*)(kl + j * KSTR + (16 * s + 8 * half) * 2); }
    f32x16 at = zero16();
#pragma unroll
    for (int s = 0; s < 4; ++s) at = MFMA32(kf[s], qf[s], at);
    float a[16];
#pragma unroll
    for (int r = 0; r < 16; ++r) { const int s = crow(r, half); const bool ok = DIR ? (s >= j) : (s <= j); a[r] = ok ? at[r] : 0.f; }
    const bf16x8 pb0 = pack8(a[0], a[1], a[2], a[3], a[4], a[5], a[6], a[7]), pb1 = pack8(a[8], a[9], a[10], a[11], a[12], a[13], a[14], a[15]);
    const int q = (lane & 15) >> 2, pp = lane & 3, blk = (lane >> 4) & 1;
    const size_t chain = (size_t)((b * 2 + DIR) * 4 + h) * NCH + gla_chain_pos(DIR, ck);
    const bf16* sin = (const bf16*)(c.ws + WS_SIN) + chain * 8192;
#pragma unroll
    for (int mt = 0; mt < 4; ++mt) {
        LAS unsigned char* vb = vl + (4 * half + q) * V2STR + (32 * mt + 16 * blk + 4 * pp) * 2;
        o[mt] = MFMA32(cat4(tr_read(vb), tr_read(vb + 8 * V2STR)), pb0, o[mt]);
        o[mt] = MFMA32(cat4(tr_read(vb + 16 * V2STR), tr_read(vb + 24 * V2STR)), pb1, o[mt]);
#pragma unroll
        for (int s = 0; s < 4; ++s) o[mt] = MFMA32(*(const bf16x8*)(sin + (size_t)(32 * mt + j) * 64 + 16 * s + 8 * half), qf[s], o[mt]);
    }
}
DI void gla_g3(const Ctx& c, int b, int h, int ck) {
    const bf16* P = (const bf16*)(c.ws + WS_P); bf16* Y = (bf16*)(c.ws + WS_YMIX);
    const int lane = c.lane, half = lane >> 5, j = lane & 31;
    LAS unsigned char* ql = c.lds + c.wave * WAVE_LDS; LAS unsigned char* kl = ql + 32 * KSTR; LAS unsigned char* vl = kl + 32 * KSTR;
    const int row0 = gla_row0(b, ck);
    gla_stage_v(P, row0, h, vl, lane);
    f32x16 o[4];
#pragma unroll
    for (int mt = 0; mt < 4; ++mt) o[mt] = zero16();
    gla_g3_dir<0>(c, P, b, h, ck, row0, ql, kl, vl, o);
    gla_g3_dir<1>(c, P, b, h, ck, row0, ql, kl, vl, o);
    float ss = 0.f;
#pragma unroll
    for (int mt = 0; mt < 4; ++mt)
#pragma unroll
        for (int r = 0; r < 16; ++r) ss += o[mt][r] * o[mt][r];
    ss += __shfl_xor(ss, 32);
    const float rstd = 1.f / sqrtf(ss * (1.f / 128.f) + LN_EPS);
    const float* gain = inp(c, 11) + (size_t)c.L * 128;
    const int row = row0 + j;
#pragma unroll
    for (int mt = 0; mt < 4; ++mt)
#pragma unroll
        for (int g4 = 0; g4 < 4; ++g4) {
            const int v0 = 32 * mt + 8 * g4 + 4 * half;
            const u32x2 gr = *(const u32x2*)(P + (size_t)row * PWP + GL_G + h * 128 + v0);
            const float gv[4] = {lo16(gr.x), hi16(gr.x), lo16(gr.y), hi16(gr.y)};
            const f32x4 gn = *(const f32x4*)(gain + v0);
            float y[4];
#pragma unroll
            for (int e = 0; e < 4; ++e) { const float on = o[mt][4 * g4 + e] * rstd * gn[e]; y[e] = on * (gv[e] / (1.f + __expf(-gv[e]))); }
            u32x2 w; w.x = pk2(y[0], y[1]); w.y = pk2(y[2], y[3]);
            *(u32x2*)(Y + (size_t)row * D + 1024 + h * 128 + v0) = w; }
}
DI void router_item(const Ctx& c, int tile) {
    const int L = c.L, lane = c.lane, r16 = lane & 15, q = lane >> 4;
    const float* x1 = (const float*)(c.ws + WS_X1); const float* stats = (const float*)(c.ws + WS_STATS); const bf16* rw = (const bf16*)(c.ws + WS_ROUTW);
    const int row = tile * 16 + r16;
    const float* mod = mod_row(c, tile * 16);
    const float mean = stats[2 * row], rstd = stats[2 * row + 1];
    f32x4 acc[4];
#pragma unroll
    for (int nt = 0; nt < 4; ++nt) acc[nt] = (f32x4){0.f, 0.f, 0.f, 0.f};
    for (int ks = 0; ks < 64; ++ks) {
        const int k0 = 32 * ks + 8 * q;
        const f32x4 xa = *(const f32x4*)(x1 + (size_t)row * D + k0), xb = *(const f32x4*)(x1 + (size_t)row * D + k0 + 4);
        const f32x4 sha = *(const f32x4*)(mod + 3 * D + k0), shb = *(const f32x4*)(mod + 3 * D + k0 + 4), sca = *(const f32x4*)(mod + 4 * D + k0), scb = *(const f32x4*)(mod + 4 * D + k0 + 4);
        const f32x4 ya = (xa - mean) * rstd * (sca + 1.f) + sha, yb = (xb - mean) * rstd * (scb + 1.f) + shb;
        const bf16x8 ah = pack8(ya.x, ya.y, ya.z, ya.w, yb.x, yb.y, yb.z, yb.w);
        float hf[8]; unpack8(ah, hf);
        const bf16x8 al = pack8(ya.x - hf[0], ya.y - hf[1], ya.z - hf[2], ya.w - hf[3], yb.x - hf[4], yb.y - hf[5], yb.z - hf[6], yb.w - hf[7]);
#pragma unroll
        for (int nt = 0; nt < 4; ++nt) {
            const bf16x8 bh = *(const bf16x8*)(rw + (size_t)(16 * nt + r16) * D + k0), bl = *(const bf16x8*)(rw + (size_t)(64 + 16 * nt + r16) * D + k0);
            acc[nt] = MFMA16(ah, bh, acc[nt]); acc[nt] = MFMA16(al, bh, acc[nt]); acc[nt] = MFMA16(ah, bl, acc[nt]);
        }
    }
    LAS float* sc = (LAS float*)(c.lds + c.wave * WAVE_LDS);
    LAS float* sl = sc + 16 * 65;
    const float* rb = inp(c, 17) + (size_t)L * NEXP;
#pragma unroll
    for (int nt = 0; nt < 4; ++nt)
#pragma unroll
        for (int r = 0; r < 4; ++r) { const int e = 16 * nt + r16, t = 4 * q + r; const float s = 1.f / (1.f + __expf(-acc[nt][r])); sc[t * 65 + e] = s; sl[t * 65 + e] = s + rb[e]; }
    asm volatile("s_waitcnt lgkmcnt(0)" ::: "memory");
    if (lane < 16) {
        const int t = lane; const int tok = tile * 16 + t;
        float gs[8];
#pragma unroll
        for (int g = 0; g < 8; ++g) { float m1 = -INFINITY, m2 = -INFINITY;
#pragma unroll
            for (int e = 0; e < 8; ++e) { const float v = sl[t * 65 + 8 * g + e]; if (v > m1) { m2 = m1; m1 = v; } else if (v > m2) m2 = v; }
            gs[g] = m1 + m2; }
        unsigned gmask = 0u;
#pragma unroll
        for (int it = 0; it < 4; ++it) { float best = -INFINITY; int bi = 0;
#pragma unroll
            for (int g = 0; g < 8; ++g) { const bool fr = ((gmask >> g) & 1u) == 0u; if (fr && gs[g] > best) { best = gs[g]; bi = g; } }
            gmask |= 1u << bi; }
        unsigned long long chosen = 0ull; float wsum = 0.f; int ei[8]; float wi[8];
#pragma unroll
        for (int k = 0; k < 8; ++k) { float best = -INFINITY; int bi = 0;
            for (int e = 0; e < 64; ++e) { const bool ok = ((gmask >> (e >> 3)) & 1u) && !((chosen >> e) & 1ull); const float v = sl[t * 65 + e]; if (ok && v > best) { best = v; bi = e; } }
            chosen |= 1ull << bi; ei[k] = bi; wi[k] = sc[t * 65 + bi]; wsum += wi[k]; }
        int* eidx = (int*)(c.ws + WS_EIDX); int* rank = (int*)(c.ws + WS_RANK); float* wts = (float*)(c.ws + WS_WTS);
        unsigned* cnt = (unsigned*)(c.ws + WS_CTL) + CW_CNT + L * 64;
        const float sc25 = 2.5f / wsum;
#pragma unroll
        for (int k = 0; k < 8; ++k) { eidx[tok * 8 + k] = ei[k]; wts[tok * 8 + k] = wi[k] * sc25; rank[tok * 8 + k] = (int)atomicAdd(cnt + ei[k], 1u); }
    }
}

DI void phase9(const Ctx& c) {
    const int L = c.L;
    const int nmoe = L == 0 ? NTOK : NLAT;
    LAS int* ts = (LAS int*)c.lds;
    const unsigned* cnt = (const unsigned*)(c.ws + WS_CTL) + CW_CNT + L * 64;
    if (c.tid == 0) { int acc = 0; for (int e = 0; e < 64; ++e) { ts[e] = acc; acc += ((int)cnt[e] + 255) >> 8; } ts[64] = acc; ts[65] = acc + nmoe / 256; }
    __syncthreads();
    int* toks = (int*)(c.ws + WS_TOKS); int* pos = (int*)(c.ws + WS_POS); int* tile_e = (int*)(c.ws + WS_TILEE);
    const int* eidx = (const int*)(c.ws + WS_EIDX); const int* rank = (const int*)(c.ws + WS_RANK);
    const int gt = blockIdx.x * 512 + c.tid, ngt = gridDim.x * 512;
    for (int i = gt; i < nmoe * 8; i += ngt) { const int e = eidx[i]; const int slot = ts[e] * 256 + rank[i]; toks[slot] = i >> 3; pos[i] = slot; }
    for (int i = gt; i < nmoe; i += ngt) toks[ts[64] * 256 + i] = i;
    for (int e = blockIdx.x; e < 65; e += gridDim.x) {
        for (int t = ts[e] + c.tid; t < ts[e + 1]; t += 512) tile_e[t] = e;
        if (e < 64) { const int n = (int)cnt[e]; for (int s = n + c.tid; s < (ts[e + 1] - ts[e]) * 256; s += 512) toks[ts[e] * 256 + s] = 0; }
    }
    if (blockIdx.x == 0 && c.tid == 0) { int* nt = (int*)(c.ws + WS_CTL) + CW_NT + L * 64; nt[0] = ts[65]; nt[1] = ts[64]; }
    __syncthreads();
}

DI void phase12(const Ctx& c) {
    const int L = c.L;
    const int nmoe = L == 0 ? NTOK : NLAT;
    const bf16* Yb = (const bf16*)(c.ws + WS_Y); const float* x1 = (const float*)(c.ws + WS_X1);
    const int* pos = (const int*)(c.ws + WS_POS); const float* wts = (const float*)(c.ws + WS_WTS);
    const int sh_tile0 = ((const int*)(c.ws + WS_CTL))[CW_NT + L * 64 + 1];
    const float* lg = inp(c, 24) + (size_t)L * D; const float* lb = inp(c, 25) + (size_t)L * D;
    for (int row = c.gw; row < nmoe; row += c.ngw) {
        const float* mod = mod_row(c, row);
        f32x4 f[8];
        { const bf16* yr = Yb + ((size_t)sh_tile0 * 256 + row) * D;
#pragma unroll
          for (int j = 0; j < 8; ++j) { const u32x2 t = *(const u32x2*)(yr + 4 * c.lane + 256 * j); f[j] = (f32x4){lo16(t.x), hi16(t.x), lo16(t.y), hi16(t.y)}; } }
        for (int k = 0; k < 8; ++k) {
            const int slot = pos[row * 8 + k]; const float w = wts[row * 8 + k];
            const bf16* yr = Yb + (size_t)slot * D;
#pragma unroll
            for (int j = 0; j < 8; ++j) { const u32x2 t = *(const u32x2*)(yr + 4 * c.lane + 256 * j); f[j] += (f32x4){lo16(t.x), hi16(t.x), lo16(t.y), hi16(t.y)} * w; }
        }
        f32x4 v[8];
#pragma unroll
        for (int j = 0; j < 8; ++j) { const int col = 4 * c.lane + 256 * j; v[j] = *(const f32x4*)(x1 + (size_t)row * D + col) * DN_ALPHA + *(const f32x4*)(mod + 5 * D + col) * f[j]; }
        float mean, rstd; row_stats(v, mean, rstd);
        float* orow = row < NLAT ? outp(c) + (size_t)row * D : (float*)(c.ws + WS_HCTX) + (size_t)(row - NLAT) * D;
#pragma unroll
        for (int j = 0; j < 8; ++j) { const int col = 4 * c.lane + 256 * j; *(f32x4*)(orow + col) = (v[j] - mean) * rstd * *(const f32x4*)(lg + col) + *(const f32x4*)(lb + col); }
    }
}

__global__ void __launch_bounds__(512, 2) fwd(Params prm) {
    extern __shared__ __attribute__((aligned(16))) unsigned char lds_raw[];
    Ctx c; c.lds = (LAS unsigned char*)lds_raw; c.tid = threadIdx.x; c.lane = c.tid & 63; c.wave = __builtin_amdgcn_readfirstlane(c.tid >> 6);
    c.gw = blockIdx.x * 8 + c.wave; c.ngw = gridDim.x * 8; c.p = (CParams*)__builtin_amdgcn_kernarg_segment_ptr(); c.L = 0;
    volatile LAS unsigned* misc = (volatile LAS unsigned*)(c.lds + LDS_MISC);
    if (c.tid < 64) misc[c.tid] = 0u;
    __syncthreads();
    unsigned char* ws = (unsigned char*)prm.ws; c.ws = ws;
    XcdBarrier bar = xcd_barrier_post((unsigned*)(ws + WS_CTL) + CW_BAR, misc + 8);
    const int lo = prm.ph_lo, hi = prm.ph_hi;
#ifndef ONLY_PH
#define ONLY_PH -1
#endif
#ifndef PHMASK
#define PHMASK 0x1fff
#endif
#define IN(k) (lo <= (k) && (k) < hi && (ONLY_PH < 0 || ((k) % NPH) == ONLY_PH) && ((PHMASK >> ((k) % NPH)) & 1))
#define REFRESH() do { { CParams* kp_ = (CParams*)__builtin_amdgcn_kernarg_segment_ptr(); asm volatile("" : "+s"(kp_)); c.p = kp_; } ws = fresh(c.p->ws); c.ws = ws; int t_ = threadIdx.x; asm volatile("" : "+v"(t_)); c.tid = t_; c.lane = t_ & 63; c.wave = __builtin_amdgcn_readfirstlane(t_ >> 6); c.gw = blockIdx.x * 8 + c.wave; } while (0)
#define SEAM(k) do { if (IN(k) && IN((k) + 1)) xcd_barrier(bar); } while (0)
    for (int L = 0; L < 2; ++L) {
        c.L = L; const int pb = L * NPH;
        if (IN(pb + 0)) { REFRESH(); phase0(c); __syncthreads(); } SEAM(pb + 0);
        if (IN(pb + 1)) { REFRESH(); phase1(c); } SEAM(pb + 1);
        if (IN(pb + 2)) { REFRESH();
            pg8::Gemm g{(const bf16*)(ws + WS_XN), (const bf16*)(ws + WS_WIN), D}; pg8::StaticOrder S; S.init(NTOK, PWP, gridDim.x, blockIdx.x);
            pg8::EpiBf16 E{(bf16*)(ws + WS_P), PWP};
            pg8::gemm_phase<pg8::EpiBf16, pg8::StaticOrder, false>(c.lds, g, S, E, nullptr);
        } SEAM(pb + 2);
        if (IN(pb + 3)) { REFRESH();
            for (int it = c.gw; it < 4096; it += c.ngw) na_item(c, it);
            for (int it = c.gw; it < 4096; it += c.ngw) swa_item(c, it);
            for (int it = c.gw; it < 16 * NCH; it += c.ngw) { const int ck = it % NCH, h = (it / NCH) & 3, dir = (it / (NCH * 4)) & 1, b = it / (NCH * 8);
                if (dir == 0) gla_g1<0>(c, b, h, ck); else gla_g1<1>(c, b, h, ck); }
            if (L == 0) for (int it = c.gw; it < 256; it += c.ngw) ctx_attn_item(c, it);
            for (int row = c.gw; row < (L == 0 ? NTOK : NLAT); row += c.ngw) conv_row(c, row);
        } SEAM(pb + 3);
        if (IN(pb + 4)) { REFRESH(); gla_scan(c); } SEAM(pb + 4);
        if (IN(pb + 5)) { REFRESH();
            for (int it = c.gw; it < 8 * NCH; it += c.ngw) { const int ck = it % NCH, h = (it / NCH) & 3, b = it / (NCH * 4);
                if (ck < 8 && L != 0) continue;
                gla_g3(c, b, h, ck); }
        } SEAM(pb + 5);
        if (IN(pb + 6)) { REFRESH();
            pg8::Gemm g{(const bf16*)(ws + WS_YMIX), (const bf16*)(ws + WS_WOUT), D}; pg8::StaticOrder S; S.init(L == 0 ? NTOK : NLAT, D, gridDim.x, blockIdx.x);
            pg8::EpiBf16 E{(bf16*)(ws + WS_T), D};
            pg8::gemm_phase<pg8::EpiBf16, pg8::StaticOrder, false>(c.lds, g, S, E, nullptr);
        } SEAM(pb + 6);
        if (IN(pb + 7)) { REFRESH(); phase7(c); } SEAM(pb + 7);
        if (IN(pb + 8)) { REFRESH(); for (int it = c.gw; it < (L == 0 ? NTOK : NLAT) / 16; it += c.ngw) router_item(c, it); } SEAM(pb + 8);
        if (IN(pb + 9)) { REFRESH(); phase9(c); } SEAM(pb + 9);
        if (IN(pb + 10)) { REFRESH();
            const int* ntp = (const int*)(ws + WS_CTL) + CW_NT + L * 64;
            pg8::Gemm g{(const bf16*)(ws + WS_XN), (const bf16*)(ws + WS_WGU), D};
            pg8::GroupOrder S{(const int*)(ws + WS_TILEE), ntp[0], 4, (int)gridDim.x, (int)blockIdx.x};
            pg8::EpiSwiglu E{(bf16*)(ws + WS_H)};
            pg8::gemm_phase<pg8::EpiSwiglu, pg8::GroupOrder, true>(c.lds, g, S, E, (const int*)(ws + WS_TOKS));
        } SEAM(pb + 10);
        if (IN(pb + 11)) { REFRESH();
            const int* ntp = (const int*)(ws + WS_CTL) + CW_NT + L * 64;
            pg8::Gemm g{(const bf16*)(ws + WS_H), (const bf16*)(ws + WS_WD), DEXP};
            pg8::GroupOrder S{(const int*)(ws + WS_TILEE), ntp[0], 8, (int)gridDim.x, (int)blockIdx.x};
            pg8::EpiBf16 E{(bf16*)(ws + WS_Y), D};
            pg8::gemm_phase<pg8::EpiBf16, pg8::GroupOrder, false>(c.lds, g, S, E, nullptr);
        } SEAM(pb + 11);
        if (IN(pb + 12)) { REFRESH(); phase12(c); } SEAM(pb + 12);
    }
#undef IN
#undef SEAM
}

#ifndef MK_ONE_LAUNCH
#define MK_ONE_LAUNCH 1
#endif
extern "C" void kernel_launch(void* const* d_in, const int* in_sizes, int n_in, void* d_out, int out_size, void* d_ws, size_t ws_size, hipStream_t stream) {
    static int grid = 0;
    if (grid == 0) {
        if (n_in != 26 || out_size != NLAT * D || ws_size < WS_END) { fprintf(stderr, "kernel_launch: unexpected shapes (n_in %d out %d ws %zu)\n", n_in, out_size, ws_size); grid = -1; return; }
        int dev = 0, cus = 0;
        if (hipGetDevice(&dev) != hipSuccess || hipDeviceGetAttribute(&cus, hipDeviceAttributeMultiprocessorCount, dev) != hipSuccess) { grid = -1; return; }
        if (hipFuncSetAttribute((const void*)fwd, hipFuncAttributeMaxDynamicSharedMemorySize, LDS_BYTES) != hipSuccess) { fprintf(stderr, "kernel_launch: hipFuncSetAttribute failed\n"); grid = -1; return; }
        int per_cu = 0;
        if (hipOccupancyMaxActiveBlocksPerMultiprocessor(&per_cu, (const void*)fwd, 512, LDS_BYTES) != hipSuccess || per_cu < 1) fprintf(stderr, "kernel_launch: occupancy query reports %d\n", per_cu);
        (void)hipGetLastError();
        grid = cus;
    }
    if (grid < 0) return;
    hipMemsetAsync((char*)d_ws + WS_CTL, 0, CTL_BYTES, stream);
    Params prm{};
    for (int i = 0; i < 26; ++i) prm.in[i] = (const GAS float*)d_in[i];
    prm.out = (GAS float*)d_out; prm.ws = (GAS unsigned char*)d_ws;
#if MK_ONE_LAUNCH
    prm.ph_lo = 0; prm.ph_hi = 2 * NPH;
    hipLaunchKernelGGL(fwd, dim3(grid), dim3(512), LDS_BYTES, stream, prm);
#else
    for (int ph = 0; ph < 2 * NPH; ++ph) { prm.ph_lo = ph; prm.ph_hi = ph + 1; hipLaunchKernelGGL(fwd, dim3(grid), dim3(512), LDS_BYTES, stream, prm); }
#endif
}
```

```cpp
#include <hip/hip_runtime.h>
#include <cstdio>

#define DI __device__ __forceinline__
#define LAS __attribute__((address_space(3)))
#if defined(__HIP_DEVICE_COMPILE__)
#define GAS __attribute__((address_space(1)))
#else
#define GAS
#endif
typedef unsigned short bf16;
typedef short bf16x8 __attribute__((ext_vector_type(8)));
typedef short s16x4 __attribute__((ext_vector_type(4)));
typedef float f32x2 __attribute__((ext_vector_type(2)));
typedef float f32x4 __attribute__((ext_vector_type(4)));
typedef float f32x8 __attribute__((ext_vector_type(8)));
typedef float f32x16 __attribute__((ext_vector_type(16)));
typedef unsigned u32x2 __attribute__((ext_vector_type(2)));
typedef unsigned u32x4 __attribute__((ext_vector_type(4)));
typedef __bf16 hbf16x2 __attribute__((ext_vector_type(2)));

constexpr int D = 2048, SEQ = 8192, CTXL = 256, NB = 2;
constexpr int NLAT = NB * SEQ, NCTX = NB * CTXL, NTOK = NLAT + NCTX;
constexpr int PW = 5408, PWP = 5632;
constexpr int NA_Q = 0, NA_K = 512, NA_V = 1024, SC_U = 1536, SC_B = 2048, SC_C = 2560, GL_Q = 3072, GL_K = 3328, GL_V = 3584, GL_G = 4096, GL_Z = 4608, SW_Q = 4640, SW_K = 5152, SW_V = 5280;
constexpr int NEXP = 64, DEXP = 512, NCH = 264;
constexpr int MAXTILES = 658;
constexpr float LN_EPS = 1e-6f, DN_ALPHA = 1.41421356237f;

constexpr size_t MiB = 1u << 20;
constexpr size_t WS_CTL = 0, CTL_BYTES = MiB;
constexpr size_t WS_MOD = 1 * MiB, WS_ROPE = 1 * MiB + 512 * 1024, WS_STATS = 2 * MiB, WS_ROUTW = 3 * MiB, WS_EIDX = 4 * MiB, WS_RANK = 5 * MiB, WS_WTS = 6 * MiB, WS_POS = 7 * MiB,
                 WS_TOKS = 8 * MiB, WS_TILEE = 9 * MiB, WS_GDEC = 10 * MiB, WS_HCTX = 12 * MiB, WS_WIN = 16 * MiB, WS_WOUT = 38 * MiB, WS_WGU = 46 * MiB, WS_WD = 306 * MiB,
                 WS_X1 = 436 * MiB, WS_XN = 568 * MiB, WS_YMIX = 634 * MiB, WS_H = 700 * MiB, WS_UT = WS_H, WS_SIN = WS_H + 66 * MiB, WS_Y = 865 * MiB, WS_P = WS_Y, WS_XL = WS_Y, WS_T = WS_Y + 192 * MiB,
                 WS_END = 1523 * MiB;
constexpr int CW_CNT = 1024, CW_NT = 2048, CW_BAR = 4096;

DI float bf2f(unsigned v) { return __uint_as_float(v << 16); }
DI unsigned pk2(float a, float b) { hbf16x2 v = __builtin_convertvector((f32x2){a, b}, hbf16x2); return __builtin_bit_cast(unsigned, v); }
DI bf16 f2bf(float a) { return (bf16)(pk2(a, 0.f) & 0xffffu); }
DI float lo16(unsigned u) { return __uint_as_float(u << 16); }
DI float hi16(unsigned u) { return __uint_as_float(u & 0xffff0000u); }
DI bf16x8 pack8(float a0, float a1, float a2, float a3, float a4, float a5, float a6, float a7) {
    u32x4 p; p.x = pk2(a0, a1); p.y = pk2(a2, a3); p.z = pk2(a4, a5); p.w = pk2(a6, a7); return __builtin_bit_cast(bf16x8, p); }
DI void unpack8(bf16x8 v, float (&f)[8]) { u32x4 p = __builtin_bit_cast(u32x4, v); f[0] = lo16(p.x); f[1] = hi16(p.x); f[2] = lo16(p.y); f[3] = hi16(p.y); f[4] = lo16(p.z); f[5] = hi16(p.z); f[6] = lo16(p.w); f[7] = hi16(p.w); }
DI float wave_sum(float v) {
#pragma unroll
    for (int o = 1; o < 64; o <<= 1) v += __shfl_xor(v, o);
    return v; }
DI int crow(int reg, int h) { return (reg & 3) + 8 * (reg >> 2) + 4 * h; }
#define MFMA32(a, b, c) __builtin_amdgcn_mfma_f32_32x32x16_bf16((a), (b), (c), 0, 0, 0)
#define MFMA16(a, b, c) __builtin_amdgcn_mfma_f32_16x16x32_bf16((a), (b), (c), 0, 0, 0)
DI s16x4 tr_read(LAS unsigned char* p) { return __builtin_amdgcn_ds_read_tr16_b64_v4i16((LAS s16x4*)p); }
DI bf16x8 cat4(s16x4 lo, s16x4 hi) { return __builtin_shufflevector(lo, hi, 0, 1, 2, 3, 4, 5, 6, 7); }
DI f32x16 zero16() { f32x16 z;
#pragma unroll
    for (int i = 0; i < 16; ++i) z[i] = 0.f; return z; }
#define XB_TMO      128
#define XB_XCNT(j)  (256  + 64 * (j))
#define XB_XSUB(j)  (1280 + 64 * (j))
#define XB_XGEN(j)  (2304 + 64 * (j))
#define XB_TOP      3328
#define XB_TOPGEN   3392
#define XCD_BAR_WORDS 3456
#define XB_SPIN_CAP (1u << 18)

__device__ __forceinline__ unsigned xb_ld(unsigned* p)              { return __hip_atomic_load(p, __ATOMIC_RELAXED, __HIP_MEMORY_SCOPE_AGENT); }
__device__ __forceinline__ unsigned xb_add(unsigned* p, unsigned v) { return __hip_atomic_fetch_add(p, v, __ATOMIC_RELAXED, __HIP_MEMORY_SCOPE_AGENT); }
__device__ __forceinline__ unsigned xb_xcc_id() { return (unsigned)__builtin_amdgcn_s_getreg((3 << 11) | 20) & 0xFu; }
#define XB_SPIN(cond, bar) do { unsigned _sp = 0; while (cond) { __builtin_amdgcn_s_sleep(1); \
    if ((++_sp & 255u) == 0u) { if (xb_ld(&(bar)[XB_TMO])) break; if (_sp > XB_SPIN_CAP) { atomicAdd(&(bar)[XB_TMO], 1u); break; } } } } while (0)

struct XcdBarrier { unsigned* bar; unsigned x; volatile LAS unsigned* st; };

__device__ __forceinline__ XcdBarrier xcd_barrier_post(unsigned* bar, volatile LAS unsigned* st) {
    XcdBarrier b; b.bar = bar; b.x = xb_xcc_id(); b.st = st;
    if (threadIdx.x == 0) (void)xb_add(&bar[XB_XCNT(b.x)], 1u);
    return b;
}
__device__ __forceinline__ void xcd_barrier_complete(unsigned* bar, unsigned x, unsigned& nloc, unsigned& nx) {
    const unsigned G = gridDim.x * gridDim.y * gridDim.z;
    unsigned sum, cnt, mine, sp = 0u;
    for (;;) {
        sum = 0u; cnt = 0u; mine = 0u;
#pragma unroll
        for (unsigned j = 0; j < 16; ++j) { const unsigned c = xb_ld(&bar[XB_XCNT(j)]); sum += c; cnt += (c > 0u) ? 1u : 0u; mine = (j == x) ? c : mine; }
        if (sum == G) break;
        __builtin_amdgcn_s_sleep(1);
        if ((++sp & 255u) == 0u) { if (xb_ld(&bar[XB_TMO])) break; if (sp > XB_SPIN_CAP) { atomicAdd(&bar[XB_TMO], 1u); break; } }
    }
    nloc = mine > 0u ? mine : 1u; nx = cnt > 0u ? cnt : 1u;
}
__device__ __forceinline__ void xcd_barrier(const XcdBarrier& b) {
    asm volatile("s_waitcnt vmcnt(0)" ::: "memory");
    __syncthreads();
    if (threadIdx.x == 0) {
        unsigned* bar = b.bar;
        __builtin_amdgcn_s_waitcnt(0);
        unsigned nloc = b.st[0], nx = b.st[1];
        if (nloc == 0u) { xcd_barrier_complete(bar, b.x, nloc, nx); b.st[0] = nloc; b.st[1] = nx; }
        const unsigned old = xb_add(&bar[XB_XSUB(b.x)], 1u);
        const unsigned gen = old / nloc;
        if (old + 1u == (gen + 1u) * nloc) {
            __builtin_amdgcn_fence(__ATOMIC_RELEASE, "agent");
            asm volatile("s_waitcnt vmcnt(0)" ::: "memory");
            const unsigned og = xb_add(&bar[XB_TOP], 1u);
            const unsigned tg = og / nx;
            if (og + 1u == (tg + 1u) * nx) xb_add(&bar[XB_TOPGEN], 1u);
            else XB_SPIN(xb_ld(&bar[XB_TOPGEN]) == tg, bar);
            __builtin_amdgcn_fence(__ATOMIC_ACQUIRE, "agent");
            xb_add(&bar[XB_XGEN(b.x)], 1u);
            asm volatile("s_waitcnt vmcnt(0)" ::: "memory");
        } else {
            XB_SPIN(xb_ld(&bar[XB_XGEN(b.x)]) == gen, bar);
            __builtin_amdgcn_fence(__ATOMIC_ACQUIRE, "agent");
            asm volatile("s_waitcnt vmcnt(0)" ::: "memory");
        }
    }
    __syncthreads();
}

namespace pg8 {
constexpr int BM = 256, BK = 64, HALF = 128, HTB = HALF * BK * 2, STAGE_BYTES = 8 * HTB, NXCD = 8, WGM = 8;
__host__ __device__ __forceinline__ int lds_byte(int r, int c) { const int st = (r >> 4) * 2 + (c >> 5), rr = r & 15, cc = c & 31, ob = rr * 64 + cc * 2; return st * 1024 + (ob ^ (((ob >> 9) & 1) << 5)); }
__host__ __device__ __forceinline__ void stage_rc(int b, int& R, int& C) { const int st = b / 1024, sb = b % 1024, swz = sb ^ (((sb >> 9) & 1) << 5); R = (st >> 1) * 16 + swz / 64; C = (st & 1) * 32 + (swz % 64) / 2; }
__host__ __device__ __forceinline__ int perm32(int rho) { const int n = rho >> 4, i = rho & 15; return 8 * (i >> 2) + 4 * n + (i & 3); }

struct Unit { int pm, pn, pc; };
struct Gemm { const bf16* A; const bf16* Bt; int K; };

struct StaticOrder {
    int nM, nN, nwg, G, c;
    __device__ void init(int M, int N, int G_, int c_) { nM = M / BM; nN = N / BM; nwg = nM * nN; G = G_; c = c_; }
    __device__ bool next(int i, Unit& u) const {
        const long L = (long)i * G + c; if (L >= nwg) return false;
        int wgid = (int)L; { const int q = nwg / NXCD, r = nwg % NXCD, xcd = wgid % NXCD, off = wgid / NXCD; wgid = (xcd < r ? xcd * (q + 1) : r * (q + 1) + (xcd - r) * q) + off; }
        const int nig = WGM * nN, gid = wgid / nig, fm = gid * WGM, gsz = (nM - fm) < WGM ? (nM - fm) : WGM;
        u.pm = fm + ((wgid % nig) % gsz); u.pn = (wgid % nig) / gsz; u.pc = u.pn; return true;
    }
};
struct GroupOrder {
    const int* tile_e; int ntiles, nN, G, c;
    __device__ bool next(int i, Unit& u) const {
        const long L = (long)i * G + c; if (L >= (long)ntiles * nN) return false;
        const int tile = (int)(L / nN), j = (int)(L % nN);
        u.pm = tile; u.pc = j; u.pn = tile_e[tile] * nN + j; return true;
    }
};

struct EpiBf16 {
    bf16* O; int ldc;
    __device__ __forceinline__ void operator()(const f32x4 (&acc)[2][2][4][2], const Unit& u, int wr, int wc, int fr, int fq) const {
        const int row0 = u.pm * BM + wr * 64 + fr, col0 = u.pc * BM + wc * 32 + 8 * fq;
#pragma unroll
        for (int ai = 0; ai < 2; ++ai)
#pragma unroll
            for (int m = 0; m < 4; ++m) { bf16* rowp = O + (size_t)(row0 + ai * HALF + m * 16) * ldc + col0;
#pragma unroll
                for (int bj = 0; bj < 2; ++bj) { const f32x4 v0 = acc[ai][bj][m][0], v1 = acc[ai][bj][m][1];
                    u32x4 w; w.x = pk2(v0[0], v0[1]); w.y = pk2(v0[2], v0[3]); w.z = pk2(v1[0], v1[1]); w.w = pk2(v1[2], v1[3]);
                    *(u32x4*)(rowp + bj * HALF) = w; } }
    }
};
struct EpiSwiglu {
    bf16* O;
    __device__ __forceinline__ void operator()(const f32x4 (&acc)[2][2][4][2], const Unit& u, int wr, int wc, int fr, int fq) const {
        const int row0 = u.pm * BM + wr * 64 + fr, col0 = u.pc * HALF + wc * 32 + 8 * fq;
#pragma unroll
        for (int ai = 0; ai < 2; ++ai)
#pragma unroll
            for (int m = 0; m < 4; ++m) { bf16* rowp = O + (size_t)(row0 + ai * HALF + m * 16) * DEXP + col0;
                float h[8];
#pragma unroll
                for (int n = 0; n < 2; ++n)
#pragma unroll
                    for (int j = 0; j < 4; ++j) { const float g = acc[ai][0][m][n][j], up = acc[ai][1][m][n][j]; h[n * 4 + j] = g / (1.f + __expf(-g)) * up; }
                u32x4 w; w.x = pk2(h[0], h[1]); w.y = pk2(h[2], h[3]); w.z = pk2(h[4], h[5]); w.w = pk2(h[6], h[7]);
                *(u32x4*)rowp = w; }
    }
};

template <class Epi, class Sched, bool GATHER>
__device__ __forceinline__ void gemm_phase(LAS unsigned char* lds, const Gemm g, const Sched& S, const Epi& E, const int* toks) {
    int tid_ = threadIdx.x; asm volatile("" : "+v"(tid_));
    const int tid = tid_, wid = __builtin_amdgcn_readfirstlane(tid >> 6), lane = tid & 63, wr = wid >> 2, wc = wid & 3, fr = lane & 15, fq = lane >> 4;
    const int K = g.K, nt = K / BK;
    int RA[2], CA[2]; unsigned voffA[2], voffB[2];
#pragma unroll
    for (int i = 0; i < 2; ++i) { int R, C; stage_rc(tid * 16 + i * 8192, R, C); const int Rb = (R & ~31) + perm32(R & 31); RA[i] = R; CA[i] = C; voffA[i] = (unsigned)(R * K + C) * 2u; voffB[i] = (unsigned)(Rb * K + C) * 2u; }
    const size_t kstep = (size_t)(BK * 2);
    const size_t hstep = (size_t)HALF * K * 2;
    const size_t tstep = 2 * hstep;
    const unsigned ldsw = (unsigned)wid * 1024u;
    const int aoff = lds_byte(wr * 64 + fr, fq * 8), boff = lds_byte(wc * 32 + fr, fq * 8);
#define PG8_SA(b, h) (((b) * 2 + (h)) * HTB)
#define PG8_SB(b, h) ((4 + (b) * 2 + (h)) * HTB)
#define PG8_STAGE(bufoff, gbase, voff) do { _Pragma("unroll") for (int _i = 0; _i < 2; ++_i) \
        __builtin_amdgcn_global_load_lds((const unsigned*)((const char*)(gbase) + (voff)[_i]), (LAS unsigned*)(lds + (bufoff) + ldsw + _i * 8192), 16, 0, 0); } while (0)
#define PG8_STAGEA(bufoff, kb, vo, ub, h) do { _Pragma("unroll") for (int _i = 0; _i < 2; ++_i) \
        __builtin_amdgcn_global_load_lds((const unsigned*)(GATHER ? (const char*)g.A + (kb) + (vo)[h][_i] : (ub) + (kb) + (h) * hstep + voffA[_i]), (LAS unsigned*)(lds + (bufoff) + ldsw + _i * 8192), 16, 0, 0); } while (0)
#define PG8_LDA(dst, b, h) do { _Pragma("unroll") for (int m = 0; m < 4; ++m) _Pragma("unroll") for (int k = 0; k < 2; ++k) dst[m][k] = *(const LAS bf16x8*)(lds + PG8_SA(b, h) + aoff + m * 2048 + k * 1024); } while (0)
#define PG8_LDB(dst, b, h) do { _Pragma("unroll") for (int n = 0; n < 2; ++n) _Pragma("unroll") for (int k = 0; k < 2; ++k) dst[n][k] = *(const LAS bf16x8*)(lds + PG8_SB(b, h) + boff + n * 2048 + k * 1024); } while (0)
#define PG8_MMA(ai, bj, At, Bt) do { __builtin_amdgcn_s_setprio(1); _Pragma("unroll") for (int m = 0; m < 4; ++m) _Pragma("unroll") for (int n = 0; n < 2; ++n) _Pragma("unroll") for (int k = 0; k < 2; ++k) \
        acc[ai][bj][m][n] = __builtin_amdgcn_mfma_f32_16x16x32_bf16(Bt[n][k], At[m][k], acc[ai][bj][m][n], 0, 0, 0); __builtin_amdgcn_s_setprio(0); } while (0)
#define PG8_WAIT_V(n) asm volatile("s_waitcnt vmcnt(" #n ")" ::: "memory")
#define PG8_WAIT_L(n) asm volatile("s_waitcnt lgkmcnt(" #n ")" ::: "memory")
#define PG8_BAR __builtin_amdgcn_s_barrier()
#define PG8_SCHED __builtin_amdgcn_sched_barrier(0)
#define PG8_VOA(dst, un) do { if (GATHER) { _Pragma("unroll") for (int _h = 0; _h < 2; ++_h) _Pragma("unroll") for (int _i = 0; _i < 2; ++_i) { \
        const int _lr = (un).pm * BM + _h * HALF + RA[_i]; const int _row = toks[_lr]; dst[_h][_i] = (unsigned)(_row * K + CA[_i]) * 2u; } \
        asm volatile("" : "+v"(dst[0][0]), "+v"(dst[0][1]), "+v"(dst[1][0]), "+v"(dst[1][1])); } } while (0)
    Unit cur, nxt; int ui = 0;
    if (!S.next(0, cur)) return;
    f32x4 acc[2][2][4][2];
#pragma unroll
    for (int a = 0; a < 2; ++a)
#pragma unroll
        for (int b = 0; b < 2; ++b)
#pragma unroll
            for (int m = 0; m < 4; ++m)
#pragma unroll
                for (int n = 0; n < 2; ++n) acc[a][b][m][n] = (f32x4){0.f, 0.f, 0.f, 0.f};
    bf16x8 At[4][2], B0[2][2], B1[2][2];
    unsigned voA[2][2] = {{0u, 0u}, {0u, 0u}}, voN[2][2] = {{0u, 0u}, {0u, 0u}};
    PG8_VOA(voA, cur);
    const char* cA = (const char*)g.A + (size_t)cur.pm * tstep;
    const char* cB = (const char*)g.Bt + (size_t)cur.pn * tstep;
    PG8_STAGE(PG8_SB(0, 0), cB, voffB); PG8_STAGEA(PG8_SA(0, 0), 0, voA, cA, 0); PG8_STAGE(PG8_SB(0, 1), cB + hstep, voffB); PG8_STAGEA(PG8_SA(0, 1), 0, voA, cA, 1);
    if (wr == 1) PG8_BAR;
    PG8_WAIT_V(4); PG8_BAR;
    PG8_STAGE(PG8_SB(1, 0), cB + kstep, voffB); PG8_STAGEA(PG8_SA(1, 0), kstep, voA, cA, 0); PG8_STAGE(PG8_SB(1, 1), cB + hstep + kstep, voffB);
    PG8_WAIT_V(6); PG8_BAR;
    for (;;) {
        const bool has_next = S.next(ui + 1, nxt);
        if (has_next) { PG8_VOA(voN, nxt); }
        else if (GATHER) {
#pragma unroll
            for (int _h = 0; _h < 2; ++_h)
#pragma unroll
                for (int _i = 0; _i < 2; ++_i) voN[_h][_i] = voA[_h][_i]; }
        const char* nA = has_next ? (const char*)g.A + (size_t)nxt.pm * tstep : cA;
        const char* nB = has_next ? (const char*)g.Bt + (size_t)nxt.pn * tstep : cB;
        for (int t = 0; t < nt; t += 2) {
            const bool last = (t == nt - 2);
            const size_t k1 = (size_t)(t + 1) * kstep;
            const size_t k2 = last ? 0 : (size_t)(t + 2) * kstep, k3 = k2 + kstep;
            const char* b2 = last ? nB : cB + (size_t)(t + 2) * kstep; const char* b3 = b2 + kstep;
            unsigned vo2[2][2] = {{0u, 0u}, {0u, 0u}};
            if (GATHER) {
#pragma unroll
                for (int _h = 0; _h < 2; ++_h)
#pragma unroll
                    for (int _i = 0; _i < 2; ++_i) vo2[_h][_i] = last ? voN[_h][_i] : voA[_h][_i]; }
            const char* a2 = last ? nA : cA;
            PG8_LDB(B0, 0, 0); PG8_SCHED; PG8_LDA(At, 0, 0); PG8_STAGEA(PG8_SA(1, 1), k1, voA, cA, 1);
            PG8_WAIT_L(8); PG8_BAR; PG8_WAIT_L(0); PG8_MMA(0, 0, At, B0); PG8_BAR; PG8_SCHED;
            PG8_LDB(B1, 0, 1); PG8_STAGE(PG8_SB(0, 0), b2, voffB);
            PG8_BAR; PG8_WAIT_L(0); PG8_MMA(0, 1, At, B1); PG8_BAR;
            PG8_LDA(At, 0, 1); PG8_STAGEA(PG8_SA(0, 0), k2, vo2, a2, 0);
            PG8_BAR; PG8_WAIT_L(0); PG8_MMA(1, 0, At, B0); PG8_BAR; PG8_SCHED;
            PG8_STAGE(PG8_SB(0, 1), b2 + hstep, voffB);
            PG8_WAIT_V(6); PG8_BAR; PG8_MMA(1, 1, At, B1); PG8_BAR;
            PG8_LDB(B0, 1, 0); PG8_SCHED; PG8_LDA(At, 1, 0); PG8_STAGEA(PG8_SA(0, 1), k2, vo2, a2, 1);
            PG8_WAIT_L(8); PG8_BAR; PG8_WAIT_L(0); PG8_MMA(0, 0, At, B0); PG8_BAR; PG8_SCHED;
            PG8_LDB(B1, 1, 1); PG8_STAGE(PG8_SB(1, 0), b3, voffB);
            PG8_BAR; PG8_WAIT_L(0); PG8_MMA(0, 1, At, B1); PG8_BAR;
            PG8_LDA(At, 1, 1); PG8_STAGEA(PG8_SA(1, 0), k3, vo2, a2, 0);
            PG8_BAR; PG8_WAIT_L(0); PG8_MMA(1, 0, At, B0); PG8_BAR; PG8_SCHED;
            PG8_STAGE(PG8_SB(1, 1), b3 + hstep, voffB);
            PG8_WAIT_V(6); PG8_BAR; PG8_MMA(1, 1, At, B1); PG8_BAR;
        }
        E(acc, cur, wr, wc, fr, fq);
        if (!has_next) break;
#pragma unroll
        for (int a = 0; a < 2; ++a)
#pragma unroll
            for (int b = 0; b < 2; ++b)
#pragma unroll
                for (int m = 0; m < 4; ++m)
#pragma unroll
                    for (int n = 0; n < 2; ++n) acc[a][b][m][n] = (f32x4){0.f, 0.f, 0.f, 0.f};
        cur = nxt; cA = nA; cB = nB; ++ui;
        if (GATHER) {
#pragma unroll
            for (int _h = 0; _h < 2; ++_h)
#pragma unroll
                for (int _i = 0; _i < 2; ++_i) voA[_h][_i] = voN[_h][_i]; }
    }
    PG8_WAIT_V(0);
    if (wr == 0) PG8_BAR;
    PG8_BAR;
#undef PG8_SA
#undef PG8_SB
#undef PG8_STAGE
#undef PG8_STAGEA
#undef PG8_LDA
#undef PG8_LDB
#undef PG8_MMA
#undef PG8_WAIT_V
#undef PG8_WAIT_L
#undef PG8_BAR
#undef PG8_SCHED
#undef PG8_VOA
}
}
struct Params {
    const GAS float* in[26];
    GAS float* out;
    GAS unsigned char* ws;
    int ph_lo, ph_hi;
};
typedef const Params __attribute__((address_space(4))) CParams;
constexpr int NPH = 13;
constexpr int WAVE_LDS = 18432;
constexpr int LDS_MISC = 8 * WAVE_LDS;
constexpr int LDS_BYTES = LDS_MISC + 1024;

struct Ctx {
    LAS unsigned char* lds; int tid, lane, wave, gw, ngw, L;
    CParams* p;
    unsigned char* ws;
};
DI unsigned char* fresh(GAS unsigned char* q) { asm volatile("" : "+s"(q)); return (unsigned char*)q; }
#define inp(c, k) ((const float*)(c).p->in[k])
#define outp(c) ((float*)(c).p->out)

DI void transpose_item(const float* W, int K, int N, bf16* WT, int drow0, LAS float* scr, int kb, int nb, int lane, bool lo_part) {
    const int k0 = 64 * kb, n0 = 32 * nb;
#pragma unroll 8
    for (int i = 0; i < 32; ++i) { const int kk = 2 * i + (lane >> 5); scr[kk * 33 + (lane & 31)] = W[(size_t)(k0 + kk) * N + n0 + (lane & 31)]; }
    asm volatile("s_waitcnt lgkmcnt(0)" ::: "memory");
    const int c = lane & 7;
#pragma unroll
    for (int j = 0; j < 4; ++j) { const int n = (lane >> 3) + 8 * j; const LAS float* s = scr + (8 * c) * 33 + n;
        float v[8];
#pragma unroll
        for (int q = 0; q < 8; ++q) { v[q] = s[q * 33]; if (lo_part) v[q] = v[q] - bf2f(f2bf(v[q])); }
        u32x4 o; o.x = pk2(v[0], v[1]); o.y = pk2(v[2], v[3]); o.z = pk2(v[4], v[5]); o.w = pk2(v[6], v[7]);
        *(u32x4*)(WT + (size_t)(drow0 + n) * K + k0 + 8 * c) = o; }
    asm volatile("s_waitcnt lgkmcnt(0)" ::: "memory");
}

DI void phase0(const Ctx& c) {
    const int L = c.L;
    unsigned char* ws = c.ws;
    {
        LAS float* sc = (LAS float*)c.lds;
        LAS float* part = (LAS float*)(c.lds + 32768);
        for (int i = c.tid; i < 3 * D; i += 512) { const int r = i / D, k = i % D; const float v = r < 2 ? inp(c, 1)[r * D + k] : inp(c, 3)[k]; sc[i] = v / (1.f + __expf(-v)); }
        __syncthreads();
        const float* wa = inp(c, 4) + (size_t)L * D * 6 * D; const float* ba = inp(c, 5) + (size_t)L * 6 * D;
        float* mod = (float*)(ws + WS_MOD);
        for (int cb = blockIdx.x; cb < 256; cb += gridDim.x) {
            const int n0 = cb * 48;
            float a0 = 0.f, a1 = 0.f, a2 = 0.f;
            if (c.lane < 48) {
                const float* wp = wa + (size_t)(c.wave * 256) * (6 * D) + n0 + c.lane;
#pragma unroll 8
                for (int k = 0; k < 256; ++k) { const float w = wp[(size_t)k * (6 * D)]; const int kk = c.wave * 256 + k; a0 += sc[kk] * w; a1 += sc[D + kk] * w; a2 += sc[2 * D + kk] * w; }
                part[(c.wave * 3 + 0) * 48 + c.lane] = a0; part[(c.wave * 3 + 1) * 48 + c.lane] = a1; part[(c.wave * 3 + 2) * 48 + c.lane] = a2;
            }
            __syncthreads();
            if (c.tid < 144) { const int r = c.tid / 48, j = c.tid % 48; float s = 0.f;
#pragma unroll
                for (int w = 0; w < 8; ++w) s += part[(w * 3 + r) * 48 + j];
                mod[r * 6 * D + n0 + j] = s + ba[n0 + j]; }
            __syncthreads();
        }
    }
    {
        LAS float* scr = (LAS float*)(c.lds + c.wave * WAVE_LDS);
        constexpr int I_IN = 32 * (PW / 32), I_OUT = 32 * 64, I_E = 1536, I_R = 64;
        constexpr int NIT = I_IN + I_OUT + 65 * I_E + 2 * I_R;
        bf16* win = (bf16*)(ws + WS_WIN); bf16* wout = (bf16*)(ws + WS_WOUT); bf16* wgu = (bf16*)(ws + WS_WGU); bf16* wd = (bf16*)(ws + WS_WD); bf16* rw = (bf16*)(ws + WS_ROUTW);
        for (int it = c.gw; it < NIT; it += c.ngw) {
            int r = it;
            if (r < I_IN) { const int nblk = PW / 32; transpose_item(inp(c, 6) + (size_t)L * D * PW, D, PW, win, 32 * (r % nblk), scr, r / nblk, r % nblk, c.lane, false); continue; } r -= I_IN;
            if (r < I_OUT) { transpose_item(inp(c, 13) + (size_t)L * D * D, D, D, wout, 32 * (r % 64), scr, r / 64, r % 64, c.lane, false); continue; } r -= I_OUT;
            if (r < 65 * I_E) {
                const int e = r / I_E, q = r % I_E, which = q / 512, idx = q % 512;
                if (which < 2) {
                    const float* W = e < 64 ? inp(c, which == 0 ? 18 : 19) + ((size_t)(L * 64 + e)) * D * DEXP : inp(c, which == 0 ? 21 : 22) + (size_t)L * D * DEXP;
                    const int kb = idx / 16, nb = idx % 16, n0 = 32 * nb;
                    transpose_item(W, D, DEXP, wgu, e * 1024 + (n0 / 128) * 256 + which * 128 + (n0 % 128), scr, kb, nb, c.lane, false);
                } else {
                    const float* W = e < 64 ? inp(c, 20) + ((size_t)(L * 64 + e)) * DEXP * D : inp(c, 23) + (size_t)L * DEXP * D;
                    const int kb = idx / 64, nb = idx % 64;
                    transpose_item(W, DEXP, D, wd, e * 2048 + 32 * nb, scr, kb, nb, c.lane, false);
                }
                continue; }
            r -= 65 * I_E;
            { const int lo = r / I_R, idx = r % I_R, kb = idx / 2, nb = idx % 2;
              transpose_item(inp(c, 16) + (size_t)L * D * NEXP, D, NEXP, rw, lo * 64 + 32 * nb, scr, kb, nb, c.lane, lo != 0); }
        }
    }
    if (L == 0) {
        float* rope = (float*)(ws + WS_ROPE);
        for (int i = blockIdx.x * 512 + c.tid; i < 128 * 16; i += gridDim.x * 512) {
            const int pos = i / 16, f = i % 16;
            const float inv = exp2f(-(float)f * (13.287712379549449f / 16.f));
            const float ang = (float)pos * inv;
            const float n = rintf(ang * 0.15915494309189535f);
            float rr = fmaf(-n, 6.28125f, ang); rr = fmaf(-n, 1.9353071795864769e-3f, rr);
            rope[2 * i] = __cosf(rr); rope[2 * i + 1] = __sinf(rr);
        }
    }
}

DI void row_stats(const f32x4 (&v)[8], float& mean, float& rstd) {
    float s = 0.f;
#pragma unroll
    for (int j = 0; j < 8; ++j) s += (v[j].x + v[j].y) + (v[j].z + v[j].w);
    mean = wave_sum(s) * (1.f / D);
    float q = 0.f;
#pragma unroll
    for (int j = 0; j < 8; ++j) { const f32x4 d = v[j] - mean; q += (d.x * d.x + d.y * d.y) + (d.z * d.z + d.w * d.w); }
    rstd = 1.f / sqrtf(wave_sum(q) * (1.f / D) + LN_EPS);
}
DI const float* mod_row(const Ctx& c, int row) { return (const float*)(c.ws + WS_MOD) + (size_t)(row < NLAT ? row / SEQ : 2) * 6 * D; }
DI const float* x_in_row(const Ctx& c, int row) {

    if (row < NLAT) return (c.L == 0 ? inp(c, 0) : (const float*)outp(c)) + (size_t)row * D;
    return (c.L == 0 ? inp(c, 2) : (const float*)(c.ws + WS_HCTX)) + (size_t)(row - NLAT) * D;
}

DI void phase1(const Ctx& c) {
    bf16* xn = (bf16*)(c.ws + WS_XN);
    for (int r2 = c.gw; r2 < NTOK / 2; r2 += c.ngw) {
        f32x4 v[2][8]; float mean[2], rstd[2];
#pragma unroll
        for (int u = 0; u < 2; ++u) { const float* xr = x_in_row(c, 2 * r2 + u);
#pragma unroll
            for (int j = 0; j < 8; ++j) v[u][j] = *(const f32x4*)(xr + 4 * c.lane + 256 * j); }
#pragma unroll
        for (int u = 0; u < 2; ++u) row_stats(v[u], mean[u], rstd[u]);
        const float* mod = mod_row(c, 2 * r2);
#pragma unroll
        for (int j = 0; j < 8; ++j) { const int col = 4 * c.lane + 256 * j;
            const f32x4 sh = *(const f32x4*)(mod + col), sc = *(const f32x4*)(mod + D + col);
#pragma unroll
            for (int u = 0; u < 2; ++u) { const f32x4 y = (v[u][j] - mean[u]) * rstd[u] * (sc + 1.f) + sh;
                u32x2 o; o.x = pk2(y.x, y.y); o.y = pk2(y.z, y.w);
                *(u32x2*)(xn + (size_t)(2 * r2 + u) * D + col) = o; } }
    }
}

DI void phase7(const Ctx& c) {
    const int L = c.L;
    bf16* xn = (bf16*)(c.ws + WS_XN); bf16* xl = (bf16*)(c.ws + WS_XL); const bf16* T = (const bf16*)(c.ws + WS_T); float* x1 = (float*)(c.ws + WS_X1);
    const float* lg = inp(c, 14) + (size_t)L * D; const float* lb = inp(c, 15) + (size_t)L * D;
    const int nrows = L == 0 ? NTOK : NLAT;
    for (int r2 = c.gw; r2 < nrows / 2; r2 += c.ngw) {
        const float* mod = mod_row(c, 2 * r2);
        f32x4 v[2][8]; float mean[2], rstd[2];
#pragma unroll
        for (int u = 0; u < 2; ++u) { const int row = 2 * r2 + u; const float* xr = x_in_row(c, row);
#pragma unroll
            for (int j = 0; j < 8; ++j) { const int col = 4 * c.lane + 256 * j;
                const f32x4 x = *(const f32x4*)(xr + col), g = *(const f32x4*)(mod + 2 * D + col);
                const u32x2 t = *(const u32x2*)(T + (size_t)row * D + col);
                v[u][j] = x * DN_ALPHA + g * (f32x4){lo16(t.x), hi16(t.x), lo16(t.y), hi16(t.y)}; } }
#pragma unroll
        for (int u = 0; u < 2; ++u) row_stats(v[u], mean[u], rstd[u]);
#pragma unroll
        for (int j = 0; j < 8; ++j) { const int col = 4 * c.lane + 256 * j; const f32x4 gg = *(const f32x4*)(lg + col), bb = *(const f32x4*)(lb + col);
#pragma unroll
            for (int u = 0; u < 2; ++u) { v[u][j] = (v[u][j] - mean[u]) * rstd[u] * gg + bb; *(f32x4*)(x1 + (size_t)(2 * r2 + u) * D + col) = v[u][j]; } }
#pragma unroll
        for (int u = 0; u < 2; ++u) row_stats(v[u], mean[u], rstd[u]);
#pragma unroll
        for (int j = 0; j < 8; ++j) { const int col = 4 * c.lane + 256 * j;
            const f32x4 sh = *(const f32x4*)(mod + 3 * D + col), sc = *(const f32x4*)(mod + 4 * D + col);
#pragma unroll
            for (int u = 0; u < 2; ++u) { const f32x4 y = (v[u][j] - mean[u]) * rstd[u] * (sc + 1.f) + sh;
                u32x2 o; o.x = pk2(y.x, y.y); o.y = pk2(y.z, y.w);
                u32x2 ol; ol.x = pk2(y.x - lo16(o.x), y.y - hi16(o.x)); ol.y = pk2(y.z - lo16(o.y), y.w - hi16(o.y));
                *(u32x2*)(xn + (size_t)(2 * r2 + u) * D + col) = o; *(u32x2*)(xl + (size_t)(2 * r2 + u) * D + col) = ol; } }
    }
}
constexpr int VSTR = 144;
struct AttnAcc { f32x16 o0, o1; float m, l; };
DI void attn_init(AttnAcc& a) { a.o0 = zero16(); a.o1 = zero16(); a.m = -INFINITY; a.l = 0.f; }

template <class ScoreF>
DI void attn_tile(AttnAcc& a, const bf16x8 (&qf)[4], const bf16x8 (&kf)[4], const bf16* vsrc, LAS unsigned char* vl, int lane, ScoreF sf) {
    const int half = lane >> 5;
    {
        const u32x4* s = (const u32x4*)vsrc; LAS unsigned char* d = vl + (lane >> 1) * VSTR + (lane & 1) * 64;
        const u32x4 v0 = s[0], v1 = s[1], v2 = s[2], v3 = s[3];
        *(LAS u32x4*)(d) = v0; *(LAS u32x4*)(d + 16) = v1; *(LAS u32x4*)(d + 32) = v2; *(LAS u32x4*)(d + 48) = v3;
    }
    f32x16 st = zero16();
#pragma unroll
    for (int s = 0; s < 4; ++s) st = MFMA32(kf[s], qf[s], st);
    float sc[16]; float mx = -INFINITY;
#pragma unroll
    for (int r = 0; r < 16; ++r) { sc[r] = sf(crow(r, half), st[r]); mx = fmaxf(mx, sc[r]); }
    mx = fmaxf(mx, __shfl_xor(mx, 32));
    const float mnew = fmaxf(a.m, mx);
    const float muse = (mnew == -INFINITY) ? 0.f : mnew;
    const float corr = __expf(a.m - muse);
    float ps = 0.f;
#pragma unroll
    for (int r = 0; r < 16; ++r) { sc[r] = __expf(sc[r] - muse); ps += sc[r]; }
    ps += __shfl_xor(ps, 32);
    a.l = a.l * corr + ps; a.m = mnew;
#pragma unroll
    for (int r = 0; r < 16; ++r) { a.o0[r] *= corr; a.o1[r] *= corr; }
    const bf16x8 pb0 = pack8(sc[0], sc[1], sc[2], sc[3], sc[4], sc[5], sc[6], sc[7]);
    const bf16x8 pb1 = pack8(sc[8], sc[9], sc[10], sc[11], sc[12], sc[13], sc[14], sc[15]);
    const int q = (lane & 15) >> 2, pp = lane & 3, blk = (lane >> 4) & 1;
    LAS unsigned char* vb = vl + (4 * half + q) * VSTR + (16 * blk + 4 * pp) * 2;
    { const bf16x8 A = cat4(tr_read(vb), tr_read(vb + 8 * VSTR)); a.o0 = MFMA32(A, pb0, a.o0); }
    { const bf16x8 A = cat4(tr_read(vb + 64), tr_read(vb + 8 * VSTR + 64)); a.o1 = MFMA32(A, pb0, a.o1); }
    { const bf16x8 A = cat4(tr_read(vb + 16 * VSTR), tr_read(vb + 24 * VSTR)); a.o0 = MFMA32(A, pb1, a.o0); }
    { const bf16x8 A = cat4(tr_read(vb + 16 * VSTR + 64), tr_read(vb + 24 * VSTR + 64)); a.o1 = MFMA32(A, pb1, a.o1); }
}
DI void attn_store(const AttnAcc& a, bf16* orow, int lane) {
    const int half = lane >> 5; const float inv = 1.f / a.l;
#pragma unroll
    for (int g = 0; g < 4; ++g) {
        u32x2 w0; w0.x = pk2(a.o0[4 * g] * inv, a.o0[4 * g + 1] * inv); w0.y = pk2(a.o0[4 * g + 2] * inv, a.o0[4 * g + 3] * inv);
        u32x2 w1; w1.x = pk2(a.o1[4 * g] * inv, a.o1[4 * g + 1] * inv); w1.y = pk2(a.o1[4 * g + 2] * inv, a.o1[4 * g + 3] * inv);
        *(u32x2*)(orow + 8 * g + 4 * half) = w0; *(u32x2*)(orow + 32 + 8 * g + 4 * half) = w1; }
}
DI void load_frags(bf16x8 (&f)[4], const bf16* row, int half) {
#pragma unroll
    for (int s = 0; s < 4; ++s) f[s] = *(const bf16x8*)(row + 16 * s + 8 * half);
}
DI void rope_frags(bf16x8 (&f)[4], int posr, int posc, int half, const float* rope) {
#pragma unroll
    for (int pr = 0; pr < 2; ++pr) {
        const int pos = pr == 0 ? posr : posc;
        const f32x4* t = (const f32x4*)(rope + (size_t)(pos * 16 + 8 * half) * 2);
        const f32x4 t0 = t[0], t1 = t[1], t2 = t[2], t3 = t[3];
        const float cs[16] = {t0.x, t0.y, t0.z, t0.w, t1.x, t1.y, t1.z, t1.w, t2.x, t2.y, t2.z, t2.w, t3.x, t3.y, t3.z, t3.w};
        float x1[8], x2[8]; unpack8(f[2 * pr], x1); unpack8(f[2 * pr + 1], x2);
        float y1[8], y2[8];
#pragma unroll
        for (int e = 0; e < 8; ++e) { const float co = cs[2 * e], si = cs[2 * e + 1]; y1[e] = x1[e] * co - x2[e] * si; y2[e] = x2[e] * co + x1[e] * si; }
        f[2 * pr] = pack8(y1[0], y1[1], y1[2], y1[3], y1[4], y1[5], y1[6], y1[7]);
        f[2 * pr + 1] = pack8(y2[0], y2[1], y2[2], y2[3], y2[4], y2[5], y2[6], y2[7]);
    }
}

DI void na_item(const Ctx& c, int item) {
    const bf16* P = (const bf16*)(c.ws + WS_P); bf16* Y = (bf16*)(c.ws + WS_YMIX);
    const int lane = c.lane, half = lane >> 5, j = lane & 31;
    const int cc = item & 1, h = (item >> 1) & 7, r = (item >> 4) & 127, b = item >> 11;
    const float* rpb = inp(c, 7) + (size_t)(c.L * 8 + h) * 15 * 31;
    LAS unsigned char* vl = c.lds + c.wave * WAVE_LDS;
    const int qrow = b * SEQ + r * 64 + 32 * cc + j;
    bf16x8 qf[4]; load_frags(qf, P + (size_t)qrow * PWP + NA_Q + h * 64, half);
    const int qc = 32 * cc + j;
    const int rs = min(max(r - 4, 0), 120);
    AttnAcc a; attn_init(a);
    for (int kr = 0; kr < 8; ++kr) {
        const float* brow = rpb + (rs + kr - r + 7) * 31;
        for (int ct = 0; ct < 2; ++ct) {
            int qc_ = qc; asm volatile("" : "+v"(qc_));
            const int qc = qc_; const int cstart = min(max(qc - 8, 0), 48);
            const int base = b * SEQ + (rs + kr) * 64 + 32 * ct;
            bf16x8 kf[4]; load_frags(kf, P + (size_t)(base + j) * PWP + NA_K + h * 64, half);
            const bf16* vsrc = P + (size_t)(base + (lane >> 1)) * PWP + NA_V + h * 64 + (lane & 1) * 32;
            attn_tile(a, qf, kf, vsrc, vl, lane, [&](int i, float raw) {
                const int kc = 32 * ct + i; const bool ok = (kc >= cstart) && (kc < cstart + 16);
                const int bi = min(max(kc - qc + 15, 0), 30);
                return ok ? raw * 0.125f + brow[bi] : -INFINITY; });
        }
    }
    for (int ct = 0; ct < 8; ++ct) {
        const int base = NLAT + b * CTXL + 32 * ct;
        bf16x8 kf[4]; load_frags(kf, P + (size_t)(base + j) * PWP + NA_K + h * 64, half);
        const bf16* vsrc = P + (size_t)(base + (lane >> 1)) * PWP + NA_V + h * 64 + (lane & 1) * 32;
        attn_tile(a, qf, kf, vsrc, vl, lane, [&](int, float raw) { return raw * 0.125f; });
    }
    attn_store(a, Y + (size_t)qrow * D + h * 64, lane);
}

DI void swa_item(const Ctx& c, int item) {
    const bf16* P = (const bf16*)(c.ws + WS_P); bf16* Y = (bf16*)(c.ws + WS_YMIX); const float* rope = (const float*)(c.ws + WS_ROPE);
    const int lane = c.lane, half = lane >> 5, j = lane & 31;
    const int hq = item & 7, qb = (item >> 3) & 255, b = item >> 11, kvh = hq >> 2;
    LAS unsigned char* vl = c.lds + c.wave * WAVE_LDS;
    const int i0 = 32 * qb, qi = i0 + j, qrow = b * SEQ + qi;
    bf16x8 qf[4]; load_frags(qf, P + (size_t)qrow * PWP + SW_Q + hq * 64, half);
    rope_frags(qf, qi >> 6, qi & 63, half, rope);
    AttnAcc a; attn_init(a);
    for (int m = 0; m < 9; ++m) {
        const int j0 = i0 - 128 + 32 * m;
        if (j0 < 0 || j0 >= SEQ) continue;
        const int kj = j0 + j;
        bf16x8 kf[4]; load_frags(kf, P + (size_t)(b * SEQ + kj) * PWP + SW_K + kvh * 64, half);
        rope_frags(kf, kj >> 6, kj & 63, half, rope);
        const bf16* vsrc = P + (size_t)(b * SEQ + j0 + (lane >> 1)) * PWP + SW_V + kvh * 64 + (lane & 1) * 32;
        attn_tile(a, qf, kf, vsrc, vl, lane, [&](int i, float raw) {
            const int dlt = j0 + i - qi; const bool ok = (dlt >= -128) && (dlt <= 128);
            return ok ? raw * 0.125f : -INFINITY; });
    }
    for (int ct = 0; ct < 8; ++ct) {
        const int base = NLAT + b * CTXL + 32 * ct;
        bf16x8 kf[4]; load_frags(kf, P + (size_t)(base + j) * PWP + SW_K + kvh * 64, half);
        const bf16* vsrc = P + (size_t)(base + (lane >> 1)) * PWP + SW_V + kvh * 64 + (lane & 1) * 32;
        attn_tile(a, qf, kf, vsrc, vl, lane, [&](int, float raw) { return raw * 0.125f; });
    }
    const float sink = inp(c, 12)[c.L * 8 + hq];
    a.l += __expf(sink - a.m);
    attn_store(a, Y + (size_t)qrow * D + 1536 + hq * 64, lane);
}

DI void ctx_attn_item(const Ctx& c, int item) {
    const bf16* P = (const bf16*)(c.ws + WS_P); bf16* Y = (bf16*)(c.ws + WS_YMIX);
    const int lane = c.lane, half = lane >> 5, j = lane & 31;
    const int h = item & 7, qb = (item >> 3) & 7, b = (item >> 6) & 1, kind = item >> 7;
    LAS unsigned char* vl = c.lds + c.wave * WAVE_LDS;
    const int qcol = kind == 0 ? NA_Q + h * 64 : SW_Q + h * 64;
    const int kcol = kind == 0 ? NA_K + h * 64 : SW_K + (h >> 2) * 64;
    const int vcol = kind == 0 ? NA_V + h * 64 : SW_V + (h >> 2) * 64;
    const int qrow = NLAT + b * CTXL + 32 * qb + j;
    bf16x8 qf[4]; load_frags(qf, P + (size_t)qrow * PWP + qcol, half);
    AttnAcc a; attn_init(a);
    for (int ct = 0; ct < 8; ++ct) {
        const int base = NLAT + b * CTXL + 32 * ct;
        bf16x8 kf[4]; load_frags(kf, P + (size_t)(base + j) * PWP + kcol, half);
        const bf16* vsrc = P + (size_t)(base + (lane >> 1)) * PWP + vcol + (lane & 1) * 32;
        attn_tile(a, qf, kf, vsrc, vl, lane, [&](int, float raw) { return raw * 0.125f; });
    }
    if (kind == 1) a.l += __expf(inp(c, 12)[c.L * 8 + h] - a.m);
    attn_store(a, Y + (size_t)qrow * D + (kind == 0 ? 0 : 1536) + h * 64, lane);
}

DI void conv_row(const Ctx& c, int row) {
    const bf16* P = (const bf16*)(c.ws + WS_P); bf16* Y = (bf16*)(c.ws + WS_YMIX);
    const int lane = c.lane, ch = 8 * lane;
    const float* w = inp(c, 8) + (size_t)c.L * 3 * 512;
    int pos, len; if (row < NLAT) { pos = row % SEQ; len = SEQ; } else { pos = (row - NLAT) % CTXL; len = CTXL; }
    float acc[8];
#pragma unroll
    for (int e = 0; e < 8; ++e) acc[e] = 0.f;
#pragma unroll
    for (int t = 0; t < 3; ++t) {
        const int q = pos + t - 1;
        if (q < 0 || q >= len) continue;
        const bf16* pr = P + (size_t)(row + t - 1) * PWP;
        float u[8], g[8]; unpack8(*(const bf16x8*)(pr + SC_U + ch), u); unpack8(*(const bf16x8*)(pr + SC_C + ch), g);
        const f32x4 w0 = *(const f32x4*)(w + t * 512 + ch), w1 = *(const f32x4*)(w + t * 512 + ch + 4);
        const float wv[8] = {w0.x, w0.y, w0.z, w0.w, w1.x, w1.y, w1.z, w1.w};
#pragma unroll
        for (int e = 0; e < 8; ++e) acc[e] += wv[e] * (g[e] * u[e]);
    }
    float gb[8]; unpack8(*(const bf16x8*)(P + (size_t)row * PWP + SC_B + ch), gb);
    *(bf16x8*)(Y + (size_t)row * D + 512 + ch) = pack8(gb[0] * acc[0], gb[1] * acc[1], gb[2] * acc[2], gb[3] * acc[3], gb[4] * acc[4], gb[5] * acc[5], gb[6] * acc[6], gb[7] * acc[7]);
}
constexpr int KSTR = 144, V2STR = 272;
DI int gla_row0(int b, int ck) { return ck < 8 ? NLAT + b * CTXL + 32 * ck : b * SEQ + 32 * (ck - 8); }
DI int gla_chain_pos(int dir, int ck) { return ck < 8 ? (dir == 0 ? ck : 7 - ck) : (dir == 0 ? ck : 8 + 255 - (ck - 8)); }

struct GlaGate { float w[16]; float bias; };
template <int DIR>
DI void gla_gate_load(const Ctx& c, int h, GlaGate& g) {

    const float* w2 = inp(c, 9) + (size_t)((c.L * 2 + DIR) * 16) * 256 + h * 64 + c.lane;
#pragma unroll
    for (int i = 0; i < 16; ++i) g.w[i] = w2[i * 256];
    g.bias = inp(c, 10)[(c.L * 2 + DIR) * 256 + h * 64 + c.lane];
}
template <int DIR>
DI float gla_la(const GlaGate& g, const bf16* prow) {
    const bf16* zr = prow + GL_Z + DIR * 16;
    float a[8], bq[8]; unpack8(*(const bf16x8*)zr, a); unpack8(*(const bf16x8*)(zr + 8), bq);
    float x = g.bias;
#pragma unroll
    for (int i = 0; i < 8; ++i) x += a[i] * g.w[i];
#pragma unroll
    for (int i = 0; i < 8; ++i) x += bq[i] * g.w[8 + i];
    return (fminf(x, 0.f) - __logf(1.f + __expf(-fabsf(x)))) * (1.f / 16.f);
}
DI void gla_stage_v(const bf16* P, int row0, int h, LAS unsigned char* vl, int lane) {
#pragma unroll
    for (int i = 0; i < 8; ++i) { const int idx = lane + 64 * i, t = idx >> 4, ch = idx & 15;
        *(LAS u32x4*)(vl + t * V2STR + ch * 16) = *(const u32x4*)(P + (size_t)(row0 + t) * PWP + GL_V + h * 128 + ch * 8); }
}

template <int DIR>
DI void gla_g1(const Ctx& c, int b, int h, int ck) {
    const bf16* P = (const bf16*)(c.ws + WS_P);
    const int lane = c.lane, half = lane >> 5;
    LAS unsigned char* kl = c.lds + c.wave * WAVE_LDS; LAS unsigned char* vl = kl + 32 * KSTR;
    const int row0 = gla_row0(b, ck), n = gla_chain_pos(DIR, ck);
    const size_t chain = (size_t)((b * 2 + DIR) * 4 + h) * NCH + n;
    GlaGate gate; gla_gate_load<DIR>(c, h, gate);
    float rev = 0.f;
#pragma unroll 2
    for (int tt = 31; tt >= 0; --tt) {
        const int t = DIR ? 31 - tt : tt;
        const bf16* prow = P + (size_t)(row0 + t) * PWP;
        const float kv = bf2f(prow[GL_K + h * 64 + lane]);
        *(LAS bf16*)(kl + t * KSTR + 2 * lane) = f2bf(kv * __expf(rev));
        rev += gla_la<DIR>(gate, prow);
    }
    ((float*)(c.ws + WS_GDEC))[chain * 64 + lane] = __expf(rev);
    gla_stage_v(P, row0, h, vl, lane);
    const int q = (lane & 15) >> 2, pp = lane & 3, blk = (lane >> 4) & 1;
    bf16* ut = (bf16*)(c.ws + WS_UT) + chain * 8192;
    bf16x8 Bf[2][2];
#pragma unroll
    for (int nt = 0; nt < 2; ++nt)
#pragma unroll
        for (int s = 0; s < 2; ++s) { LAS unsigned char* a = kl + (16 * s + 8 * half + q) * KSTR + (32 * nt + 16 * blk + 4 * pp) * 2; Bf[nt][s] = cat4(tr_read(a), tr_read(a + 4 * KSTR)); }
#pragma unroll
    for (int mt = 0; mt < 4; ++mt) {
        bf16x8 Af[2];
#pragma unroll
        for (int s = 0; s < 2; ++s) { LAS unsigned char* a = vl + (16 * s + 8 * half + q) * V2STR + (32 * mt + 16 * blk + 4 * pp) * 2; Af[s] = cat4(tr_read(a), tr_read(a + 4 * V2STR)); }
#pragma unroll
        for (int nt = 0; nt < 2; ++nt) {
            f32x16 acc = zero16();
            acc = MFMA32(Af[0], Bf[nt][0], acc); acc = MFMA32(Af[1], Bf[nt][1], acc);
#pragma unroll
            for (int r = 0; r < 16; ++r) ut[(32 * mt + crow(r, half)) * 64 + 32 * nt + (lane & 31)] = f2bf(acc[r]);
        }
    }
}

DI void gla_scan(const Ctx& c) {

    const bf16* ut = (const bf16*)(c.ws + WS_UT); bf16* sin = (bf16*)(c.ws + WS_SIN); const float* gd = (const float*)(c.ws + WS_GDEC);
    for (int e = blockIdx.x * 512 + c.tid; e < 16 * 8192; e += gridDim.x * 512) {
        const int chain = e >> 13, el = e & 8191, k = el & 63;
        const size_t base = (size_t)chain * NCH * 8192 + el;
        const float* g = gd + (size_t)chain * NCH * 64 + k;
        float st = 0.f;
        for (int n0 = 0; n0 < NCH; n0 += 8) {
            float u[8], gg[8];
#pragma unroll
            for (int i = 0; i < 8; ++i) { u[i] = bf2f(ut[base + (size_t)(n0 + i) * 8192]); gg[i] = g[(n0 + i) * 64]; }
#pragma unroll
            for (int i = 0; i < 8; ++i) { sin[base + (size_t)(n0 + i) * 8192] = f2bf(st); st = gg[i] * st + u[i]; }
        }
    }
}

template <int DIR>
DI void gla_g3_dir(const Ctx& c, const bf16* P, int b, int h, int ck, int row0, LAS unsigned char* ql, LAS unsigned char* kl, LAS unsigned char* vl, f32x16 (&o)[4]) {
    const int lane = c.lane, half = lane >> 5, j = lane & 31;
    { GlaGate gate; gla_gate_load<DIR>(c, h, gate);
      float cum = 0.f;
#pragma unroll 2
      for (int tt = 0; tt < 32; ++tt) {
        const int t = DIR ? 31 - tt : tt;
        const bf16* prow = P + (size_t)(row0 + t) * PWP;
        cum += gla_la<DIR>(gate, prow);
        const float qv = bf2f(prow[GL_Q + h * 64 + lane]), kv = bf2f(prow[GL_K + h * 64 + lane]);
        *(LAS bf16*)(ql + t * KSTR + 2 * lane) = f2bf(qv * __expf(cum) * 0.125f);
        *(LAS bf16*)(kl + t * KSTR + 2 * lane) = f2bf(kv * __expf(-cum));
      } }
    bf16x8 qf[4], kf[4];
#pragma unroll
    for (int s = 0; s < 4; ++s) { qf[s] = *(const LAS bf16x8*)(ql + j * KSTR + (16 * s + 8 * half) * 2); kf[s] = *(const LAS bf16x8*)(kl + j * KSTR + (16 * s + 8 * half) * 2); }
    f32x16 at = zero16();
#pragma unroll
    for (int s = 0; s < 4; ++s) at = MFMA32(kf[s], qf[s], at);
    float a[16];
#pragma unroll
    for (int r = 0; r < 16; ++r) { const int s = crow(r, half); const bool ok = DIR ? (s >= j) : (s <= j); a[r] = ok ? at[r] : 0.f; }
    const bf16x8 pb0 = pack8(a[0], a[1], a[2], a[3], a[4], a[5], a[6], a[7]), pb1 = pack8(a[8], a[9], a[10], a[11], a[12], a[13], a[14], a[15]);
    const int q = (lane & 15) >> 2, pp = lane & 3, blk = (lane >> 4) & 1;
    const size_t chain = (size_t)((b * 2 + DIR) * 4 + h) * NCH + gla_chain_pos(DIR, ck);
    const bf16* sin = (const bf16*)(c.ws + WS_SIN) + chain * 8192;
#pragma unroll
    for (int mt = 0; mt < 4; ++mt) {
        LAS unsigned char* vb = vl + (4 * half + q) * V2STR + (32 * mt + 16 * blk + 4 * pp) * 2;
        o[mt] = MFMA32(cat4(tr_read(vb), tr_read(vb + 8 * V2STR)), pb0, o[mt]);
        o[mt] = MFMA32(cat4(tr_read(vb + 16 * V2STR), tr_read(vb + 24 * V2STR)), pb1, o[mt]);
#pragma unroll
        for (int s = 0; s < 4; ++s) o[mt] = MFMA32(*(const bf16x8*)(sin + (size_t)(32 * mt + j) * 64 + 16 * s + 8 * half), qf[s], o[mt]);
    }
}
DI void gla_g3(const Ctx& c, int b, int h, int ck) {
    const bf16* P = (const bf16*)(c.ws + WS_P); bf16* Y = (bf16*)(c.ws + WS_YMIX);
    const int lane = c.lane, half = lane >> 5, j = lane & 31;
    LAS unsigned char* ql = c.lds + c.wave * WAVE_LDS; LAS unsigned char* kl = ql + 32 * KSTR; LAS unsigned char* vl = kl + 32 * KSTR;
    const int row0 = gla_row0(b, ck);
    gla_stage_v(P, row0, h, vl, lane);
    f32x16 o[4];
#pragma unroll
    for (int mt = 0; mt < 4; ++mt) o[mt] = zero16();
    gla_g3_dir<0>(c, P, b, h, ck, row0, ql, kl, vl, o);
    gla_g3_dir<1>(c, P, b, h, ck, row0, ql, kl, vl, o);
    float ss = 0.f;
#pragma unroll
    for (int mt = 0; mt < 4; ++mt)
#pragma unroll
        for (int r = 0; r < 16; ++r) ss += o[mt][r] * o[mt][r];
    ss += __shfl_xor(ss, 32);
    const float rstd = 1.f / sqrtf(ss * (1.f / 128.f) + LN_EPS);
    const float* gain = inp(c, 11) + (size_t)c.L * 128;
    const int row = row0 + j;
#pragma unroll
    for (int mt = 0; mt < 4; ++mt)
#pragma unroll
        for (int g4 = 0; g4 < 4; ++g4) {
            const int v0 = 32 * mt + 8 * g4 + 4 * half;
            const u32x2 gr = *(const u32x2*)(P + (size_t)row * PWP + GL_G + h * 128 + v0);
            const float gv[4] = {lo16(gr.x), hi16(gr.x), lo16(gr.y), hi16(gr.y)};
            const f32x4 gn = *(const f32x4*)(gain + v0);
            float y[4];
#pragma unroll
            for (int e = 0; e < 4; ++e) { const float on = o[mt][4 * g4 + e] * rstd * gn[e]; y[e] = on * (gv[e] / (1.f + __expf(-gv[e]))); }
            u32x2 w; w.x = pk2(y[0], y[1]); w.y = pk2(y[2], y[3]);
            *(u32x2*)(Y + (size_t)row * D + 1024 + h * 128 + v0) = w; }
}
DI void router_phase(const Ctx& c) {
    const int L = c.L, lane = c.lane, r16 = lane & 15, q = lane >> 4;
    const bf16* xn = (const bf16*)(c.ws + WS_XN); const bf16* xl = (const bf16*)(c.ws + WS_XL); const bf16* rw = (const bf16*)(c.ws + WS_ROUTW);
    const float* rb = inp(c, 17) + (size_t)L * NEXP;
    int* eidx = (int*)(c.ws + WS_EIDX); int* rank = (int*)(c.ws + WS_RANK); float* wts = (float*)(c.ws + WS_WTS);
    unsigned* cnt = (unsigned*)(c.ws + WS_CTL) + CW_CNT + L * 64;
    LAS float* sc = (LAS float*)(c.lds + c.wave * WAVE_LDS);
    LAS float* sl = sc + 16 * 65;
    LAS unsigned* lcnt = (LAS unsigned*)(c.lds + LDS_MISC + 256);
    LAS unsigned* lbase = lcnt + 64;
    const int nitems = (L == 0 ? NTOK : NLAT) / 16;
    for (int it0 = 0; it0 < nitems; it0 += c.ngw) {
        if (c.tid < 64) lcnt[c.tid] = 0u;
        __syncthreads();
        const int tile = it0 + c.gw; const bool act = tile < nitems;
        int e0 = 0, e1 = 0, li0 = 0, li1 = 0; float w0 = 0.f, w1 = 0.f;
        if (act) {
            const int row = tile * 16 + r16;
            f32x4 acc[4];
#pragma unroll
            for (int nt = 0; nt < 4; ++nt) acc[nt] = (f32x4){0.f, 0.f, 0.f, 0.f};
#pragma unroll 4
            for (int ks = 0; ks < 64; ++ks) {
                const int k0 = 32 * ks + 8 * q;
                const bf16x8 ah = *(const bf16x8*)(xn + (size_t)row * D + k0), al = *(const bf16x8*)(xl + (size_t)row * D + k0);
#pragma unroll
                for (int nt = 0; nt < 4; ++nt) {
                    const bf16x8 bh = *(const bf16x8*)(rw + (size_t)(16 * nt + r16) * D + k0), bl = *(const bf16x8*)(rw + (size_t)(64 + 16 * nt + r16) * D + k0);
                    acc[nt] = MFMA16(ah, bh, acc[nt]); acc[nt] = MFMA16(al, bh, acc[nt]); acc[nt] = MFMA16(ah, bl, acc[nt]);
                }
            }
#pragma unroll
            for (int nt = 0; nt < 4; ++nt)
#pragma unroll
                for (int r = 0; r < 4; ++r) { const int e = 16 * nt + r16, t = 4 * q + r; const float s = 1.f / (1.f + __expf(-acc[nt][r])); sc[t * 65 + e] = s; sl[t * 65 + e] = s + rb[e]; }
            asm volatile("s_waitcnt lgkmcnt(0)" ::: "memory");
            const int t = lane >> 2, s4 = lane & 3;
            float v[16];
#pragma unroll
            for (int i = 0; i < 16; ++i) v[i] = sl[t * 65 + 16 * s4 + i];
            float ga, gb;
            { float m1 = -INFINITY, m2 = -INFINITY;
#pragma unroll
              for (int i = 0; i < 8; ++i) { if (v[i] > m1) { m2 = m1; m1 = v[i]; } else if (v[i] > m2) m2 = v[i]; }
              ga = m1 + m2; m1 = -INFINITY; m2 = -INFINITY;
#pragma unroll
              for (int i = 8; i < 16; ++i) { if (v[i] > m1) { m2 = m1; m1 = v[i]; } else if (v[i] > m2) m2 = v[i]; }
              gb = m1 + m2; }
            float gs[8];
#pragma unroll
            for (int s2 = 0; s2 < 4; ++s2) { gs[2 * s2] = __shfl(ga, (lane & ~3) | s2); gs[2 * s2 + 1] = __shfl(gb, (lane & ~3) | s2); }
            unsigned gmask = 0u;
#pragma unroll
            for (int it = 0; it < 4; ++it) { float best = -INFINITY; int bi = 0;
#pragma unroll
                for (int g = 0; g < 8; ++g) { const bool fr = ((gmask >> g) & 1u) == 0u; if (fr && gs[g] > best) { best = gs[g]; bi = g; } }
                gmask |= 1u << bi; }
            const bool oka = (gmask >> (2 * s4)) & 1u, okb = (gmask >> (2 * s4 + 1)) & 1u;
#pragma unroll
            for (int i = 0; i < 16; ++i) v[i] = ((i < 8) ? oka : okb) ? v[i] : -INFINITY;
            float wsum = 0.f;
#pragma unroll
            for (int rd = 0; rd < 8; ++rd) {
                float best = -INFINITY; int bi = 16 * s4;
#pragma unroll
                for (int i = 0; i < 16; ++i) if (v[i] > best) { best = v[i]; bi = 16 * s4 + i; }
#pragma unroll
                for (int o = 1; o < 4; o <<= 1) { const float ob = __shfl_xor(best, o); const int oi = __shfl_xor(bi, o); if (ob > best || (ob == best && oi < bi)) { best = ob; bi = oi; } }
                const float w = sc[t * 65 + bi]; wsum += w;
                if ((bi >> 4) == s4) {
#pragma unroll
                    for (int i = 0; i < 16; ++i) v[i] = (i == (bi & 15)) ? -INFINITY : v[i]; }
                if ((rd & 3) == s4) { if (rd < 4) { e0 = bi; w0 = w; } else { e1 = bi; w1 = w; } }
            }
            const float sc25 = 2.5f / wsum; w0 *= sc25; w1 *= sc25;
            li0 = (int)__hip_atomic_fetch_add((unsigned*)(lcnt + e0), 1u, __ATOMIC_RELAXED, __HIP_MEMORY_SCOPE_WORKGROUP); li1 = (int)__hip_atomic_fetch_add((unsigned*)(lcnt + e1), 1u, __ATOMIC_RELAXED, __HIP_MEMORY_SCOPE_WORKGROUP);
        }
        __syncthreads();
        if (c.tid < 64) { const unsigned n = lcnt[c.tid]; lbase[c.tid] = n ? atomicAdd(cnt + c.tid, n) : 0u; }
        __syncthreads();
        if (act) {
            const int tok = tile * 16 + (lane >> 2), s4 = lane & 3;
            eidx[tok * 8 + s4] = e0; wts[tok * 8 + s4] = w0; rank[tok * 8 + s4] = (int)lbase[e0] + li0;
            eidx[tok * 8 + s4 + 4] = e1; wts[tok * 8 + s4 + 4] = w1; rank[tok * 8 + s4 + 4] = (int)lbase[e1] + li1;
        }
        __syncthreads();
    }
}

DI void phase9(const Ctx& c) {
    const int L = c.L;
    const int nmoe = L == 0 ? NTOK : NLAT;
    LAS int* ts = (LAS int*)c.lds;
    const unsigned* cnt = (const unsigned*)(c.ws + WS_CTL) + CW_CNT + L * 64;
    if (c.tid == 0) { int acc = 0; for (int e = 0; e < 64; ++e) { ts[e] = acc; acc += ((int)cnt[e] + 255) >> 8; } ts[64] = acc; ts[65] = acc + nmoe / 256; }
    __syncthreads();
    int* toks = (int*)(c.ws + WS_TOKS); int* pos = (int*)(c.ws + WS_POS); int* tile_e = (int*)(c.ws + WS_TILEE);
    const int* eidx = (const int*)(c.ws + WS_EIDX); const int* rank = (const int*)(c.ws + WS_RANK);
    const int gt = blockIdx.x * 512 + c.tid, ngt = gridDim.x * 512;
    for (int i = gt; i < nmoe * 8; i += ngt) { const int e = eidx[i]; const int slot = ts[e] * 256 + rank[i]; toks[slot] = i >> 3; pos[i] = slot; }
    for (int i = gt; i < nmoe; i += ngt) toks[ts[64] * 256 + i] = i;
    for (int e = blockIdx.x; e < 65; e += gridDim.x) {
        for (int t = ts[e] + c.tid; t < ts[e + 1]; t += 512) tile_e[t] = e;
        if (e < 64) { const int n = (int)cnt[e]; for (int s = n + c.tid; s < (ts[e + 1] - ts[e]) * 256; s += 512) toks[ts[e] * 256 + s] = 0; }
    }
    if (blockIdx.x == 0 && c.tid == 0) { int* nt = (int*)(c.ws + WS_CTL) + CW_NT + L * 64; nt[0] = ts[65]; nt[1] = ts[64]; }
    __syncthreads();
}

DI void phase12(const Ctx& c) {
    const int L = c.L;
    const int nmoe = L == 0 ? NTOK : NLAT;
    const bf16* Yb = (const bf16*)(c.ws + WS_Y); const float* x1 = (const float*)(c.ws + WS_X1);
    const int* pos = (const int*)(c.ws + WS_POS); const float* wts = (const float*)(c.ws + WS_WTS);
    const int sh_tile0 = ((const int*)(c.ws + WS_CTL))[CW_NT + L * 64 + 1];
    const float* lg = inp(c, 24) + (size_t)L * D; const float* lb = inp(c, 25) + (size_t)L * D;
    for (int row = c.gw; row < nmoe; row += c.ngw) {
        const float* mod = mod_row(c, row);
        f32x4 f[8];
        int slot[8]; float w[8];
        { const int4 s0 = *(const int4*)(pos + row * 8), s1 = *(const int4*)(pos + row * 8 + 4); const f32x4 q0 = *(const f32x4*)(wts + row * 8), q1 = *(const f32x4*)(wts + row * 8 + 4);
          slot[0] = s0.x; slot[1] = s0.y; slot[2] = s0.z; slot[3] = s0.w; slot[4] = s1.x; slot[5] = s1.y; slot[6] = s1.z; slot[7] = s1.w;
          w[0] = q0.x; w[1] = q0.y; w[2] = q0.z; w[3] = q0.w; w[4] = q1.x; w[5] = q1.y; w[6] = q1.z; w[7] = q1.w; }
        {
            u32x2 y[5][8];
#pragma unroll
            for (int k = 0; k < 5; ++k) { const bf16* yr = Yb + (size_t)(k == 4 ? sh_tile0 * 256 + row : slot[k]) * D;
#pragma unroll
                for (int j = 0; j < 8; ++j) y[k][j] = *(const u32x2*)(yr + 4 * c.lane + 256 * j); }
#pragma unroll
            for (int j = 0; j < 8; ++j) { f[j] = (f32x4){lo16(y[4][j].x), hi16(y[4][j].x), lo16(y[4][j].y), hi16(y[4][j].y)};
#pragma unroll
                for (int k = 0; k < 4; ++k) f[j] += (f32x4){lo16(y[k][j].x), hi16(y[k][j].x), lo16(y[k][j].y), hi16(y[k][j].y)} * w[k]; }
        }
        {
            u32x2 y[4][8];
#pragma unroll
            for (int k = 0; k < 4; ++k) { const bf16* yr = Yb + (size_t)slot[4 + k] * D;
#pragma unroll
                for (int j = 0; j < 8; ++j) y[k][j] = *(const u32x2*)(yr + 4 * c.lane + 256 * j); }
#pragma unroll
            for (int j = 0; j < 8; ++j)
#pragma unroll
                for (int k = 0; k < 4; ++k) f[j] += (f32x4){lo16(y[k][j].x), hi16(y[k][j].x), lo16(y[k][j].y), hi16(y[k][j].y)} * w[4 + k];
        }
        f32x4 v[8];
#pragma unroll
        for (int j = 0; j < 8; ++j) { const int col = 4 * c.lane + 256 * j; v[j] = *(const f32x4*)(x1 + (size_t)row * D + col) * DN_ALPHA + *(const f32x4*)(mod + 5 * D + col) * f[j]; }
        float mean, rstd; row_stats(v, mean, rstd);
        float* orow = row < NLAT ? outp(c) + (size_t)row * D : (float*)(c.ws + WS_HCTX) + (size_t)(row - NLAT) * D;
#pragma unroll
        for (int j = 0; j < 8; ++j) { const int col = 4 * c.lane + 256 * j; *(f32x4*)(orow + col) = (v[j] - mean) * rstd * *(const f32x4*)(lg + col) + *(const f32x4*)(lb + col); }
    }
}

__global__ void __launch_bounds__(512, 2) fwd(Params prm) {
    extern __shared__ __attribute__((aligned(16))) unsigned char lds_raw[];
    Ctx c; c.lds = (LAS unsigned char*)lds_raw; c.tid = threadIdx.x; c.lane = c.tid & 63; c.wave = __builtin_amdgcn_readfirstlane(c.tid >> 6);
    c.gw = blockIdx.x * 8 + c.wave; c.ngw = gridDim.x * 8; c.p = (CParams*)__builtin_amdgcn_kernarg_segment_ptr(); c.L = 0;
    volatile LAS unsigned* misc = (volatile LAS unsigned*)(c.lds + LDS_MISC);
    if (c.tid < 64) misc[c.tid] = 0u;
    __syncthreads();
    unsigned char* ws = (unsigned char*)prm.ws; c.ws = ws;
    XcdBarrier bar = xcd_barrier_post((unsigned*)(ws + WS_CTL) + CW_BAR, misc + 8);
    const int lo = prm.ph_lo, hi = prm.ph_hi;
#ifndef ONLY_PH
#define ONLY_PH -1
#endif
#ifndef DUPMASK
#define DUPMASK 0
#endif
#ifndef PHMASK
#define PHMASK 0x1fff
#endif
#define IN(k) (lo <= (k) && (k) < hi && (ONLY_PH < 0 || ((k) % NPH) == ONLY_PH) && ((PHMASK >> ((k) % NPH)) & 1))
#define REFRESH() do { { CParams* kp_ = (CParams*)__builtin_amdgcn_kernarg_segment_ptr(); asm volatile("" : "+s"(kp_)); c.p = kp_; } ws = fresh(c.p->ws); c.ws = ws; int t_ = threadIdx.x; asm volatile("" : "+v"(t_)); c.tid = t_; c.lane = t_ & 63; c.wave = __builtin_amdgcn_readfirstlane(t_ >> 6); c.gw = blockIdx.x * 8 + c.wave; } while (0)
#define SEAM(k) do { if (IN(k) && IN((k) + 1)) xcd_barrier(bar); } while (0)
    for (int L = 0; L < 2; ++L) {
        c.L = L; const int pb = L * NPH;
        if (IN(pb + 0)) { for (int rep_ = 0; rep_ <= ((DUPMASK >> 0) & 1); ++rep_) { if (rep_) xcd_barrier(bar); REFRESH(); phase0(c); __syncthreads(); } } SEAM(pb + 0);
        if (IN(pb + 1)) { for (int rep_ = 0; rep_ <= ((DUPMASK >> 1) & 1); ++rep_) { if (rep_) xcd_barrier(bar); REFRESH(); phase1(c); } } SEAM(pb + 1);
        if (IN(pb + 2)) { for (int rep_ = 0; rep_ <= ((DUPMASK >> 2) & 1); ++rep_) { if (rep_) xcd_barrier(bar); REFRESH();
            pg8::Gemm g{(const bf16*)(ws + WS_XN), (const bf16*)(ws + WS_WIN), D}; pg8::StaticOrder S; S.init(NTOK, PWP, gridDim.x, blockIdx.x);
            pg8::EpiBf16 E{(bf16*)(ws + WS_P), PWP};
            pg8::gemm_phase<pg8::EpiBf16, pg8::StaticOrder, false>(c.lds, g, S, E, nullptr);
        } } SEAM(pb + 2);
        if (IN(pb + 3)) { for (int rep_ = 0; rep_ <= ((DUPMASK >> 3) & 1); ++rep_) { if (rep_) xcd_barrier(bar); REFRESH();
            for (int it = c.gw; it < 4096; it += c.ngw) na_item(c, it);
            for (int it = c.gw; it < 4096; it += c.ngw) swa_item(c, it);
            for (int it = c.gw; it < 16 * NCH; it += c.ngw) { const int ck = it % NCH, h = (it / NCH) & 3, dir = (it / (NCH * 4)) & 1, b = it / (NCH * 8);
                if (dir == 0) gla_g1<0>(c, b, h, ck); else gla_g1<1>(c, b, h, ck); }
            if (L == 0) for (int it = c.gw; it < 256; it += c.ngw) ctx_attn_item(c, it);
            for (int row = c.gw; row < (L == 0 ? NTOK : NLAT); row += c.ngw) conv_row(c, row);
        } } SEAM(pb + 3);
        if (IN(pb + 4)) { for (int rep_ = 0; rep_ <= ((DUPMASK >> 4) & 1); ++rep_) { if (rep_) xcd_barrier(bar); REFRESH(); gla_scan(c); } } SEAM(pb + 4);
        if (IN(pb + 5)) { for (int rep_ = 0; rep_ <= ((DUPMASK >> 5) & 1); ++rep_) { if (rep_) xcd_barrier(bar); REFRESH();
            for (int it = c.gw; it < 8 * NCH; it += c.ngw) { const int ck = it % NCH, h = (it / NCH) & 3, b = it / (NCH * 4);
                if (ck < 8 && L != 0) continue;
                gla_g3(c, b, h, ck); }
        } } SEAM(pb + 5);
        if (IN(pb + 6)) { for (int rep_ = 0; rep_ <= ((DUPMASK >> 6) & 1); ++rep_) { if (rep_) xcd_barrier(bar); REFRESH();
            pg8::Gemm g{(const bf16*)(ws + WS_YMIX), (const bf16*)(ws + WS_WOUT), D}; pg8::StaticOrder S; S.init(L == 0 ? NTOK : NLAT, D, gridDim.x, blockIdx.x);
            pg8::EpiBf16 E{(bf16*)(ws + WS_T), D};
            pg8::gemm_phase<pg8::EpiBf16, pg8::StaticOrder, false>(c.lds, g, S, E, nullptr);
        } } SEAM(pb + 6);
        if (IN(pb + 7)) { for (int rep_ = 0; rep_ <= ((DUPMASK >> 7) & 1); ++rep_) { if (rep_) xcd_barrier(bar); REFRESH(); phase7(c); } } SEAM(pb + 7);
        if (IN(pb + 8)) { for (int rep_ = 0; rep_ <= ((DUPMASK >> 8) & 1); ++rep_) { if (rep_) xcd_barrier(bar); REFRESH(); router_phase(c); } } SEAM(pb + 8);
        if (IN(pb + 9)) { for (int rep_ = 0; rep_ <= ((DUPMASK >> 9) & 1); ++rep_) { if (rep_) xcd_barrier(bar); REFRESH(); phase9(c); } } SEAM(pb + 9);
        if (IN(pb + 10)) { for (int rep_ = 0; rep_ <= ((DUPMASK >> 10) & 1); ++rep_) { if (rep_) xcd_barrier(bar); REFRESH();
            const int* ntp = (const int*)(ws + WS_CTL) + CW_NT + L * 64;
            pg8::Gemm g{(const bf16*)(ws + WS_XN), (const bf16*)(ws + WS_WGU), D};
            pg8::GroupOrder S{(const int*)(ws + WS_TILEE), ntp[0], 4, (int)gridDim.x, (int)blockIdx.x};
            pg8::EpiSwiglu E{(bf16*)(ws + WS_H)};
            pg8::gemm_phase<pg8::EpiSwiglu, pg8::GroupOrder, true>(c.lds, g, S, E, (const int*)(ws + WS_TOKS));
        } } SEAM(pb + 10);
        if (IN(pb + 11)) { for (int rep_ = 0; rep_ <= ((DUPMASK >> 11) & 1); ++rep_) { if (rep_) xcd_barrier(bar); REFRESH();
            const int* ntp = (const int*)(ws + WS_CTL) + CW_NT + L * 64;
            pg8::Gemm g{(const bf16*)(ws + WS_H), (const bf16*)(ws + WS_WD), DEXP};
            pg8::GroupOrder S{(const int*)(ws + WS_TILEE), ntp[0], 8, (int)gridDim.x, (int)blockIdx.x};
            pg8::EpiBf16 E{(bf16*)(ws + WS_Y), D};
            pg8::gemm_phase<pg8::EpiBf16, pg8::GroupOrder, false>(c.lds, g, S, E, nullptr);
        } } SEAM(pb + 11);
        if (IN(pb + 12)) { for (int rep_ = 0; rep_ <= ((DUPMASK >> 12) & 1); ++rep_) { if (rep_) xcd_barrier(bar); REFRESH(); phase12(c); } } SEAM(pb + 12);
    }
#undef IN
#undef SEAM
}

#ifndef MK_ONE_LAUNCH
#define MK_ONE_LAUNCH 1
#endif
extern "C" void kernel_launch(void* const* d_in, const int* in_sizes, int n_in, void* d_out, int out_size, void* d_ws, size_t ws_size, hipStream_t stream) {
    static int grid = 0;
    if (grid == 0) {
        if (n_in != 26 || out_size != NLAT * D || ws_size < WS_END) { fprintf(stderr, "kernel_launch: unexpected shapes (n_in %d out %d ws %zu)\n", n_in, out_size, ws_size); grid = -1; return; }
        int dev = 0, cus = 0;
        if (hipGetDevice(&dev) != hipSuccess || hipDeviceGetAttribute(&cus, hipDeviceAttributeMultiprocessorCount, dev) != hipSuccess) { grid = -1; return; }
        if (hipFuncSetAttribute((const void*)fwd, hipFuncAttributeMaxDynamicSharedMemorySize, LDS_BYTES) != hipSuccess) { fprintf(stderr, "kernel_launch: hipFuncSetAttribute failed\n"); grid = -1; return; }
        int per_cu = 0;
        if (hipOccupancyMaxActiveBlocksPerMultiprocessor(&per_cu, (const void*)fwd, 512, LDS_BYTES) != hipSuccess || per_cu < 1) fprintf(stderr, "kernel_launch: occupancy query reports %d\n", per_cu);
        (void)hipGetLastError();
        grid = cus;
    }
    if (grid < 0) return;
    hipMemsetAsync((char*)d_ws + WS_CTL, 0, CTL_BYTES, stream);
    Params prm{};
    for (int i = 0; i < 26; ++i) prm.in[i] = (const GAS float*)d_in[i];
    prm.out = (GAS float*)d_out; prm.ws = (GAS unsigned char*)d_ws;
#if MK_ONE_LAUNCH
    prm.ph_lo = 0; prm.ph_hi = 2 * NPH;
    hipLaunchKernelGGL(fwd, dim3(grid), dim3(512), LDS_BYTES, stream, prm);
#else
    for (int ph = 0; ph < 2 * NPH; ++ph) { prm.ph_lo = ph; prm.ph_hi = ph + 1; hipLaunchKernelGGL(fwd, dim3(grid), dim3(512), LDS_BYTES, stream, prm); }
#endif
}
```

```cpp
#include <hip/hip_runtime.h>
#include <cstdio>

#define DI __device__ __forceinline__
#define LAS __attribute__((address_space(3)))
#if defined(__HIP_DEVICE_COMPILE__)
#define GAS __attribute__((address_space(1)))
#else
#define GAS
#endif
typedef unsigned short bf16;
typedef short bf16x8 __attribute__((ext_vector_type(8)));
typedef short s16x4 __attribute__((ext_vector_type(4)));
typedef float f32x2 __attribute__((ext_vector_type(2)));
typedef float f32x4 __attribute__((ext_vector_type(4)));
typedef float f32x8 __attribute__((ext_vector_type(8)));
typedef float f32x16 __attribute__((ext_vector_type(16)));
typedef unsigned u32x2 __attribute__((ext_vector_type(2)));
typedef unsigned u32x4 __attribute__((ext_vector_type(4)));
typedef __bf16 hbf16x2 __attribute__((ext_vector_type(2)));

constexpr int D = 2048, SEQ = 8192, CTXL = 256, NB = 2;
constexpr int NLAT = NB * SEQ, NCTX = NB * CTXL, NTOK = NLAT + NCTX;
constexpr int PW = 5408, PWP = 5632;
constexpr int NA_Q = 0, NA_K = 512, NA_V = 1024, SC_U = 1536, SC_B = 2048, SC_C = 2560, GL_Q = 3072, GL_K = 3328, GL_V = 3584, GL_G = 4096, GL_Z = 4608, SW_Q = 4640, SW_K = 5152, SW_V = 5280;
constexpr int NEXP = 64, DEXP = 512, NCH = 264;
constexpr int MAXTILES = 658;
constexpr float LN_EPS = 1e-6f, DN_ALPHA = 1.41421356237f;

constexpr size_t MiB = 1u << 20;
constexpr size_t WS_CTL = 0, CTL_BYTES = MiB;
constexpr size_t WS_MOD = 1 * MiB, WS_ROPE = 1 * MiB + 512 * 1024, WS_STATS = 2 * MiB, WS_ROUTW = 3 * MiB, WS_EIDX = 4 * MiB, WS_RANK = 5 * MiB, WS_WTS = 6 * MiB, WS_POS = 7 * MiB,
                 WS_TOKS = 8 * MiB, WS_TILEE = 9 * MiB, WS_GDEC = 10 * MiB, WS_HCTX = 12 * MiB, WS_WIN = 16 * MiB, WS_WOUT = 38 * MiB, WS_WGU = 46 * MiB, WS_WD = 306 * MiB,
                 WS_X1 = 436 * MiB, WS_XN = 568 * MiB, WS_YMIX = 634 * MiB, WS_H = 700 * MiB, WS_UT = WS_H, WS_SIN = WS_H + 66 * MiB, WS_Y = 865 * MiB, WS_P = WS_Y, WS_XL = WS_Y, WS_XQ = WS_YMIX, WS_T = WS_Y + 192 * MiB,
                 WS_END = 1523 * MiB;
constexpr int CW_CNT = 1024, CW_NT = 2048, CW_BAR = 4096;

DI float bf2f(unsigned v) { return __uint_as_float(v << 16); }
DI unsigned pk2(float a, float b) { hbf16x2 v = __builtin_convertvector((f32x2){a, b}, hbf16x2); return __builtin_bit_cast(unsigned, v); }
DI bf16 f2bf(float a) { return (bf16)(pk2(a, 0.f) & 0xffffu); }
DI float lo16(unsigned u) { return __uint_as_float(u << 16); }
DI float hi16(unsigned u) { return __uint_as_float(u & 0xffff0000u); }
DI bf16x8 pack8(float a0, float a1, float a2, float a3, float a4, float a5, float a6, float a7) {
    u32x4 p; p.x = pk2(a0, a1); p.y = pk2(a2, a3); p.z = pk2(a4, a5); p.w = pk2(a6, a7); return __builtin_bit_cast(bf16x8, p); }
DI void unpack8(bf16x8 v, float (&f)[8]) { u32x4 p = __builtin_bit_cast(u32x4, v); f[0] = lo16(p.x); f[1] = hi16(p.x); f[2] = lo16(p.y); f[3] = hi16(p.y); f[4] = lo16(p.z); f[5] = hi16(p.z); f[6] = lo16(p.w); f[7] = hi16(p.w); }
DI float wave_sum(float v) {
#pragma unroll
    for (int o = 1; o < 64; o <<= 1) v += __shfl_xor(v, o);
    return v; }
DI int crow(int reg, int h) { return (reg & 3) + 8 * (reg >> 2) + 4 * h; }
#define MFMA32(a, b, c) __builtin_amdgcn_mfma_f32_32x32x16_bf16((a), (b), (c), 0, 0, 0)
#define MFMA16(a, b, c) __builtin_amdgcn_mfma_f32_16x16x32_bf16((a), (b), (c), 0, 0, 0)
DI s16x4 tr_read(LAS unsigned char* p) { return __builtin_amdgcn_ds_read_tr16_b64_v4i16((LAS s16x4*)p); }
DI bf16x8 cat4(s16x4 lo, s16x4 hi) { return __builtin_shufflevector(lo, hi, 0, 1, 2, 3, 4, 5, 6, 7); }
DI f32x16 zero16() { f32x16 z;
#pragma unroll
    for (int i = 0; i < 16; ++i) z[i] = 0.f; return z; }

#ifndef EMU_FP8
#define EMU_FP8 0
#endif
DI float q8(float x) { const int p = __builtin_amdgcn_cvt_pk_fp8_f32(x, x, 0, false); return __builtin_amdgcn_cvt_f32_fp8(p, 0); }
#define XB_TMO      128
#define XB_XCNT(j)  (256  + 64 * (j))
#define XB_XSUB(j)  (1280 + 64 * (j))
#define XB_XGEN(j)  (2304 + 64 * (j))
#define XB_TOP      3328
#define XB_TOPGEN   3392
#define XCD_BAR_WORDS 3456
#define XB_SPIN_CAP (1u << 18)

__device__ __forceinline__ unsigned xb_ld(unsigned* p)              { return __hip_atomic_load(p, __ATOMIC_RELAXED, __HIP_MEMORY_SCOPE_AGENT); }
__device__ __forceinline__ unsigned xb_add(unsigned* p, unsigned v) { return __hip_atomic_fetch_add(p, v, __ATOMIC_RELAXED, __HIP_MEMORY_SCOPE_AGENT); }
__device__ __forceinline__ unsigned xb_xcc_id() { return (unsigned)__builtin_amdgcn_s_getreg((3 << 11) | 20) & 0xFu; }
#define XB_SPIN(cond, bar) do { unsigned _sp = 0; while (cond) { __builtin_amdgcn_s_sleep(1); \
    if ((++_sp & 255u) == 0u) { if (xb_ld(&(bar)[XB_TMO])) break; if (_sp > XB_SPIN_CAP) { atomicAdd(&(bar)[XB_TMO], 1u); break; } } } } while (0)

struct XcdBarrier { unsigned* bar; unsigned x; volatile LAS unsigned* st; };

__device__ __forceinline__ XcdBarrier xcd_barrier_post(unsigned* bar, volatile LAS unsigned* st) {
    XcdBarrier b; b.bar = bar; b.x = xb_xcc_id(); b.st = st;
    if (threadIdx.x == 0) (void)xb_add(&bar[XB_XCNT(b.x)], 1u);
    return b;
}
__device__ __forceinline__ void xcd_barrier_complete(unsigned* bar, unsigned x, unsigned& nloc, unsigned& nx) {
    const unsigned G = gridDim.x * gridDim.y * gridDim.z;
    unsigned sum, cnt, mine, sp = 0u;
    for (;;) {
        sum = 0u; cnt = 0u; mine = 0u;
#pragma unroll
        for (unsigned j = 0; j < 16; ++j) { const unsigned c = xb_ld(&bar[XB_XCNT(j)]); sum += c; cnt += (c > 0u) ? 1u : 0u; mine = (j == x) ? c : mine; }
        if (sum == G) break;
        __builtin_amdgcn_s_sleep(1);
        if ((++sp & 255u) == 0u) { if (xb_ld(&bar[XB_TMO])) break; if (sp > XB_SPIN_CAP) { atomicAdd(&bar[XB_TMO], 1u); break; } }
    }
    nloc = mine > 0u ? mine : 1u; nx = cnt > 0u ? cnt : 1u;
}
__device__ __forceinline__ void xcd_barrier(const XcdBarrier& b) {
    asm volatile("s_waitcnt vmcnt(0)" ::: "memory");
    __syncthreads();
    if (threadIdx.x == 0) {
        unsigned* bar = b.bar;
        __builtin_amdgcn_s_waitcnt(0);
        unsigned nloc = b.st[0], nx = b.st[1];
        if (nloc == 0u) { xcd_barrier_complete(bar, b.x, nloc, nx); b.st[0] = nloc; b.st[1] = nx; }
        const unsigned old = xb_add(&bar[XB_XSUB(b.x)], 1u);
        const unsigned gen = old / nloc;
        if (old + 1u == (gen + 1u) * nloc) {
            __builtin_amdgcn_fence(__ATOMIC_RELEASE, "agent");
            asm volatile("s_waitcnt vmcnt(0)" ::: "memory");
            const unsigned og = xb_add(&bar[XB_TOP], 1u);
            const unsigned tg = og / nx;
            if (og + 1u == (tg + 1u) * nx) xb_add(&bar[XB_TOPGEN], 1u);
            else XB_SPIN(xb_ld(&bar[XB_TOPGEN]) == tg, bar);
            __builtin_amdgcn_fence(__ATOMIC_ACQUIRE, "agent");
            xb_add(&bar[XB_XGEN(b.x)], 1u);
            asm volatile("s_waitcnt vmcnt(0)" ::: "memory");
        } else {
            XB_SPIN(xb_ld(&bar[XB_XGEN(b.x)]) == gen, bar);
            __builtin_amdgcn_fence(__ATOMIC_ACQUIRE, "agent");
            asm volatile("s_waitcnt vmcnt(0)" ::: "memory");
        }
    }
    __syncthreads();
}

namespace pg8 {
constexpr int BM = 256, BK = 64, HALF = 128, HTB = HALF * BK * 2, STAGE_BYTES = 8 * HTB, NXCD = 8, WGM = 8;
__host__ __device__ __forceinline__ int lds_byte(int r, int c) { const int st = (r >> 4) * 2 + (c >> 5), rr = r & 15, cc = c & 31, ob = rr * 64 + cc * 2; return st * 1024 + (ob ^ (((ob >> 9) & 1) << 5)); }
__host__ __device__ __forceinline__ void stage_rc(int b, int& R, int& C) { const int st = b / 1024, sb = b % 1024, swz = sb ^ (((sb >> 9) & 1) << 5); R = (st >> 1) * 16 + swz / 64; C = (st & 1) * 32 + (swz % 64) / 2; }
__host__ __device__ __forceinline__ int perm32(int rho) { const int n = rho >> 4, i = rho & 15; return 8 * (i >> 2) + 4 * n + (i & 3); }

typedef int i32x8 __attribute__((ext_vector_type(8)));
typedef int i32x4 __attribute__((ext_vector_type(4)));
__device__ __forceinline__ i32x8 cat8(bf16x8 a, bf16x8 b) { return __builtin_shufflevector(__builtin_bit_cast(i32x4, a), __builtin_bit_cast(i32x4, b), 0, 1, 2, 3, 4, 5, 6, 7); }
struct Unit { int pm, pn, pc; };
struct Gemm { const bf16* A; const bf16* Bt; int K; };

struct StaticOrder {
    int nM, nN, nwg, G, c;
    __device__ void init(int M, int N, int G_, int c_) { nM = M / BM; nN = N / BM; nwg = nM * nN; G = G_; c = c_; }
    __device__ bool next(int i, Unit& u) const {
        const long L = (long)i * G + c; if (L >= nwg) return false;
        int wgid = (int)L; { const int q = nwg / NXCD, r = nwg % NXCD, xcd = wgid % NXCD, off = wgid / NXCD; wgid = (xcd < r ? xcd * (q + 1) : r * (q + 1) + (xcd - r) * q) + off; }
        const int nig = WGM * nN, gid = wgid / nig, fm = gid * WGM, gsz = (nM - fm) < WGM ? (nM - fm) : WGM;
        u.pm = fm + ((wgid % nig) % gsz); u.pn = (wgid % nig) / gsz; u.pc = u.pn; return true;
    }
};
struct GroupOrder {
    const int* tile_e; int ntiles, nN, G, c;
    __device__ bool next(int i, Unit& u) const {
        const long L = (long)i * G + c; if (L >= (long)ntiles * nN) return false;
        const int tile = (int)(L / nN), j = (int)(L % nN);
        u.pm = tile; u.pc = j; u.pn = tile_e[tile] * nN + j; return true;
    }
};

struct EpiBf16 {
    bf16* O; int ldc; float scale;
    __device__ __forceinline__ void operator()(const f32x4 (&acc)[2][2][4][2], const Unit& u, int wr, int wc, int fr, int fq) const {
        const int row0 = u.pm * BM + wr * 64 + fr, col0 = u.pc * BM + wc * 32 + 8 * fq;
#pragma unroll
        for (int ai = 0; ai < 2; ++ai)
#pragma unroll
            for (int m = 0; m < 4; ++m) { bf16* rowp = O + (size_t)(row0 + ai * HALF + m * 16) * ldc + col0;
#pragma unroll
                for (int bj = 0; bj < 2; ++bj) { const f32x4 v0 = acc[ai][bj][m][0] * scale, v1 = acc[ai][bj][m][1] * scale;
                    u32x4 w; w.x = pk2(v0[0], v0[1]); w.y = pk2(v0[2], v0[3]); w.z = pk2(v1[0], v1[1]); w.w = pk2(v1[2], v1[3]);
                    *(u32x4*)(rowp + bj * HALF) = w; } }
    }
};
struct EpiSwiglu {
    bf16* O;
    __device__ __forceinline__ void operator()(const f32x4 (&acc)[2][2][4][2], const Unit& u, int wr, int wc, int fr, int fq) const {
        const int row0 = u.pm * BM + wr * 64 + fr, col0 = u.pc * HALF + wc * 32 + 8 * fq;
#pragma unroll
        for (int ai = 0; ai < 2; ++ai)
#pragma unroll
            for (int m = 0; m < 4; ++m) { bf16* rowp = O + (size_t)(row0 + ai * HALF + m * 16) * DEXP + col0;
                float h[8];
#pragma unroll
                for (int n = 0; n < 2; ++n)
#pragma unroll
                    for (int j = 0; j < 4; ++j) { const float g = acc[ai][0][m][n][j], up = acc[ai][1][m][n][j]; h[n * 4 + j] = g * up * __builtin_amdgcn_rcpf(1.f + __expf(-g)); }
                u32x4 w; w.x = pk2(h[0], h[1]); w.y = pk2(h[2], h[3]); w.z = pk2(h[4], h[5]); w.w = pk2(h[6], h[7]);
                *(u32x4*)rowp = w; }
    }
};

struct EpiSwiglu8 {
    unsigned char* O;
    __device__ __forceinline__ void operator()(const f32x4 (&acc)[2][2][4][2], const Unit& u, int wr, int wc, int fr, int fq) const {
        const int row0 = u.pm * BM + wr * 64 + fr, col0 = u.pc * HALF + wc * 32 + 8 * fq;
#pragma unroll
        for (int ai = 0; ai < 2; ++ai)
#pragma unroll
            for (int m = 0; m < 4; ++m) { unsigned char* rowp = O + (size_t)(row0 + ai * HALF + m * 16) * DEXP + col0;
                float h[8];
#pragma unroll
                for (int n = 0; n < 2; ++n)
#pragma unroll
                    for (int j = 0; j < 4; ++j) { const float g = acc[ai][0][m][n][j] * (1.f / 64.f), up = acc[ai][1][m][n][j] * (1.f / 64.f); h[n * 4 + j] = g * up * __builtin_amdgcn_rcpf(1.f + __expf(-g)); }
                u32x2 w; int p0 = __builtin_amdgcn_cvt_pk_fp8_f32(h[0], h[1], 0, false); p0 = __builtin_amdgcn_cvt_pk_fp8_f32(h[2], h[3], p0, true);
                int p1 = __builtin_amdgcn_cvt_pk_fp8_f32(h[4], h[5], 0, false); p1 = __builtin_amdgcn_cvt_pk_fp8_f32(h[6], h[7], p1, true);
                w.x = (unsigned)p0; w.y = (unsigned)p1;
                *(u32x2*)rowp = w; }
    }
};

template <class Epi, class Sched, bool GATHER, bool FP8 = false>
__device__ __forceinline__ void gemm_phase(LAS unsigned char* lds, const Gemm g, const Sched& S, const Epi& E, const int* toks) {
    int tid_ = threadIdx.x; asm volatile("" : "+v"(tid_));
    const int tid = tid_, wid = __builtin_amdgcn_readfirstlane(tid >> 6), lane = tid & 63, wr = wid >> 2, wc = wid & 3, fr = lane & 15, fq = lane >> 4;
    int K_ = g.K; asm volatile("" : "+s"(K_));
    const int K = K_, nt = K / BK;
    int RA[2], CA[2]; unsigned voffA[2], voffB[2];
#pragma unroll
    for (int i = 0; i < 2; ++i) { int R, C; stage_rc(tid * 16 + i * 8192, R, C); const int Rb = (R & ~31) + perm32(R & 31); RA[i] = R; CA[i] = C; voffA[i] = (unsigned)(R * K + C) * 2u; voffB[i] = (unsigned)(Rb * K + C) * 2u; }
    const size_t kstep = (size_t)(BK * 2);
    const size_t hstep = (size_t)HALF * K * 2;
    const size_t tstep = 2 * hstep;
    const unsigned ldsw = (unsigned)wid * 1024u;
    const int aoff = lds_byte(wr * 64 + fr, fq * 8), boff = lds_byte(wc * 32 + fr, fq * 8);
#define PG8_SA(b, h) (((b) * 2 + (h)) * HTB)
#define PG8_SB(b, h) ((4 + (b) * 2 + (h)) * HTB)
#define PG8_STAGE(bufoff, gbase, voff) do { _Pragma("unroll") for (int _i = 0; _i < 2; ++_i) \
        __builtin_amdgcn_global_load_lds((const unsigned*)((const char*)(gbase) + (voff)[_i]), (LAS unsigned*)(lds + (bufoff) + ldsw + _i * 8192), 16, 0, 0); } while (0)
#define PG8_STAGEA(bufoff, kb, vo, ub, h) do { _Pragma("unroll") for (int _i = 0; _i < 2; ++_i) \
        __builtin_amdgcn_global_load_lds((const unsigned*)(GATHER ? (const char*)g.A + (kb) + (vo)[h][_i] : (ub) + (kb) + (h) * hstep + voffA[_i]), (LAS unsigned*)(lds + (bufoff) + ldsw + _i * 8192), 16, 0, 0); } while (0)
#define PG8_LDA(dst, b, h) do { _Pragma("unroll") for (int m = 0; m < 4; ++m) _Pragma("unroll") for (int k = 0; k < 2; ++k) dst[m][k] = *(const LAS bf16x8*)(lds + PG8_SA(b, h) + aoff + m * 2048 + k * 1024); } while (0)
#define PG8_LDB(dst, b, h) do { _Pragma("unroll") for (int n = 0; n < 2; ++n) _Pragma("unroll") for (int k = 0; k < 2; ++k) dst[n][k] = *(const LAS bf16x8*)(lds + PG8_SB(b, h) + boff + n * 2048 + k * 1024); } while (0)
#define PG8_MMA(ai, bj, At, Bt) do { __builtin_amdgcn_s_setprio(1); _Pragma("unroll") for (int m = 0; m < 4; ++m) _Pragma("unroll") for (int n = 0; n < 2; ++n) { \
        if (FP8) { asm volatile("v_mfma_f32_16x16x128_f8f6f4 %0, %1, %2, %0" : "+v"(acc[ai][bj][m][n]) : "v"(cat8(Bt[n][0], Bt[n][1])), "v"(cat8(At[m][0], At[m][1]))); }   \
        else { _Pragma("unroll") for (int k = 0; k < 2; ++k) acc[ai][bj][m][n] = __builtin_amdgcn_mfma_f32_16x16x32_bf16(Bt[n][k], At[m][k], acc[ai][bj][m][n], 0, 0, 0); } } \
        __builtin_amdgcn_s_setprio(0); } while (0)
#define PG8_WAIT_V(n) asm volatile("s_waitcnt vmcnt(" #n ")" ::: "memory")
#define PG8_WAIT_L(n) asm volatile("s_waitcnt lgkmcnt(" #n ")" ::: "memory")
#define PG8_BAR __builtin_amdgcn_s_barrier()
#define PG8_SCHED __builtin_amdgcn_sched_barrier(0)
#define PG8_VOA(dst, un) do { if (GATHER) { _Pragma("unroll") for (int _h = 0; _h < 2; ++_h) _Pragma("unroll") for (int _i = 0; _i < 2; ++_i) { \
        const int _lr = (un).pm * BM + _h * HALF + RA[_i]; const int _row = toks[_lr]; dst[_h][_i] = (unsigned)(_row * K + CA[_i]) * 2u; } \
        asm volatile("" : "+v"(dst[0][0]), "+v"(dst[0][1]), "+v"(dst[1][0]), "+v"(dst[1][1])); } } while (0)
    Unit cur, nxt; int ui = 0;
    if (!S.next(0, cur)) return;
    f32x4 acc[2][2][4][2];
#pragma unroll
    for (int a = 0; a < 2; ++a)
#pragma unroll
        for (int b = 0; b < 2; ++b)
#pragma unroll
            for (int m = 0; m < 4; ++m)
#pragma unroll
                for (int n = 0; n < 2; ++n) acc[a][b][m][n] = (f32x4){0.f, 0.f, 0.f, 0.f};
    bf16x8 At[4][2], B0[2][2], B1[2][2];
    unsigned voA[2][2] = {{0u, 0u}, {0u, 0u}}, voN[2][2] = {{0u, 0u}, {0u, 0u}};
    PG8_VOA(voA, cur);
    const char* cA = (const char*)g.A + (size_t)cur.pm * tstep;
    const char* cB = (const char*)g.Bt + (size_t)cur.pn * tstep;
    PG8_STAGE(PG8_SB(0, 0), cB, voffB); PG8_STAGEA(PG8_SA(0, 0), 0, voA, cA, 0); PG8_STAGE(PG8_SB(0, 1), cB + hstep, voffB); PG8_STAGEA(PG8_SA(0, 1), 0, voA, cA, 1);
    if (wr == 1) PG8_BAR;
    PG8_WAIT_V(4); PG8_BAR;
    PG8_STAGE(PG8_SB(1, 0), cB + kstep, voffB); PG8_STAGEA(PG8_SA(1, 0), kstep, voA, cA, 0); PG8_STAGE(PG8_SB(1, 1), cB + hstep + kstep, voffB);
    PG8_WAIT_V(6); PG8_BAR;
    for (;;) {
        const bool has_next = S.next(ui + 1, nxt);
        if (has_next) { PG8_VOA(voN, nxt); }
        else if (GATHER) {
#pragma unroll
            for (int _h = 0; _h < 2; ++_h)
#pragma unroll
                for (int _i = 0; _i < 2; ++_i) voN[_h][_i] = voA[_h][_i]; }
        const char* nA = has_next ? (const char*)g.A + (size_t)nxt.pm * tstep : cA;
        const char* nB = has_next ? (const char*)g.Bt + (size_t)nxt.pn * tstep : cB;
        for (int t = 0; t < nt; t += 2) {
            const bool last = (t == nt - 2);
            const size_t k1 = (size_t)(t + 1) * kstep;
            const size_t k2 = last ? 0 : (size_t)(t + 2) * kstep, k3 = k2 + kstep;
            const char* b2 = last ? nB : cB + (size_t)(t + 2) * kstep; const char* b3 = b2 + kstep;
            unsigned vo2[2][2] = {{0u, 0u}, {0u, 0u}};
            if (GATHER) {
#pragma unroll
                for (int _h = 0; _h < 2; ++_h)
#pragma unroll
                    for (int _i = 0; _i < 2; ++_i) vo2[_h][_i] = last ? voN[_h][_i] : voA[_h][_i]; }
            const char* a2 = last ? nA : cA;
            PG8_LDB(B0, 0, 0); PG8_SCHED; PG8_LDA(At, 0, 0); PG8_STAGEA(PG8_SA(1, 1), k1, voA, cA, 1);
            PG8_WAIT_L(8); PG8_BAR; PG8_WAIT_L(0); PG8_MMA(0, 0, At, B0); PG8_BAR; PG8_SCHED;
            PG8_LDB(B1, 0, 1); PG8_STAGE(PG8_SB(0, 0), b2, voffB);
            PG8_BAR; PG8_WAIT_L(0); PG8_MMA(0, 1, At, B1); PG8_BAR;
            PG8_LDA(At, 0, 1); PG8_STAGEA(PG8_SA(0, 0), k2, vo2, a2, 0);
            PG8_BAR; PG8_WAIT_L(0); PG8_MMA(1, 0, At, B0); PG8_BAR; PG8_SCHED;
            PG8_STAGE(PG8_SB(0, 1), b2 + hstep, voffB);
            PG8_WAIT_V(6); PG8_BAR; PG8_MMA(1, 1, At, B1); PG8_BAR;
            PG8_LDB(B0, 1, 0); PG8_SCHED; PG8_LDA(At, 1, 0); PG8_STAGEA(PG8_SA(0, 1), k2, vo2, a2, 1);
            PG8_WAIT_L(8); PG8_BAR; PG8_WAIT_L(0); PG8_MMA(0, 0, At, B0); PG8_BAR; PG8_SCHED;
            PG8_LDB(B1, 1, 1); PG8_STAGE(PG8_SB(1, 0), b3, voffB);
            PG8_BAR; PG8_WAIT_L(0); PG8_MMA(0, 1, At, B1); PG8_BAR;
            PG8_LDA(At, 1, 1); PG8_STAGEA(PG8_SA(1, 0), k3, vo2, a2, 0);
            PG8_BAR; PG8_WAIT_L(0); PG8_MMA(1, 0, At, B0); PG8_BAR; PG8_SCHED;
            PG8_STAGE(PG8_SB(1, 1), b3 + hstep, voffB);
            PG8_WAIT_V(6); PG8_BAR; PG8_MMA(1, 1, At, B1); PG8_BAR;
        }
        if (FP8) asm volatile("s_nop 15\n\ts_nop 15" ::: "memory");
        E(acc, cur, wr, wc, fr, fq);
        if (!has_next) break;
#pragma unroll
        for (int a = 0; a < 2; ++a)
#pragma unroll
            for (int b = 0; b < 2; ++b)
#pragma unroll
                for (int m = 0; m < 4; ++m)
#pragma unroll
                    for (int n = 0; n < 2; ++n) acc[a][b][m][n] = (f32x4){0.f, 0.f, 0.f, 0.f};
        cur = nxt; cA = nA; cB = nB; ++ui;
        if (GATHER) {
#pragma unroll
            for (int _h = 0; _h < 2; ++_h)
#pragma unroll
                for (int _i = 0; _i < 2; ++_i) voA[_h][_i] = voN[_h][_i]; }
    }
    PG8_WAIT_V(0);
    if (wr == 0) PG8_BAR;
    PG8_BAR;
#undef PG8_SA
#undef PG8_SB
#undef PG8_STAGE
#undef PG8_STAGEA
#undef PG8_LDA
#undef PG8_LDB
#undef PG8_MMA
#undef PG8_WAIT_V
#undef PG8_WAIT_L
#undef PG8_BAR
#undef PG8_SCHED
#undef PG8_VOA
}
}
struct Params {
    const GAS float* in[26];
    GAS float* out;
    GAS unsigned char* ws;
    int ph_lo, ph_hi;
};
typedef const Params __attribute__((address_space(4))) CParams;
constexpr int NPH = 13;
constexpr int WAVE_LDS = 19968;
constexpr int LDS_MISC = 8 * WAVE_LDS;
constexpr int LDS_BYTES = LDS_MISC + 1024;

struct Ctx {
    LAS unsigned char* lds; int tid, lane, wave, gw, ngw, L;
    CParams* p;
    unsigned char* ws;
};
DI unsigned char* fresh(GAS unsigned char* q) { asm volatile("" : "+s"(q)); return (unsigned char*)q; }
#define inp(c, k) ((const float*)(c).p->in[k])
#define outp(c) ((float*)(c).p->out)

DI void transpose_item(const float* W, int K, int N, bf16* WT, int drow0, LAS float* scr, int kb, int nb, int lane, bool lo_part, float qs = 0.f) {
    const int k0 = 64 * kb, n0 = 32 * nb;
#pragma unroll 8
    for (int i = 0; i < 32; ++i) { const int kk = 2 * i + (lane >> 5); scr[kk * 33 + (lane & 31)] = W[(size_t)(k0 + kk) * N + n0 + (lane & 31)]; }
    asm volatile("s_waitcnt lgkmcnt(0)" ::: "memory");
    const int c = lane & 7;
#pragma unroll
    for (int j = 0; j < 4; ++j) { const int n = (lane >> 3) + 8 * j; const LAS float* s = scr + (8 * c) * 33 + n;
        float v[8];
#pragma unroll
        for (int q = 0; q < 8; ++q) { v[q] = s[q * 33]; if (lo_part) v[q] = v[q] - bf2f(f2bf(v[q])); if (EMU_FP8 && qs != 0.f) v[q] = q8(v[q] * qs) / qs; }
        u32x4 o; o.x = pk2(v[0], v[1]); o.y = pk2(v[2], v[3]); o.z = pk2(v[4], v[5]); o.w = pk2(v[6], v[7]);
        *(u32x4*)(WT + (size_t)(drow0 + n) * K + k0 + 8 * c) = o; }
    asm volatile("s_waitcnt lgkmcnt(0)" ::: "memory");
}

DI void transpose_item8(const float* W, int K, int N, unsigned char* WT, int drow0, LAS float* scr, int kb, int nb, int lane) {
    const int k0 = 64 * kb, n0 = 32 * nb;
#pragma unroll 8
    for (int i = 0; i < 32; ++i) { const int kk = 2 * i + (lane >> 5); scr[kk * 33 + (lane & 31)] = W[(size_t)(k0 + kk) * N + n0 + (lane & 31)]; }
    asm volatile("s_waitcnt lgkmcnt(0)" ::: "memory");
    const int c = lane & 7;
#pragma unroll
    for (int j = 0; j < 4; ++j) { const int n = (lane >> 3) + 8 * j; const LAS float* s = scr + (8 * c) * 33 + n;
        float v[8];
#pragma unroll
        for (int q = 0; q < 8; ++q) v[q] = s[q * 33] * 64.f;
        int p0 = __builtin_amdgcn_cvt_pk_fp8_f32(v[0], v[1], 0, false); p0 = __builtin_amdgcn_cvt_pk_fp8_f32(v[2], v[3], p0, true);
        int p1 = __builtin_amdgcn_cvt_pk_fp8_f32(v[4], v[5], 0, false); p1 = __builtin_amdgcn_cvt_pk_fp8_f32(v[6], v[7], p1, true);
        u32x2 o; o.x = (unsigned)p0; o.y = (unsigned)p1;
        *(u32x2*)(WT + (size_t)(drow0 + n) * K + k0 + 8 * c) = o; }
    asm volatile("s_waitcnt lgkmcnt(0)" ::: "memory");
}

DI void phase0(const Ctx& c) {
    const int L = c.L;
    unsigned char* ws = c.ws;
    {
        LAS float* sc = (LAS float*)c.lds;
        LAS float* part = (LAS float*)(c.lds + 32768);
        for (int i = c.tid; i < 3 * D; i += 512) { const int r = i / D, k = i % D; const float v = r < 2 ? inp(c, 1)[r * D + k] : inp(c, 3)[k]; sc[i] = v / (1.f + __expf(-v)); }
        __syncthreads();
        const float* wa = inp(c, 4) + (size_t)L * D * 6 * D; const float* ba = inp(c, 5) + (size_t)L * 6 * D;
        float* mod = (float*)(ws + WS_MOD);
        for (int cb = blockIdx.x; cb < 256; cb += gridDim.x) {
            const int n0 = cb * 48;
            float a0 = 0.f, a1 = 0.f, a2 = 0.f;
            if (c.lane < 48) {
                const float* wp = wa + (size_t)(c.wave * 256) * (6 * D) + n0 + c.lane;
#pragma unroll 8
                for (int k = 0; k < 256; ++k) { const float w = wp[(size_t)k * (6 * D)]; const int kk = c.wave * 256 + k; a0 += sc[kk] * w; a1 += sc[D + kk] * w; a2 += sc[2 * D + kk] * w; }
                part[(c.wave * 3 + 0) * 48 + c.lane] = a0; part[(c.wave * 3 + 1) * 48 + c.lane] = a1; part[(c.wave * 3 + 2) * 48 + c.lane] = a2;
            }
            __syncthreads();
            if (c.tid < 144) { const int r = c.tid / 48, j = c.tid % 48; float s = 0.f;
#pragma unroll
                for (int w = 0; w < 8; ++w) s += part[(w * 3 + r) * 48 + j];
                mod[r * 6 * D + n0 + j] = s + ba[n0 + j]; }
            __syncthreads();
        }
    }
    {
        LAS float* scr = (LAS float*)(c.lds + c.wave * WAVE_LDS);
        constexpr int I_IN = 32 * (PW / 32), I_OUT = 32 * 64, I_E = 1536, I_R = 64;
        constexpr int NIT = I_IN + I_OUT + 65 * I_E + 2 * I_R;
        bf16* win = (bf16*)(ws + WS_WIN); bf16* wout = (bf16*)(ws + WS_WOUT); bf16* wgu = (bf16*)(ws + WS_WGU); bf16* wd = (bf16*)(ws + WS_WD); bf16* rw = (bf16*)(ws + WS_ROUTW);
        for (int it = c.gw; it < NIT; it += c.ngw) {
            int r = it;
            if (r < I_IN) { const int nblk = PW / 32; transpose_item(inp(c, 6) + (size_t)L * D * PW, D, PW, win, 32 * (r % nblk), scr, r / nblk, r % nblk, c.lane, false); continue; } r -= I_IN;
            if (r < I_OUT) { transpose_item(inp(c, 13) + (size_t)L * D * D, D, D, wout, 32 * (r % 64), scr, r / 64, r % 64, c.lane, false); continue; } r -= I_OUT;
            if (r < 65 * I_E) {
                const int e = r / I_E, q = r % I_E, which = q / 512, idx = q % 512;
                if (which < 2) {
                    const float* W = e < 64 ? inp(c, which == 0 ? 18 : 19) + ((size_t)(L * 64 + e)) * D * DEXP : inp(c, which == 0 ? 21 : 22) + (size_t)L * D * DEXP;
                    const int kb = idx / 16, nb = idx % 16, n0 = 32 * nb;
                    transpose_item8(W, D, DEXP, (unsigned char*)wgu, e * 1024 + (n0 / 128) * 256 + which * 128 + (n0 % 128), scr, kb, nb, c.lane);
                } else {
                    const float* W = e < 64 ? inp(c, 20) + ((size_t)(L * 64 + e)) * DEXP * D : inp(c, 23) + (size_t)L * DEXP * D;
                    const int kb = idx / 64, nb = idx % 64;
                    transpose_item8(W, DEXP, D, (unsigned char*)wd, e * 2048 + 32 * nb, scr, kb, nb, c.lane);
                }
                continue; }
            r -= 65 * I_E;
            { const int lo = r / I_R, idx = r % I_R, kb = idx / 2, nb = idx % 2;
              transpose_item(inp(c, 16) + (size_t)L * D * NEXP, D, NEXP, rw, lo * 64 + 32 * nb, scr, kb, nb, c.lane, lo != 0); }
        }
    }
    if (L == 0) {
        float* rope = (float*)(ws + WS_ROPE);
        for (int i = blockIdx.x * 512 + c.tid; i < 128 * 16; i += gridDim.x * 512) {
            const int pos = i / 16, f = i % 16;
            const float inv = exp2f(-(float)f * (13.287712379549449f / 16.f));
            const float ang = (float)pos * inv;
            const float n = rintf(ang * 0.15915494309189535f);
            float rr = fmaf(-n, 6.28125f, ang); rr = fmaf(-n, 1.9353071795864769e-3f, rr);
            rope[2 * i] = __cosf(rr); rope[2 * i + 1] = __sinf(rr);
        }
    }
}

DI void row_stats(const f32x4 (&v)[8], float& mean, float& rstd) {
    float s = 0.f;
#pragma unroll
    for (int j = 0; j < 8; ++j) s += (v[j].x + v[j].y) + (v[j].z + v[j].w);
    mean = wave_sum(s) * (1.f / D);
    float q = 0.f;
#pragma unroll
    for (int j = 0; j < 8; ++j) { const f32x4 d = v[j] - mean; q += (d.x * d.x + d.y * d.y) + (d.z * d.z + d.w * d.w); }
    rstd = 1.f / sqrtf(wave_sum(q) * (1.f / D) + LN_EPS);
}
DI const float* mod_row(const Ctx& c, int row) { return (const float*)(c.ws + WS_MOD) + (size_t)(row < NLAT ? row / SEQ : 2) * 6 * D; }
DI const float* x_in_row(const Ctx& c, int row) {

    if (row < NLAT) return (c.L == 0 ? inp(c, 0) : (const float*)outp(c)) + (size_t)row * D;
    return (c.L == 0 ? inp(c, 2) : (const float*)(c.ws + WS_HCTX)) + (size_t)(row - NLAT) * D;
}

DI void phase1(const Ctx& c) {
    bf16* xn = (bf16*)(c.ws + WS_XN);
    for (int r2 = c.gw; r2 < NTOK / 2; r2 += c.ngw) {
        f32x4 v[2][8]; float mean[2], rstd[2];
#pragma unroll
        for (int u = 0; u < 2; ++u) { const float* xr = x_in_row(c, 2 * r2 + u);
#pragma unroll
            for (int j = 0; j < 8; ++j) v[u][j] = *(const f32x4*)(xr + 4 * c.lane + 256 * j); }
#pragma unroll
        for (int u = 0; u < 2; ++u) row_stats(v[u], mean[u], rstd[u]);
        const float* mod = mod_row(c, 2 * r2);
#pragma unroll
        for (int j = 0; j < 8; ++j) { const int col = 4 * c.lane + 256 * j;
            const f32x4 sh = *(const f32x4*)(mod + col), sc = *(const f32x4*)(mod + D + col);
#pragma unroll
            for (int u = 0; u < 2; ++u) { const f32x4 y = (v[u][j] - mean[u]) * rstd[u] * (sc + 1.f) + sh;
                u32x2 o; o.x = pk2(y.x, y.y); o.y = pk2(y.z, y.w);
                *(u32x2*)(xn + (size_t)(2 * r2 + u) * D + col) = o; } }
    }
}

DI void phase7(const Ctx& c) {
    const int L = c.L;
    bf16* xn = (bf16*)(c.ws + WS_XN); bf16* xl = (bf16*)(c.ws + WS_XL); const bf16* T = (const bf16*)(c.ws + WS_T); float* x1 = (float*)(c.ws + WS_X1);
    const float* lg = inp(c, 14) + (size_t)L * D; const float* lb = inp(c, 15) + (size_t)L * D;
    const int nrows = L == 0 ? NTOK : NLAT;
    for (int r2 = c.gw; r2 < nrows / 2; r2 += c.ngw) {
        const float* mod = mod_row(c, 2 * r2);
        f32x4 v[2][8]; float mean[2], rstd[2];
#pragma unroll
        for (int u = 0; u < 2; ++u) { const int row = 2 * r2 + u; const float* xr = x_in_row(c, row);
#pragma unroll
            for (int j = 0; j < 8; ++j) { const int col = 4 * c.lane + 256 * j;
                const f32x4 x = *(const f32x4*)(xr + col), g = *(const f32x4*)(mod + 2 * D + col);
                const u32x2 t = *(const u32x2*)(T + (size_t)row * D + col);
                v[u][j] = x * DN_ALPHA + g * (f32x4){lo16(t.x), hi16(t.x), lo16(t.y), hi16(t.y)}; } }
#pragma unroll
        for (int u = 0; u < 2; ++u) row_stats(v[u], mean[u], rstd[u]);
#pragma unroll
        for (int j = 0; j < 8; ++j) { const int col = 4 * c.lane + 256 * j; const f32x4 gg = *(const f32x4*)(lg + col), bb = *(const f32x4*)(lb + col);
#pragma unroll
            for (int u = 0; u < 2; ++u) { v[u][j] = (v[u][j] - mean[u]) * rstd[u] * gg + bb; *(f32x4*)(x1 + (size_t)(2 * r2 + u) * D + col) = v[u][j]; } }
#pragma unroll
        for (int u = 0; u < 2; ++u) row_stats(v[u], mean[u], rstd[u]);
#pragma unroll
        for (int j = 0; j < 8; ++j) { const int col = 4 * c.lane + 256 * j;
            const f32x4 sh = *(const f32x4*)(mod + 3 * D + col), sc = *(const f32x4*)(mod + 4 * D + col);
#pragma unroll
            for (int u = 0; u < 2; ++u) { const f32x4 y = (v[u][j] - mean[u]) * rstd[u] * (sc + 1.f) + sh;
                u32x2 o; o.x = pk2(y.x, y.y); o.y = pk2(y.z, y.w);
                u32x2 ol; ol.x = pk2(y.x - lo16(o.x), y.y - hi16(o.x)); ol.y = pk2(y.z - lo16(o.y), y.w - hi16(o.y));
                *(u32x2*)(xn + (size_t)(2 * r2 + u) * D + col) = o; *(u32x2*)(xl + (size_t)(2 * r2 + u) * D + col) = ol;
                { int pq = __builtin_amdgcn_cvt_pk_fp8_f32(y.x, y.y, 0, false); pq = __builtin_amdgcn_cvt_pk_fp8_f32(y.z, y.w, pq, true); *(int*)((unsigned char*)(c.ws + WS_XQ) + (size_t)(2 * r2 + u) * D + col) = pq; } } }
    }
}
constexpr int VSTR = 144;
struct AttnAcc { f32x16 o0, o1; float m, l; };
DI void attn_init(AttnAcc& a) { a.o0 = zero16(); a.o1 = zero16(); a.m = -INFINITY; a.l = 0.f; }

struct KV { bf16x8 k[4]; u32x4 v[4]; };
DI void attn_load(KV& t, const bf16* krow, const bf16* vsrc, int half) {
#pragma unroll
    for (int s = 0; s < 4; ++s) t.k[s] = *(const bf16x8*)(krow + 16 * s + 8 * half);
    const u32x4* sv = (const u32x4*)vsrc; t.v[0] = sv[0]; t.v[1] = sv[1]; t.v[2] = sv[2]; t.v[3] = sv[3];
}
template <class ScoreF>
DI void attn_tile(AttnAcc& a, const bf16x8 (&qf)[4], const bf16x8 (&kf)[4], const u32x4 (&vr)[4], LAS unsigned char* vl, int lane, ScoreF sf) {
    const int half = lane >> 5;
    {
        LAS unsigned char* d = vl + (lane >> 1) * VSTR + (lane & 1) * 64;
        *(LAS u32x4*)(d) = vr[0]; *(LAS u32x4*)(d + 16) = vr[1]; *(LAS u32x4*)(d + 32) = vr[2]; *(LAS u32x4*)(d + 48) = vr[3];
    }
    f32x16 st = zero16();
#pragma unroll
    for (int s = 0; s < 4; ++s) st = MFMA32(kf[s], qf[s], st);
    float sc[16]; float mx = -INFINITY;
#pragma unroll
    for (int r = 0; r < 16; ++r) { sc[r] = sf(crow(r, half), st[r]); mx = fmaxf(mx, sc[r]); }
    mx = fmaxf(mx, __shfl_xor(mx, 32));
    const float mnew = fmaxf(a.m, mx);
    const float muse = (mnew == -INFINITY) ? 0.f : mnew;
    const float corr = __expf(a.m - muse);
    float ps = 0.f;
#pragma unroll
    for (int r = 0; r < 16; ++r) { sc[r] = __expf(sc[r] - muse); ps += sc[r]; }
    ps += __shfl_xor(ps, 32);
    a.l = a.l * corr + ps; a.m = mnew;
#pragma unroll
    for (int r = 0; r < 16; ++r) { a.o0[r] *= corr; a.o1[r] *= corr; }
    const bf16x8 pb0 = pack8(sc[0], sc[1], sc[2], sc[3], sc[4], sc[5], sc[6], sc[7]);
    const bf16x8 pb1 = pack8(sc[8], sc[9], sc[10], sc[11], sc[12], sc[13], sc[14], sc[15]);
    const int q = (lane & 15) >> 2, pp = lane & 3, blk = (lane >> 4) & 1;
    LAS unsigned char* vb = vl + (4 * half + q) * VSTR + (16 * blk + 4 * pp) * 2;
    { const bf16x8 A = cat4(tr_read(vb), tr_read(vb + 8 * VSTR)); a.o0 = MFMA32(A, pb0, a.o0); }
    { const bf16x8 A = cat4(tr_read(vb + 64), tr_read(vb + 8 * VSTR + 64)); a.o1 = MFMA32(A, pb0, a.o1); }
    { const bf16x8 A = cat4(tr_read(vb + 16 * VSTR), tr_read(vb + 24 * VSTR)); a.o0 = MFMA32(A, pb1, a.o0); }
    { const bf16x8 A = cat4(tr_read(vb + 16 * VSTR + 64), tr_read(vb + 24 * VSTR + 64)); a.o1 = MFMA32(A, pb1, a.o1); }
}
DI void attn_store(const AttnAcc& a, bf16* orow, int lane) {
    const int half = lane >> 5; const float inv = 1.f / a.l;
#pragma unroll
    for (int g = 0; g < 4; ++g) {
        u32x2 w0; w0.x = pk2(a.o0[4 * g] * inv, a.o0[4 * g + 1] * inv); w0.y = pk2(a.o0[4 * g + 2] * inv, a.o0[4 * g + 3] * inv);
        u32x2 w1; w1.x = pk2(a.o1[4 * g] * inv, a.o1[4 * g + 1] * inv); w1.y = pk2(a.o1[4 * g + 2] * inv, a.o1[4 * g + 3] * inv);
        *(u32x2*)(orow + 8 * g + 4 * half) = w0; *(u32x2*)(orow + 32 + 8 * g + 4 * half) = w1; }
}
DI void load_frags(bf16x8 (&f)[4], const bf16* row, int half) {
#pragma unroll
    for (int s = 0; s < 4; ++s) f[s] = *(const bf16x8*)(row + 16 * s + 8 * half);
}
DI void rope_frags(bf16x8 (&f)[4], int posr, int posc, int half, const float* rope) {
#pragma unroll
    for (int pr = 0; pr < 2; ++pr) {
        const int pos = pr == 0 ? posr : posc;
        const f32x4* t = (const f32x4*)(rope + (size_t)(pos * 16 + 8 * half) * 2);
        const f32x4 t0 = t[0], t1 = t[1], t2 = t[2], t3 = t[3];
        const float cs[16] = {t0.x, t0.y, t0.z, t0.w, t1.x, t1.y, t1.z, t1.w, t2.x, t2.y, t2.z, t2.w, t3.x, t3.y, t3.z, t3.w};
        float x1[8], x2[8]; unpack8(f[2 * pr], x1); unpack8(f[2 * pr + 1], x2);
        float y1[8], y2[8];
#pragma unroll
        for (int e = 0; e < 8; ++e) { const float co = cs[2 * e], si = cs[2 * e + 1]; y1[e] = x1[e] * co - x2[e] * si; y2[e] = x2[e] * co + x1[e] * si; }
        f[2 * pr] = pack8(y1[0], y1[1], y1[2], y1[3], y1[4], y1[5], y1[6], y1[7]);
        f[2 * pr + 1] = pack8(y2[0], y2[1], y2[2], y2[3], y2[4], y2[5], y2[6], y2[7]);
    }
}

DI void na_item(const Ctx& c, int item) {
    const bf16* P = (const bf16*)(c.ws + WS_P); bf16* Y = (bf16*)(c.ws + WS_YMIX);
    const int lane = c.lane, half = lane >> 5, j = lane & 31;
    const int cc = item & 1, h = (item >> 1) & 7, r = (item >> 4) & 127, b = item >> 11;
    const float* rpb = inp(c, 7) + (size_t)(c.L * 8 + h) * 15 * 31;
    LAS unsigned char* vl = c.lds + c.wave * WAVE_LDS;
    const int qrow = b * SEQ + r * 64 + 32 * cc + j;
    bf16x8 qf[4]; load_frags(qf, P + (size_t)qrow * PWP + NA_Q + h * 64, half);
    const int qc0 = 32 * cc + j;
    const int rs = min(max(r - 4, 0), 120);
    AttnAcc a; attn_init(a);
    auto base_of = [&](int t) { return t < 16 ? b * SEQ + (rs + (t >> 1)) * 64 + 32 * (t & 1) : NLAT + b * CTXL + 32 * (t - 16); };
    auto load = [&](KV& kv, int t) { const int base = base_of(t);
        attn_load(kv, P + (size_t)(base + j) * PWP + NA_K + h * 64, P + (size_t)(base + (lane >> 1)) * PWP + NA_V + h * 64 + (lane & 1) * 32, half); };
    auto compute = [&](KV& kv, int t) {
        int qc_ = qc0; asm volatile("" : "+v"(qc_));
        const int qc = qc_, cstart = min(max(qc - 8, 0), 48);
        const bool isctx = t >= 16; const int kc0 = 32 * (t & 1);
        const float* brow = rpb + (rs + (t >> 1) - r + 7) * 31;
        attn_tile(a, qf, kv.k, kv.v, vl, lane, [&](int i, float raw) {
            const int kc = kc0 + i; const bool ok = isctx || ((kc >= cstart) && (kc < cstart + 16));
            const int bi = min(max(kc - qc + 15, 0), 30);
            const float bias = isctx ? 0.f : brow[bi];
            return ok ? raw * 0.125f + bias : -INFINITY; }); };
    KV A, B; load(A, 0);
    for (int t = 0; t < 24; t += 2) { load(B, t + 1); compute(A, t); if (t + 2 < 24) load(A, t + 2); compute(B, t + 1); }
    attn_store(a, Y + (size_t)qrow * D + h * 64, lane);
}

DI void swa_item(const Ctx& c, int item) {
    const bf16* P = (const bf16*)(c.ws + WS_P); bf16* Y = (bf16*)(c.ws + WS_YMIX); const float* rope = (const float*)(c.ws + WS_ROPE);
    const int lane = c.lane, half = lane >> 5, j = lane & 31;
    const int hq = item & 7, qb = (item >> 3) & 255, b = item >> 11, kvh = hq >> 2;
    LAS unsigned char* vl = c.lds + c.wave * WAVE_LDS;
    const int i0 = 32 * qb, qi = i0 + j, qrow = b * SEQ + qi;
    bf16x8 qf[4]; load_frags(qf, P + (size_t)qrow * PWP + SW_Q + hq * 64, half);
    rope_frags(qf, qi >> 6, qi & 63, half, rope);
    AttnAcc a; attn_init(a);
    const int m_lo = max(0, 4 - qb), m_hi = min(9, 260 - qb), nw = m_hi - m_lo, nt = nw + 8;
    auto load = [&](KV& kv, int t) {
        const int base = t < nw ? b * SEQ + i0 - 128 + 32 * (m_lo + t) : NLAT + b * CTXL + 32 * (t - nw);
        attn_load(kv, P + (size_t)(base + j) * PWP + SW_K + kvh * 64, P + (size_t)(base + (lane >> 1)) * PWP + SW_V + kvh * 64 + (lane & 1) * 32, half); };
    auto compute = [&](KV& kv, int t) {
        const bool isctx = t >= nw; const int j0 = i0 - 128 + 32 * (m_lo + t);
        if (!isctx) { const int kj = j0 + j; rope_frags(kv.k, kj >> 6, kj & 63, half, rope); }
        attn_tile(a, qf, kv.k, kv.v, vl, lane, [&](int i, float raw) {
            const int dlt = j0 + i - qi; const bool ok = isctx || ((dlt >= -128) && (dlt <= 128));
            return ok ? raw * 0.125f : -INFINITY; }); };
    KV A, B; load(A, 0);
    for (int t = 0; t < nt; t += 2) {
        if (t + 1 < nt) load(B, t + 1);
        compute(A, t);
        if (t + 1 < nt) { if (t + 2 < nt) load(A, t + 2); compute(B, t + 1); }
    }
    const float sink = inp(c, 12)[c.L * 8 + hq];
    a.l += __expf(sink - a.m);
    attn_store(a, Y + (size_t)qrow * D + 1536 + hq * 64, lane);
}

DI void ctx_attn_item(const Ctx& c, int item) {
    const bf16* P = (const bf16*)(c.ws + WS_P); bf16* Y = (bf16*)(c.ws + WS_YMIX);
    const int lane = c.lane, half = lane >> 5, j = lane & 31;
    const int h = item & 7, qb = (item >> 3) & 7, b = (item >> 6) & 1, kind = item >> 7;
    LAS unsigned char* vl = c.lds + c.wave * WAVE_LDS;
    const int qcol = kind == 0 ? NA_Q + h * 64 : SW_Q + h * 64;
    const int kcol = kind == 0 ? NA_K + h * 64 : SW_K + (h >> 2) * 64;
    const int vcol = kind == 0 ? NA_V + h * 64 : SW_V + (h >> 2) * 64;
    const int qrow = NLAT + b * CTXL + 32 * qb + j;
    bf16x8 qf[4]; load_frags(qf, P + (size_t)qrow * PWP + qcol, half);
    AttnAcc a; attn_init(a);
    auto load = [&](KV& kv, int t) { const int base = NLAT + b * CTXL + 32 * t;
        attn_load(kv, P + (size_t)(base + j) * PWP + kcol, P + (size_t)(base + (lane >> 1)) * PWP + vcol + (lane & 1) * 32, half); };
    KV A, B; load(A, 0);
    for (int t = 0; t < 8; t += 2) {
        load(B, t + 1);
        attn_tile(a, qf, A.k, A.v, vl, lane, [&](int, float raw) { return raw * 0.125f; });
        if (t + 2 < 8) load(A, t + 2);
        attn_tile(a, qf, B.k, B.v, vl, lane, [&](int, float raw) { return raw * 0.125f; });
    }
    if (kind == 1) a.l += __expf(inp(c, 12)[c.L * 8 + h] - a.m);
    attn_store(a, Y + (size_t)qrow * D + (kind == 0 ? 0 : 1536) + h * 64, lane);
}

DI void conv_row(const Ctx& c, int row) {
    const bf16* P = (const bf16*)(c.ws + WS_P); bf16* Y = (bf16*)(c.ws + WS_YMIX);
    const int lane = c.lane, ch = 8 * lane;
    const float* w = inp(c, 8) + (size_t)c.L * 3 * 512;
    int pos, len; if (row < NLAT) { pos = row % SEQ; len = SEQ; } else { pos = (row - NLAT) % CTXL; len = CTXL; }
    float acc[8];
#pragma unroll
    for (int e = 0; e < 8; ++e) acc[e] = 0.f;
#pragma unroll
    for (int t = 0; t < 3; ++t) {
        const int q = pos + t - 1;
        if (q < 0 || q >= len) continue;
        const bf16* pr = P + (size_t)(row + t - 1) * PWP;
        float u[8], g[8]; unpack8(*(const bf16x8*)(pr + SC_U + ch), u); unpack8(*(const bf16x8*)(pr + SC_C + ch), g);
        const f32x4 w0 = *(const f32x4*)(w + t * 512 + ch), w1 = *(const f32x4*)(w + t * 512 + ch + 4);
        const float wv[8] = {w0.x, w0.y, w0.z, w0.w, w1.x, w1.y, w1.z, w1.w};
#pragma unroll
        for (int e = 0; e < 8; ++e) acc[e] += wv[e] * (g[e] * u[e]);
    }
    float gb[8]; unpack8(*(const bf16x8*)(P + (size_t)row * PWP + SC_B + ch), gb);
    *(bf16x8*)(Y + (size_t)row * D + 512 + ch) = pack8(gb[0] * acc[0], gb[1] * acc[1], gb[2] * acc[2], gb[3] * acc[3], gb[4] * acc[4], gb[5] * acc[5], gb[6] * acc[6], gb[7] * acc[7]);
}
constexpr int KSTR = 144, V2STR = 272;
DI int gla_row0(int b, int ck) { return ck < 8 ? NLAT + b * CTXL + 32 * ck : b * SEQ + 32 * (ck - 8); }
DI int gla_chain_pos(int dir, int ck) { return ck < 8 ? (dir == 0 ? ck : 7 - ck) : (dir == 0 ? ck : 8 + 255 - (ck - 8)); }

struct GlaGate { float w[16]; float bias; };
template <int DIR>
DI void gla_gate_load(const Ctx& c, int h, GlaGate& g) {
    const float* w2 = inp(c, 9) + (size_t)((c.L * 2 + DIR) * 16) * 256 + h * 64 + c.lane;
#pragma unroll
    for (int i = 0; i < 16; ++i) g.w[i] = w2[i * 256];
    g.bias = inp(c, 10)[(c.L * 2 + DIR) * 256 + h * 64 + c.lane];
}
DI void gla_stage_z(const bf16* P, int row0, LAS unsigned char* zl, int lane) {
    const u32x4* s = (const u32x4*)(P + (size_t)(row0 + (lane >> 1)) * PWP + GL_Z + (lane & 1) * 16);
    const u32x4 v0 = s[0], v1 = s[1];
    *(LAS u32x4*)(zl + lane * 32) = v0; *(LAS u32x4*)(zl + lane * 32 + 16) = v1;
}
template <int DIR>
DI float gla_la(const GlaGate& g, const LAS unsigned char* zl, int t) {
    const LAS unsigned char* zr = zl + t * 64 + DIR * 32;
    float a[8], bq[8]; unpack8(*(const LAS bf16x8*)zr, a); unpack8(*(const LAS bf16x8*)(zr + 16), bq);
    float x = g.bias;
#pragma unroll
    for (int i = 0; i < 8; ++i) x += a[i] * g.w[i];
#pragma unroll
    for (int i = 0; i < 8; ++i) x += bq[i] * g.w[8 + i];
    return (fminf(x, 0.f) - __logf(1.f + __expf(-fabsf(x)))) * (1.f / 16.f);
}
DI void gla_stage_v(const bf16* P, int row0, int h, LAS unsigned char* vl, int lane) {
#pragma unroll
    for (int i = 0; i < 8; ++i) { const int idx = lane + 64 * i, t = idx >> 4, ch = idx & 15;
        *(LAS u32x4*)(vl + t * V2STR + ch * 16) = *(const u32x4*)(P + (size_t)(row0 + t) * PWP + GL_V + h * 128 + ch * 8); }
}

template <int DIR>
DI void gla_g1(const Ctx& c, int b, int h, int ck) {
    const bf16* P = (const bf16*)(c.ws + WS_P);
    const int lane = c.lane, half = lane >> 5;
    LAS unsigned char* kl = c.lds + c.wave * WAVE_LDS; LAS unsigned char* vl = kl + 32 * KSTR;
    const int row0 = gla_row0(b, ck), n = gla_chain_pos(DIR, ck);
    const size_t chain = (size_t)((b * 2 + DIR) * 4 + h) * NCH + n;
    GlaGate gate; gla_gate_load<DIR>(c, h, gate);
    LAS unsigned char* zl = vl + 32 * V2STR;
    gla_stage_z(P, row0, zl, lane);
    bf16 kraw[32];
#pragma unroll
    for (int t = 0; t < 32; ++t) kraw[t] = P[(size_t)(row0 + t) * PWP + GL_K + h * 64 + lane];
    float rev = 0.f;
#pragma unroll
    for (int tt = 31; tt >= 0; --tt) {
        const int t = DIR ? 31 - tt : tt;
        *(LAS bf16*)(kl + t * KSTR + 2 * lane) = f2bf(bf2f(kraw[t]) * __expf(rev));
        rev += gla_la<DIR>(gate, zl, t);
    }
    ((float*)(c.ws + WS_GDEC))[chain * 64 + lane] = __expf(rev);
    gla_stage_v(P, row0, h, vl, lane);
    const int q = (lane & 15) >> 2, pp = lane & 3, blk = (lane >> 4) & 1;
    bf16* ut = (bf16*)(c.ws + WS_UT) + chain * 8192;
    bf16x8 Bf[2][2];
#pragma unroll
    for (int nt = 0; nt < 2; ++nt)
#pragma unroll
        for (int s = 0; s < 2; ++s) { LAS unsigned char* a = kl + (16 * s + 8 * half + q) * KSTR + (32 * nt + 16 * blk + 4 * pp) * 2; Bf[nt][s] = cat4(tr_read(a), tr_read(a + 4 * KSTR)); }
#pragma unroll
    for (int mt = 0; mt < 4; ++mt) {
        bf16x8 Af[2];
#pragma unroll
        for (int s = 0; s < 2; ++s) { LAS unsigned char* a = vl + (16 * s + 8 * half + q) * V2STR + (32 * mt + 16 * blk + 4 * pp) * 2; Af[s] = cat4(tr_read(a), tr_read(a + 4 * V2STR)); }
#pragma unroll
        for (int nt = 0; nt < 2; ++nt) {
            f32x16 acc = zero16();
            acc = MFMA32(Af[0], Bf[nt][0], acc); acc = MFMA32(Af[1], Bf[nt][1], acc);
#pragma unroll
            for (int r = 0; r < 16; ++r) ut[(32 * mt + crow(r, half)) * 64 + 32 * nt + (lane & 31)] = f2bf(acc[r]);
        }
    }
}

DI void gla_scan(const Ctx& c) {

    const bf16* ut = (const bf16*)(c.ws + WS_UT); bf16* sin = (bf16*)(c.ws + WS_SIN); const float* gd = (const float*)(c.ws + WS_GDEC);
    for (int e = blockIdx.x * 512 + c.tid; e < 16 * 8192; e += gridDim.x * 512) {
        const int chain = e >> 13, el = e & 8191, k = el & 63;
        const size_t base = (size_t)chain * NCH * 8192 + el;
        const float* g = gd + (size_t)chain * NCH * 64 + k;
        float st = 0.f;
        for (int n0 = 0; n0 < NCH; n0 += 24) {
            float u[24], gg[24];
#pragma unroll
            for (int i = 0; i < 24; ++i) { u[i] = bf2f(ut[base + (size_t)(n0 + i) * 8192]); gg[i] = g[(n0 + i) * 64]; }
#pragma unroll
            for (int i = 0; i < 24; ++i) { sin[base + (size_t)(n0 + i) * 8192] = f2bf(st); st = gg[i] * st + u[i]; }
        }
    }
}

template <int DIR>
DI void gla_g3_dir(const Ctx& c, const bf16* P, int b, int h, int ck, int row0, LAS unsigned char* ql, LAS unsigned char* kl, LAS unsigned char* vl, LAS unsigned char* zl, f32x16 (&o)[4]) {
    const int lane = c.lane, half = lane >> 5, j = lane & 31;
    { GlaGate gate; gla_gate_load<DIR>(c, h, gate);
      bf16 qraw[32], kraw[32];
#pragma unroll
      for (int t = 0; t < 32; ++t) { qraw[t] = P[(size_t)(row0 + t) * PWP + GL_Q + h * 64 + lane]; kraw[t] = P[(size_t)(row0 + t) * PWP + GL_K + h * 64 + lane]; }
      float cum = 0.f;
#pragma unroll
      for (int tt = 0; tt < 32; ++tt) {
        const int t = DIR ? 31 - tt : tt;
        cum += gla_la<DIR>(gate, zl, t);
        *(LAS bf16*)(ql + t * KSTR + 2 * lane) = f2bf(bf2f(qraw[t]) * __expf(cum) * 0.125f);
        *(LAS bf16*)(kl + t * KSTR + 2 * lane) = f2bf(bf2f(kraw[t]) * __expf(-cum));
      } }
    bf16x8 qf[4], kf[4];
#pragma unroll
    for (int s = 0; s < 4; ++s) { qf[s] = *(const LAS bf16x8*)(ql + j * KSTR + (16 * s + 8 * half) * 2); kf[s] = *(const LAS bf16x8*)(kl + j * KSTR + (16 * s + 8 * half) * 2); }
    f32x16 at = zero16();
#pragma unroll
    for (int s = 0; s < 4; ++s) at = MFMA32(kf[s], qf[s], at);
    float a[16];
#pragma unroll
    for (int r = 0; r < 16; ++r) { const int s = crow(r, half); const bool ok = DIR ? (s >= j) : (s <= j); a[r] = ok ? at[r] : 0.f; }
    const bf16x8 pb0 = pack8(a[0], a[1], a[2], a[3], a[4], a[5], a[6], a[7]), pb1 = pack8(a[8], a[9], a[10], a[11], a[12], a[13], a[14], a[15]);
    const int q = (lane & 15) >> 2, pp = lane & 3, blk = (lane >> 4) & 1;
    const size_t chain = (size_t)((b * 2 + DIR) * 4 + h) * NCH + gla_chain_pos(DIR, ck);
    const bf16* sin = (const bf16*)(c.ws + WS_SIN) + chain * 8192;
#pragma unroll
    for (int mt = 0; mt < 4; ++mt) {
        LAS unsigned char* vb = vl + (4 * half + q) * V2STR + (32 * mt + 16 * blk + 4 * pp) * 2;
        o[mt] = MFMA32(cat4(tr_read(vb), tr_read(vb + 8 * V2STR)), pb0, o[mt]);
        o[mt] = MFMA32(cat4(tr_read(vb + 16 * V2STR), tr_read(vb + 24 * V2STR)), pb1, o[mt]);
#pragma unroll
        for (int s = 0; s < 4; ++s) o[mt] = MFMA32(*(const bf16x8*)(sin + (size_t)(32 * mt + j) * 64 + 16 * s + 8 * half), qf[s], o[mt]);
    }
}
DI void gla_g3(const Ctx& c, int b, int h, int ck) {
    const bf16* P = (const bf16*)(c.ws + WS_P); bf16* Y = (bf16*)(c.ws + WS_YMIX);
    const int lane = c.lane, half = lane >> 5, j = lane & 31;
    LAS unsigned char* ql = c.lds + c.wave * WAVE_LDS; LAS unsigned char* kl = ql + 32 * KSTR; LAS unsigned char* vl = kl + 32 * KSTR;
    const int row0 = gla_row0(b, ck);
    LAS unsigned char* zl = vl + 32 * V2STR;
    gla_stage_v(P, row0, h, vl, lane); gla_stage_z(P, row0, zl, lane);
    f32x16 o[4];
#pragma unroll
    for (int mt = 0; mt < 4; ++mt) o[mt] = zero16();
    gla_g3_dir<0>(c, P, b, h, ck, row0, ql, kl, vl, zl, o);
    gla_g3_dir<1>(c, P, b, h, ck, row0, ql, kl, vl, zl, o);
    float ss = 0.f;
#pragma unroll
    for (int mt = 0; mt < 4; ++mt)
#pragma unroll
        for (int r = 0; r < 16; ++r) ss += o[mt][r] * o[mt][r];
    ss += __shfl_xor(ss, 32);
    const float rstd = 1.f / sqrtf(ss * (1.f / 128.f) + LN_EPS);
    const float* gain = inp(c, 11) + (size_t)c.L * 128;
    const int row = row0 + j;
#pragma unroll
    for (int mt = 0; mt < 4; ++mt)
#pragma unroll
        for (int g4 = 0; g4 < 4; ++g4) {
            const int v0 = 32 * mt + 8 * g4 + 4 * half;
            const u32x2 gr = *(const u32x2*)(P + (size_t)row * PWP + GL_G + h * 128 + v0);
            const float gv[4] = {lo16(gr.x), hi16(gr.x), lo16(gr.y), hi16(gr.y)};
            const f32x4 gn = *(const f32x4*)(gain + v0);
            float y[4];
#pragma unroll
            for (int e = 0; e < 4; ++e) { const float on = o[mt][4 * g4 + e] * rstd * gn[e]; y[e] = on * (gv[e] / (1.f + __expf(-gv[e]))); }
            u32x2 w; w.x = pk2(y[0], y[1]); w.y = pk2(y[2], y[3]);
            *(u32x2*)(Y + (size_t)row * D + 1024 + h * 128 + v0) = w; }
}
DI void router_phase(const Ctx& c) {
    const int L = c.L, lane = c.lane, r16 = lane & 15, q = lane >> 4;
    const bf16* xn = (const bf16*)(c.ws + WS_XN); const bf16* xl = (const bf16*)(c.ws + WS_XL); const bf16* rw = (const bf16*)(c.ws + WS_ROUTW);
    const float* rb = inp(c, 17) + (size_t)L * NEXP;
    int* eidx = (int*)(c.ws + WS_EIDX); int* rank = (int*)(c.ws + WS_RANK); float* wts = (float*)(c.ws + WS_WTS);
    unsigned* cnt = (unsigned*)(c.ws + WS_CTL) + CW_CNT + L * 64;
    LAS float* sc = (LAS float*)(c.lds + c.wave * WAVE_LDS);
    LAS float* sl = sc + 16 * 65;
    LAS unsigned* lcnt = (LAS unsigned*)(c.lds + LDS_MISC + 256);
    LAS unsigned* lbase = lcnt + 64;
    const int nitems = (L == 0 ? NTOK : NLAT) / 16;
    for (int it0 = 0; it0 < nitems; it0 += c.ngw) {
        if (c.tid < 64) lcnt[c.tid] = 0u;
        __syncthreads();
        const int tile = it0 + c.gw; const bool act = tile < nitems;
        int e0 = 0, e1 = 0, li0 = 0, li1 = 0; float w0 = 0.f, w1 = 0.f;
        if (act) {
            const int row = tile * 16 + r16;
            f32x4 acc[4];
#pragma unroll
            for (int nt = 0; nt < 4; ++nt) acc[nt] = (f32x4){0.f, 0.f, 0.f, 0.f};
#pragma unroll 4
            for (int ks = 0; ks < 64; ++ks) {
                const int k0 = 32 * ks + 8 * q;
                const bf16x8 ah = *(const bf16x8*)(xn + (size_t)row * D + k0), al = *(const bf16x8*)(xl + (size_t)row * D + k0);
#pragma unroll
                for (int nt = 0; nt < 4; ++nt) {
                    const bf16x8 bh = *(const bf16x8*)(rw + (size_t)(16 * nt + r16) * D + k0), bl = *(const bf16x8*)(rw + (size_t)(64 + 16 * nt + r16) * D + k0);
                    acc[nt] = MFMA16(ah, bh, acc[nt]); acc[nt] = MFMA16(al, bh, acc[nt]); acc[nt] = MFMA16(ah, bl, acc[nt]);
                }
            }
#pragma unroll
            for (int nt = 0; nt < 4; ++nt)
#pragma unroll
                for (int r = 0; r < 4; ++r) { const int e = 16 * nt + r16, t = 4 * q + r; const float s = 1.f / (1.f + __expf(-acc[nt][r])); sc[t * 65 + e] = s; sl[t * 65 + e] = s + rb[e]; }
            asm volatile("s_waitcnt lgkmcnt(0)" ::: "memory");
            const int t = lane >> 2, s4 = lane & 3;
            float v[16];
#pragma unroll
            for (int i = 0; i < 16; ++i) v[i] = sl[t * 65 + 16 * s4 + i];
            float ga, gb;
            { float m1 = -INFINITY, m2 = -INFINITY;
#pragma unroll
              for (int i = 0; i < 8; ++i) { if (v[i] > m1) { m2 = m1; m1 = v[i]; } else if (v[i] > m2) m2 = v[i]; }
              ga = m1 + m2; m1 = -INFINITY; m2 = -INFINITY;
#pragma unroll
              for (int i = 8; i < 16; ++i) { if (v[i] > m1) { m2 = m1; m1 = v[i]; } else if (v[i] > m2) m2 = v[i]; }
              gb = m1 + m2; }
            float gs[8];
#pragma unroll
            for (int s2 = 0; s2 < 4; ++s2) { gs[2 * s2] = __shfl(ga, (lane & ~3) | s2); gs[2 * s2 + 1] = __shfl(gb, (lane & ~3) | s2); }
            unsigned gmask = 0u;
#pragma unroll
            for (int it = 0; it < 4; ++it) { float best = -INFINITY; int bi = 0;
#pragma unroll
                for (int g = 0; g < 8; ++g) { const bool fr = ((gmask >> g) & 1u) == 0u; if (fr && gs[g] > best) { best = gs[g]; bi = g; } }
                gmask |= 1u << bi; }
            const bool oka = (gmask >> (2 * s4)) & 1u, okb = (gmask >> (2 * s4 + 1)) & 1u;
#pragma unroll
            for (int i = 0; i < 16; ++i) v[i] = ((i < 8) ? oka : okb) ? v[i] : -INFINITY;
            float wsum = 0.f;
#pragma unroll
            for (int rd = 0; rd < 8; ++rd) {
                float best = -INFINITY; int bi = 16 * s4;
#pragma unroll
                for (int i = 0; i < 16; ++i) if (v[i] > best) { best = v[i]; bi = 16 * s4 + i; }
#pragma unroll
                for (int o = 1; o < 4; o <<= 1) { const float ob = __shfl_xor(best, o); const int oi = __shfl_xor(bi, o); if (ob > best || (ob == best && oi < bi)) { best = ob; bi = oi; } }
                const float w = sc[t * 65 + bi]; wsum += w;
                if ((bi >> 4) == s4) {
#pragma unroll
                    for (int i = 0; i < 16; ++i) v[i] = (i == (bi & 15)) ? -INFINITY : v[i]; }
                if ((rd & 3) == s4) { if (rd < 4) { e0 = bi; w0 = w; } else { e1 = bi; w1 = w; } }
            }
            const float sc25 = 2.5f / wsum; w0 *= sc25; w1 *= sc25;
            li0 = (int)__hip_atomic_fetch_add((unsigned*)(lcnt + e0), 1u, __ATOMIC_RELAXED, __HIP_MEMORY_SCOPE_WORKGROUP); li1 = (int)__hip_atomic_fetch_add((unsigned*)(lcnt + e1), 1u, __ATOMIC_RELAXED, __HIP_MEMORY_SCOPE_WORKGROUP);
        }
        __syncthreads();
        if (c.tid < 64) { const unsigned n = lcnt[c.tid]; lbase[c.tid] = n ? atomicAdd(cnt + c.tid, n) : 0u; }
        __syncthreads();
        if (act) {
            const int tok = tile * 16 + (lane >> 2), s4 = lane & 3;
            eidx[tok * 8 + s4] = e0; wts[tok * 8 + s4] = w0; rank[tok * 8 + s4] = (int)lbase[e0] + li0;
            eidx[tok * 8 + s4 + 4] = e1; wts[tok * 8 + s4 + 4] = w1; rank[tok * 8 + s4 + 4] = (int)lbase[e1] + li1;
        }
        __syncthreads();
    }
}

DI void phase9(const Ctx& c) {
    const int L = c.L;
    const int nmoe = L == 0 ? NTOK : NLAT;
    LAS int* ts = (LAS int*)c.lds;
    const unsigned* cnt = (const unsigned*)(c.ws + WS_CTL) + CW_CNT + L * 64;
    if (c.tid == 0) { int acc = 0; for (int e = 0; e < 64; ++e) { ts[e] = acc; acc += ((int)cnt[e] + 255) >> 8; } ts[64] = acc; ts[65] = acc + nmoe / 256; }
    __syncthreads();
    int* toks = (int*)(c.ws + WS_TOKS); int* pos = (int*)(c.ws + WS_POS); int* tile_e = (int*)(c.ws + WS_TILEE);
    const int* eidx = (const int*)(c.ws + WS_EIDX); const int* rank = (const int*)(c.ws + WS_RANK);
    const int gt = blockIdx.x * 512 + c.tid, ngt = gridDim.x * 512;
    for (int i = gt; i < nmoe * 8; i += ngt) { const int e = eidx[i]; const int slot = ts[e] * 256 + rank[i]; toks[slot] = i >> 3; pos[i] = slot; }
    for (int i = gt; i < nmoe; i += ngt) toks[ts[64] * 256 + i] = i;
    for (int e = blockIdx.x; e < 65; e += gridDim.x) {
        for (int t = ts[e] + c.tid; t < ts[e + 1]; t += 512) tile_e[t] = e;
        if (e < 64) { const int n = (int)cnt[e]; for (int s = n + c.tid; s < (ts[e + 1] - ts[e]) * 256; s += 512) toks[ts[e] * 256 + s] = 0; }
    }
    if (blockIdx.x == 0 && c.tid == 0) { int* nt = (int*)(c.ws + WS_CTL) + CW_NT + L * 64; nt[0] = ts[65]; nt[1] = ts[64]; }
    __syncthreads();
}

DI void phase12(const Ctx& c) {
    const int L = c.L;
    const int nmoe = L == 0 ? NTOK : NLAT;
    const bf16* Yb = (const bf16*)(c.ws + WS_Y); const float* x1 = (const float*)(c.ws + WS_X1);
    const int* pos = (const int*)(c.ws + WS_POS); const float* wts = (const float*)(c.ws + WS_WTS);
    const int sh_tile0 = ((const int*)(c.ws + WS_CTL))[CW_NT + L * 64 + 1];
    const float* lg = inp(c, 24) + (size_t)L * D; const float* lb = inp(c, 25) + (size_t)L * D;
    for (int row = c.gw; row < nmoe; row += c.ngw) {
        const float* mod = mod_row(c, row);
        f32x4 f[8];
        int slot[8]; float w[8];
        { const int4 s0 = *(const int4*)(pos + row * 8), s1 = *(const int4*)(pos + row * 8 + 4); const f32x4 q0 = *(const f32x4*)(wts + row * 8), q1 = *(const f32x4*)(wts + row * 8 + 4);
          slot[0] = s0.x; slot[1] = s0.y; slot[2] = s0.z; slot[3] = s0.w; slot[4] = s1.x; slot[5] = s1.y; slot[6] = s1.z; slot[7] = s1.w;
          w[0] = q0.x; w[1] = q0.y; w[2] = q0.z; w[3] = q0.w; w[4] = q1.x; w[5] = q1.y; w[6] = q1.z; w[7] = q1.w; }
        {
            u32x2 y[5][8];
#pragma unroll
            for (int k = 0; k < 5; ++k) { const bf16* yr = Yb + (size_t)(k == 4 ? sh_tile0 * 256 + row : slot[k]) * D;
#pragma unroll
                for (int j = 0; j < 8; ++j) y[k][j] = *(const u32x2*)(yr + 4 * c.lane + 256 * j); }
#pragma unroll
            for (int j = 0; j < 8; ++j) { f[j] = (f32x4){lo16(y[4][j].x), hi16(y[4][j].x), lo16(y[4][j].y), hi16(y[4][j].y)};
#pragma unroll
                for (int k = 0; k < 4; ++k) f[j] += (f32x4){lo16(y[k][j].x), hi16(y[k][j].x), lo16(y[k][j].y), hi16(y[k][j].y)} * w[k]; }
        }
        {
            u32x2 y[4][8];
#pragma unroll
            for (int k = 0; k < 4; ++k) { const bf16* yr = Yb + (size_t)slot[4 + k] * D;
#pragma unroll
                for (int j = 0; j < 8; ++j) y[k][j] = *(const u32x2*)(yr + 4 * c.lane + 256 * j); }
#pragma unroll
            for (int j = 0; j < 8; ++j)
#pragma unroll
                for (int k = 0; k < 4; ++k) f[j] += (f32x4){lo16(y[k][j].x), hi16(y[k][j].x), lo16(y[k][j].y), hi16(y[k][j].y)} * w[4 + k];
        }
        f32x4 v[8];
#pragma unroll
        for (int j = 0; j < 8; ++j) { const int col = 4 * c.lane + 256 * j; v[j] = *(const f32x4*)(x1 + (size_t)row * D + col) * DN_ALPHA + *(const f32x4*)(mod + 5 * D + col) * f[j]; }
        float mean, rstd; row_stats(v, mean, rstd);
        float* orow = row < NLAT ? outp(c) + (size_t)row * D : (float*)(c.ws + WS_HCTX) + (size_t)(row - NLAT) * D;
#pragma unroll
        for (int j = 0; j < 8; ++j) { const int col = 4 * c.lane + 256 * j; *(f32x4*)(orow + col) = (v[j] - mean) * rstd * *(const f32x4*)(lg + col) + *(const f32x4*)(lb + col); }
    }
}

DI int xcd_vid() { const int G = gridDim.x, bx = blockIdx.x; return (G % 8 == 0) ? (bx % 8) * (G / 8) + bx / 8 : bx; }
__global__ void __launch_bounds__(512, 2) fwd(Params prm) {
    extern __shared__ __attribute__((aligned(16))) unsigned char lds_raw[];
    Ctx c; c.lds = (LAS unsigned char*)lds_raw; c.tid = threadIdx.x; c.lane = c.tid & 63; c.wave = __builtin_amdgcn_readfirstlane(c.tid >> 6);
    c.gw = blockIdx.x * 8 + c.wave; c.ngw = gridDim.x * 8; c.p = (CParams*)__builtin_amdgcn_kernarg_segment_ptr(); c.L = 0;
    volatile LAS unsigned* misc = (volatile LAS unsigned*)(c.lds + LDS_MISC);
    if (c.tid < 64) misc[c.tid] = 0u;
    __syncthreads();
    unsigned char* ws = (unsigned char*)prm.ws; c.ws = ws;
    XcdBarrier bar = xcd_barrier_post((unsigned*)(ws + WS_CTL) + CW_BAR, misc + 8);
    const int lo = prm.ph_lo, hi = prm.ph_hi;
#ifndef ONLY_PH
#define ONLY_PH -1
#endif
#ifndef DUPMASK
#define DUPMASK 0
#endif
#ifndef PHMASK
#define PHMASK 0x1fff
#endif
#define IN(k) (lo <= (k) && (k) < hi && (ONLY_PH < 0 || ((k) % NPH) == ONLY_PH) && ((PHMASK >> ((k) % NPH)) & 1))
#define REFRESH() do { { CParams* kp_ = (CParams*)__builtin_amdgcn_kernarg_segment_ptr(); asm volatile("" : "+s"(kp_)); c.p = kp_; } ws = fresh(c.p->ws); c.ws = ws; int t_ = threadIdx.x; asm volatile("" : "+v"(t_)); c.tid = t_; c.lane = t_ & 63; c.wave = __builtin_amdgcn_readfirstlane(t_ >> 6); c.gw = blockIdx.x * 8 + c.wave; } while (0)
#define SEAM(k) do { if (IN(k) && IN((k) + 1)) xcd_barrier(bar); } while (0)
    for (int L = 0; L < 2; ++L) {
        c.L = L; const int pb = L * NPH;
        if (IN(pb + 0)) { for (int rep_ = 0; rep_ <= ((DUPMASK >> 0) & 1); ++rep_) { if (rep_) xcd_barrier(bar); REFRESH(); phase0(c); __syncthreads(); } } SEAM(pb + 0);
        if (IN(pb + 1)) { for (int rep_ = 0; rep_ <= ((DUPMASK >> 1) & 1); ++rep_) { if (rep_) xcd_barrier(bar); REFRESH(); phase1(c); } } SEAM(pb + 1);
        if (IN(pb + 2)) { for (int rep_ = 0; rep_ <= ((DUPMASK >> 2) & 1); ++rep_) { if (rep_) xcd_barrier(bar); REFRESH();
            pg8::Gemm g{(const bf16*)(ws + WS_XN), (const bf16*)(ws + WS_WIN), D}; pg8::StaticOrder S; S.init(NTOK, PWP, gridDim.x, blockIdx.x);
            pg8::EpiBf16 E{(bf16*)(ws + WS_P), PWP, 1.f};
            pg8::gemm_phase<pg8::EpiBf16, pg8::StaticOrder, false>(c.lds, g, S, E, nullptr);
        } } SEAM(pb + 2);
        if (IN(pb + 3)) { for (int rep_ = 0; rep_ <= ((DUPMASK >> 3) & 1); ++rep_) { if (rep_) xcd_barrier(bar); REFRESH();
            for (int it = c.gw; it < 4096; it += c.ngw) na_item(c, it);
            for (int it = c.gw; it < 4096; it += c.ngw) swa_item(c, it);
            for (int it = c.gw; it < 16 * NCH; it += c.ngw) { const int ck = it % NCH, h = (it / NCH) & 3, dir = (it / (NCH * 4)) & 1, b = it / (NCH * 8);
                if (dir == 0) gla_g1<0>(c, b, h, ck); else gla_g1<1>(c, b, h, ck); }
            if (L == 0) for (int it = c.gw; it < 256; it += c.ngw) ctx_attn_item(c, it);
            for (int row = c.gw; row < (L == 0 ? NTOK : NLAT); row += c.ngw) conv_row(c, row);
        } } SEAM(pb + 3);
        if (IN(pb + 4)) { for (int rep_ = 0; rep_ <= ((DUPMASK >> 4) & 1); ++rep_) { if (rep_) xcd_barrier(bar); REFRESH(); gla_scan(c); } } SEAM(pb + 4);
        if (IN(pb + 5)) { for (int rep_ = 0; rep_ <= ((DUPMASK >> 5) & 1); ++rep_) { if (rep_) xcd_barrier(bar); REFRESH();
            for (int it = c.gw; it < 8 * NCH; it += c.ngw) { const int ck = it % NCH, h = (it / NCH) & 3, b = it / (NCH * 4);
                if (ck < 8 && L != 0) continue;
                gla_g3(c, b, h, ck); }
        } } SEAM(pb + 5);
        if (IN(pb + 6)) { for (int rep_ = 0; rep_ <= ((DUPMASK >> 6) & 1); ++rep_) { if (rep_) xcd_barrier(bar); REFRESH();
            pg8::Gemm g{(const bf16*)(ws + WS_YMIX), (const bf16*)(ws + WS_WOUT), D}; pg8::StaticOrder S; S.init(L == 0 ? NTOK : NLAT, D, gridDim.x, blockIdx.x);
            pg8::EpiBf16 E{(bf16*)(ws + WS_T), D, 1.f};
            pg8::gemm_phase<pg8::EpiBf16, pg8::StaticOrder, false>(c.lds, g, S, E, nullptr);
        } } SEAM(pb + 6);
        if (IN(pb + 7)) { for (int rep_ = 0; rep_ <= ((DUPMASK >> 7) & 1); ++rep_) { if (rep_) xcd_barrier(bar); REFRESH(); phase7(c); } } SEAM(pb + 7);
        if (IN(pb + 8)) { for (int rep_ = 0; rep_ <= ((DUPMASK >> 8) & 1); ++rep_) { if (rep_) xcd_barrier(bar); REFRESH(); router_phase(c); } } SEAM(pb + 8);
        if (IN(pb + 9)) { for (int rep_ = 0; rep_ <= ((DUPMASK >> 9) & 1); ++rep_) { if (rep_) xcd_barrier(bar); REFRESH(); phase9(c); } } SEAM(pb + 9);
        if (IN(pb + 10)) { for (int rep_ = 0; rep_ <= ((DUPMASK >> 10) & 1); ++rep_) { if (rep_) xcd_barrier(bar); REFRESH();
            const int* ntp = (const int*)(ws + WS_CTL) + CW_NT + L * 64;
            pg8::Gemm g{(const bf16*)(ws + WS_XQ), (const bf16*)(ws + WS_WGU), D / 2};
            pg8::GroupOrder S{(const int*)(ws + WS_TILEE), ntp[0], 4, (int)gridDim.x, xcd_vid()};
            pg8::EpiSwiglu8 E{(unsigned char*)(ws + WS_H)};
            pg8::gemm_phase<pg8::EpiSwiglu8, pg8::GroupOrder, true, true>(c.lds, g, S, E, (const int*)(ws + WS_TOKS));
        } } SEAM(pb + 10);
        if (IN(pb + 11)) { for (int rep_ = 0; rep_ <= ((DUPMASK >> 11) & 1); ++rep_) { if (rep_) xcd_barrier(bar); REFRESH();
            const int* ntp = (const int*)(ws + WS_CTL) + CW_NT + L * 64;
            pg8::Gemm g{(const bf16*)(ws + WS_H), (const bf16*)(ws + WS_WD), DEXP / 2};
            pg8::GroupOrder S{(const int*)(ws + WS_TILEE), ntp[0], 8, (int)gridDim.x, xcd_vid()};
            pg8::EpiBf16 E{(bf16*)(ws + WS_Y), D, 1.f / 64.f};
            pg8::gemm_phase<pg8::EpiBf16, pg8::GroupOrder, false, true>(c.lds, g, S, E, nullptr);
        } } SEAM(pb + 11);
        if (IN(pb + 12)) { for (int rep_ = 0; rep_ <= ((DUPMASK >> 12) & 1); ++rep_) { if (rep_) xcd_barrier(bar); REFRESH(); phase12(c); } } SEAM(pb + 12);
    }
#undef IN
#undef SEAM
}

#ifndef MK_ONE_LAUNCH
#define MK_ONE_LAUNCH 1
#endif
extern "C" void kernel_launch(void* const* d_in, const int* in_sizes, int n_in, void* d_out, int out_size, void* d_ws, size_t ws_size, hipStream_t stream) {
    static int grid = 0;
    if (grid == 0) {
        if (n_in != 26 || out_size != NLAT * D || ws_size < WS_END) { fprintf(stderr, "kernel_launch: unexpected shapes (n_in %d out %d ws %zu)\n", n_in, out_size, ws_size); grid = -1; return; }
        int dev = 0, cus = 0;
        if (hipGetDevice(&dev) != hipSuccess || hipDeviceGetAttribute(&cus, hipDeviceAttributeMultiprocessorCount, dev) != hipSuccess) { grid = -1; return; }
        if (hipFuncSetAttribute((const void*)fwd, hipFuncAttributeMaxDynamicSharedMemorySize, LDS_BYTES) != hipSuccess) { fprintf(stderr, "kernel_launch: hipFuncSetAttribute failed\n"); grid = -1; return; }
        int per_cu = 0;
        if (hipOccupancyMaxActiveBlocksPerMultiprocessor(&per_cu, (const void*)fwd, 512, LDS_BYTES) != hipSuccess || per_cu < 1) fprintf(stderr, "kernel_launch: occupancy query reports %d\n", per_cu);
        (void)hipGetLastError();
        grid = cus;
    }
    if (grid < 0) return;
    hipMemsetAsync((char*)d_ws + WS_CTL, 0, CTL_BYTES, stream);
    Params prm{};
    for (int i = 0; i < 26; ++i) prm.in[i] = (const GAS float*)d_in[i];
    prm.out = (GAS float*)d_out; prm.ws = (GAS unsigned char*)d_ws;
#if MK_ONE_LAUNCH
    prm.ph_lo = 0; prm.ph_hi = 2 * NPH;
    hipLaunchKernelGGL(fwd, dim3(grid), dim3(512), LDS_BYTES, stream, prm);
#else
    for (int ph = 0; ph < 2 * NPH; ++ph) { prm.ph_lo = ph; prm.ph_hi = ph + 1; hipLaunchKernelGGL(fwd, dim3(grid), dim3(512), LDS_BYTES, stream, prm); }
#endif
}
```

```cpp
#include <hip/hip_runtime.h>
#include <cstdio>

#define DI __device__ __forceinline__
#define LAS __attribute__((address_space(3)))
#if defined(__HIP_DEVICE_COMPILE__)
#define GAS __attribute__((address_space(1)))
#else
#define GAS
#endif
typedef unsigned short bf16;
typedef short bf16x8 __attribute__((ext_vector_type(8)));
typedef short s16x4 __attribute__((ext_vector_type(4)));
typedef float f32x2 __attribute__((ext_vector_type(2)));
typedef float f32x4 __attribute__((ext_vector_type(4)));
typedef float f32x8 __attribute__((ext_vector_type(8)));
typedef float f32x16 __attribute__((ext_vector_type(16)));
typedef unsigned u32x2 __attribute__((ext_vector_type(2)));
typedef unsigned u32x4 __attribute__((ext_vector_type(4)));
typedef __bf16 hbf16x2 __attribute__((ext_vector_type(2)));

constexpr int D = 2048, SEQ = 8192, CTXL = 256, NB = 2;
constexpr int NLAT = NB * SEQ, NCTX = NB * CTXL, NTOK = NLAT + NCTX;
constexpr int PW = 5408, PWP = 5632;
constexpr int NA_Q = 0, NA_K = 512, NA_V = 1024, SC_U = 1536, SC_B = 2048, SC_C = 2560, GL_Q = 3072, GL_K = 3328, GL_V = 3584, GL_G = 4096, GL_Z = 4608, SW_Q = 4640, SW_K = 5152, SW_V = 5280;
constexpr int NEXP = 64, DEXP = 512, NCH = 264;
constexpr int MAXTILES = 658;
constexpr float LN_EPS = 1e-6f, DN_ALPHA = 1.41421356237f;

constexpr size_t MiB = 1u << 20;
constexpr size_t WS_CTL = 0, CTL_BYTES = MiB;
constexpr size_t WS_MOD = 1 * MiB, WS_ROPE = 1 * MiB + 512 * 1024, WS_STATS = 2 * MiB, WS_ROUTW = 3 * MiB, WS_EIDX = 4 * MiB, WS_RANK = 5 * MiB, WS_WTS = 6 * MiB, WS_POS = 7 * MiB,
                 WS_TOKS = 8 * MiB, WS_TILEE = 9 * MiB, WS_GDEC = 10 * MiB, WS_HCTX = 12 * MiB, WS_WIN = 16 * MiB, WS_WOUT = 38 * MiB, WS_WGU = 46 * MiB, WS_WD = 306 * MiB,
                 WS_X1 = 436 * MiB, WS_XN = 568 * MiB, WS_YMIX = 634 * MiB, WS_H = 700 * MiB, WS_UT = WS_H, WS_SIN = WS_H + 66 * MiB, WS_ER = WS_H + 132 * MiB, WS_Y = 865 * MiB, WS_P = WS_Y, WS_XL = WS_Y, WS_XQ = WS_YMIX, WS_XB = WS_X1 + 66 * MiB, WS_T = WS_Y + 192 * MiB,
                 WS_WGU1 = 1523 * MiB, WS_WD1 = 1653 * MiB,
                 WS_END = 1783 * MiB;
constexpr int CW_CNT = 1024, CW_NT = 2048, CW_CV = 3072, CW_BAR = 4096;

DI float bf2f(unsigned v) { return __uint_as_float(v << 16); }
DI unsigned pk2(float a, float b) { hbf16x2 v = __builtin_convertvector((f32x2){a, b}, hbf16x2); return __builtin_bit_cast(unsigned, v); }
DI bf16 f2bf(float a) { return (bf16)(pk2(a, 0.f) & 0xffffu); }
DI float lo16(unsigned u) { return __uint_as_float(u << 16); }
DI float hi16(unsigned u) { return __uint_as_float(u & 0xffff0000u); }
DI bf16x8 pack8(float a0, float a1, float a2, float a3, float a4, float a5, float a6, float a7) {
    u32x4 p; p.x = pk2(a0, a1); p.y = pk2(a2, a3); p.z = pk2(a4, a5); p.w = pk2(a6, a7); return __builtin_bit_cast(bf16x8, p); }
DI void unpack8(bf16x8 v, float (&f)[8]) { u32x4 p = __builtin_bit_cast(u32x4, v); f[0] = lo16(p.x); f[1] = hi16(p.x); f[2] = lo16(p.y); f[3] = hi16(p.y); f[4] = lo16(p.z); f[5] = hi16(p.z); f[6] = lo16(p.w); f[7] = hi16(p.w); }
DI unsigned pk4_fp8(float a, float b, float c, float d) { int p = __builtin_amdgcn_cvt_pk_fp8_f32(a, b, 0, false); p = __builtin_amdgcn_cvt_pk_fp8_f32(c, d, p, true); return (unsigned)p; }
DI float wave_sum(float v) {
#pragma unroll
    for (int o = 1; o < 64; o <<= 1) v += __shfl_xor(v, o);
    return v; }
DI int lane_id_fresh() { int l; asm volatile("v_mbcnt_lo_u32_b32 %0, -1, 0\n\tv_mbcnt_hi_u32_b32 %0, -1, %0" : "=v"(l)); return l; }
DI int crow(int reg, int h) { return (reg & 3) + 8 * (reg >> 2) + 4 * h; }
#define MFMA32(a, b, c) __builtin_amdgcn_mfma_f32_32x32x16_bf16((a), (b), (c), 0, 0, 0)
#define MFMA16(a, b, c) __builtin_amdgcn_mfma_f32_16x16x32_bf16((a), (b), (c), 0, 0, 0)
DI s16x4 tr_read(LAS unsigned char* p) { return __builtin_amdgcn_ds_read_tr16_b64_v4i16((LAS s16x4*)p); }
DI bf16x8 cat4(s16x4 lo, s16x4 hi) { return __builtin_shufflevector(lo, hi, 0, 1, 2, 3, 4, 5, 6, 7); }
DI f32x16 zero16() { f32x16 z;
#pragma unroll
    for (int i = 0; i < 16; ++i) z[i] = 0.f; return z; }

#ifndef EMU_FP8
#define EMU_FP8 0
#endif
DI float q8(float x) { const int p = __builtin_amdgcn_cvt_pk_fp8_f32(x, x, 0, false); return __builtin_amdgcn_cvt_f32_fp8(p, 0); }
#define XB_TMO      128
#define XB_XCNT(j)  (256  + 64 * (j))
#define XB_XSUB(j)  (1280 + 64 * (j))
#define XB_XGEN(j)  (2304 + 64 * (j))
#define XB_TOP      3328
#define XB_TOPGEN   3392
#define XCD_BAR_WORDS 3456
#define XB_SPIN_CAP (1u << 18)

__device__ __forceinline__ unsigned xb_ld(unsigned* p)              { return __hip_atomic_load(p, __ATOMIC_RELAXED, __HIP_MEMORY_SCOPE_AGENT); }
__device__ __forceinline__ unsigned xb_add(unsigned* p, unsigned v) { return __hip_atomic_fetch_add(p, v, __ATOMIC_RELAXED, __HIP_MEMORY_SCOPE_AGENT); }
__device__ __forceinline__ unsigned xb_xcc_id() { return (unsigned)__builtin_amdgcn_s_getreg((3 << 11) | 20) & 0xFu; }
#define XB_SPIN(cond, bar) do { unsigned _sp = 0; while (cond) { __builtin_amdgcn_s_sleep(1); \
    if ((++_sp & 255u) == 0u) { if (xb_ld(&(bar)[XB_TMO])) break; if (_sp > XB_SPIN_CAP) { atomicAdd(&(bar)[XB_TMO], 1u); break; } } } } while (0)

struct XcdBarrier { unsigned* bar; unsigned x; volatile LAS unsigned* st; unsigned w0; };
__device__ __forceinline__ bool xb_thread0(const XcdBarrier& b) { return b.w0 != 0u && lane_id_fresh() == 0; }

__device__ __forceinline__ XcdBarrier xcd_barrier_post(unsigned* bar, volatile LAS unsigned* st) {
    XcdBarrier b; b.bar = bar; b.x = xb_xcc_id(); b.st = st; b.w0 = (__builtin_amdgcn_readfirstlane(threadIdx.x >> 6) == 0) ? 1u : 0u;
    if (threadIdx.x == 0) (void)xb_add(&bar[XB_XCNT(b.x)], 1u);
    return b;
}
__device__ __forceinline__ void xcd_barrier_complete(unsigned* bar, unsigned x, unsigned& nloc, unsigned& nx) {
    const unsigned G = gridDim.x * gridDim.y * gridDim.z;
    unsigned sum, cnt, mine, sp = 0u;
    for (;;) {
        sum = 0u; cnt = 0u; mine = 0u;
#pragma unroll
        for (unsigned j = 0; j < 16; ++j) { const unsigned c = xb_ld(&bar[XB_XCNT(j)]); sum += c; cnt += (c > 0u) ? 1u : 0u; mine = (j == x) ? c : mine; }
        if (sum == G) break;
        __builtin_amdgcn_s_sleep(1);
        if ((++sp & 255u) == 0u) { if (xb_ld(&bar[XB_TMO])) break; if (sp > XB_SPIN_CAP) { atomicAdd(&bar[XB_TMO], 1u); break; } }
    }
    nloc = mine > 0u ? mine : 1u; nx = cnt > 0u ? cnt : 1u;
}
__device__ __forceinline__ void xcd_barrier(const XcdBarrier& b) {
    asm volatile("s_waitcnt vmcnt(0)" ::: "memory");
    __syncthreads();
    if (threadIdx.x == 0) {
        unsigned* bar = b.bar;
        __builtin_amdgcn_s_waitcnt(0);
        unsigned nloc = b.st[0], nx = b.st[1];
        if (nloc == 0u) { xcd_barrier_complete(bar, b.x, nloc, nx); b.st[0] = nloc; b.st[1] = nx; }
        const unsigned old = xb_add(&bar[XB_XSUB(b.x)], 1u);
        const unsigned gen = old / nloc;
        if (old + 1u == (gen + 1u) * nloc) {
            __builtin_amdgcn_fence(__ATOMIC_RELEASE, "agent");
            asm volatile("s_waitcnt vmcnt(0)" ::: "memory");
            const unsigned og = xb_add(&bar[XB_TOP], 1u);
            const unsigned tg = og / nx;
            if (og + 1u == (tg + 1u) * nx) xb_add(&bar[XB_TOPGEN], 1u);
            else XB_SPIN(xb_ld(&bar[XB_TOPGEN]) == tg, bar);
            __builtin_amdgcn_fence(__ATOMIC_ACQUIRE, "agent");
            xb_add(&bar[XB_XGEN(b.x)], 1u);
            asm volatile("s_waitcnt vmcnt(0)" ::: "memory");
        } else {
            XB_SPIN(xb_ld(&bar[XB_XGEN(b.x)]) == gen, bar);
            __builtin_amdgcn_fence(__ATOMIC_ACQUIRE, "agent");
            asm volatile("s_waitcnt vmcnt(0)" ::: "memory");
        }
    }
    __syncthreads();
}

#ifndef PROBE_SKIP_STORES
#define PROBE_SKIP_STORES 0
#endif
namespace pg8 {
constexpr int BM = 256, BK = 64, HALF = 128, HTB = HALF * BK * 2, STAGE_BYTES = 8 * HTB, NXCD = 8, WGM = 8;
__host__ __device__ __forceinline__ int lds_byte(int r, int c) { const int st = (r >> 4) * 2 + (c >> 5), rr = r & 15, cc = c & 31, ob = rr * 64 + cc * 2; return st * 1024 + (ob ^ (((ob >> 9) & 1) << 5)); }
__host__ __device__ __forceinline__ void stage_rc(int b, int& R, int& C) { const int st = b / 1024, sb = b % 1024, swz = sb ^ (((sb >> 9) & 1) << 5); R = (st >> 1) * 16 + swz / 64; C = (st & 1) * 32 + (swz % 64) / 2; }
__host__ __device__ __forceinline__ int perm32(int rho) { const int n = rho >> 4, i = rho & 15; return 8 * (i >> 2) + 4 * n + (i & 3); }

typedef int i32x8 __attribute__((ext_vector_type(8)));
typedef int i32x4 __attribute__((ext_vector_type(4)));
__device__ __forceinline__ i32x8 cat8(bf16x8 a, bf16x8 b) { return __builtin_shufflevector(__builtin_bit_cast(i32x4, a), __builtin_bit_cast(i32x4, b), 0, 1, 2, 3, 4, 5, 6, 7); }
struct Unit { int pm, pn, pc; };
struct Gemm { const bf16* A; const bf16* Bt; int K; };

struct StaticOrder {
    int nM, nN, nwg, G, c;
    __device__ void init(int M, int N, int G_, int c_) { nM = M / BM; nN = N / BM; nwg = nM * nN; G = G_; c = c_; }
    __device__ bool next(int i, Unit& u) const {
        const long L = (long)i * G + c; if (L >= nwg) return false;
        int wgid = (int)L; { const int q = nwg / NXCD, r = nwg % NXCD, xcd = wgid % NXCD, off = wgid / NXCD; wgid = (xcd < r ? xcd * (q + 1) : r * (q + 1) + (xcd - r) * q) + off; }
        const int nig = WGM * nN, gid = wgid / nig, fm = gid * WGM, gsz = (nM - fm) < WGM ? (nM - fm) : WGM;
        u.pm = fm + ((wgid % nig) % gsz); u.pn = (wgid % nig) / gsz; u.pc = u.pn; return true;
    }
    __device__ bool short_deal() const { const int rem = nwg % G; return rem != 0 && c >= rem; }
};
struct GroupOrder {
    const int* tile_e; int ntiles, nN, G, c;
    __device__ bool next(int i, Unit& u) const {
        const long L = (long)i * G + c; if (L >= (long)ntiles * nN) return false;
        const int tile = (int)(L / nN), j = (int)(L % nN);
        u.pm = tile; u.pc = j; u.pn = tile_e[tile] * nN + j; return true;
    }
    __device__ bool short_deal() const { const int rem = (ntiles * nN) % G; return rem != 0 && c >= rem; }
};

struct EpiBf16 {
    static constexpr bool P64 = true;
    bf16* O; int ldc; float scale; int skip;
    __device__ __forceinline__ void operator()(const f32x4 (&acc)[2][2][4][2], const Unit& u, int wr, int wc, int fr, int fq) const {
        if (PROBE_SKIP_STORES && skip) return;
        const int row0 = u.pm * BM + wr * 64 + fr, col0 = u.pc * BM + wc * 64 + 16 * fq;
#pragma unroll
        for (int ai = 0; ai < 2; ++ai)
#pragma unroll
            for (int m = 0; m < 4; ++m) { bf16* rowp = O + (size_t)(row0 + ai * HALF + m * 16) * ldc + col0;
#pragma unroll
                for (int bj = 0; bj < 2; ++bj) { const f32x4 v0 = acc[ai][bj][m][0] * scale, v1 = acc[ai][bj][m][1] * scale;
                    u32x4 w; w.x = pk2(v0[0], v0[1]); w.y = pk2(v0[2], v0[3]); w.z = pk2(v1[0], v1[1]); w.w = pk2(v1[2], v1[3]);
                    *(u32x4*)(rowp + 8 * bj) = w; } }
    }
};
struct EpiFp8 {
    static constexpr bool P64 = true;
    unsigned char* O; int ldc; float scale; int skip;
    __device__ __forceinline__ void operator()(const f32x4 (&acc)[2][2][4][2], const Unit& u, int wr, int wc, int fr, int fq) const {
        if (PROBE_SKIP_STORES && skip) return;
        const int row0 = u.pm * BM + wr * 64 + fr, col0 = u.pc * BM + wc * 64 + 16 * fq;
#pragma unroll
        for (int ai = 0; ai < 2; ++ai)
#pragma unroll
            for (int m = 0; m < 4; ++m) { unsigned char* rowp = O + (size_t)(row0 + ai * HALF + m * 16) * ldc + col0;
                u32x4 w;
#pragma unroll
                for (int bj = 0; bj < 2; ++bj) { const f32x4 v0 = acc[ai][bj][m][0] * scale, v1 = acc[ai][bj][m][1] * scale;
                    w[2 * bj] = pk4_fp8(v0[0], v0[1], v0[2], v0[3]); w[2 * bj + 1] = pk4_fp8(v1[0], v1[1], v1[2], v1[3]); }
                *(u32x4*)rowp = w; }
    }
};
struct EpiSwiglu8 {
    static constexpr bool P64 = false;
    unsigned char* O;
    __device__ __forceinline__ void operator()(const f32x4 (&acc)[2][2][4][2], const Unit& u, int wr, int wc, int fr, int fq) const {
        const int row0 = u.pm * BM + wr * 64 + fr, col0 = u.pc * HALF + wc * 32 + 8 * fq;
#pragma unroll
        for (int ai = 0; ai < 2; ++ai)
#pragma unroll
            for (int m = 0; m < 4; ++m) { unsigned char* rowp = O + (size_t)(row0 + ai * HALF + m * 16) * DEXP + col0;
                float h[8];
#pragma unroll
                for (int n = 0; n < 2; ++n)
#pragma unroll
                    for (int j = 0; j < 4; ++j) { const float g = acc[ai][0][m][n][j] * (1.f / 64.f), up = acc[ai][1][m][n][j] * (1.f / 64.f); h[n * 4 + j] = g * up * __builtin_amdgcn_rcpf(1.f + __expf(-g)); }
                u32x2 w; int p0 = __builtin_amdgcn_cvt_pk_fp8_f32(h[0], h[1], 0, false); p0 = __builtin_amdgcn_cvt_pk_fp8_f32(h[2], h[3], p0, true);
                int p1 = __builtin_amdgcn_cvt_pk_fp8_f32(h[4], h[5], 0, false); p1 = __builtin_amdgcn_cvt_pk_fp8_f32(h[6], h[7], p1, true);
                w.x = (unsigned)p0; w.y = (unsigned)p1;
                *(u32x2*)rowp = w; }
    }
};

template <class Epi, class Sched, bool GATHER, bool FP8 = false>
__device__ __forceinline__ void gemm_phase(LAS unsigned char* lds, const Gemm g, const Sched& S, const Epi& E, const int* toks, int tid_in) {
    int tid_ = threadIdx.x; (void)tid_in; asm volatile("" : "+v"(tid_));
    const int tid = tid_, wid = __builtin_amdgcn_readfirstlane(tid >> 6), lane = tid & 63, wr = wid >> 2, wc = wid & 3, fr = lane & 15, fq = lane >> 4;
    int K_ = g.K; asm volatile("" : "+s"(K_));
    const int K = K_, nt = K / BK;
    unsigned voffA[2], voffB[2];
#pragma unroll
    for (int i = 0; i < 2; ++i) { int R, C; stage_rc(tid * 16 + i * 8192, R, C);
        const int rho_ = R & 31, Rb = Epi::P64 ? 64 * (R >> 5) + 16 * ((rho_ & 15) >> 2) + 4 * (rho_ >> 4) + (rho_ & 3) : (R & ~31) + perm32(rho_);
        voffA[i] = (unsigned)(R * K + C) * 2u; voffB[i] = (unsigned)(Rb * K + C) * 2u; }
    const size_t kstep = (size_t)(BK * 2);
    const size_t hstep = (size_t)HALF * K * 2;
    const size_t tstep = 2 * hstep;
    const size_t bstep = Epi::P64 ? (size_t)16 * K : hstep;
    const unsigned ldsw = (unsigned)wid * 1024u;
    const int aoff = lds_byte(wr * 64 + fr, fq * 8), boff = lds_byte(wc * 32 + fr, fq * 8);
#define PG8_SA(b, h) (((b) * 2 + (h)) * HTB)
#define PG8_SB(b, h) ((4 + (b) * 2 + (h)) * HTB)
#define PG8_STAGE(bufoff, gbase, voff) do { _Pragma("unroll") for (int _i = 0; _i < 2; ++_i) \
        __builtin_amdgcn_global_load_lds((const unsigned*)((const char*)(gbase) + (voff)[_i]), (LAS unsigned*)(lds + (bufoff) + ldsw + _i * 8192), 16, 0, 0); } while (0)
#define PG8_STAGEA(bufoff, kb, vo, ub, h) do { _Pragma("unroll") for (int _i = 0; _i < 2; ++_i) \
        __builtin_amdgcn_global_load_lds((const unsigned*)(GATHER ? (const char*)g.A + (kb) + (vo)[h][_i] : (ub) + (kb) + (h) * hstep + voffA[_i]), (LAS unsigned*)(lds + (bufoff) + ldsw + _i * 8192), 16, 0, 0); } while (0)
#define PG8_LDA(dst, b, h) do { _Pragma("unroll") for (int m = 0; m < 4; ++m) _Pragma("unroll") for (int k = 0; k < 2; ++k) dst[m][k] = *(const LAS bf16x8*)(lds + PG8_SA(b, h) + aoff + m * 2048 + k * 1024); } while (0)
#define PG8_LDB(dst, b, h) do { _Pragma("unroll") for (int n = 0; n < 2; ++n) _Pragma("unroll") for (int k = 0; k < 2; ++k) dst[n][k] = *(const LAS bf16x8*)(lds + PG8_SB(b, h) + boff + n * 2048 + k * 1024); } while (0)
#define PG8_MMA(ai, bj, At, Bt) do { __builtin_amdgcn_s_setprio(1); _Pragma("unroll") for (int m = 0; m < 4; ++m) _Pragma("unroll") for (int n = 0; n < 2; ++n) { \
        if (FP8) { asm volatile("v_mfma_f32_16x16x128_f8f6f4 %0, %1, %2, %0" : "+v"(acc[ai][bj][m][n]) : "v"(cat8(Bt[n][0], Bt[n][1])), "v"(cat8(At[m][0], At[m][1]))); }   \
        else { _Pragma("unroll") for (int k = 0; k < 2; ++k) acc[ai][bj][m][n] = __builtin_amdgcn_mfma_f32_16x16x32_bf16(Bt[n][k], At[m][k], acc[ai][bj][m][n], 0, 0, 0); } } \
        __builtin_amdgcn_s_setprio(0); } while (0)
#define PG8_WAIT_V(n) asm volatile("s_waitcnt vmcnt(" #n ")" ::: "memory")
#define PG8_WAIT_L(n) asm volatile("s_waitcnt lgkmcnt(" #n ")" ::: "memory")
#define PG8_BAR __builtin_amdgcn_s_barrier()
#define PG8_SCHED __builtin_amdgcn_sched_barrier(0)
    LAS int* ids = (LAS int*)(lds + STAGE_BYTES);
#define PG8_VOA(dst, uidx, un) do { if (GATHER) { _Pragma("unroll") for (int _h = 0; _h < 2; ++_h) _Pragma("unroll") for (int _i = 0; _i < 2; ++_i) { int _t = tid; asm volatile("" : "+v"(_t)); int _R, _C; stage_rc(_t * 16 + _i * 8192, _R, _C); \
        const int _row = ids[(uidx) * BM + _h * HALF + _R]; dst[_h][_i] = (unsigned)(_row * K + _C) * 2u; } } } while (0)
    if (GATHER) {
        Unit uu;
        for (int i = 0; i < 24; ++i) { if (!S.next(i, uu)) break; if (tid < BM) ids[i * BM + tid] = toks[uu.pm * BM + tid]; }
        __syncthreads();
    }
    Unit cur, nxt; int ui = 0;
    if (!S.next(0, cur)) return;
    f32x4 acc[2][2][4][2];
#pragma unroll
    for (int a = 0; a < 2; ++a)
#pragma unroll
        for (int b = 0; b < 2; ++b)
#pragma unroll
            for (int m = 0; m < 4; ++m)
#pragma unroll
                for (int n = 0; n < 2; ++n) acc[a][b][m][n] = (f32x4){0.f, 0.f, 0.f, 0.f};
    bf16x8 At[4][2], B0[2][2], B1[2][2];
    unsigned voA[2][2] = {{0u, 0u}, {0u, 0u}}, voN[2][2] = {{0u, 0u}, {0u, 0u}};
    PG8_VOA(voA, 0, cur);
    const char* cA = (const char*)g.A + (size_t)cur.pm * tstep;
    const char* cB = (const char*)g.Bt + (size_t)cur.pn * tstep;
    PG8_STAGE(PG8_SB(0, 0), cB, voffB); PG8_STAGEA(PG8_SA(0, 0), 0, voA, cA, 0); PG8_STAGE(PG8_SB(0, 1), cB + bstep, voffB); PG8_STAGEA(PG8_SA(0, 1), 0, voA, cA, 1);
    if (wr == 1) PG8_BAR;
    PG8_WAIT_V(4); PG8_BAR;
    PG8_STAGE(PG8_SB(1, 0), cB + kstep, voffB); PG8_STAGEA(PG8_SA(1, 0), kstep, voA, cA, 0); PG8_STAGE(PG8_SB(1, 1), cB + bstep + kstep, voffB);
    PG8_WAIT_V(6); PG8_BAR;
    for (;;) {
        const bool has_next = S.next(ui + 1, nxt);
        if (has_next) { PG8_VOA(voN, ui + 1, nxt); }
        else if (GATHER) {
#pragma unroll
            for (int _h = 0; _h < 2; ++_h)
#pragma unroll
                for (int _i = 0; _i < 2; ++_i) voN[_h][_i] = voA[_h][_i]; }
        const char* nA = has_next ? (const char*)g.A + (size_t)nxt.pm * tstep : cA;
        const char* nB = has_next ? (const char*)g.Bt + (size_t)nxt.pn * tstep : cB;
        for (int t = 0; t < nt; t += 2) {
            const bool last = (t == nt - 2);
            const size_t k1 = (size_t)(t + 1) * kstep;
            const size_t k2 = last ? 0 : (size_t)(t + 2) * kstep, k3 = k2 + kstep;
            const char* b2 = last ? nB : cB + (size_t)(t + 2) * kstep; const char* b3 = b2 + kstep;
            unsigned vo2[2][2] = {{0u, 0u}, {0u, 0u}};
            if (GATHER) {
#pragma unroll
                for (int _h = 0; _h < 2; ++_h)
#pragma unroll
                    for (int _i = 0; _i < 2; ++_i) vo2[_h][_i] = last ? voN[_h][_i] : voA[_h][_i]; }
            const char* a2 = last ? nA : cA;
            PG8_LDB(B0, 0, 0); PG8_SCHED; PG8_LDA(At, 0, 0); PG8_STAGEA(PG8_SA(1, 1), k1, voA, cA, 1);
            PG8_WAIT_L(8); PG8_BAR; PG8_WAIT_L(0); PG8_MMA(0, 0, At, B0); PG8_BAR; PG8_SCHED;
            PG8_LDB(B1, 0, 1); PG8_STAGE(PG8_SB(0, 0), b2, voffB);
            PG8_BAR; PG8_WAIT_L(0); PG8_MMA(0, 1, At, B1); PG8_BAR;
            PG8_LDA(At, 0, 1); PG8_STAGEA(PG8_SA(0, 0), k2, vo2, a2, 0);
            PG8_BAR; PG8_WAIT_L(0); PG8_MMA(1, 0, At, B0); PG8_BAR; PG8_SCHED;
            PG8_STAGE(PG8_SB(0, 1), b2 + bstep, voffB);
            PG8_WAIT_V(6); PG8_BAR; PG8_MMA(1, 1, At, B1); PG8_BAR;
            PG8_LDB(B0, 1, 0); PG8_SCHED; PG8_LDA(At, 1, 0); PG8_STAGEA(PG8_SA(0, 1), k2, vo2, a2, 1);
            PG8_WAIT_L(8); PG8_BAR; PG8_WAIT_L(0); PG8_MMA(0, 0, At, B0); PG8_BAR; PG8_SCHED;
            PG8_LDB(B1, 1, 1); PG8_STAGE(PG8_SB(1, 0), b3, voffB);
            PG8_BAR; PG8_WAIT_L(0); PG8_MMA(0, 1, At, B1); PG8_BAR;
            PG8_LDA(At, 1, 1); PG8_STAGEA(PG8_SA(1, 0), k3, vo2, a2, 0);
            PG8_BAR; PG8_WAIT_L(0); PG8_MMA(1, 0, At, B0); PG8_BAR; PG8_SCHED;
            PG8_STAGE(PG8_SB(1, 1), b3 + bstep, voffB);
            PG8_WAIT_V(6); PG8_BAR; PG8_MMA(1, 1, At, B1); PG8_BAR;
        }
        if (FP8) asm volatile("s_nop 15\n\ts_nop 15" ::: "memory");
        E(acc, cur, wr, wc, fr, fq);
        if (!has_next) break;
#pragma unroll
        for (int a = 0; a < 2; ++a)
#pragma unroll
            for (int b = 0; b < 2; ++b)
#pragma unroll
                for (int m = 0; m < 4; ++m)
#pragma unroll
                    for (int n = 0; n < 2; ++n) acc[a][b][m][n] = (f32x4){0.f, 0.f, 0.f, 0.f};
        cur = nxt; cA = nA; cB = nB; ++ui;
        if (GATHER) {
#pragma unroll
            for (int _h = 0; _h < 2; ++_h)
#pragma unroll
                for (int _i = 0; _i < 2; ++_i) voA[_h][_i] = voN[_h][_i]; }
    }
    PG8_WAIT_V(0);
    if (wr == 0) PG8_BAR;
    PG8_BAR;
#undef PG8_SA
#undef PG8_SB
#undef PG8_STAGE
#undef PG8_STAGEA
#undef PG8_LDA
#undef PG8_LDB
#undef PG8_MMA
#undef PG8_WAIT_V
#undef PG8_WAIT_L
#undef PG8_BAR
#undef PG8_SCHED
#undef PG8_VOA
}
}
struct Params {
    const GAS float* in[26];
    GAS float* out;
    GAS unsigned char* ws;
    int ph_lo, ph_hi;
};
typedef const Params __attribute__((address_space(4))) CParams;
constexpr int NPH = 13;
constexpr int WAVE_LDS = 19968;
constexpr int LDS_MISC = 8 * WAVE_LDS;
constexpr int LDS_BYTES = LDS_MISC + 1024;

struct Ctx {
    LAS unsigned char* lds; int tid, lane, wave, gw, ngw, L, bid, nblk;
    CParams* p;
    unsigned char* ws;
};
DI unsigned char* fresh(GAS unsigned char* q) { asm volatile("" : "+s"(q)); return (unsigned char*)q; }
#define inp(c, k) ((const float*)(c).p->in[k])
#define outp(c) ((float*)(c).p->out)

DI void transpose_item(const float* W, int K, int N, bf16* WT, int drow0, LAS float* scr, int kb, int nb, int lane, bool lo_part, float qs = 0.f) {
    const int k0 = 64 * kb, n0 = 32 * nb;
#pragma unroll 8
    for (int i = 0; i < 32; ++i) { const int kk = 2 * i + (lane >> 5); scr[kk * 33 + (lane & 31)] = W[(size_t)(k0 + kk) * N + n0 + (lane & 31)]; }
    asm volatile("s_waitcnt lgkmcnt(0)" ::: "memory");
    const int c = lane & 7;
#pragma unroll
    for (int j = 0; j < 4; ++j) { const int n = (lane >> 3) + 8 * j; const LAS float* s = scr + (8 * c) * 33 + n;
        float v[8];
#pragma unroll
        for (int q = 0; q < 8; ++q) { v[q] = s[q * 33]; if (lo_part) v[q] = v[q] - bf2f(f2bf(v[q])); if (EMU_FP8 && qs != 0.f) v[q] = q8(v[q] * qs) / qs; }
        u32x4 o; o.x = pk2(v[0], v[1]); o.y = pk2(v[2], v[3]); o.z = pk2(v[4], v[5]); o.w = pk2(v[6], v[7]);
        *(u32x4*)(WT + (size_t)(drow0 + n) * K + k0 + 8 * c) = o; }
    asm volatile("s_waitcnt lgkmcnt(0)" ::: "memory");
}

DI void transpose_item8(const float* W, int K, int N, unsigned char* WT, int drow0, LAS float* scr, int kb, int nb, int lane) {
    const int k0 = 64 * kb, n0 = 64 * nb;
    f32x4 v[16];
    const int ncol = min(n0 + 4 * (lane & 15), N - 4);
#pragma unroll
    for (int i = 0; i < 16; ++i) v[i] = *(const f32x4*)(W + (size_t)(k0 + 4 * i + (lane >> 4)) * N + ncol);
#pragma unroll
    for (int i = 0; i < 16; ++i) { LAS float* d = scr + (4 * i + (lane >> 4)) * 65 + 4 * (lane & 15); d[0] = v[i].x; d[1] = v[i].y; d[2] = v[i].z; d[3] = v[i].w; }
    asm volatile("s_waitcnt lgkmcnt(0)" ::: "memory");
    const int c = lane & 7;
#pragma unroll
    for (int j = 0; j < 8; ++j) { const int n = (lane >> 3) + 8 * j; const LAS float* s = scr + (8 * c) * 65 + n;
        float q[8];
#pragma unroll
        for (int e = 0; e < 8; ++e) q[e] = s[e * 65] * 64.f;
        int p0 = __builtin_amdgcn_cvt_pk_fp8_f32(q[0], q[1], 0, false); p0 = __builtin_amdgcn_cvt_pk_fp8_f32(q[2], q[3], p0, true);
        int p1 = __builtin_amdgcn_cvt_pk_fp8_f32(q[4], q[5], 0, false); p1 = __builtin_amdgcn_cvt_pk_fp8_f32(q[6], q[7], p1, true);
        u32x2 o; o.x = (unsigned)p0; o.y = (unsigned)p1;
        *(u32x2*)(WT + (size_t)(drow0 + n) * K + k0 + 8 * c) = o; }
    asm volatile("s_waitcnt lgkmcnt(0)" ::: "memory");
}

struct CvItem { const float* src; unsigned char* dst; int K, N; };
DI bool cv_decode(const Ctx& c, int L, int r, CvItem& it) {
    constexpr int I_E = 768;
    if (r >= 65 * I_E) return false;
    unsigned char* ws = c.ws; const size_t wgu_off = L == 0 ? WS_WGU : WS_WGU1, wd_off = L == 0 ? WS_WD : WS_WD1;
    const int e = r / I_E, q = r % I_E, which = q / 256, idx = q % 256;
    if (which < 2) {
        const float* W = e < 64 ? inp(c, which == 0 ? 18 : 19) + ((size_t)(L * 64 + e)) * D * DEXP : inp(c, which == 0 ? 21 : 22) + (size_t)L * D * DEXP;
        const int kb = idx / 8, nb = idx % 8, n0 = 64 * nb, k0 = 64 * kb;
        it.K = D; it.N = DEXP; it.src = W + (size_t)k0 * DEXP + n0;
        it.dst = (unsigned char*)(ws + wgu_off) + (size_t)(e * 1024 + (n0 / 128) * 256 + which * 128 + (n0 % 128)) * D + k0;
    } else {
        const float* W = e < 64 ? inp(c, 20) + ((size_t)(L * 64 + e)) * DEXP * D : inp(c, 23) + (size_t)L * DEXP * D;
        const int kb = idx / 32, nb = idx % 32, n0 = 64 * nb, k0 = 64 * kb;
        it.K = DEXP; it.N = D; it.src = W + (size_t)k0 * D + n0;
        it.dst = (unsigned char*)(ws + wd_off) + (size_t)(e * 2048 + n0) * DEXP + k0;
    }
    return true;
}
DI void cv_load(const CvItem& it, f32x4 (&v)[16], int lane) {
#pragma unroll
    for (int i = 0; i < 16; ++i) v[i] = __builtin_nontemporal_load((const f32x4*)(it.src + (size_t)(4 * i + (lane >> 4)) * it.N + 4 * (lane & 15)));
}
DI void cv_store(const CvItem& it, const f32x4 (&v)[16], LAS float* scr, int lane) {
#pragma unroll
    for (int i = 0; i < 16; ++i) { LAS float* d = scr + (4 * i + (lane >> 4)) * 65 + 4 * (lane & 15); d[0] = v[i].x; d[1] = v[i].y; d[2] = v[i].z; d[3] = v[i].w; }
    asm volatile("s_waitcnt lgkmcnt(0)" ::: "memory");
    const int c8 = lane & 7;
#pragma unroll
    for (int j = 0; j < 8; ++j) { const int n = (lane >> 3) + 8 * j; const LAS float* s = scr + (8 * c8) * 65 + n;
        float q[8];
#pragma unroll
        for (int e = 0; e < 8; ++e) q[e] = s[e * 65] * 64.f;
        u32x2 o; o.x = pk4_fp8(q[0], q[1], q[2], q[3]); o.y = pk4_fp8(q[4], q[5], q[6], q[7]);
        *(u32x2*)(it.dst + (size_t)n * it.K + 8 * c8) = o; }
    asm volatile("s_waitcnt lgkmcnt(0)" ::: "memory");
}
DI void convert_experts(const Ctx& c, int L, int it0, int step) {
    LAS float* scr = (LAS float*)(c.lds + c.wave * WAVE_LDS);
    CvItem ia, ib; f32x4 va[16], vb[16];
    int r = it0;
    bool ha = cv_decode(c, L, r, ia); if (ha) cv_load(ia, va, c.lane);
    while (ha) {
        const bool hb = cv_decode(c, L, r + step, ib); if (hb) cv_load(ib, vb, c.lane);
        cv_store(ia, va, scr, c.lane);
        if (!hb) break;
        ha = cv_decode(c, L, r + 2 * step, ia); if (ha) cv_load(ia, va, c.lane);
        cv_store(ib, vb, scr, c.lane);
        r += 2 * step;
    }
}
DI void cv_steal(const Ctx& c, int npairs) {
    LAS float* scr = (LAS float*)(c.lds + c.wave * WAVE_LDS);
    unsigned* ctr = (unsigned*)(c.ws + WS_CTL) + CW_CV;
    for (int i = 0; i < npairs; ++i) {
        unsigned idx = 0u;
        if (c.lane == 0) idx = __hip_atomic_fetch_add(ctr, 2u, __ATOMIC_RELAXED, __HIP_MEMORY_SCOPE_AGENT);
        const int r = __builtin_amdgcn_readfirstlane((int)idx);
        CvItem ia, ib; f32x4 va[16], vb[16];
        const bool ha = cv_decode(c, 1, r, ia); if (!ha) break;
        cv_load(ia, va, c.lane);
        const bool hb = cv_decode(c, 1, r + 1, ib); if (hb) cv_load(ib, vb, c.lane);
        cv_store(ia, va, scr, c.lane);
        if (hb) cv_store(ib, vb, scr, c.lane);
    }
}

DI void phase0(const Ctx& c) {
    const int L = c.L;
    unsigned char* ws = c.ws;
    if (L == 0) {
        LAS float* sc = (LAS float*)c.lds;
        LAS float* part = (LAS float*)(c.lds + 32768);
        for (int i = c.tid; i < 3 * D; i += 512) { const int r = i / D, k = i % D; const float v = r < 2 ? inp(c, 1)[r * D + k] : inp(c, 3)[k]; sc[i] = v / (1.f + __expf(-v)); }
        __syncthreads();
        for (int cb = c.bid; cb < 512; cb += c.nblk) {
            const int Lm = cb >> 8, n0 = (cb & 255) * 48;
            const float* wa = inp(c, 4) + (size_t)Lm * D * 6 * D; const float* ba = inp(c, 5) + (size_t)Lm * 6 * D;
            float* mod = (float*)(ws + WS_MOD) + (size_t)Lm * 3 * 6 * D;
            float a0 = 0.f, a1 = 0.f, a2 = 0.f;
            if (c.lane < 48) {
                const float* wp = wa + (size_t)(c.wave * 256) * (6 * D) + n0 + c.lane;
                for (int k0 = 0; k0 < 256; k0 += 32) {
                    float wv[32];
#pragma unroll
                    for (int k = 0; k < 32; ++k) wv[k] = wp[(size_t)(k0 + k) * (6 * D)];
#pragma unroll
                    for (int k = 0; k < 32; ++k) { const int kk = c.wave * 256 + k0 + k; a0 += sc[kk] * wv[k]; a1 += sc[D + kk] * wv[k]; a2 += sc[2 * D + kk] * wv[k]; }
                }
                part[(c.wave * 3 + 0) * 48 + c.lane] = a0; part[(c.wave * 3 + 1) * 48 + c.lane] = a1; part[(c.wave * 3 + 2) * 48 + c.lane] = a2;
            }
            __syncthreads();
            if (c.tid < 144) { const int r = c.tid / 48, j = c.tid % 48; float s = 0.f;
#pragma unroll
                for (int w = 0; w < 8; ++w) s += part[(w * 3 + r) * 48 + j];
                mod[r * 6 * D + n0 + j] = s + ba[n0 + j]; }
            __syncthreads();
        }
    }
    __syncthreads();
    {
        LAS float* scr = (LAS float*)(c.lds + c.wave * WAVE_LDS);
        constexpr int I_IN = 32 * ((PW + 63) / 64), I_OUT = 32 * 32, I_R = 64;
        constexpr int NIT = I_IN + I_OUT + 2 * I_R;
        bf16* win = (bf16*)(ws + WS_WIN); bf16* wout = (bf16*)(ws + WS_WOUT); bf16* rw = (bf16*)(ws + WS_ROUTW);
        for (int it = c.gw; it < NIT; it += c.ngw) {
            int r = it;
            if (r < I_IN) { const int nblk = (PW + 63) / 64; transpose_item8(inp(c, 6) + (size_t)L * D * PW, D, PW, (unsigned char*)win, 64 * (r % nblk), scr, r / nblk, r % nblk, c.lane); continue; } r -= I_IN;
            if (r < I_OUT) { transpose_item8(inp(c, 13) + (size_t)L * D * D, D, D, (unsigned char*)wout, 64 * (r % 32), scr, r / 32, r % 32, c.lane); continue; } r -= I_OUT;
            { const int lo = r / I_R, idx = r % I_R, kb = idx / 2, nb = idx % 2;
              transpose_item(inp(c, 16) + (size_t)L * D * NEXP, D, NEXP, rw, lo * 64 + 32 * nb, scr, kb, nb, c.lane, lo != 0); }
        }
    }
    if (L == 0) convert_experts(c, 0, c.gw, c.ngw);
    else { const int r0 = (int)__hip_atomic_load((unsigned*)(c.ws + WS_CTL) + CW_CV, __ATOMIC_RELAXED, __HIP_MEMORY_SCOPE_AGENT);
           convert_experts(c, 1, r0 + c.gw, c.ngw); }
    if (L == 0) {
        float* rope = (float*)(ws + WS_ROPE);
        for (int i = c.bid * 512 + c.tid; i < 128 * 16; i += c.nblk * 512) {
            const int pos = i / 16, f = i % 16;
            const float inv = exp2f(-(float)f * (13.287712379549449f / 16.f));
            const float ang = (float)pos * inv;
            const float n = rintf(ang * 0.15915494309189535f);
            float rr = fmaf(-n, 6.28125f, ang); rr = fmaf(-n, 1.9353071795864769e-3f, rr);
            rope[2 * i] = __cosf(rr); rope[2 * i + 1] = __sinf(rr);
        }
    }
}

DI void row_stats(const f32x4 (&v)[8], float& mean, float& rstd) {
    float s = 0.f;
#pragma unroll
    for (int j = 0; j < 8; ++j) s += (v[j].x + v[j].y) + (v[j].z + v[j].w);
    mean = wave_sum(s) * (1.f / D);
    float q = 0.f;
#pragma unroll
    for (int j = 0; j < 8; ++j) { const f32x4 d = v[j] - mean; q += (d.x * d.x + d.y * d.y) + (d.z * d.z + d.w * d.w); }
    rstd = 1.f / sqrtf(wave_sum(q) * (1.f / D) + LN_EPS);
}
DI const float* mod_row_l(const Ctx& c, int row, int l) { return (const float*)(c.ws + WS_MOD) + (size_t)(l * 3 + (row < NLAT ? row / SEQ : 2)) * 6 * D; }
DI const float* mod_row(const Ctx& c, int row) { return mod_row_l(c, row, c.L); }
DI const float* x_in_row(const Ctx& c, int row) {

    if (row < NLAT) return inp(c, 0) + (size_t)row * D;
    return inp(c, 2) + (size_t)(row - NLAT) * D;
}

DI void phase1(const Ctx& c) {
    unsigned char* xn = (unsigned char*)(c.ws + WS_XN);
    for (int r2 = c.gw; r2 < NTOK / 2; r2 += c.ngw) {
        f32x4 v[2][8]; float mean[2], rstd[2];
#pragma unroll
        for (int u = 0; u < 2; ++u) { const float* xr = x_in_row(c, 2 * r2 + u);
#pragma unroll
            for (int j = 0; j < 8; ++j) v[u][j] = *(const f32x4*)(xr + 4 * c.lane + 256 * j); }
#pragma unroll
        for (int u = 0; u < 2; ++u) row_stats(v[u], mean[u], rstd[u]);
        const float* mod = mod_row(c, 2 * r2);
#pragma unroll
        for (int j = 0; j < 8; ++j) { const int col = 4 * c.lane + 256 * j;
            const f32x4 sh = *(const f32x4*)(mod + col), sc = *(const f32x4*)(mod + D + col);
#pragma unroll
            for (int u = 0; u < 2; ++u) { const f32x4 y = (v[u][j] - mean[u]) * rstd[u] * (sc + 1.f) + sh;
                *(unsigned*)(xn + (size_t)(2 * r2 + u) * D + col) = pk4_fp8(y.x, y.y, y.z, y.w); } }
    }
}

DI void phase7(const Ctx& c) {
    const int L = c.L;
    bf16* xn = (bf16*)(c.ws + WS_XN); bf16* xl = (bf16*)(c.ws + WS_XL); const bf16* T = (const bf16*)(c.ws + WS_T); bf16* x1 = (bf16*)(c.ws + WS_X1);
    const bf16* xb = (const bf16*)(c.ws + WS_XB);
    const float* lg = inp(c, 14) + (size_t)L * D; const float* lb = inp(c, 15) + (size_t)L * D;
    const int nrows = L == 0 ? NTOK : NLAT;
    for (int r2 = c.gw; r2 < nrows / 2; r2 += c.ngw) {
        const float* mod = mod_row(c, 2 * r2);
        f32x4 v[2][8]; float mean[2], rstd[2];
#pragma unroll
        for (int u = 0; u < 2; ++u) { const int row = 2 * r2 + u;
            if (L == 0) { const float* xr = x_in_row(c, row);
#pragma unroll
                for (int j = 0; j < 8; ++j) v[u][j] = *(const f32x4*)(xr + 4 * c.lane + 256 * j); }
            else {
#pragma unroll
                for (int j = 0; j < 8; ++j) { const u32x2 t = *(const u32x2*)(xb + (size_t)row * D + 4 * c.lane + 256 * j); v[u][j] = (f32x4){lo16(t.x), hi16(t.x), lo16(t.y), hi16(t.y)}; } }
#pragma unroll
            for (int j = 0; j < 8; ++j) { const int col = 4 * c.lane + 256 * j;
                const f32x4 g = *(const f32x4*)(mod + 2 * D + col);
                const u32x2 t = *(const u32x2*)(T + (size_t)row * D + col);
                v[u][j] = v[u][j] * DN_ALPHA + g * (f32x4){lo16(t.x), hi16(t.x), lo16(t.y), hi16(t.y)}; } }
#pragma unroll
        for (int u = 0; u < 2; ++u) row_stats(v[u], mean[u], rstd[u]);
#pragma unroll
        for (int j = 0; j < 8; ++j) { const int col = 4 * c.lane + 256 * j; const f32x4 gg = *(const f32x4*)(lg + col), bb = *(const f32x4*)(lb + col);
#pragma unroll
            for (int u = 0; u < 2; ++u) { v[u][j] = (v[u][j] - mean[u]) * rstd[u] * gg + bb; u32x2 o; o.x = pk2(v[u][j].x, v[u][j].y); o.y = pk2(v[u][j].z, v[u][j].w); *(u32x2*)(x1 + (size_t)(2 * r2 + u) * D + col) = o; } }
#pragma unroll
        for (int u = 0; u < 2; ++u) row_stats(v[u], mean[u], rstd[u]);
#pragma unroll
        for (int j = 0; j < 8; ++j) { const int col = 4 * c.lane + 256 * j;
            const f32x4 sh = *(const f32x4*)(mod + 3 * D + col), sc = *(const f32x4*)(mod + 4 * D + col);
#pragma unroll
            for (int u = 0; u < 2; ++u) { const f32x4 y = (v[u][j] - mean[u]) * rstd[u] * (sc + 1.f) + sh;
                u32x2 o; o.x = pk2(y.x, y.y); o.y = pk2(y.z, y.w);
                u32x2 ol; ol.x = pk2(y.x - lo16(o.x), y.y - hi16(o.x)); ol.y = pk2(y.z - lo16(o.y), y.w - hi16(o.y));
                *(u32x2*)(xn + (size_t)(2 * r2 + u) * D + col) = o; *(u32x2*)(xl + (size_t)(2 * r2 + u) * D + col) = ol;
                { int pq = __builtin_amdgcn_cvt_pk_fp8_f32(y.x, y.y, 0, false); pq = __builtin_amdgcn_cvt_pk_fp8_f32(y.z, y.w, pq, true); *(int*)((unsigned char*)(c.ws + WS_XQ) + (size_t)(2 * r2 + u) * D + col) = pq; } } }
    }
}
constexpr float QK_SCALE_L2 = 0.125f * 1.4426950408889634f, LOG2E = 1.4426950408889634f;
constexpr int VSTR = 144;
struct AttnAcc { f32x16 o0, o1; float m, l; };
DI void attn_init(AttnAcc& a) { a.o0 = zero16(); a.o1 = zero16(); a.m = -INFINITY; a.l = 0.f; }

struct KV { bf16x8 k[4]; u32x4 v[4]; };
DI void attn_load(KV& t, const bf16* krow, const bf16* vsrc, int half) {
#pragma unroll
    for (int s = 0; s < 4; ++s) t.k[s] = *(const bf16x8*)(krow + 16 * s + 8 * half);
    const u32x4* sv = (const u32x4*)vsrc; t.v[0] = sv[0]; t.v[1] = sv[1]; t.v[2] = sv[2]; t.v[3] = sv[3];
}
template <class ScoreF>
DI void attn_tile(AttnAcc& a, const bf16x8 (&qf)[4], const bf16x8 (&kf)[4], const u32x4 (&vr)[4], LAS unsigned char* vl, int lane, ScoreF sf) {
    const int half = lane >> 5;
    {
        LAS unsigned char* d = vl + (lane >> 1) * VSTR + (lane & 1) * 64;
        *(LAS u32x4*)(d) = vr[0]; *(LAS u32x4*)(d + 16) = vr[1]; *(LAS u32x4*)(d + 32) = vr[2]; *(LAS u32x4*)(d + 48) = vr[3];
    }
    f32x16 st = zero16();
#pragma unroll
    for (int s = 0; s < 4; ++s) st = MFMA32(kf[s], qf[s], st);
    float sc[16]; float mx = -INFINITY;
#pragma unroll
    for (int r = 0; r < 16; ++r) { sc[r] = sf(r, crow(r, half), st[r]); mx = fmaxf(mx, sc[r]); }
    mx = fmaxf(mx, __shfl_xor(mx, 32));
    const float mnew = fmaxf(a.m, mx);
    const float muse = (mnew == -INFINITY) ? 0.f : mnew;
    float ps = 0.f;
#pragma unroll
    for (int r = 0; r < 16; ++r) { sc[r] = __builtin_amdgcn_exp2f(sc[r] - muse); ps += sc[r]; }
    ps += __shfl_xor(ps, 32);
    if (__any(mnew != a.m)) {
        const float corr = __builtin_amdgcn_exp2f(a.m - muse);
        a.l *= corr;
#pragma unroll
        for (int r = 0; r < 16; ++r) { a.o0[r] *= corr; a.o1[r] *= corr; }
    }
    a.l += ps; a.m = mnew;
    const bf16x8 pb0 = pack8(sc[0], sc[1], sc[2], sc[3], sc[4], sc[5], sc[6], sc[7]);
    const bf16x8 pb1 = pack8(sc[8], sc[9], sc[10], sc[11], sc[12], sc[13], sc[14], sc[15]);
    const int q = (lane & 15) >> 2, pp = lane & 3, blk = (lane >> 4) & 1;
    LAS unsigned char* vb = vl + (4 * half + q) * VSTR + (16 * blk + 4 * pp) * 2;
    { const bf16x8 A = cat4(tr_read(vb), tr_read(vb + 8 * VSTR)); a.o0 = MFMA32(A, pb0, a.o0); }
    { const bf16x8 A = cat4(tr_read(vb + 64), tr_read(vb + 8 * VSTR + 64)); a.o1 = MFMA32(A, pb0, a.o1); }
    { const bf16x8 A = cat4(tr_read(vb + 16 * VSTR), tr_read(vb + 24 * VSTR)); a.o0 = MFMA32(A, pb1, a.o0); }
    { const bf16x8 A = cat4(tr_read(vb + 16 * VSTR + 64), tr_read(vb + 24 * VSTR + 64)); a.o1 = MFMA32(A, pb1, a.o1); }
}
DI void attn_store(const AttnAcc& a, unsigned char* orow, int lane) {
    const int half = lane >> 5; const float inv = 1.f / a.l;
#pragma unroll
    for (int g = 0; g < 4; ++g) {
        *(unsigned*)(orow + 8 * g + 4 * half) = pk4_fp8(a.o0[4 * g] * inv, a.o0[4 * g + 1] * inv, a.o0[4 * g + 2] * inv, a.o0[4 * g + 3] * inv);
        *(unsigned*)(orow + 32 + 8 * g + 4 * half) = pk4_fp8(a.o1[4 * g] * inv, a.o1[4 * g + 1] * inv, a.o1[4 * g + 2] * inv, a.o1[4 * g + 3] * inv); }
}
DI void load_frags(bf16x8 (&f)[4], const bf16* row, int half) {
#pragma unroll
    for (int s = 0; s < 4; ++s) f[s] = *(const bf16x8*)(row + 16 * s + 8 * half);
}
DI void rope_frags(bf16x8 (&f)[4], int posr, int posc, int half, const float* rope) {
#pragma unroll
    for (int pr = 0; pr < 2; ++pr) {
        const int pos = pr == 0 ? posr : posc;
        const f32x4* t = (const f32x4*)(rope + (size_t)(pos * 16 + 8 * half) * 2);
        const f32x4 t0 = t[0], t1 = t[1], t2 = t[2], t3 = t[3];
        const float cs[16] = {t0.x, t0.y, t0.z, t0.w, t1.x, t1.y, t1.z, t1.w, t2.x, t2.y, t2.z, t2.w, t3.x, t3.y, t3.z, t3.w};
        float x1[8], x2[8]; unpack8(f[2 * pr], x1); unpack8(f[2 * pr + 1], x2);
        float y1[8], y2[8];
#pragma unroll
        for (int e = 0; e < 8; ++e) { const float co = cs[2 * e], si = cs[2 * e + 1]; y1[e] = x1[e] * co - x2[e] * si; y2[e] = x2[e] * co + x1[e] * si; }
        f[2 * pr] = pack8(y1[0], y1[1], y1[2], y1[3], y1[4], y1[5], y1[6], y1[7]);
        f[2 * pr + 1] = pack8(y2[0], y2[1], y2[2], y2[3], y2[4], y2[5], y2[6], y2[7]);
    }
}

DI void na_item(const Ctx& c, int item) {
    const bf16* P = (const bf16*)(c.ws + WS_P); unsigned char* Y = (unsigned char*)(c.ws + WS_YMIX);
    const int lane = c.lane, half = lane >> 5, j = lane & 31;
    const int cc = item & 1, h = (item >> 1) & 7, r = (item >> 4) & 127, b = item >> 11;
    const float* rpb = inp(c, 7) + (size_t)(c.L * 8 + h) * 15 * 31;
    LAS unsigned char* vl = c.lds + c.wave * WAVE_LDS; LAS float* tbl = (LAS float*)(vl + 32 * VSTR);
#pragma unroll
    for (int i = 0; i < 8; ++i) { const int e = lane + 64 * i; if (e < 15 * 31) tbl[(e / 31) * 128 + 48 + (e % 31)] = rpb[e] * LOG2E; }
    const int qrow = b * SEQ + r * 64 + 32 * cc + j;
    bf16x8 qf[4]; load_frags(qf, P + (size_t)qrow * PWP + NA_Q + h * 64, half);
    const int qc = 32 * cc + j, cstart = min(max(qc - 8, 0), 48);
    const int rs = min(max(r - 4, 0), 120);
    const int cb8 = cc ? 24 : 32;
    unsigned okf = 0u, okp = 0u;
#pragma unroll
    for (int rr = 0; rr < 16; ++rr) { const int kf = 32 * cc + crow(rr, half), kp = cb8 + (rr & 3) + 4 * half;
        okf |= ((kf >= cstart) && (kf < cstart + 16)) ? (1u << rr) : 0u; okp |= ((kp >= cstart) && (kp < cstart + 16)) ? (1u << rr) : 0u; }
    AttnAcc a; attn_init(a);
    auto key_row = [&](int t, int i) {
        if (t < 8) return b * SEQ + (rs + t) * 64 + 32 * cc + i;
        if (t < 10) return b * SEQ + (rs + 4 * (t - 8) + (i >> 3)) * 64 + cb8 + (i & 7);
        return NLAT + b * CTXL + 32 * (t - 10) + i; };
    auto load = [&](KV& kv, int t) {
        attn_load(kv, P + (size_t)key_row(t, j) * PWP + NA_K + h * 64, P + (size_t)key_row(t, lane >> 1) * PWP + NA_V + h * 64 + (lane & 1) * 32, half); };
    auto full = [&](KV& kv, int t) {
        const LAS float* bp = tbl + (rs + t - r + 7) * 128 + 32 * cc - qc + 63 + 4 * half;
        attn_tile(a, qf, kv.k, kv.v, vl, lane, [&](int rr, int, float raw) { return ((okf >> rr) & 1u) ? raw * QK_SCALE_L2 + bp[crow(rr, 0)] : -INFINITY; }); };
    auto packed = [&](KV& kv, int t) {
        const LAS float* bp = tbl + (rs + 4 * (t - 8) - r + 7) * 128 + cb8 - qc + 63 + 4 * half;
        attn_tile(a, qf, kv.k, kv.v, vl, lane, [&](int rr, int, float raw) { return ((okp >> rr) & 1u) ? raw * QK_SCALE_L2 + bp[(rr >> 2) * 128 + (rr & 3)] : -INFINITY; }); };
    auto ctx = [&](KV& kv) { attn_tile(a, qf, kv.k, kv.v, vl, lane, [&](int, int, float raw) { return raw * QK_SCALE_L2; }); };
    KV A, B; load(A, 0);
    for (int t = 0; t < 8; t += 2) { load(B, t + 1); full(A, t); load(A, t + 2); full(B, t + 1); }
    { load(B, 9); packed(A, 8); load(A, 10); packed(B, 9); }
    for (int t = 10; t < 18; t += 2) { load(B, t + 1); ctx(A); if (t + 2 < 18) load(A, t + 2); ctx(B); }
    attn_store(a, Y + (size_t)qrow * D + h * 64, lane);
}

DI void rope_prepass(const Ctx& c) {
    bf16* P = (bf16*)(c.ws + WS_P); const float* rope = (const float*)(c.ws + WS_ROPE);
    for (int row = c.gw; row < NLAT; row += c.ngw) {
        const int t = row % SEQ, pr = t >> 6, pc = t & 63;
#pragma unroll
        for (int i = 0; i < 5; ++i) {
            const int p = c.lane + 64 * i, head = p >> 5, pair = p & 31, hs = pair >> 4, f = pair & 15;
            bf16* base = P + (size_t)row * PWP + (head < 8 ? SW_Q + head * 64 : SW_K + (head - 8) * 64) + 32 * hs + f;
            const f32x2 cs = *(const f32x2*)(rope + (size_t)((hs ? pc : pr) * 16 + f) * 2);
            const float x1 = bf2f(base[0]), x2 = bf2f(base[16]);
            base[0] = f2bf(x1 * cs.x - x2 * cs.y); base[16] = f2bf(x2 * cs.x + x1 * cs.y);
        }
    }
}

DI void swa_item(const Ctx& c, int item) {
    const bf16* P = (const bf16*)(c.ws + WS_P); unsigned char* Y = (unsigned char*)(c.ws + WS_YMIX);
    const int lane = c.lane, half = lane >> 5, j = lane & 31;
    const int hq = item & 7, qb = (item >> 3) & 255, b = item >> 11, kvh = hq >> 2;
    LAS unsigned char* vl = c.lds + c.wave * WAVE_LDS;
    const int i0 = 32 * qb, qi = i0 + j, qrow = b * SEQ + qi;
    bf16x8 qf[4]; load_frags(qf, P + (size_t)qrow * PWP + SW_Q + hq * 64, half);
    AttnAcc a; attn_init(a);
    const int m_lo = max(0, 4 - qb), m_hi = min(9, 260 - qb), nw = m_hi - m_lo, nt = nw + 8;
    auto load = [&](KV& kv, int t) {
        const int base = t < nw ? b * SEQ + i0 - 128 + 32 * (m_lo + t) : NLAT + b * CTXL + 32 * (t - nw);
        attn_load(kv, P + (size_t)(base + j) * PWP + SW_K + kvh * 64, P + (size_t)(base + (lane >> 1)) * PWP + SW_V + kvh * 64 + (lane & 1) * 32, half); };
    auto compute = [&](KV& kv, int t) {
        const int m = m_lo + t; const bool edge = t < nw && (m == 0 || m == 8);
        if (edge) { const int j0 = i0 - 128 + 32 * m;
            attn_tile(a, qf, kv.k, kv.v, vl, lane, [&](int, int i, float raw) { const int dlt = j0 + i - qi; return ((dlt >= -128) && (dlt <= 128)) ? raw * QK_SCALE_L2 : -INFINITY; }); }
        else attn_tile(a, qf, kv.k, kv.v, vl, lane, [&](int, int, float raw) { return raw * QK_SCALE_L2; }); };
    KV A, B; load(A, 0);
    for (int t = 0; t < nt; t += 2) {
        if (t + 1 < nt) load(B, t + 1);
        compute(A, t);
        if (t + 1 < nt) { if (t + 2 < nt) load(A, t + 2); compute(B, t + 1); }
    }
    const float sink = inp(c, 12)[c.L * 8 + hq];
    a.l += __builtin_amdgcn_exp2f(sink * LOG2E - a.m);
    attn_store(a, Y + (size_t)qrow * D + 1536 + hq * 64, lane);
}

DI void ctx_attn_item(const Ctx& c, int item) {
    const bf16* P = (const bf16*)(c.ws + WS_P); unsigned char* Y = (unsigned char*)(c.ws + WS_YMIX);
    const int lane = c.lane, half = lane >> 5, j = lane & 31;
    const int h = item & 7, qb = (item >> 3) & 7, b = (item >> 6) & 1, kind = item >> 7;
    LAS unsigned char* vl = c.lds + c.wave * WAVE_LDS;
    const int qcol = kind == 0 ? NA_Q + h * 64 : SW_Q + h * 64;
    const int kcol = kind == 0 ? NA_K + h * 64 : SW_K + (h >> 2) * 64;
    const int vcol = kind == 0 ? NA_V + h * 64 : SW_V + (h >> 2) * 64;
    const int qrow = NLAT + b * CTXL + 32 * qb + j;
    bf16x8 qf[4]; load_frags(qf, P + (size_t)qrow * PWP + qcol, half);
    AttnAcc a; attn_init(a);
    auto load = [&](KV& kv, int t) { const int base = NLAT + b * CTXL + 32 * t;
        attn_load(kv, P + (size_t)(base + j) * PWP + kcol, P + (size_t)(base + (lane >> 1)) * PWP + vcol + (lane & 1) * 32, half); };
    KV A, B; load(A, 0);
    for (int t = 0; t < 8; t += 2) {
        load(B, t + 1);
        attn_tile(a, qf, A.k, A.v, vl, lane, [&](int, int, float raw) { return raw * QK_SCALE_L2; });
        if (t + 2 < 8) load(A, t + 2);
        attn_tile(a, qf, B.k, B.v, vl, lane, [&](int, int, float raw) { return raw * QK_SCALE_L2; });
    }
    if (kind == 1) a.l += __builtin_amdgcn_exp2f(inp(c, 12)[c.L * 8 + h] * LOG2E - a.m);
    attn_store(a, Y + (size_t)qrow * D + (kind == 0 ? 0 : 1536) + h * 64, lane);
}

DI void conv_rows4(const Ctx& c, int row0, int stride, int nrows) {
    const bf16* P = (const bf16*)(c.ws + WS_P); unsigned char* Y = (unsigned char*)(c.ws + WS_YMIX);
    const int lane = c.lane, ch = 8 * lane;
    const float* w = inp(c, 8) + (size_t)c.L * 3 * 512;
    f32x4 wv[3][2];
#pragma unroll
    for (int t = 0; t < 3; ++t) { wv[t][0] = *(const f32x4*)(w + t * 512 + ch); wv[t][1] = *(const f32x4*)(w + t * 512 + ch + 4); }
    bf16x8 u[4][3], g[4][3], gb[4]; bool ok[4][3]; int rows[4];
#pragma unroll
    for (int r = 0; r < 4; ++r) {
        const int row = row0 + r * stride; rows[r] = row;
        const bool live = row < nrows; const int rr = live ? row : 0;
        int pos, len; if (rr < NLAT) { pos = rr % SEQ; len = SEQ; } else { pos = (rr - NLAT) % CTXL; len = CTXL; }
#pragma unroll
        for (int t = 0; t < 3; ++t) { const int q = pos + t - 1; ok[r][t] = live && q >= 0 && q < len; const bf16* pr = P + (size_t)(ok[r][t] ? rr + t - 1 : rr) * PWP;
            u[r][t] = *(const bf16x8*)(pr + SC_U + ch); g[r][t] = *(const bf16x8*)(pr + SC_C + ch); }
        gb[r] = *(const bf16x8*)(P + (size_t)rr * PWP + SC_B + ch);
    }
#pragma unroll
    for (int r = 0; r < 4; ++r) {
        if (rows[r] >= nrows) continue;
        float acc[8];
#pragma unroll
        for (int e = 0; e < 8; ++e) acc[e] = 0.f;
#pragma unroll
        for (int t = 0; t < 3; ++t) { float uf[8], gf[8]; unpack8(u[r][t], uf); unpack8(g[r][t], gf);
            const float wf[8] = {wv[t][0].x, wv[t][0].y, wv[t][0].z, wv[t][0].w, wv[t][1].x, wv[t][1].y, wv[t][1].z, wv[t][1].w};
            const float m = ok[r][t] ? 1.f : 0.f;
#pragma unroll
            for (int e = 0; e < 8; ++e) acc[e] += m * wf[e] * (gf[e] * uf[e]); }
        float bf_[8]; unpack8(gb[r], bf_);
        u32x2 o; o.x = pk4_fp8(bf_[0] * acc[0], bf_[1] * acc[1], bf_[2] * acc[2], bf_[3] * acc[3]); o.y = pk4_fp8(bf_[4] * acc[4], bf_[5] * acc[5], bf_[6] * acc[6], bf_[7] * acc[7]);
        *(u32x2*)(Y + (size_t)rows[r] * D + 512 + ch) = o;
    }
}
constexpr int KSTR = 144, V2STR = 272;
DI int gla_row0(int b, int ck) { return ck < 8 ? NLAT + b * CTXL + 32 * ck : b * SEQ + 32 * (ck - 8); }
DI int gla_chain_pos(int dir, int ck) { return ck < 8 ? (dir == 0 ? ck : 7 - ck) : (dir == 0 ? ck : 8 + 255 - (ck - 8)); }

struct GlaGate { float w[16]; float bias; };
template <int DIR>
DI void gla_gate_load(const Ctx& c, int h, GlaGate& g) {
    const float* w2 = inp(c, 9) + (size_t)((c.L * 2 + DIR) * 16) * 256 + h * 64 + c.lane;
#pragma unroll
    for (int i = 0; i < 16; ++i) g.w[i] = w2[i * 256];
    g.bias = inp(c, 10)[(c.L * 2 + DIR) * 256 + h * 64 + c.lane];
}
DI void gla_stage_z(const bf16* P, int row0, LAS unsigned char* zl, int lane) {
    const u32x4* s = (const u32x4*)(P + (size_t)(row0 + (lane >> 1)) * PWP + GL_Z + (lane & 1) * 16);
    const u32x4 v0 = s[0], v1 = s[1];
    *(LAS u32x4*)(zl + lane * 32) = v0; *(LAS u32x4*)(zl + lane * 32 + 16) = v1;
}
template <int DIR>
DI float gla_la(const GlaGate& g, const LAS unsigned char* zl, int t) {
    const LAS unsigned char* zr = zl + t * 64 + DIR * 32;
    float a[8], bq[8]; unpack8(*(const LAS bf16x8*)zr, a); unpack8(*(const LAS bf16x8*)(zr + 16), bq);
    float x = g.bias;
#pragma unroll
    for (int i = 0; i < 8; ++i) x += a[i] * g.w[i];
#pragma unroll
    for (int i = 0; i < 8; ++i) x += bq[i] * g.w[8 + i];
    return (fminf(x, 0.f) - __logf(1.f + __expf(-fabsf(x)))) * (1.f / 16.f);
}
DI void gla_stage_v(const bf16* P, int row0, int h, LAS unsigned char* vl, int lane) {
#pragma unroll
    for (int i = 0; i < 8; ++i) { const int idx = lane + 64 * i, t = idx >> 4, ch = idx & 15;
        *(LAS u32x4*)(vl + t * V2STR + ch * 16) = *(const u32x4*)(P + (size_t)(row0 + t) * PWP + GL_V + h * 128 + ch * 8); }
}
DI void gla_load_qk(u32x4 (&r)[4], const bf16* P, int row0, int col, int lane) {
    const u32x4* s = (const u32x4*)(P + (size_t)(row0 + (lane >> 1)) * PWP + col + (lane & 1) * 32);
    r[0] = s[0]; r[1] = s[1]; r[2] = s[2]; r[3] = s[3];
}
DI void gla_put_qk(const u32x4 (&r)[4], LAS unsigned char* l, int lane) {
    LAS unsigned char* d = l + (lane >> 1) * KSTR + (lane & 1) * 64;
    *(LAS u32x4*)(d) = r[0]; *(LAS u32x4*)(d + 16) = r[1]; *(LAS u32x4*)(d + 32) = r[2]; *(LAS u32x4*)(d + 48) = r[3];
}

template <int DIR>
DI void gla_g1(const Ctx& c, int b, int h, int ck) {
    const bf16* P = (const bf16*)(c.ws + WS_P);
    const int lane = c.lane, half = lane >> 5;
    LAS unsigned char* kl = c.lds + c.wave * WAVE_LDS; LAS unsigned char* vl = kl + 32 * KSTR; LAS unsigned char* zl = vl + 32 * V2STR;
    const int row0 = gla_row0(b, ck), n = gla_chain_pos(DIR, ck);
    const size_t chain = (size_t)((b * 2 + DIR) * 4 + h) * NCH + n;
    u32x4 kr[4]; gla_load_qk(kr, P, row0, GL_K + h * 64, lane);
    GlaGate gate; gla_gate_load<DIR>(c, h, gate);
    gla_stage_z(P, row0, zl, lane);
    gla_stage_v(P, row0, h, vl, lane);
    gla_put_qk(kr, kl, lane);
    bf16* erp = (bf16*)(c.ws + WS_ER) + chain * 2048;
    float rev = 0.f;
#pragma unroll
    for (int tt = 31; tt >= 0; --tt) {
        const int t = DIR ? 31 - tt : tt;
        LAS bf16* kp = (LAS bf16*)(kl + t * KSTR + 2 * lane);
        const float er = __expf(rev);
        *kp = f2bf(bf2f(*kp) * er);
        erp[t * 64 + lane] = f2bf(er);
        rev += gla_la<DIR>(gate, zl, t);
    }
    ((float*)(c.ws + WS_GDEC))[chain * 64 + lane] = __expf(rev);
    const int q = (lane & 15) >> 2, pp = lane & 3, blk = (lane >> 4) & 1;
    bf16* ut = (bf16*)(c.ws + WS_UT) + chain * 8192;
    bf16x8 Kf[2][2];
#pragma unroll
    for (int nt = 0; nt < 2; ++nt)
#pragma unroll
        for (int s = 0; s < 2; ++s) { LAS unsigned char* a = kl + (16 * s + 8 * half + q) * KSTR + (32 * nt + 16 * blk + 4 * pp) * 2; Kf[nt][s] = cat4(tr_read(a), tr_read(a + 4 * KSTR)); }
#pragma unroll
    for (int mt = 0; mt < 4; ++mt) {
        bf16x8 Vf[2];
#pragma unroll
        for (int s = 0; s < 2; ++s) { LAS unsigned char* a = vl + (16 * s + 8 * half + q) * V2STR + (32 * mt + 16 * blk + 4 * pp) * 2; Vf[s] = cat4(tr_read(a), tr_read(a + 4 * V2STR)); }
#pragma unroll
        for (int nt = 0; nt < 2; ++nt) {
            f32x16 acc = zero16();
            acc = MFMA32(Kf[nt][0], Vf[0], acc); acc = MFMA32(Kf[nt][1], Vf[1], acc);
            bf16* up = ut + (size_t)(32 * mt + (lane & 31)) * 64 + 32 * nt + 4 * half;
#pragma unroll
            for (int g4 = 0; g4 < 4; ++g4) { u32x2 w; w.x = pk2(acc[4 * g4], acc[4 * g4 + 1]); w.y = pk2(acc[4 * g4 + 2], acc[4 * g4 + 3]); *(u32x2*)(up + 8 * g4) = w; }
        }
    }
}

DI void gla_scan(const Ctx& c) {

    const bf16* ut = (const bf16*)(c.ws + WS_UT); bf16* sin = (bf16*)(c.ws + WS_SIN); const float* gd = (const float*)(c.ws + WS_GDEC);
    for (int e = c.bid * 512 + c.tid; e < 16 * 8192; e += c.nblk * 512) {
        const int chain = e >> 13, el = e & 8191, k = el & 63;
        const size_t base = (size_t)chain * NCH * 8192 + el;
        const float* g = gd + (size_t)chain * NCH * 64 + k;
        float st = 0.f;
        for (int n0 = 0; n0 < NCH; n0 += 88) {
            float u[88], gg[88];
#pragma unroll
            for (int i = 0; i < 88; ++i) { u[i] = bf2f(ut[base + (size_t)(n0 + i) * 8192]); gg[i] = g[(n0 + i) * 64]; }
#pragma unroll
            for (int i = 0; i < 88; ++i) { sin[base + (size_t)(n0 + i) * 8192] = f2bf(st); st = gg[i] * st + u[i]; }
        }
    }
}

template <int DIR>
DI void gla_g3_dir(const Ctx& c, int b, int h, int ck, const unsigned (&qc)[16], const unsigned (&kc)[16], LAS unsigned char* ql, LAS unsigned char* kl, LAS unsigned char* vl, LAS unsigned char* zl, f32x16 (&o)[4]) {
    const int lane = c.lane, half = lane >> 5, j = lane & 31;
    const size_t chain = (size_t)((b * 2 + DIR) * 4 + h) * NCH + gla_chain_pos(DIR, ck);
    const bf16* sin = (const bf16*)(c.ws + WS_SIN) + chain * 8192;
    bf16x8 sf[2][4], sg[2][4];
#pragma unroll
    for (int mt = 0; mt < 2; ++mt)
#pragma unroll
        for (int s = 0; s < 4; ++s) sf[mt][s] = *(const bf16x8*)(sin + (size_t)(32 * mt + j) * 64 + 16 * s + 8 * half);
    { const float gd = ((const float*)(c.ws + WS_GDEC))[chain * 64 + lane];
      const bf16* erp = (const bf16*)(c.ws + WS_ER) + chain * 2048;
      bf16 er[32];
#pragma unroll
      for (int t = 0; t < 32; ++t) er[t] = erp[t * 64 + lane];
#pragma unroll
      for (int t = 0; t < 32; ++t) {
        const float e1 = gd * __builtin_amdgcn_rcpf(bf2f(er[t]));
        const float qv = (t & 1) ? hi16(qc[t >> 1]) : lo16(qc[t >> 1]), kv = (t & 1) ? hi16(kc[t >> 1]) : lo16(kc[t >> 1]);
        *(LAS bf16*)(ql + t * KSTR + 2 * lane) = f2bf(qv * e1 * 0.125f);
        *(LAS bf16*)(kl + t * KSTR + 2 * lane) = f2bf(kv * __builtin_amdgcn_rcpf(e1));
      } }
#pragma unroll
    for (int mt = 0; mt < 2; ++mt)
#pragma unroll
        for (int s = 0; s < 4; ++s) sg[mt][s] = *(const bf16x8*)(sin + (size_t)(32 * (mt + 2) + j) * 64 + 16 * s + 8 * half);
    bf16x8 qf[4], kf[4];
#pragma unroll
    for (int s = 0; s < 4; ++s) { qf[s] = *(const LAS bf16x8*)(ql + j * KSTR + (16 * s + 8 * half) * 2); kf[s] = *(const LAS bf16x8*)(kl + j * KSTR + (16 * s + 8 * half) * 2); }
    f32x16 at = zero16();
#pragma unroll
    for (int s = 0; s < 4; ++s) at = MFMA32(kf[s], qf[s], at);
    float a[16];
#pragma unroll
    for (int r = 0; r < 16; ++r) { const int s = crow(r, half); const bool ok = DIR ? (s >= j) : (s <= j); a[r] = ok ? at[r] : 0.f; }
    const bf16x8 pb0 = pack8(a[0], a[1], a[2], a[3], a[4], a[5], a[6], a[7]), pb1 = pack8(a[8], a[9], a[10], a[11], a[12], a[13], a[14], a[15]);
    const int q = (lane & 15) >> 2, pp = lane & 3, blk = (lane >> 4) & 1;
#pragma unroll
    for (int mt = 0; mt < 4; ++mt) {
        LAS unsigned char* vb = vl + (4 * half + q) * V2STR + (32 * mt + 16 * blk + 4 * pp) * 2;
        o[mt] = MFMA32(cat4(tr_read(vb), tr_read(vb + 8 * V2STR)), pb0, o[mt]);
        o[mt] = MFMA32(cat4(tr_read(vb + 16 * V2STR), tr_read(vb + 24 * V2STR)), pb1, o[mt]);
#pragma unroll
        for (int s = 0; s < 4; ++s) o[mt] = MFMA32(mt < 2 ? sf[mt & 1][s] : sg[mt & 1][s], qf[s], o[mt]);
    }
}
DI void gla_g3(const Ctx& c, int b, int h, int ck) {
    const bf16* P = (const bf16*)(c.ws + WS_P); unsigned char* Y = (unsigned char*)(c.ws + WS_YMIX);
    const int lane = c.lane, half = lane >> 5, j = lane & 31;
    LAS unsigned char* ql = c.lds + c.wave * WAVE_LDS; LAS unsigned char* kl = ql + 32 * KSTR; LAS unsigned char* vl = kl + 32 * KSTR; LAS unsigned char* zl = vl + 32 * V2STR;
    const int row0 = gla_row0(b, ck);
    { u32x4 qr[4], kr[4]; gla_load_qk(qr, P, row0, GL_Q + h * 64, lane); gla_load_qk(kr, P, row0, GL_K + h * 64, lane);
      gla_stage_v(P, row0, h, vl, lane);
      gla_put_qk(qr, ql, lane); gla_put_qk(kr, kl, lane); }
    unsigned qc[16], kc[16];
#pragma unroll
    for (int i = 0; i < 16; ++i) {
        qc[i] = (unsigned)*(const LAS bf16*)(ql + (2 * i) * KSTR + 2 * lane) | ((unsigned)*(const LAS bf16*)(ql + (2 * i + 1) * KSTR + 2 * lane) << 16);
        kc[i] = (unsigned)*(const LAS bf16*)(kl + (2 * i) * KSTR + 2 * lane) | ((unsigned)*(const LAS bf16*)(kl + (2 * i + 1) * KSTR + 2 * lane) << 16); }
    f32x16 o[4];
#pragma unroll
    for (int mt = 0; mt < 4; ++mt) o[mt] = zero16();
    gla_g3_dir<0>(c, b, h, ck, qc, kc, ql, kl, vl, zl, o);
    gla_g3_dir<1>(c, b, h, ck, qc, kc, ql, kl, vl, zl, o);
    float ss = 0.f;
#pragma unroll
    for (int mt = 0; mt < 4; ++mt)
#pragma unroll
        for (int r = 0; r < 16; ++r) ss += o[mt][r] * o[mt][r];
    ss += __shfl_xor(ss, 32);
    const float rstd = 1.f / sqrtf(ss * (1.f / 128.f) + LN_EPS);
    const float* gain = inp(c, 11) + (size_t)c.L * 128;
    const int row = row0 + j;
#pragma unroll
    for (int mt = 0; mt < 4; ++mt)
#pragma unroll
        for (int g4 = 0; g4 < 4; ++g4) {
            const int v0 = 32 * mt + 8 * g4 + 4 * half;
            const u32x2 gr = *(const u32x2*)(P + (size_t)row * PWP + GL_G + h * 128 + v0);
            const float gv[4] = {lo16(gr.x), hi16(gr.x), lo16(gr.y), hi16(gr.y)};
            const f32x4 gn = *(const f32x4*)(gain + v0);
            float y[4];
#pragma unroll
            for (int e = 0; e < 4; ++e) { const float on = o[mt][4 * g4 + e] * rstd * gn[e]; y[e] = on * (gv[e] / (1.f + __expf(-gv[e]))); }
            *(unsigned*)(Y + (size_t)row * D + 1024 + h * 128 + v0) = pk4_fp8(y[0], y[1], y[2], y[3]); }
}
template <int NT>
DI void router_phase(const Ctx& c, int rows_per_chunk, int nchunks) {
    const int L = c.L, lane = c.lane, r16 = lane & 15, q = lane >> 4, w = c.wave;
    const bf16* xn = (const bf16*)(c.ws + WS_XN); const bf16* xl = (const bf16*)(c.ws + WS_XL); const bf16* rw = (const bf16*)(c.ws + WS_ROUTW);
    const float* rb = inp(c, 17) + (size_t)L * NEXP;
    int* eidx = (int*)(c.ws + WS_EIDX); int* rank = (int*)(c.ws + WS_RANK); float* wts = (float*)(c.ws + WS_WTS);
    unsigned* cnt = (unsigned*)(c.ws + WS_CTL) + CW_CNT + L * 64;
    LAS float* part = (LAS float*)c.lds;
    LAS float* sc = (LAS float*)(c.lds + 98304);
    LAS float* sl = sc + 5 * 16 * 65;
    LAS unsigned* lcnt = (LAS unsigned*)(c.lds + LDS_MISC + 256);
    LAS unsigned* lbase = lcnt + 64;
    for (int chunk = c.bid; chunk < nchunks; chunk += c.nblk) {
        const int row0 = chunk * rows_per_chunk, rowlast = row0 + rows_per_chunk - 1;
        if (c.tid < 64) lcnt[c.tid] = 0u;
        f32x4 acc[NT][4];
#pragma unroll
        for (int t = 0; t < NT; ++t)
#pragma unroll
            for (int nt = 0; nt < 4; ++nt) acc[t][nt] = (f32x4){0.f, 0.f, 0.f, 0.f};
#pragma unroll 2
        for (int ks = 0; ks < 8; ++ks) {
            const int k0 = 256 * w + 32 * ks + 8 * q;
            bf16x8 bh[4], bl[4];
#pragma unroll
            for (int nt = 0; nt < 4; ++nt) { bh[nt] = *(const bf16x8*)(rw + (size_t)(16 * nt + r16) * D + k0); bl[nt] = *(const bf16x8*)(rw + (size_t)(64 + 16 * nt + r16) * D + k0); }
#pragma unroll
            for (int t = 0; t < NT; ++t) {
                const int row = min(row0 + 16 * t + r16, rowlast);
                const bf16x8 ah = *(const bf16x8*)(xn + (size_t)row * D + k0), al = *(const bf16x8*)(xl + (size_t)row * D + k0);
#pragma unroll
                for (int nt = 0; nt < 4; ++nt) { acc[t][nt] = MFMA16(ah, bh[nt], acc[t][nt]); acc[t][nt] = MFMA16(al, bh[nt], acc[t][nt]); acc[t][nt] = MFMA16(ah, bl[nt], acc[t][nt]); }
            }
        }
#pragma unroll
        for (int g = 0; g < 2; ++g) {
            const int t0 = 3 * g, tn = (g == 0) ? (NT < 3 ? NT : 3) : NT - 3;
            __syncthreads();
#pragma unroll
            for (int tt = 0; tt < 3; ++tt) if (tt < tn)
#pragma unroll
                for (int nt = 0; nt < 4; ++nt)
#pragma unroll
                    for (int r = 0; r < 4; ++r) part[(w * 3 + tt) * 1024 + (4 * q + r) * 64 + 16 * nt + r16] = acc[t0 + tt][nt][r];
            __syncthreads();
            for (int e = c.tid; e < tn * 1024; e += 512) {
                const int tt = e >> 10, el = e & 1023, tok = el >> 6, ex = el & 63;
                float sum = 0.f;
#pragma unroll
                for (int ww = 0; ww < 8; ++ww) sum += part[(ww * 3 + tt) * 1024 + el];
                const float sg = 1.f / (1.f + __expf(-sum));
                sc[((t0 + tt) * 16 + tok) * 65 + ex] = sg; sl[((t0 + tt) * 16 + tok) * 65 + ex] = sg + rb[ex];
            }
        }
        __syncthreads();
        int e0 = 0, e1 = 0, li0 = 0, li1 = 0; float w0 = 0.f, w1 = 0.f;
        const int tk = lane >> 2, s4 = lane & 3;
        const int tokrow = row0 + 16 * w + tk;
        const bool act = (w < NT) && (tokrow <= rowlast);
        if (act) {
            const LAS float* slt = sl + (w * 16 + tk) * 65; const LAS float* sct = sc + (w * 16 + tk) * 65;
            float v[16];
#pragma unroll
            for (int i = 0; i < 16; ++i) v[i] = slt[16 * s4 + i];
            float ga, gb;
            { float m1 = -INFINITY, m2 = -INFINITY;
#pragma unroll
              for (int i = 0; i < 8; ++i) { if (v[i] > m1) { m2 = m1; m1 = v[i]; } else if (v[i] > m2) m2 = v[i]; }
              ga = m1 + m2; m1 = -INFINITY; m2 = -INFINITY;
#pragma unroll
              for (int i = 8; i < 16; ++i) { if (v[i] > m1) { m2 = m1; m1 = v[i]; } else if (v[i] > m2) m2 = v[i]; }
              gb = m1 + m2; }
            float gs[8];
#pragma unroll
            for (int s2 = 0; s2 < 4; ++s2) { gs[2 * s2] = __shfl(ga, (lane & ~3) | s2); gs[2 * s2 + 1] = __shfl(gb, (lane & ~3) | s2); }
            unsigned gmask = 0u;
#pragma unroll
            for (int it = 0; it < 4; ++it) { float best = -INFINITY; int bi = 0;
#pragma unroll
                for (int g = 0; g < 8; ++g) { const bool fr = ((gmask >> g) & 1u) == 0u; if (fr && gs[g] > best) { best = gs[g]; bi = g; } }
                gmask |= 1u << bi; }
            const bool oka = (gmask >> (2 * s4)) & 1u, okb = (gmask >> (2 * s4 + 1)) & 1u;
#pragma unroll
            for (int i = 0; i < 16; ++i) v[i] = ((i < 8) ? oka : okb) ? v[i] : -INFINITY;
            float wsum = 0.f;
#pragma unroll
            for (int rd = 0; rd < 8; ++rd) {
                float best = -INFINITY; int bi = 16 * s4;
#pragma unroll
                for (int i = 0; i < 16; ++i) if (v[i] > best) { best = v[i]; bi = 16 * s4 + i; }
#pragma unroll
                for (int o = 1; o < 4; o <<= 1) { const float ob = __shfl_xor(best, o); const int oi = __shfl_xor(bi, o); if (ob > best || (ob == best && oi < bi)) { best = ob; bi = oi; } }
                const float wv = sct[bi]; wsum += wv;
                if ((bi >> 4) == s4) {
#pragma unroll
                    for (int i = 0; i < 16; ++i) v[i] = (i == (bi & 15)) ? -INFINITY : v[i]; }
                if ((rd & 3) == s4) { if (rd < 4) { e0 = bi; w0 = wv; } else { e1 = bi; w1 = wv; } }
            }
            const float sc25 = 2.5f / wsum; w0 *= sc25; w1 *= sc25;
            li0 = (int)__hip_atomic_fetch_add((unsigned*)(lcnt + e0), 1u, __ATOMIC_RELAXED, __HIP_MEMORY_SCOPE_WORKGROUP); li1 = (int)__hip_atomic_fetch_add((unsigned*)(lcnt + e1), 1u, __ATOMIC_RELAXED, __HIP_MEMORY_SCOPE_WORKGROUP);
        }
        __syncthreads();
        if (c.tid < 64) { const unsigned n = lcnt[c.tid]; lbase[c.tid] = n ? atomicAdd(cnt + c.tid, n) : 0u; }
        __syncthreads();
        if (act) {
            eidx[tokrow * 8 + s4] = e0; wts[tokrow * 8 + s4] = w0; rank[tokrow * 8 + s4] = (int)lbase[e0] + li0;
            eidx[tokrow * 8 + s4 + 4] = e1; wts[tokrow * 8 + s4 + 4] = w1; rank[tokrow * 8 + s4 + 4] = (int)lbase[e1] + li1;
        }
        __syncthreads();
    }
}

DI void phase9(const Ctx& c) {
    const int L = c.L;
    const int nmoe = L == 0 ? NTOK : NLAT;
    LAS int* ts = (LAS int*)c.lds;
    const unsigned* cnt = (const unsigned*)(c.ws + WS_CTL) + CW_CNT + L * 64;
    if (c.tid == 0) { int acc = 0; for (int e = 0; e < 64; ++e) { ts[e] = acc; acc += ((int)cnt[e] + 255) >> 8; } ts[64] = acc; ts[65] = acc + nmoe / 256; }
    __syncthreads();
    int* toks = (int*)(c.ws + WS_TOKS); int* pos = (int*)(c.ws + WS_POS); int* tile_e = (int*)(c.ws + WS_TILEE);
    const int* eidx = (const int*)(c.ws + WS_EIDX); const int* rank = (const int*)(c.ws + WS_RANK);
    const int gt = c.bid * 512 + c.tid, ngt = c.nblk * 512;
    for (int i = gt; i < nmoe * 8; i += ngt) { const int e = eidx[i]; const int slot = ts[e] * 256 + rank[i]; toks[slot] = i >> 3; pos[i] = slot; }
    for (int i = gt; i < nmoe; i += ngt) toks[ts[64] * 256 + i] = i;
    for (int e = c.bid; e < 65; e += c.nblk) {
        for (int t = ts[e] + c.tid; t < ts[e + 1]; t += 512) tile_e[t] = e;
        if (e < 64) { const int n = (int)cnt[e]; for (int s = n + c.tid; s < (ts[e + 1] - ts[e]) * 256; s += 512) toks[ts[e] * 256 + s] = 0; }
    }
    if (c.bid == 0 && c.tid == 0) { int* nt = (int*)(c.ws + WS_CTL) + CW_NT + L * 64; nt[0] = ts[65]; nt[1] = ts[64]; }
    __syncthreads();
}

DI void phase12(const Ctx& c) {
    const int L = c.L;
    const int nmoe = L == 0 ? NTOK : NLAT;
    const unsigned char* Yb = (const unsigned char*)(c.ws + WS_Y); const bf16* x1 = (const bf16*)(c.ws + WS_X1);
    const int* pos = (const int*)(c.ws + WS_POS); const float* wts = (const float*)(c.ws + WS_WTS);
    const int sh_tile0 = ((const int*)(c.ws + WS_CTL))[CW_NT + L * 64 + 1];
    const float* lg = inp(c, 24) + (size_t)L * D; const float* lb = inp(c, 25) + (size_t)L * D;
    int4 ns0 = {0, 0, 0, 0}, ns1 = {0, 0, 0, 0}; f32x4 nq0 = {0.f, 0.f, 0.f, 0.f}, nq1 = {0.f, 0.f, 0.f, 0.f};
    if (c.gw < nmoe) { ns0 = *(const int4*)(pos + c.gw * 8); ns1 = *(const int4*)(pos + c.gw * 8 + 4); nq0 = *(const f32x4*)(wts + c.gw * 8); nq1 = *(const f32x4*)(wts + c.gw * 8 + 4); }
    for (int row = c.gw; row < nmoe; row += c.ngw) {
        const float* mod = mod_row(c, row);
        f32x4 f[8];
        int slot[8]; float w[8];
        { const int4 s0 = ns0, s1 = ns1; const f32x4 q0 = nq0, q1 = nq1;
          slot[0] = s0.x; slot[1] = s0.y; slot[2] = s0.z; slot[3] = s0.w; slot[4] = s1.x; slot[5] = s1.y; slot[6] = s1.z; slot[7] = s1.w;
          w[0] = q0.x; w[1] = q0.y; w[2] = q0.z; w[3] = q0.w; w[4] = q1.x; w[5] = q1.y; w[6] = q1.z; w[7] = q1.w; }
        { const int nr = row + c.ngw; if (nr < nmoe) { ns0 = *(const int4*)(pos + nr * 8); ns1 = *(const int4*)(pos + nr * 8 + 4); nq0 = *(const f32x4*)(wts + nr * 8); nq1 = *(const f32x4*)(wts + nr * 8 + 4); } }
        {
            u32x4 y[9][2];
#pragma unroll
            for (int k = 0; k < 9; ++k) { const unsigned char* yr = Yb + (size_t)(k == 8 ? sh_tile0 * 256 + row : slot[k]) * D + 16 * c.lane;
                y[k][0] = *(const u32x4*)yr; y[k][1] = *(const u32x4*)(yr + 1024); }
#pragma unroll
            for (int j = 0; j < 2; ++j)
#pragma unroll
                for (int q = 0; q < 4; ++q) {
                    { const int d = (int)y[8][j][q]; const f32x2 a = __builtin_amdgcn_cvt_pk_f32_fp8(d, false), b2 = __builtin_amdgcn_cvt_pk_f32_fp8(d, true); f[4 * j + q] = (f32x4){a.x, a.y, b2.x, b2.y}; }
#pragma unroll
                    for (int k = 0; k < 8; ++k) { const int d = (int)y[k][j][q]; const f32x2 a = __builtin_amdgcn_cvt_pk_f32_fp8(d, false), b2 = __builtin_amdgcn_cvt_pk_f32_fp8(d, true); f[4 * j + q] += (f32x4){a.x, a.y, b2.x, b2.y} * w[k]; }
                    f[4 * j + q] = f[4 * j + q] * 0.125f; }
        }
        f32x4 v[8];
#pragma unroll
        for (int j = 0; j < 2; ++j) { const int cb = 1024 * j + 16 * c.lane;
            const u32x4 ta = *(const u32x4*)(x1 + (size_t)row * D + cb), tb = *(const u32x4*)(x1 + (size_t)row * D + cb + 8);
            const f32x4 xa[4] = {(f32x4){lo16(ta.x), hi16(ta.x), lo16(ta.y), hi16(ta.y)}, (f32x4){lo16(ta.z), hi16(ta.z), lo16(ta.w), hi16(ta.w)},
                                 (f32x4){lo16(tb.x), hi16(tb.x), lo16(tb.y), hi16(tb.y)}, (f32x4){lo16(tb.z), hi16(tb.z), lo16(tb.w), hi16(tb.w)}};
#pragma unroll
            for (int q = 0; q < 4; ++q) v[4 * j + q] = xa[q] * DN_ALPHA + *(const f32x4*)(mod + 5 * D + cb + 4 * q) * f[4 * j + q]; }
        float mean, rstd; row_stats(v, mean, rstd);
#pragma unroll
        for (int j = 0; j < 2; ++j)
#pragma unroll
            for (int q = 0; q < 4; ++q) { const int col = 1024 * j + 16 * c.lane + 4 * q; v[4 * j + q] = (v[4 * j + q] - mean) * rstd * *(const f32x4*)(lg + col) + *(const f32x4*)(lb + col); }
        if (L == 1) {
            float* orow = outp(c) + (size_t)row * D;
#pragma unroll
            for (int j = 0; j < 2; ++j)
#pragma unroll
                for (int q = 0; q < 4; ++q) *(f32x4*)(orow + 1024 * j + 16 * c.lane + 4 * q) = v[4 * j + q];
        } else if (row < NLAT) {
            bf16* xb = (bf16*)(c.ws + WS_XB);
#pragma unroll
            for (int j = 0; j < 2; ++j) { u32x4 oa, ob;
                oa.x = pk2(v[4 * j][0], v[4 * j][1]); oa.y = pk2(v[4 * j][2], v[4 * j][3]); oa.z = pk2(v[4 * j + 1][0], v[4 * j + 1][1]); oa.w = pk2(v[4 * j + 1][2], v[4 * j + 1][3]);
                ob.x = pk2(v[4 * j + 2][0], v[4 * j + 2][1]); ob.y = pk2(v[4 * j + 2][2], v[4 * j + 2][3]); ob.z = pk2(v[4 * j + 3][0], v[4 * j + 3][1]); ob.w = pk2(v[4 * j + 3][2], v[4 * j + 3][3]);
                *(u32x4*)(xb + (size_t)row * D + 1024 * j + 16 * c.lane) = oa; *(u32x4*)(xb + (size_t)row * D + 1024 * j + 16 * c.lane + 8) = ob; }
        }
        if (L == 0) {
            const float* mod1 = mod_row_l(c, row, 1); unsigned char* xn = (unsigned char*)(c.ws + WS_XN);
            row_stats(v, mean, rstd);
#pragma unroll
            for (int j = 0; j < 2; ++j) { const int cb = 1024 * j + 16 * c.lane; u32x4 o;
#pragma unroll
                for (int q = 0; q < 4; ++q) { const f32x4 sh = *(const f32x4*)(mod1 + cb + 4 * q), sc = *(const f32x4*)(mod1 + D + cb + 4 * q);
                    const f32x4 yv = (v[4 * j + q] - mean) * rstd * (sc + 1.f) + sh; o[q] = pk4_fp8(yv.x, yv.y, yv.z, yv.w); }
                *(u32x4*)(xn + (size_t)row * D + cb) = o; }
        }
    }
}

DI int xcd_vid(int G, int bx) { return (G % 8 == 0) ? (bx % 8) * (G / 8) + bx / 8 : bx; }
__global__ void __launch_bounds__(512, 2) fwd(Params prm) {
    extern __shared__ __attribute__((aligned(16))) unsigned char lds_raw[];
    const int wave_s = __builtin_amdgcn_readfirstlane(threadIdx.x >> 6);
    Ctx c; c.lds = (LAS unsigned char*)lds_raw; c.tid = threadIdx.x; c.lane = c.tid & 63; c.wave = __builtin_amdgcn_readfirstlane(c.tid >> 6);
    c.gw = blockIdx.x * 8 + c.wave; c.ngw = gridDim.x * 8; c.bid = blockIdx.x; c.nblk = gridDim.x; c.p = (CParams*)__builtin_amdgcn_kernarg_segment_ptr(); c.L = 0;
    volatile LAS unsigned* misc = (volatile LAS unsigned*)(c.lds + LDS_MISC);
    if (c.tid < 64) misc[c.tid] = 0u;
    __syncthreads();
    unsigned char* ws = (unsigned char*)prm.ws; c.ws = ws;
    XcdBarrier bar = xcd_barrier_post((unsigned*)(ws + WS_CTL) + CW_BAR, misc + 8);
    const int lo = prm.ph_lo, hi = prm.ph_hi;
    int gdim = gridDim.x, bidx = blockIdx.x;
#ifndef ONLY_PH
#define ONLY_PH -1
#endif
#ifndef STAGGER_US
#define STAGGER_US 0
#endif
#ifndef NCV_P2
#define NCV_P2 8
#define CVQ_P2 16
#define NCV_P6 32
#define CVQ_P6 7
#define NCV_P10 16
#define CVQ_P10 26
#define NCV_P11 8
#define CVQ_P11 20
#endif
#ifndef PROBE_BARRIERS
#define PROBE_BARRIERS 0
#endif
#ifndef DUPMASK
#define DUPMASK 0
#endif
#ifndef PHMASK
#define PHMASK 0x1fff
#endif
#define IN(k) (lo <= (k) && (k) < hi && (ONLY_PH < 0 || ((k) % NPH) == ONLY_PH) && ((PHMASK >> ((k) % NPH)) & 1))
#define REFRESH() do { { CParams* kp_ = (CParams*)__builtin_amdgcn_kernarg_segment_ptr(); asm volatile("" : "+s"(kp_)); c.p = kp_; } ws = fresh(c.p->ws); c.ws = ws; int t_ = threadIdx.x; asm volatile("" : "+v"(t_)); c.tid = t_; c.lane = t_ & 63; c.wave = __builtin_amdgcn_readfirstlane(t_ >> 6); gdim = gridDim.x; bidx = blockIdx.x; asm volatile("" : "+s"(gdim), "+s"(bidx)); c.gw = bidx * 8 + c.wave; c.ngw = gdim * 8; c.bid = bidx; c.nblk = gdim; } while (0)
#define SEAM(k) do { if (IN(k) && IN((k) + 1)) xcd_barrier(bar); } while (0)
    for (int L = 0; L < 2; ++L) {
        c.L = L; const int pb = L * NPH;
        if (IN(pb + 0)) { for (int rep_ = 0; rep_ <= ((DUPMASK >> 0) & 1); ++rep_) { if (rep_) xcd_barrier(bar); REFRESH(); phase0(c); __syncthreads(); } } SEAM(pb + 0);
        if (IN(pb + 1)) { for (int rep_ = 0; rep_ <= ((DUPMASK >> 1) & 1); ++rep_) { if (rep_) xcd_barrier(bar); REFRESH(); if (L == 0) phase1(c); } } if (L == 0) SEAM(pb + 1);
        if (IN(pb + 2)) { for (int rep_ = 0; rep_ <= ((DUPMASK >> 2) & 1); ++rep_) { if (rep_) xcd_barrier(bar); REFRESH();
            const int ncv = (L == 0 && gdim == 256) ? NCV_P2 : 0, gG = gdim - ncv;
            if (bidx >= gG) cv_steal(c, CVQ_P2);
            else {
            pg8::Gemm g{(const bf16*)(ws + WS_XN), (const bf16*)(ws + WS_WIN), D / 2}; pg8::StaticOrder S; S.init(NTOK, PWP, gG, bidx);
            pg8::EpiBf16 E{(bf16*)(ws + WS_P), PWP, 1.f / 64.f, rep_};
            pg8::gemm_phase<pg8::EpiBf16, pg8::StaticOrder, false, true>(c.lds, g, S, E, nullptr, c.tid);
            }
        } } SEAM(pb + 2);
        if (IN(pb + 2) && IN(pb + 3)) { REFRESH(); rope_prepass(c); xcd_barrier(bar); }
        if (IN(pb + 3)) { for (int rep_ = 0; rep_ <= ((DUPMASK >> 3) & 1); ++rep_) { if (rep_) xcd_barrier(bar); REFRESH();
            const int gw1 = (c.gw + c.ngw / 2) % c.ngw, gw2 = (c.gw + 3 * (c.ngw / 4)) % c.ngw, gw3 = (c.gw + c.ngw / 4) % c.ngw;
            for (int it = c.gw; it < 4096; it += c.ngw) na_item(c, it);
            for (int it = c.gw; it < 4096; it += c.ngw) swa_item(c, it);
            for (int it = gw1; it < 16 * NCH; it += c.ngw) { const int ck = it % NCH, h = (it / NCH) & 3, dir = (it / (NCH * 4)) & 1, b = it / (NCH * 8);
                if (dir == 0) gla_g1<0>(c, b, h, ck); else gla_g1<1>(c, b, h, ck); }
            if (L == 0) for (int it = gw2; it < 256; it += c.ngw) ctx_attn_item(c, it);
            for (int row = gw3; row < (L == 0 ? NTOK : NLAT); row += 4 * c.ngw) conv_rows4(c, row, c.ngw, L == 0 ? NTOK : NLAT);
        } } SEAM(pb + 3);
        if (PROBE_BARRIERS && IN(pb + 4)) { for (int i_ = 0; i_ < PROBE_BARRIERS; ++i_) xcd_barrier(bar); }
        if (IN(pb + 4)) { for (int rep_ = 0; rep_ <= ((DUPMASK >> 4) & 1); ++rep_) { if (rep_) xcd_barrier(bar); REFRESH(); gla_scan(c); } } SEAM(pb + 4);
        if (IN(pb + 5)) { for (int rep_ = 0; rep_ <= ((DUPMASK >> 5) & 1); ++rep_) { if (rep_) xcd_barrier(bar); REFRESH();
            for (int it = c.gw; it < 8 * NCH; it += c.ngw) { const int ck = it % NCH, h = (it / NCH) & 3, b = it / (NCH * 4);
                if (ck < 8 && L != 0) continue;
                gla_g3(c, b, h, ck); }
        } } SEAM(pb + 5);
        if (IN(pb + 6)) { for (int rep_ = 0; rep_ <= ((DUPMASK >> 6) & 1); ++rep_) { if (rep_) xcd_barrier(bar); REFRESH();
            const int ncv = (L == 0 && gdim == 256) ? NCV_P6 : 0, gG = gdim - ncv;
            if (bidx >= gG) cv_steal(c, CVQ_P6);
            else {
            pg8::Gemm g{(const bf16*)(ws + WS_YMIX), (const bf16*)(ws + WS_WOUT), D / 2};
            pg8::StaticOrder S; S.init(L == 0 ? NTOK : NLAT, D, gG, bidx);
            pg8::EpiBf16 E{(bf16*)(ws + WS_T), D, 1.f / 64.f, rep_};
            pg8::gemm_phase<pg8::EpiBf16, pg8::StaticOrder, false, true>(c.lds, g, S, E, nullptr, c.tid);
            }
        } } SEAM(pb + 6);
        if (IN(pb + 7)) { for (int rep_ = 0; rep_ <= ((DUPMASK >> 7) & 1); ++rep_) { if (rep_) xcd_barrier(bar); REFRESH(); phase7(c); } } SEAM(pb + 7);
        if (IN(pb + 8)) { for (int rep_ = 0; rep_ <= ((DUPMASK >> 8) & 1); ++rep_) { if (rep_) { xcd_barrier(bar); if (blockIdx.x == 0 && c.tid < 64) ((unsigned*)(ws + WS_CTL))[CW_CNT + L * 64 + c.tid] = 0u; xcd_barrier(bar); } REFRESH(); if (L == 0) router_phase<5>(c, 66, 256); else router_phase<4>(c, 64, 256); } } SEAM(pb + 8);
        if (IN(pb + 9)) { for (int rep_ = 0; rep_ <= ((DUPMASK >> 9) & 1); ++rep_) { if (rep_) xcd_barrier(bar); REFRESH(); phase9(c); } } SEAM(pb + 9);
        if (IN(pb + 10)) { for (int rep_ = 0; rep_ <= ((DUPMASK >> 10) & 1); ++rep_) { if (rep_) xcd_barrier(bar); REFRESH();
            const int* ntp = (const int*)(ws + WS_CTL) + CW_NT + L * 64;
            const int ncv = (L == 0 && gdim == 256) ? NCV_P10 : 0, gG = gdim - ncv;
            if (bidx >= gG) cv_steal(c, CVQ_P10);
            else {
            pg8::Gemm g{(const bf16*)(ws + WS_XQ), (const bf16*)(ws + (L == 0 ? WS_WGU : WS_WGU1)), D / 2};
            pg8::GroupOrder S{(const int*)(ws + WS_TILEE), ntp[0], 4, gG, xcd_vid(gG, bidx)};
            pg8::EpiSwiglu8 E{(unsigned char*)(ws + WS_H)};
            pg8::gemm_phase<pg8::EpiSwiglu8, pg8::GroupOrder, true, true>(c.lds, g, S, E, (const int*)(ws + WS_TOKS), c.tid);
            }
        } } SEAM(pb + 10);
        if (IN(pb + 11)) { for (int rep_ = 0; rep_ <= ((DUPMASK >> 11) & 1); ++rep_) { if (rep_) xcd_barrier(bar); REFRESH();
            const int* ntp = (const int*)(ws + WS_CTL) + CW_NT + L * 64;
            const int ncv = (L == 0 && gdim == 256) ? NCV_P11 : 0, gG = gdim - ncv;
            if (bidx >= gG) cv_steal(c, CVQ_P11);
            else {
            pg8::Gemm g{(const bf16*)(ws + WS_H), (const bf16*)(ws + (L == 0 ? WS_WD : WS_WD1)), DEXP / 2};
            pg8::GroupOrder S{(const int*)(ws + WS_TILEE), ntp[0], 8, gG, xcd_vid(gG, bidx)};
            pg8::EpiFp8 E{(unsigned char*)(ws + WS_Y), D, 8.f / 64.f, rep_};
            pg8::gemm_phase<pg8::EpiFp8, pg8::GroupOrder, false, true>(c.lds, g, S, E, nullptr, c.tid);
            }
        } } SEAM(pb + 11);
        if (IN(pb + 12)) { for (int rep_ = 0; rep_ <= ((DUPMASK >> 12) & 1); ++rep_) { if (rep_) xcd_barrier(bar); REFRESH(); phase12(c); } }
    }
#undef IN
#undef SEAM
}

#ifndef MK_ONE_LAUNCH
#define MK_ONE_LAUNCH 1
#endif
extern "C" void kernel_launch(void* const* d_in, const int* in_sizes, int n_in, void* d_out, int out_size, void* d_ws, size_t ws_size, hipStream_t stream) {
    static int grid = 0;
    if (grid == 0) {
        if (n_in != 26 || out_size != NLAT * D || ws_size < WS_END) { fprintf(stderr, "kernel_launch: unexpected shapes (n_in %d out %d ws %zu)\n", n_in, out_size, ws_size); grid = -1; return; }
        int dev = 0, cus = 0;
        if (hipGetDevice(&dev) != hipSuccess || hipDeviceGetAttribute(&cus, hipDeviceAttributeMultiprocessorCount, dev) != hipSuccess) { grid = -1; return; }
        if (hipFuncSetAttribute((const void*)fwd, hipFuncAttributeMaxDynamicSharedMemorySize, LDS_BYTES) != hipSuccess) { fprintf(stderr, "kernel_launch: hipFuncSetAttribute failed\n"); grid = -1; return; }
        int per_cu = 0;
        if (hipOccupancyMaxActiveBlocksPerMultiprocessor(&per_cu, (const void*)fwd, 512, LDS_BYTES) != hipSuccess || per_cu < 1) fprintf(stderr, "kernel_launch: occupancy query reports %d\n", per_cu);
        (void)hipGetLastError();
        grid = cus;
    }
    if (grid < 0) return;
    hipMemsetAsync((char*)d_ws + WS_CTL, 0, CTL_BYTES, stream);
    Params prm{};
    for (int i = 0; i < 26; ++i) prm.in[i] = (const GAS float*)d_in[i];
    prm.out = (GAS float*)d_out; prm.ws = (GAS unsigned char*)d_ws;
#if MK_ONE_LAUNCH
    prm.ph_lo = 0; prm.ph_hi = 2 * NPH;
    hipLaunchKernelGGL(fwd, dim3(grid), dim3(512), LDS_BYTES, stream, prm);
#else
    for (int ph = 0; ph < 2 * NPH; ++ph) { prm.ph_lo = ph; prm.ph_hi = ph + 1; hipLaunchKernelGGL(fwd, dim3(grid), dim3(512), LDS_BYTES, stream, prm); }
#endif
}
```

```cpp
#include <hip/hip_runtime.h>
#include <cstdio>

#define DI __device__ __forceinline__
#define LAS __attribute__((address_space(3)))
#if defined(__HIP_DEVICE_COMPILE__)
#define GAS __attribute__((address_space(1)))
#else
#define GAS
#endif
typedef unsigned short bf16;
typedef short bf16x8 __attribute__((ext_vector_type(8)));
typedef short s16x4 __attribute__((ext_vector_type(4)));
typedef float f32x2 __attribute__((ext_vector_type(2)));
typedef float f32x4 __attribute__((ext_vector_type(4)));
typedef float f32x8 __attribute__((ext_vector_type(8)));
typedef float f32x16 __attribute__((ext_vector_type(16)));
typedef unsigned u32x2 __attribute__((ext_vector_type(2)));
typedef unsigned u32x4 __attribute__((ext_vector_type(4)));
typedef __bf16 hbf16x2 __attribute__((ext_vector_type(2)));

constexpr int D = 2048, SEQ = 8192, CTXL = 256, NB = 2;
constexpr int NLAT = NB * SEQ, NCTX = NB * CTXL, NTOK = NLAT + NCTX;
constexpr int PW = 5408, PWP = 5632;
constexpr int NA_Q = 0, NA_K = 512, NA_V = 1024, SC_U = 1536, SC_B = 2048, SC_C = 2560, GL_Q = 3072, GL_K = 3328, GL_V = 3584, GL_G = 4096, GL_Z = 4608, SW_Q = 4640, SW_K = 5152, SW_V = 5280;
constexpr int NEXP = 64, DEXP = 512, NCH = 264;
constexpr int MAXTILES = 658;
constexpr float LN_EPS = 1e-6f, DN_ALPHA = 1.41421356237f;

constexpr size_t MiB = 1u << 20;
constexpr size_t WS_CTL = 0, CTL_BYTES = MiB;
constexpr size_t WS_MOD = 1 * MiB, WS_ROPE = 1 * MiB + 512 * 1024, WS_STATS = 2 * MiB, WS_ROUTW = 3 * MiB, WS_EIDX = 4 * MiB, WS_RANK = 5 * MiB, WS_WTS = 6 * MiB, WS_POS = 7 * MiB,
                 WS_TOKS = 8 * MiB, WS_TILEE = 9 * MiB, WS_GDEC = 10 * MiB, WS_HCTX = 12 * MiB, WS_WIN = 16 * MiB, WS_WOUT = 38 * MiB, WS_WGU = 46 * MiB, WS_WD = 306 * MiB,
                 WS_X1 = 436 * MiB, WS_XN = 568 * MiB, WS_YMIX = 634 * MiB, WS_H = 700 * MiB, WS_UT = WS_H, WS_SIN = WS_H + 66 * MiB, WS_ER = WS_H + 132 * MiB, WS_Y = 865 * MiB, WS_P = WS_Y, WS_XL = WS_Y, WS_XQ = WS_YMIX, WS_XB = WS_X1 + 66 * MiB, WS_T = WS_Y + 192 * MiB,
                 WS_WGU1 = 1523 * MiB, WS_WD1 = 1653 * MiB,
                 WS_END = 1783 * MiB;
constexpr int CW_CNT = 1024, CW_NT = 2048, CW_CV = 3072, CW_BAR = 4096;

DI float bf2f(unsigned v) { return __uint_as_float(v << 16); }
DI unsigned pk2(float a, float b) { hbf16x2 v = __builtin_convertvector((f32x2){a, b}, hbf16x2); return __builtin_bit_cast(unsigned, v); }
DI bf16 f2bf(float a) { return (bf16)(pk2(a, 0.f) & 0xffffu); }
DI float lo16(unsigned u) { return __uint_as_float(u << 16); }
DI float hi16(unsigned u) { return __uint_as_float(u & 0xffff0000u); }
DI bf16x8 pack8(float a0, float a1, float a2, float a3, float a4, float a5, float a6, float a7) {
    u32x4 p; p.x = pk2(a0, a1); p.y = pk2(a2, a3); p.z = pk2(a4, a5); p.w = pk2(a6, a7); return __builtin_bit_cast(bf16x8, p); }
DI void unpack8(bf16x8 v, float (&f)[8]) { u32x4 p = __builtin_bit_cast(u32x4, v); f[0] = lo16(p.x); f[1] = hi16(p.x); f[2] = lo16(p.y); f[3] = hi16(p.y); f[4] = lo16(p.z); f[5] = hi16(p.z); f[6] = lo16(p.w); f[7] = hi16(p.w); }
DI unsigned pk4_fp8(float a, float b, float c, float d) { int p = __builtin_amdgcn_cvt_pk_fp8_f32(a, b, 0, false); p = __builtin_amdgcn_cvt_pk_fp8_f32(c, d, p, true); return (unsigned)p; }
DI int lane_id_fresh() { int l; asm volatile("v_mbcnt_lo_u32_b32 %0, -1, 0\n\tv_mbcnt_hi_u32_b32 %0, -1, %0" : "=v"(l)); return l; }
DI float bperm_f(int srclane, float v) { return __int_as_float(__builtin_amdgcn_ds_bpermute(srclane << 2, __float_as_int(v))); }
DI int bperm_i(int srclane, int v) { return __builtin_amdgcn_ds_bpermute(srclane << 2, v); }
DI float wave_sum(float v) {
    const int l = lane_id_fresh();
#pragma unroll
    for (int o = 1; o < 64; o <<= 1) v += bperm_f(l ^ o, v);
    return v; }
DI int crow(int reg, int h) { return (reg & 3) + 8 * (reg >> 2) + 4 * h; }
#define MFMA32(a, b, c) __builtin_amdgcn_mfma_f32_32x32x16_bf16((a), (b), (c), 0, 0, 0)
#define MFMA16(a, b, c) __builtin_amdgcn_mfma_f32_16x16x32_bf16((a), (b), (c), 0, 0, 0)
DI s16x4 tr_read(LAS unsigned char* p) { return __builtin_amdgcn_ds_read_tr16_b64_v4i16((LAS s16x4*)p); }
DI bf16x8 cat4(s16x4 lo, s16x4 hi) { return __builtin_shufflevector(lo, hi, 0, 1, 2, 3, 4, 5, 6, 7); }
DI f32x16 zero16() { f32x16 z;
#pragma unroll
    for (int i = 0; i < 16; ++i) z[i] = 0.f; return z; }

#ifndef EMU_FP8
#define EMU_FP8 0
#endif
DI float q8(float x) { const int p = __builtin_amdgcn_cvt_pk_fp8_f32(x, x, 0, false); return __builtin_amdgcn_cvt_f32_fp8(p, 0); }
#define XB_TMO      128
#define XB_XCNT(j)  (256  + 64 * (j))
#define XB_XSUB(j)  (1280 + 64 * (j))
#define XB_XGEN(j)  (2304 + 64 * (j))
#define XB_TOP      3328
#define XB_TOPGEN   3392
#define XCD_BAR_WORDS 3456
#define XB_SPIN_CAP (1u << 18)

__device__ __forceinline__ unsigned xb_ld(unsigned* p)              { return __hip_atomic_load(p, __ATOMIC_RELAXED, __HIP_MEMORY_SCOPE_AGENT); }
__device__ __forceinline__ unsigned xb_add(unsigned* p, unsigned v) { return __hip_atomic_fetch_add(p, v, __ATOMIC_RELAXED, __HIP_MEMORY_SCOPE_AGENT); }
__device__ __forceinline__ unsigned xb_xcc_id() { return (unsigned)__builtin_amdgcn_s_getreg((3 << 11) | 20) & 0xFu; }
#define XB_SPIN(cond, bar) do { unsigned _sp = 0; while (cond) { __builtin_amdgcn_s_sleep(1); \
    if ((++_sp & 255u) == 0u) { if (xb_ld(&(bar)[XB_TMO])) break; if (_sp > XB_SPIN_CAP) { atomicAdd(&(bar)[XB_TMO], 1u); break; } } } } while (0)

struct XcdBarrier { unsigned* bar; unsigned x; volatile LAS unsigned* st; unsigned w0; };
__device__ __forceinline__ bool xb_thread0(const XcdBarrier& b) { return b.w0 != 0u && lane_id_fresh() == 0; }

__device__ __forceinline__ XcdBarrier xcd_barrier_post(unsigned* bar, volatile LAS unsigned* st) {
    XcdBarrier b; b.bar = bar; b.x = xb_xcc_id(); b.st = st; b.w0 = (__builtin_amdgcn_readfirstlane(threadIdx.x >> 6) == 0) ? 1u : 0u;
    if (threadIdx.x == 0) (void)xb_add(&bar[XB_XCNT(b.x)], 1u);
    return b;
}
__device__ __forceinline__ void xcd_barrier_complete(unsigned* bar, unsigned x, unsigned& nloc, unsigned& nx) {
    const unsigned G = gridDim.x * gridDim.y * gridDim.z;
    unsigned sum, cnt, mine, sp = 0u;
    for (;;) {
        sum = 0u; cnt = 0u; mine = 0u;
#pragma unroll
        for (unsigned j = 0; j < 16; ++j) { const unsigned c = xb_ld(&bar[XB_XCNT(j)]); sum += c; cnt += (c > 0u) ? 1u : 0u; mine = (j == x) ? c : mine; }
        if (sum == G) break;
        __builtin_amdgcn_s_sleep(1);
        if ((++sp & 255u) == 0u) { if (xb_ld(&bar[XB_TMO])) break; if (sp > XB_SPIN_CAP) { atomicAdd(&bar[XB_TMO], 1u); break; } }
    }
    nloc = mine > 0u ? mine : 1u; nx = cnt > 0u ? cnt : 1u;
}
__device__ __forceinline__ void xcd_barrier(const XcdBarrier& b) {
    asm volatile("s_waitcnt vmcnt(0)" ::: "memory");
    __syncthreads();
    if (xb_thread0(b)) {
        unsigned* bar = b.bar;
        __builtin_amdgcn_s_waitcnt(0);
        unsigned nloc = b.st[0], nx = b.st[1];
        if (nloc == 0u) { xcd_barrier_complete(bar, b.x, nloc, nx); b.st[0] = nloc; b.st[1] = nx; }
        const unsigned old = xb_add(&bar[XB_XSUB(b.x)], 1u);
        const unsigned gen = old / nloc;
        if (old + 1u == (gen + 1u) * nloc) {
            __builtin_amdgcn_fence(__ATOMIC_RELEASE, "agent");
            asm volatile("s_waitcnt vmcnt(0)" ::: "memory");
            const unsigned og = xb_add(&bar[XB_TOP], 1u);
            const unsigned tg = og / nx;
            if (og + 1u == (tg + 1u) * nx) xb_add(&bar[XB_TOPGEN], 1u);
            else XB_SPIN(xb_ld(&bar[XB_TOPGEN]) == tg, bar);
            __builtin_amdgcn_fence(__ATOMIC_ACQUIRE, "agent");
            xb_add(&bar[XB_XGEN(b.x)], 1u);
            asm volatile("s_waitcnt vmcnt(0)" ::: "memory");
        } else {
            XB_SPIN(xb_ld(&bar[XB_XGEN(b.x)]) == gen, bar);
            __builtin_amdgcn_fence(__ATOMIC_ACQUIRE, "agent");
            asm volatile("s_waitcnt vmcnt(0)" ::: "memory");
        }
    }
    __syncthreads();
}

#ifndef PROBE_SKIP_STORES
#define PROBE_SKIP_STORES 0
#endif
namespace pg8 {
constexpr int BM = 256, BK = 64, HALF = 128, HTB = HALF * BK * 2, STAGE_BYTES = 8 * HTB, NXCD = 8, WGM = 8;
__host__ __device__ __forceinline__ int lds_byte(int r, int c) { const int st = (r >> 4) * 2 + (c >> 5), rr = r & 15, cc = c & 31, ob = rr * 64 + cc * 2; return st * 1024 + (ob ^ (((ob >> 9) & 1) << 5)); }
__host__ __device__ __forceinline__ void stage_rc(int b, int& R, int& C) { const int st = b / 1024, sb = b % 1024, swz = sb ^ (((sb >> 9) & 1) << 5); R = (st >> 1) * 16 + swz / 64; C = (st & 1) * 32 + (swz % 64) / 2; }
__host__ __device__ __forceinline__ int perm32(int rho) { const int n = rho >> 4, i = rho & 15; return 8 * (i >> 2) + 4 * n + (i & 3); }

typedef int i32x8 __attribute__((ext_vector_type(8)));
typedef int i32x4 __attribute__((ext_vector_type(4)));
__device__ __forceinline__ i32x8 cat8(bf16x8 a, bf16x8 b) { return __builtin_shufflevector(__builtin_bit_cast(i32x4, a), __builtin_bit_cast(i32x4, b), 0, 1, 2, 3, 4, 5, 6, 7); }
struct Unit { int pm, pn, pc; };
struct Gemm { const bf16* A; const bf16* Bt; int K; };

struct StaticOrder {
    int nM, nN, nwg, G, c;
    __device__ void init(int M, int N, int G_, int c_) { nM = M / BM; nN = N / BM; nwg = nM * nN; G = G_; c = c_; }
    __device__ bool next(int i, Unit& u) const {
        const int L = i * G + c; if (L >= nwg) return false;
        int wgid = L; { const int q = nwg / NXCD, r = nwg % NXCD, xcd = wgid % NXCD, off = wgid / NXCD; wgid = (xcd < r ? xcd * (q + 1) : r * (q + 1) + (xcd - r) * q) + off; }
        const int nig = WGM * nN, gid = wgid / nig, fm = gid * WGM, gsz = (nM - fm) < WGM ? (nM - fm) : WGM;
        u.pm = fm + ((wgid % nig) % gsz); u.pn = (wgid % nig) / gsz; u.pc = u.pn; return true;
    }
    __device__ bool short_deal() const { const int rem = nwg % G; return rem != 0 && c >= rem; }
    static constexpr bool PRELOAD = false;
    __device__ void preload(int) const {}
    __device__ int row_tile(int i) const { Unit u; return next(i, u) ? u.pm : -1; }
};
struct GroupOrder {
    const int* tile_e; int nU, nN, G, c; LAS int* te;
    static constexpr bool PRELOAD = true;
    __device__ void preload(int tid) const { if (tid < 24) { const int L = tid * G + c; te[tid] = L < nU ? tile_e[L / nN] : 0; } }
    __device__ bool next(int i, Unit& u) const {
        const int L = i * G + c; if (L >= nU) return false;
        const int tile = L / nN, j = L % nN;
        u.pm = tile; u.pc = j; u.pn = __builtin_amdgcn_readfirstlane(te[i]) * nN + j; return true;
    }
    __device__ bool short_deal() const { const int rem = nU % G; return rem != 0 && c >= rem; }
    __device__ int row_tile(int i) const { const int L = i * G + c; return L < nU ? L / nN : -1; }
};

struct EpiBf16 {
    static constexpr bool P64 = true; static constexpr int NS = 16;
    bf16* O; int ldc; float scale; int skip;
    __device__ __forceinline__ void operator()(const f32x4 (&acc)[2][2][4][2], const Unit& u, int wr, int wc, int fr, int fq) const {
        if (PROBE_SKIP_STORES && skip) return;
        const int row0 = u.pm * BM + wr * 64 + fr, col0 = u.pc * BM + wc * 64 + 16 * fq;
#pragma unroll
        for (int ai = 0; ai < 2; ++ai)
#pragma unroll
            for (int m = 0; m < 4; ++m) { bf16* rowp = O + (size_t)(row0 + ai * HALF + m * 16) * ldc + col0;
#pragma unroll
                for (int bj = 0; bj < 2; ++bj) { const f32x4 v0 = acc[ai][bj][m][0] * scale, v1 = acc[ai][bj][m][1] * scale;
                    u32x4 w; w.x = pk2(v0[0], v0[1]); w.y = pk2(v0[2], v0[3]); w.z = pk2(v1[0], v1[1]); w.w = pk2(v1[2], v1[3]);
                    *(u32x4*)(rowp + 8 * bj) = w; } }
    }
};
struct EpiFp8 {
    static constexpr bool P64 = true; static constexpr int NS = 8;
    unsigned char* O; int ldc; float scale; int skip;
    __device__ __forceinline__ void operator()(const f32x4 (&acc)[2][2][4][2], const Unit& u, int wr, int wc, int fr, int fq) const {
        if (PROBE_SKIP_STORES && skip) return;
        const int row0 = u.pm * BM + wr * 64 + fr, col0 = u.pc * BM + wc * 64 + 16 * fq;
#pragma unroll
        for (int ai = 0; ai < 2; ++ai)
#pragma unroll
            for (int m = 0; m < 4; ++m) { unsigned char* rowp = O + (size_t)(row0 + ai * HALF + m * 16) * ldc + col0;
                u32x4 w;
#pragma unroll
                for (int bj = 0; bj < 2; ++bj) { const f32x4 v0 = acc[ai][bj][m][0] * scale, v1 = acc[ai][bj][m][1] * scale;
                    w[2 * bj] = pk4_fp8(v0[0], v0[1], v0[2], v0[3]); w[2 * bj + 1] = pk4_fp8(v1[0], v1[1], v1[2], v1[3]); }
                *(u32x4*)rowp = w; }
    }
};
struct EpiSwiglu8 {
    static constexpr bool P64 = false; static constexpr int NS = 8;
    unsigned char* O;
    __device__ __forceinline__ void operator()(const f32x4 (&acc)[2][2][4][2], const Unit& u, int wr, int wc, int fr, int fq) const {
        const int row0 = u.pm * BM + wr * 64 + fr, col0 = u.pc * HALF + wc * 32 + 8 * fq;
#pragma unroll
        for (int ai = 0; ai < 2; ++ai)
#pragma unroll
            for (int m = 0; m < 4; ++m) { unsigned char* rowp = O + (size_t)(row0 + ai * HALF + m * 16) * DEXP + col0;
                float h[8];
#pragma unroll
                for (int n = 0; n < 2; ++n)
#pragma unroll
                    for (int j = 0; j < 4; ++j) { const float g = acc[ai][0][m][n][j], up = acc[ai][1][m][n][j];
                        h[n * 4 + j] = (g * up) * __builtin_amdgcn_rcpf(__builtin_fmaf(__builtin_amdgcn_exp2f(g * (-1.4426950408889634f / 64.f)), 4096.f, 4096.f)); }
                u32x2 w; int p0 = __builtin_amdgcn_cvt_pk_fp8_f32(h[0], h[1], 0, false); p0 = __builtin_amdgcn_cvt_pk_fp8_f32(h[2], h[3], p0, true);
                int p1 = __builtin_amdgcn_cvt_pk_fp8_f32(h[4], h[5], 0, false); p1 = __builtin_amdgcn_cvt_pk_fp8_f32(h[6], h[7], p1, true);
                w.x = (unsigned)p0; w.y = (unsigned)p1;
                *(u32x2*)rowp = w; }
    }
};

template <class Epi, class Sched, bool GATHER, bool FP8 = false>
__device__ __forceinline__ void gemm_phase(LAS unsigned char* lds, const Gemm g, const Sched& S, const Epi& E, const int* toks, int tid_in) {
    int tid_ = tid_in; asm volatile("" : "+v"(tid_));
    const int tid = tid_, wid = __builtin_amdgcn_readfirstlane(tid >> 6), lane = tid & 63, wr = wid >> 2, wc = wid & 3, fr = lane & 15, fq = lane >> 4;
    int K_ = g.K; asm volatile("" : "+s"(K_));
    const int K = K_, nt = K / BK;
    unsigned voffA[2], voffB[2];
#pragma unroll
    for (int i = 0; i < 2; ++i) { int R, C; stage_rc(tid * 16 + i * 8192, R, C);
        const int rho_ = R & 31, Rb = Epi::P64 ? 64 * (R >> 5) + 16 * ((rho_ & 15) >> 2) + 4 * (rho_ >> 4) + (rho_ & 3) : (R & ~31) + perm32(rho_);
        voffA[i] = (unsigned)(R * K + C) * 2u; voffB[i] = (unsigned)(Rb * K + C) * 2u; }
    const size_t kstep = (size_t)(BK * 2);
    const size_t hstep = (size_t)HALF * K * 2;
    const size_t tstep = 2 * hstep;
    const size_t bstep = Epi::P64 ? (size_t)16 * K : hstep;
    const unsigned ldsw = (unsigned)wid * 1024u;
    const int aoff = lds_byte(wr * 64 + fr, fq * 8), boff = lds_byte(wc * 32 + fr, fq * 8);
#define PG8_SA(b, h) (((b) * 2 + (h)) * HTB)
#define PG8_SB(b, h) ((4 + (b) * 2 + (h)) * HTB)
#define PG8_STAGE(bufoff, gbase, voff) do { _Pragma("unroll") for (int _i = 0; _i < 2; ++_i) \
        __builtin_amdgcn_global_load_lds((const unsigned*)((const char*)(gbase) + (voff)[_i]), (LAS unsigned*)(lds + (bufoff) + ldsw + _i * 8192), 16, 0, 0); } while (0)
#define PG8_STAGEA(bufoff, kb, vo, ub, h) do { _Pragma("unroll") for (int _i = 0; _i < 2; ++_i) \
        __builtin_amdgcn_global_load_lds((const unsigned*)(GATHER ? (const char*)g.A + (kb) + (vo)[h][_i] : (ub) + (kb) + (h) * hstep + voffA[_i]), (LAS unsigned*)(lds + (bufoff) + ldsw + _i * 8192), 16, 0, 0); } while (0)
#define PG8_LDA(dst, b, h) do { _Pragma("unroll") for (int m = 0; m < 4; ++m) _Pragma("unroll") for (int k = 0; k < 2; ++k) dst[m][k] = *(const LAS bf16x8*)(lds + PG8_SA(b, h) + aoff + m * 2048 + k * 1024); } while (0)
#define PG8_LDB(dst, b, h) do { _Pragma("unroll") for (int n = 0; n < 2; ++n) _Pragma("unroll") for (int k = 0; k < 2; ++k) dst[n][k] = *(const LAS bf16x8*)(lds + PG8_SB(b, h) + boff + n * 2048 + k * 1024); } while (0)
#define PG8_MMA(ai, bj, At, Bt) do { __builtin_amdgcn_s_setprio(1); _Pragma("unroll") for (int m = 0; m < 4; ++m) _Pragma("unroll") for (int n = 0; n < 2; ++n) { \
        if (FP8) { asm volatile("v_mfma_f32_16x16x128_f8f6f4 %0, %1, %2, %0" : "+v"(acc[ai][bj][m][n]) : "v"(cat8(Bt[n][0], Bt[n][1])), "v"(cat8(At[m][0], At[m][1]))); }   \
        else { _Pragma("unroll") for (int k = 0; k < 2; ++k) acc[ai][bj][m][n] = __builtin_amdgcn_mfma_f32_16x16x32_bf16(Bt[n][k], At[m][k], acc[ai][bj][m][n], 0, 0, 0); } } \
        __builtin_amdgcn_s_setprio(0); } while (0)
#define PG8_WAIT_V(n) asm volatile("s_waitcnt vmcnt(" #n ")" ::: "memory")
#define PG8_WAIT_L(n) asm volatile("s_waitcnt lgkmcnt(" #n ")" ::: "memory")
#define PG8_BAR __builtin_amdgcn_s_barrier()
#define PG8_SCHED __builtin_amdgcn_sched_barrier(0)
    LAS int* ids = (LAS int*)(lds + STAGE_BYTES);
#define PG8_VOA(dst, uidx, un) do { if (GATHER) { _Pragma("unroll") for (int _h = 0; _h < 2; ++_h) _Pragma("unroll") for (int _i = 0; _i < 2; ++_i) { int _t = tid; asm volatile("" : "+v"(_t)); int _R, _C; stage_rc(_t * 16 + _i * 8192, _R, _C); \
        const int _row = ids[(uidx) * BM + _h * HALF + _R]; dst[_h][_i] = (unsigned)(_row * K + _C) * 2u; } } } while (0)
    if (Sched::PRELOAD) { S.preload(tid); __syncthreads(); }
    if (GATHER) {
        const int hi = tid >> 8, r = tid & 255;
        for (int i0 = 0; i0 < 24; i0 += 12) {
            int v[6];
#pragma unroll
            for (int k = 0; k < 6; ++k) { const int pm = S.row_tile(i0 + 2 * k + hi); v[k] = pm >= 0 ? toks[pm * BM + r] : 0; }
#pragma unroll
            for (int k = 0; k < 6; ++k) ids[(i0 + 2 * k + hi) * BM + r] = v[k];
            if (S.row_tile(i0 + 12) < 0) break;
        }
        __syncthreads();
    }
    Unit cur, nxt; int ui = 0;
    if (!S.next(0, cur)) return;
    f32x4 acc[2][2][4][2];
#pragma unroll
    for (int a = 0; a < 2; ++a)
#pragma unroll
        for (int b = 0; b < 2; ++b)
#pragma unroll
            for (int m = 0; m < 4; ++m)
#pragma unroll
                for (int n = 0; n < 2; ++n) acc[a][b][m][n] = (f32x4){0.f, 0.f, 0.f, 0.f};
    bf16x8 At[4][2], B0[2][2], B1[2][2];
    unsigned voA[2][2] = {{0u, 0u}, {0u, 0u}}, voN[2][2] = {{0u, 0u}, {0u, 0u}};
    PG8_VOA(voA, 0, cur);
    const char* cA = (const char*)g.A + (size_t)cur.pm * tstep;
    const char* cB = (const char*)g.Bt + (size_t)cur.pn * tstep;
    PG8_STAGE(PG8_SB(0, 0), cB, voffB); PG8_STAGEA(PG8_SA(0, 0), 0, voA, cA, 0); PG8_STAGE(PG8_SB(0, 1), cB + bstep, voffB); PG8_STAGEA(PG8_SA(0, 1), 0, voA, cA, 1);
    if (wr == 1) PG8_BAR;
    PG8_WAIT_V(4); PG8_BAR;
    PG8_STAGE(PG8_SB(1, 0), cB + kstep, voffB); PG8_STAGEA(PG8_SA(1, 0), kstep, voA, cA, 0); PG8_STAGE(PG8_SB(1, 1), cB + bstep + kstep, voffB);
    PG8_WAIT_V(6); PG8_BAR;
    for (;;) {
        const bool has_next = S.next(ui + 1, nxt);
        if (has_next) { PG8_VOA(voN, ui + 1, nxt); }
        else if (GATHER) {
#pragma unroll
            for (int _h = 0; _h < 2; ++_h)
#pragma unroll
                for (int _i = 0; _i < 2; ++_i) voN[_h][_i] = voA[_h][_i]; }
        const char* nA = has_next ? (const char*)g.A + (size_t)nxt.pm * tstep : cA;
        const char* nB = has_next ? (const char*)g.Bt + (size_t)nxt.pn * tstep : cB;
        for (int t = 0; t < nt; t += 2) {
            const bool last = (t == nt - 2);
            const size_t k1 = (size_t)(t + 1) * kstep;
            const size_t k2 = last ? 0 : (size_t)(t + 2) * kstep, k3 = k2 + kstep;
            const char* b2 = last ? nB : cB + (size_t)(t + 2) * kstep; const char* b3 = b2 + kstep;
            unsigned vo2[2][2] = {{0u, 0u}, {0u, 0u}};
            if (GATHER) {
#pragma unroll
                for (int _h = 0; _h < 2; ++_h)
#pragma unroll
                    for (int _i = 0; _i < 2; ++_i) vo2[_h][_i] = last ? voN[_h][_i] : voA[_h][_i]; }
            const char* a2 = last ? nA : cA;
            const bool pre = (ui > 0) && (t == 0);
            PG8_LDB(B0, 0, 0); PG8_SCHED; PG8_LDA(At, 0, 0); if (!pre) PG8_STAGEA(PG8_SA(1, 1), k1, voA, cA, 1);
            PG8_WAIT_L(8); PG8_BAR; PG8_WAIT_L(0); PG8_MMA(0, 0, At, B0); PG8_BAR; PG8_SCHED;
            PG8_LDB(B1, 0, 1); PG8_STAGE(PG8_SB(0, 0), b2, voffB);
            PG8_BAR; PG8_WAIT_L(0); PG8_MMA(0, 1, At, B1); PG8_BAR;
            PG8_LDA(At, 0, 1); PG8_STAGEA(PG8_SA(0, 0), k2, vo2, a2, 0);
            PG8_BAR; PG8_WAIT_L(0); PG8_MMA(1, 0, At, B0); PG8_BAR; PG8_SCHED;
            PG8_STAGE(PG8_SB(0, 1), b2 + bstep, voffB);
            if (pre) asm volatile("s_waitcnt vmcnt(%0)" :: "n"(6 + Epi::NS) : "memory");
            else PG8_WAIT_V(6);
            PG8_BAR; PG8_MMA(1, 1, At, B1); PG8_BAR;
            PG8_LDB(B0, 1, 0); PG8_SCHED; PG8_LDA(At, 1, 0); PG8_STAGEA(PG8_SA(0, 1), k2, vo2, a2, 1);
            PG8_WAIT_L(8); PG8_BAR; PG8_WAIT_L(0); PG8_MMA(0, 0, At, B0); PG8_BAR; PG8_SCHED;
            PG8_LDB(B1, 1, 1); PG8_STAGE(PG8_SB(1, 0), b3, voffB);
            PG8_BAR; PG8_WAIT_L(0); PG8_MMA(0, 1, At, B1); PG8_BAR;
            PG8_LDA(At, 1, 1); PG8_STAGEA(PG8_SA(1, 0), k3, vo2, a2, 0);
            PG8_BAR; PG8_WAIT_L(0); PG8_MMA(1, 0, At, B0); PG8_BAR; PG8_SCHED;
            PG8_STAGE(PG8_SB(1, 1), b3 + bstep, voffB);
            PG8_WAIT_V(6); PG8_BAR; PG8_MMA(1, 1, At, B1); PG8_BAR;
        }
        if (has_next) PG8_STAGEA(PG8_SA(1, 1), kstep, voN, nA, 1);
        if (FP8) asm volatile("s_nop 15\n\ts_nop 15" ::: "memory");
        E(acc, cur, wr, wc, fr, fq);
        if (!has_next) break;
#pragma unroll
        for (int a = 0; a < 2; ++a)
#pragma unroll
            for (int b = 0; b < 2; ++b)
#pragma unroll
                for (int m = 0; m < 4; ++m)
#pragma unroll
                    for (int n = 0; n < 2; ++n) acc[a][b][m][n] = (f32x4){0.f, 0.f, 0.f, 0.f};
        cur = nxt; cA = nA; cB = nB; ++ui;
        if (GATHER) {
#pragma unroll
            for (int _h = 0; _h < 2; ++_h)
#pragma unroll
                for (int _i = 0; _i < 2; ++_i) voA[_h][_i] = voN[_h][_i]; }
    }
    PG8_WAIT_V(0);
    if (wr == 0) PG8_BAR;
    PG8_BAR;
#undef PG8_SA
#undef PG8_SB
#undef PG8_STAGE
#undef PG8_STAGEA
#undef PG8_LDA
#undef PG8_LDB
#undef PG8_MMA
#undef PG8_WAIT_V
#undef PG8_WAIT_L
#undef PG8_BAR
#undef PG8_SCHED
#undef PG8_VOA
}
}
struct Params {
    const GAS float* in[26];
    GAS float* out;
    GAS unsigned char* ws;
    int ph_lo, ph_hi;
};
typedef const Params __attribute__((address_space(4))) CParams;
constexpr int NPH = 13;
constexpr int WAVE_LDS = 19968;
constexpr int LDS_MISC = 8 * WAVE_LDS;
constexpr int LDS_BYTES = LDS_MISC + 1024;

struct Ctx {
    LAS unsigned char* lds; int tid, lane, wave, gw, ngw, L, bid, nblk;
    CParams* p;
    unsigned char* ws;
};
DI unsigned char* fresh(GAS unsigned char* q) { asm volatile("" : "+s"(q)); return (unsigned char*)q; }
#define inp(c, k) ((const float*)(c).p->in[k])
#define outp(c) ((float*)(c).p->out)

DI void transpose_item(const float* W, int K, int N, bf16* WT, int drow0, LAS float* scr, int kb, int nb, int lane, bool lo_part, float qs = 0.f) {
    const int k0 = 64 * kb, n0 = 32 * nb;
#pragma unroll 8
    for (int i = 0; i < 32; ++i) { const int kk = 2 * i + (lane >> 5); scr[kk * 33 + (lane & 31)] = W[(size_t)(k0 + kk) * N + n0 + (lane & 31)]; }
    asm volatile("s_waitcnt lgkmcnt(0)" ::: "memory");
    const int c = lane & 7;
#pragma unroll
    for (int j = 0; j < 4; ++j) { const int n = (lane >> 3) + 8 * j; const LAS float* s = scr + (8 * c) * 33 + n;
        float v[8];
#pragma unroll
        for (int q = 0; q < 8; ++q) { v[q] = s[q * 33]; if (lo_part) v[q] = v[q] - bf2f(f2bf(v[q])); if (EMU_FP8 && qs != 0.f) v[q] = q8(v[q] * qs) / qs; }
        u32x4 o; o.x = pk2(v[0], v[1]); o.y = pk2(v[2], v[3]); o.z = pk2(v[4], v[5]); o.w = pk2(v[6], v[7]);
        *(u32x4*)(WT + (size_t)(drow0 + n) * K + k0 + 8 * c) = o; }
    asm volatile("s_waitcnt lgkmcnt(0)" ::: "memory");
}

DI void transpose_item8(const float* W, int K, int N, unsigned char* WT, int drow0, LAS float* scr, int kb, int nb, int lane) {
    const int k0 = 64 * kb, n0 = 64 * nb;
    f32x4 v[16];
    const int ncol = min(n0 + 4 * (lane & 15), N - 4);
#pragma unroll
    for (int i = 0; i < 16; ++i) v[i] = *(const f32x4*)(W + (size_t)(k0 + 4 * i + (lane >> 4)) * N + ncol);
#pragma unroll
    for (int i = 0; i < 16; ++i) { LAS float* d = scr + (4 * i + (lane >> 4)) * 65 + 4 * (lane & 15); d[0] = v[i].x; d[1] = v[i].y; d[2] = v[i].z; d[3] = v[i].w; }
    asm volatile("s_waitcnt lgkmcnt(0)" ::: "memory");
    const int c = lane & 7;
#pragma unroll
    for (int j = 0; j < 8; ++j) { const int n = (lane >> 3) + 8 * j; const LAS float* s = scr + (8 * c) * 65 + n;
        float q[8];
#pragma unroll
        for (int e = 0; e < 8; ++e) q[e] = s[e * 65] * 64.f;
        int p0 = __builtin_amdgcn_cvt_pk_fp8_f32(q[0], q[1], 0, false); p0 = __builtin_amdgcn_cvt_pk_fp8_f32(q[2], q[3], p0, true);
        int p1 = __builtin_amdgcn_cvt_pk_fp8_f32(q[4], q[5], 0, false); p1 = __builtin_amdgcn_cvt_pk_fp8_f32(q[6], q[7], p1, true);
        u32x2 o; o.x = (unsigned)p0; o.y = (unsigned)p1;
        *(u32x2*)(WT + (size_t)(drow0 + n) * K + k0 + 8 * c) = o; }
    asm volatile("s_waitcnt lgkmcnt(0)" ::: "memory");
}

struct CvItem { const float* src; unsigned char* dst; int K, N; };
DI bool cv_decode(const Ctx& c, int L, int r, CvItem& it) {
    constexpr int I_E = 768;
    if (r >= 65 * I_E) return false;
    unsigned char* ws = c.ws; const size_t wgu_off = L == 0 ? WS_WGU : WS_WGU1, wd_off = L == 0 ? WS_WD : WS_WD1;
    const int e = r / I_E, q = r % I_E, which = q / 256, idx = q % 256;
    if (which < 2) {
        const float* W = e < 64 ? inp(c, which == 0 ? 18 : 19) + ((size_t)(L * 64 + e)) * D * DEXP : inp(c, which == 0 ? 21 : 22) + (size_t)L * D * DEXP;
        const int kb = idx / 8, nb = idx % 8, n0 = 64 * nb, k0 = 64 * kb;
        it.K = D; it.N = DEXP; it.src = W + (size_t)k0 * DEXP + n0;
        it.dst = (unsigned char*)(ws + wgu_off) + (size_t)(e * 1024 + (n0 / 128) * 256 + which * 128 + (n0 % 128)) * D + k0;
    } else {
        const float* W = e < 64 ? inp(c, 20) + ((size_t)(L * 64 + e)) * DEXP * D : inp(c, 23) + (size_t)L * DEXP * D;
        const int kb = idx / 32, nb = idx % 32, n0 = 64 * nb, k0 = 64 * kb;
        it.K = DEXP; it.N = D; it.src = W + (size_t)k0 * D + n0;
        it.dst = (unsigned char*)(ws + wd_off) + (size_t)(e * 2048 + n0) * DEXP + k0;
    }
    return true;
}
DI void cv_load(const CvItem& it, f32x4 (&v)[16], int lane) {
#pragma unroll
    for (int i = 0; i < 16; ++i) v[i] = __builtin_nontemporal_load((const f32x4*)(it.src + (size_t)(4 * i + (lane >> 4)) * it.N + 4 * (lane & 15)));
}
DI void cv_store(const CvItem& it, const f32x4 (&v)[16], LAS float* scr, int lane) {
#pragma unroll
    for (int i = 0; i < 16; ++i) { LAS float* d = scr + (4 * i + (lane >> 4)) * 65 + 4 * (lane & 15); d[0] = v[i].x; d[1] = v[i].y; d[2] = v[i].z; d[3] = v[i].w; }
    asm volatile("s_waitcnt lgkmcnt(0)" ::: "memory");
    const int c8 = lane & 7;
#pragma unroll
    for (int j = 0; j < 8; ++j) { const int n = (lane >> 3) + 8 * j; const LAS float* s = scr + (8 * c8) * 65 + n;
        float q[8];
#pragma unroll
        for (int e = 0; e < 8; ++e) q[e] = s[e * 65] * 64.f;
        u32x2 o; o.x = pk4_fp8(q[0], q[1], q[2], q[3]); o.y = pk4_fp8(q[4], q[5], q[6], q[7]);
        *(u32x2*)(it.dst + (size_t)n * it.K + 8 * c8) = o; }
    asm volatile("s_waitcnt lgkmcnt(0)" ::: "memory");
}
DI void convert_experts(const Ctx& c, int L, int it0, int step) {
    LAS float* scr = (LAS float*)(c.lds + c.wave * WAVE_LDS);
    CvItem ia, ib; f32x4 va[16], vb[16];
    int r = it0;
    bool ha = cv_decode(c, L, r, ia); if (ha) cv_load(ia, va, c.lane);
    while (ha) {
        const bool hb = cv_decode(c, L, r + step, ib); if (hb) cv_load(ib, vb, c.lane);
        cv_store(ia, va, scr, c.lane);
        if (!hb) break;
        ha = cv_decode(c, L, r + 2 * step, ia); if (ha) cv_load(ia, va, c.lane);
        cv_store(ib, vb, scr, c.lane);
        r += 2 * step;
    }
}
DI void cv_steal(const Ctx& c, int npairs) {
    LAS float* scr = (LAS float*)(c.lds + c.wave * WAVE_LDS);
    unsigned* ctr = (unsigned*)(c.ws + WS_CTL) + CW_CV;
    for (int i = 0; i < npairs; ++i) {
        unsigned idx = 0u;
        if (c.lane == 0) idx = __hip_atomic_fetch_add(ctr, 2u, __ATOMIC_RELAXED, __HIP_MEMORY_SCOPE_AGENT);
        const int r = __builtin_amdgcn_readfirstlane((int)idx);
        CvItem ia, ib; f32x4 va[16], vb[16];
        const bool ha = cv_decode(c, 1, r, ia); if (!ha) break;
        cv_load(ia, va, c.lane);
        const bool hb = cv_decode(c, 1, r + 1, ib); if (hb) cv_load(ib, vb, c.lane);
        cv_store(ia, va, scr, c.lane);
        if (hb) cv_store(ib, vb, scr, c.lane);
    }
}

DI void phase0(const Ctx& c) {
    const int L = c.L;
    unsigned char* ws = c.ws;
    if (L == 0) {
        LAS float* sc = (LAS float*)c.lds;
        LAS float* part = (LAS float*)(c.lds + 32768);
        for (int i = c.tid; i < 3 * D; i += 512) { const int r = i / D, k = i % D; const float v = r < 2 ? inp(c, 1)[r * D + k] : inp(c, 3)[k]; sc[i] = v / (1.f + __expf(-v)); }
        __syncthreads();
        for (int cb = c.bid; cb < 512; cb += c.nblk) {
            const int Lm = cb >> 8, n0 = (cb & 255) * 48;
            const float* wa = inp(c, 4) + (size_t)Lm * D * 6 * D; const float* ba = inp(c, 5) + (size_t)Lm * 6 * D;
            float* mod = (float*)(ws + WS_MOD) + (size_t)Lm * 3 * 6 * D;
            float a0 = 0.f, a1 = 0.f, a2 = 0.f;
            if (c.lane < 48) {
                const float* wp = wa + (size_t)(c.wave * 256) * (6 * D) + n0 + c.lane;
                for (int k0 = 0; k0 < 256; k0 += 32) {
                    float wv[32];
#pragma unroll
                    for (int k = 0; k < 32; ++k) wv[k] = wp[(size_t)(k0 + k) * (6 * D)];
#pragma unroll
                    for (int k = 0; k < 32; ++k) { const int kk = c.wave * 256 + k0 + k; a0 += sc[kk] * wv[k]; a1 += sc[D + kk] * wv[k]; a2 += sc[2 * D + kk] * wv[k]; }
                }
                part[(c.wave * 3 + 0) * 48 + c.lane] = a0; part[(c.wave * 3 + 1) * 48 + c.lane] = a1; part[(c.wave * 3 + 2) * 48 + c.lane] = a2;
            }
            __syncthreads();
            if (c.tid < 144) { const int r = c.tid / 48, j = c.tid % 48; float s = 0.f;
#pragma unroll
                for (int w = 0; w < 8; ++w) s += part[(w * 3 + r) * 48 + j];
                mod[r * 6 * D + n0 + j] = s + ba[n0 + j]; }
            __syncthreads();
        }
    }
    __syncthreads();
    {
        LAS float* scr = (LAS float*)(c.lds + c.wave * WAVE_LDS);
        constexpr int I_IN = 32 * ((PW + 63) / 64), I_OUT = 32 * 32, I_R = 64;
        constexpr int NIT = I_IN + I_OUT + 2 * I_R;
        bf16* win = (bf16*)(ws + WS_WIN); bf16* wout = (bf16*)(ws + WS_WOUT); bf16* rw = (bf16*)(ws + WS_ROUTW);
        for (int it = c.gw; it < NIT; it += c.ngw) {
            int r = it;
            if (r < I_IN) { const int nblk = (PW + 63) / 64; transpose_item8(inp(c, 6) + (size_t)L * D * PW, D, PW, (unsigned char*)win, 64 * (r % nblk), scr, r / nblk, r % nblk, c.lane); continue; } r -= I_IN;
            if (r < I_OUT) { transpose_item8(inp(c, 13) + (size_t)L * D * D, D, D, (unsigned char*)wout, 64 * (r % 32), scr, r / 32, r % 32, c.lane); continue; } r -= I_OUT;
            { const int lo = r / I_R, idx = r % I_R, kb = idx / 2, nb = idx % 2;
              transpose_item(inp(c, 16) + (size_t)L * D * NEXP, D, NEXP, rw, lo * 64 + 32 * nb, scr, kb, nb, c.lane, lo != 0); }
        }
    }
    if (L == 0) convert_experts(c, 0, c.gw, c.ngw);
    else { const int r0 = (int)__hip_atomic_load((unsigned*)(c.ws + WS_CTL) + CW_CV, __ATOMIC_RELAXED, __HIP_MEMORY_SCOPE_AGENT);
           convert_experts(c, 1, r0 + c.gw, c.ngw); }
    if (L == 0) {
        float* rope = (float*)(ws + WS_ROPE);
        for (int i = c.bid * 512 + c.tid; i < 128 * 16; i += c.nblk * 512) {
            const int pos = i / 16, f = i % 16;
            const float inv = exp2f(-(float)f * (13.287712379549449f / 16.f));
            const float ang = (float)pos * inv;
            const float n = rintf(ang * 0.15915494309189535f);
            float rr = fmaf(-n, 6.28125f, ang); rr = fmaf(-n, 1.9353071795864769e-3f, rr);
            rope[2 * i] = __cosf(rr); rope[2 * i + 1] = __sinf(rr);
        }
    }
}

DI void row_stats(const f32x4 (&v)[8], float& mean, float& rstd) {
    float s = 0.f;
#pragma unroll
    for (int j = 0; j < 8; ++j) s += (v[j].x + v[j].y) + (v[j].z + v[j].w);
    mean = wave_sum(s) * (1.f / D);
    float q = 0.f;
#pragma unroll
    for (int j = 0; j < 8; ++j) { const f32x4 d = v[j] - mean; q += (d.x * d.x + d.y * d.y) + (d.z * d.z + d.w * d.w); }
    rstd = 1.f / sqrtf(wave_sum(q) * (1.f / D) + LN_EPS);
}
DI const float* mod_row_l(const Ctx& c, int row, int l) { return (const float*)(c.ws + WS_MOD) + (size_t)(l * 3 + (row < NLAT ? row / SEQ : 2)) * 6 * D; }
DI const float* mod_row(const Ctx& c, int row) { return mod_row_l(c, row, c.L); }
DI const float* x_in_row(const Ctx& c, int row) {

    if (row < NLAT) return inp(c, 0) + (size_t)row * D;
    return inp(c, 2) + (size_t)(row - NLAT) * D;
}

DI void phase1(const Ctx& c) {
    unsigned char* xn = (unsigned char*)(c.ws + WS_XN);
    for (int r2 = c.gw; r2 < NTOK / 2; r2 += c.ngw) {
        f32x4 v[2][8]; float mean[2], rstd[2];
#pragma unroll
        for (int u = 0; u < 2; ++u) { const float* xr = x_in_row(c, 2 * r2 + u);
#pragma unroll
            for (int j = 0; j < 8; ++j) v[u][j] = *(const f32x4*)(xr + 4 * c.lane + 256 * j); }
#pragma unroll
        for (int u = 0; u < 2; ++u) row_stats(v[u], mean[u], rstd[u]);
        const float* mod = mod_row(c, 2 * r2);
#pragma unroll
        for (int j = 0; j < 8; ++j) { const int col = 4 * c.lane + 256 * j;
            const f32x4 sh = *(const f32x4*)(mod + col), sc = *(const f32x4*)(mod + D + col);
#pragma unroll
            for (int u = 0; u < 2; ++u) { const f32x4 y = (v[u][j] - mean[u]) * rstd[u] * (sc + 1.f) + sh;
                *(unsigned*)(xn + (size_t)(2 * r2 + u) * D + col) = pk4_fp8(y.x, y.y, y.z, y.w); } }
    }
}

DI void phase7(const Ctx& c) {
    const int L = c.L;
    bf16* xl = (bf16*)(c.ws + WS_XL); const bf16* T = (const bf16*)(c.ws + WS_T); bf16* x1 = (bf16*)(c.ws + WS_X1);
    const bf16* xb = (const bf16*)(c.ws + WS_XB);
    const float* lg = inp(c, 14) + (size_t)L * D; const float* lb = inp(c, 15) + (size_t)L * D;
    const int nrows = L == 0 ? NTOK : NLAT;
    for (int r2 = c.gw; r2 < nrows / 2; r2 += c.ngw) {
        const float* mod = mod_row(c, 2 * r2);
        f32x4 v[2][8]; float mean[2], rstd[2];
#pragma unroll
        for (int u = 0; u < 2; ++u) { const int row = 2 * r2 + u;
            if (L == 0) { const float* xr = x_in_row(c, row);
#pragma unroll
                for (int j = 0; j < 8; ++j) v[u][j] = *(const f32x4*)(xr + 4 * c.lane + 256 * j); }
            else {
#pragma unroll
                for (int j = 0; j < 8; ++j) { const u32x2 t = *(const u32x2*)(xb + (size_t)row * D + 4 * c.lane + 256 * j); v[u][j] = (f32x4){lo16(t.x), hi16(t.x), lo16(t.y), hi16(t.y)}; } }
#pragma unroll
            for (int j = 0; j < 8; ++j) { const int col = 4 * c.lane + 256 * j;
                const f32x4 g = *(const f32x4*)(mod + 2 * D + col);
                const u32x2 t = *(const u32x2*)(T + (size_t)row * D + col);
                v[u][j] = v[u][j] * DN_ALPHA + g * (f32x4){lo16(t.x), hi16(t.x), lo16(t.y), hi16(t.y)}; } }
#pragma unroll
        for (int u = 0; u < 2; ++u) row_stats(v[u], mean[u], rstd[u]);
#pragma unroll
        for (int j = 0; j < 8; ++j) { const int col = 4 * c.lane + 256 * j; const f32x4 gg = *(const f32x4*)(lg + col), bb = *(const f32x4*)(lb + col);
#pragma unroll
            for (int u = 0; u < 2; ++u) { v[u][j] = (v[u][j] - mean[u]) * rstd[u] * gg + bb; u32x2 o; o.x = pk2(v[u][j].x, v[u][j].y); o.y = pk2(v[u][j].z, v[u][j].w); *(u32x2*)(x1 + (size_t)(2 * r2 + u) * D + col) = o; } }
#pragma unroll
        for (int u = 0; u < 2; ++u) row_stats(v[u], mean[u], rstd[u]);
#pragma unroll
        for (int j = 0; j < 8; ++j) { const int col = 4 * c.lane + 256 * j;
            const f32x4 sh = *(const f32x4*)(mod + 3 * D + col), sc = *(const f32x4*)(mod + 4 * D + col);
#pragma unroll
            for (int u = 0; u < 2; ++u) { const f32x4 y = (v[u][j] - mean[u]) * rstd[u] * (sc + 1.f) + sh;
                int pq = __builtin_amdgcn_cvt_pk_fp8_f32(y.x, y.y, 0, false); pq = __builtin_amdgcn_cvt_pk_fp8_f32(y.z, y.w, pq, true);
                const f32x2 qa = __builtin_amdgcn_cvt_pk_f32_fp8(pq, false), qb = __builtin_amdgcn_cvt_pk_f32_fp8(pq, true);
                u32x2 ol; ol.x = pk2(y.x - qa.x, y.y - qa.y); ol.y = pk2(y.z - qb.x, y.w - qb.y);
                *(u32x2*)(xl + (size_t)(2 * r2 + u) * D + col) = ol;
                *(int*)((unsigned char*)(c.ws + WS_XQ) + (size_t)(2 * r2 + u) * D + col) = pq; } }
    }
}
constexpr float QK_SCALE_L2 = 0.125f * 1.4426950408889634f, LOG2E = 1.4426950408889634f;
constexpr int VSTR = 144;
struct AttnAcc { f32x16 o0, o1; float m, l; };
DI void attn_init(AttnAcc& a) { a.o0 = zero16(); a.o1 = zero16(); a.m = -INFINITY; a.l = 0.f; }

constexpr int KLOFF = 12288;
struct KV { u32x4 k[4]; u32x4 v[4]; };
template <class RowF>
DI void attn_load(KV& t, const bf16* P, RowF rowf, int kcol, int vcol, int lane) {
#pragma unroll
    for (int i = 0; i < 4; ++i) { const bf16* rp = P + (size_t)rowf((lane >> 3) + 8 * i) * PWP + (lane & 7) * 8; t.k[i] = *(const u32x4*)(rp + kcol); t.v[i] = *(const u32x4*)(rp + vcol); }
}
template <class ScoreF>
DI void attn_tile(AttnAcc& a, const bf16x8 (&qf)[4], const u32x4 (&kr)[4], const u32x4 (&vr)[4], LAS unsigned char* vl, int lane, ScoreF sf) {
    const int half = lane >> 5;
    bf16x8 kf[4];
    {
        LAS unsigned char* d = vl + (lane >> 3) * VSTR + (lane & 7) * 16;
#pragma unroll
        for (int i = 0; i < 4; ++i) { *(LAS u32x4*)(d + KLOFF + 8 * i * VSTR) = kr[i]; *(LAS u32x4*)(d + 8 * i * VSTR) = vr[i]; }
        const LAS unsigned char* ks = vl + KLOFF + (lane & 31) * VSTR + 16 * half;
#pragma unroll
        for (int s = 0; s < 4; ++s) kf[s] = *(const LAS bf16x8*)(ks + 32 * s);
    }
    f32x16 st = zero16();
#pragma unroll
    for (int s = 0; s < 4; ++s) st = MFMA32(kf[s], qf[s], st);
    float sc[16]; float mx = -INFINITY;
#pragma unroll
    for (int r = 0; r < 16; ++r) { sc[r] = sf(r, crow(r, half), st[r]); mx = fmaxf(mx, sc[r]); }
    mx = fmaxf(mx, bperm_f(lane ^ 32, mx));
    const float mnew = fmaxf(a.m, mx);
    const float muse = (mnew == -INFINITY) ? 0.f : mnew;
    float ps = 0.f;
#pragma unroll
    for (int r = 0; r < 16; ++r) { sc[r] = __builtin_amdgcn_exp2f(sc[r] - muse); ps += sc[r]; }
    ps += bperm_f(lane ^ 32, ps);
    if (__any(mnew != a.m)) {
        const float corr = __builtin_amdgcn_exp2f(a.m - muse);
        a.l *= corr;
#pragma unroll
        for (int r = 0; r < 16; ++r) { a.o0[r] *= corr; a.o1[r] *= corr; }
    }
    a.l += ps; a.m = mnew;
    const bf16x8 pb0 = pack8(sc[0], sc[1], sc[2], sc[3], sc[4], sc[5], sc[6], sc[7]);
    const bf16x8 pb1 = pack8(sc[8], sc[9], sc[10], sc[11], sc[12], sc[13], sc[14], sc[15]);
    const int q = (lane & 15) >> 2, pp = lane & 3, blk = (lane >> 4) & 1;
    LAS unsigned char* vb = vl + (4 * half + q) * VSTR + (16 * blk + 4 * pp) * 2;
    { const bf16x8 A = cat4(tr_read(vb), tr_read(vb + 8 * VSTR)); a.o0 = MFMA32(A, pb0, a.o0); }
    { const bf16x8 A = cat4(tr_read(vb + 64), tr_read(vb + 8 * VSTR + 64)); a.o1 = MFMA32(A, pb0, a.o1); }
    { const bf16x8 A = cat4(tr_read(vb + 16 * VSTR), tr_read(vb + 24 * VSTR)); a.o0 = MFMA32(A, pb1, a.o0); }
    { const bf16x8 A = cat4(tr_read(vb + 16 * VSTR + 64), tr_read(vb + 24 * VSTR + 64)); a.o1 = MFMA32(A, pb1, a.o1); }
}
DI void attn_store(const AttnAcc& a, unsigned char* y0, LAS unsigned char* ol, int lane) {
    const int half = lane >> 5; const float inv = 1.f / a.l;
    LAS unsigned char* d = ol + (lane & 31) * 80 + 4 * half;
#pragma unroll
    for (int g = 0; g < 4; ++g) {
        *(LAS unsigned*)(d + 8 * g) = pk4_fp8(a.o0[4 * g] * inv, a.o0[4 * g + 1] * inv, a.o0[4 * g + 2] * inv, a.o0[4 * g + 3] * inv);
        *(LAS unsigned*)(d + 32 + 8 * g) = pk4_fp8(a.o1[4 * g] * inv, a.o1[4 * g + 1] * inv, a.o1[4 * g + 2] * inv, a.o1[4 * g + 3] * inv); }
#pragma unroll
    for (int i = 0; i < 2; ++i) { const int row = 16 * i + (lane >> 2);
        *(u32x4*)(y0 + (size_t)row * D + (lane & 3) * 16) = *(const LAS u32x4*)(ol + row * 80 + (lane & 3) * 16); }
}
DI void load_frags(bf16x8 (&f)[4], const bf16* row, int half) {
#pragma unroll
    for (int s = 0; s < 4; ++s) f[s] = *(const bf16x8*)(row + 16 * s + 8 * half);
}
DI void rope_frags(bf16x8 (&f)[4], int posr, int posc, int half, const float* rope) {
#pragma unroll
    for (int pr = 0; pr < 2; ++pr) {
        const int pos = pr == 0 ? posr : posc;
        const f32x4* t = (const f32x4*)(rope + (size_t)(pos * 16 + 8 * half) * 2);
        const f32x4 t0 = t[0], t1 = t[1], t2 = t[2], t3 = t[3];
        const float cs[16] = {t0.x, t0.y, t0.z, t0.w, t1.x, t1.y, t1.z, t1.w, t2.x, t2.y, t2.z, t2.w, t3.x, t3.y, t3.z, t3.w};
        float x1[8], x2[8]; unpack8(f[2 * pr], x1); unpack8(f[2 * pr + 1], x2);
        float y1[8], y2[8];
#pragma unroll
        for (int e = 0; e < 8; ++e) { const float co = cs[2 * e], si = cs[2 * e + 1]; y1[e] = x1[e] * co - x2[e] * si; y2[e] = x2[e] * co + x1[e] * si; }
        f[2 * pr] = pack8(y1[0], y1[1], y1[2], y1[3], y1[4], y1[5], y1[6], y1[7]);
        f[2 * pr + 1] = pack8(y2[0], y2[1], y2[2], y2[3], y2[4], y2[5], y2[6], y2[7]);
    }
}

DI void na_item(const Ctx& c, int item) {
    const bf16* P = (const bf16*)(c.ws + WS_P); unsigned char* Y = (unsigned char*)(c.ws + WS_YMIX);
    const int lane = c.lane, half = lane >> 5, j = lane & 31;
    const int cc = item & 1, g_ = item >> 3, h = (g_ >> 3) & 7, r = (((g_ & 7) | (((g_ >> 6) & 3) << 3)) << 2) | ((item >> 1) & 3), b = g_ >> 8;
    const float* rpb = inp(c, 7) + (size_t)(c.L * 8 + h) * 15 * 31;
    LAS unsigned char* vl = c.lds + c.wave * WAVE_LDS; LAS float* tbl = (LAS float*)(vl + 32 * VSTR);
#pragma unroll
    for (int i = 0; i < 8; ++i) { const int e = lane + 64 * i; if (e < 15 * 31) tbl[(e / 31) * 128 + 48 + (e % 31)] = rpb[e] * LOG2E; }
    const int qrow = b * SEQ + r * 64 + 32 * cc + j;
    bf16x8 qf[4]; load_frags(qf, P + (size_t)qrow * PWP + NA_Q + h * 64, half);
    const int qc = 32 * cc + j, cstart = min(max(qc - 8, 0), 48);
    const int rs = min(max(r - 4, 0), 120);
    const int cb8 = cc ? 24 : 32;
    unsigned okf = 0u, okp = 0u;
#pragma unroll
    for (int rr = 0; rr < 16; ++rr) { const int kf = 32 * cc + crow(rr, half), kp = cb8 + (rr & 3) + 4 * half;
        okf |= ((kf >= cstart) && (kf < cstart + 16)) ? (1u << rr) : 0u; okp |= ((kp >= cstart) && (kp < cstart + 16)) ? (1u << rr) : 0u; }
    AttnAcc a; attn_init(a);
    auto key_row = [&](int t, int i) {
        if (t < 8) return b * SEQ + (rs + t) * 64 + 32 * cc + i;
        if (t < 10) return b * SEQ + (rs + 4 * (t - 8) + (i >> 3)) * 64 + cb8 + (i & 7);
        return NLAT + b * CTXL + 32 * (t - 10) + i; };
    auto load = [&](KV& kv, int t) { attn_load(kv, P, [&](int i) { return key_row(t, i); }, NA_K + h * 64, NA_V + h * 64, lane); };
    auto full = [&](KV& kv, int t) {
        const LAS float* bp = tbl + (rs + t - r + 7) * 128 + 32 * cc - qc + 63 + 4 * half;
        attn_tile(a, qf, kv.k, kv.v, vl, lane, [&](int rr, int, float raw) { const float sb = raw * QK_SCALE_L2 + bp[crow(rr, 0)]; return ((okf >> rr) & 1u) ? sb : -INFINITY; }); };
    auto packed = [&](KV& kv, int t) {
        const LAS float* bp = tbl + (rs + 4 * (t - 8) - r + 7) * 128 + cb8 - qc + 63 + 4 * half;
        attn_tile(a, qf, kv.k, kv.v, vl, lane, [&](int rr, int, float raw) { const float sb = raw * QK_SCALE_L2 + bp[(rr >> 2) * 128 + (rr & 3)]; return ((okp >> rr) & 1u) ? sb : -INFINITY; }); };
    auto ctx = [&](KV& kv) { attn_tile(a, qf, kv.k, kv.v, vl, lane, [&](int, int, float raw) { return raw * QK_SCALE_L2; }); };
    KV A, B; load(A, 0);
    for (int t = 0; t < 8; t += 2) { load(B, t + 1); full(A, t); load(A, t + 2); full(B, t + 1); }
    { load(B, 9); packed(A, 8); load(A, 10); packed(B, 9); }
    for (int t = 10; t < 18; t += 2) { load(B, t + 1); ctx(A); if (t + 2 < 18) load(A, t + 2); ctx(B); }
    attn_store(a, Y + (size_t)(qrow - j) * D + h * 64, vl, lane);
}

DI void rope_prepass(const Ctx& c) {
    bf16* P = (bf16*)(c.ws + WS_P); const float* rope = (const float*)(c.ws + WS_ROPE);
    for (int r0 = c.gw * 8; r0 < NLAT; r0 += c.ngw * 8) {
        u32x4 xa[5], xb[5]; f32x4 cs[5][4]; bf16* bp[5];
#pragma unroll
        for (int i = 0; i < 5; ++i) {
            const int q = c.lane + 64 * i, rk = q / 40, u = q - 40 * rk, row = r0 + rk, t = row % SEQ, pr = t >> 6, pc = t & 63;
            const int head = u >> 2, hs = (u >> 1) & 1, g = u & 1;
            bp[i] = P + (size_t)row * PWP + SW_Q + head * 64 + 32 * hs + 8 * g;
            xa[i] = *(const u32x4*)bp[i]; xb[i] = *(const u32x4*)(bp[i] + 16);
            const f32x4* tp = (const f32x4*)(rope + (size_t)((hs ? pc : pr) * 16 + 8 * g) * 2);
            cs[i][0] = tp[0]; cs[i][1] = tp[1]; cs[i][2] = tp[2]; cs[i][3] = tp[3];
        }
#pragma unroll
        for (int i = 0; i < 5; ++i) {
            float x1[8], x2[8], y1[8], y2[8]; unpack8(__builtin_bit_cast(bf16x8, xa[i]), x1); unpack8(__builtin_bit_cast(bf16x8, xb[i]), x2);
#pragma unroll
            for (int e = 0; e < 8; ++e) { const float co = cs[i][e >> 1][2 * (e & 1)], si = cs[i][e >> 1][2 * (e & 1) + 1]; y1[e] = x1[e] * co - x2[e] * si; y2[e] = x2[e] * co + x1[e] * si; }
            *(bf16x8*)bp[i] = pack8(y1[0], y1[1], y1[2], y1[3], y1[4], y1[5], y1[6], y1[7]);
            *(bf16x8*)(bp[i] + 16) = pack8(y2[0], y2[1], y2[2], y2[3], y2[4], y2[5], y2[6], y2[7]);
        }
    }
}

DI void swa_item(const Ctx& c, int item) {
    const bf16* P = (const bf16*)(c.ws + WS_P); unsigned char* Y = (unsigned char*)(c.ws + WS_YMIX);
    const int lane = c.lane, half = lane >> 5, j = lane & 31;
    const int qb = (item >> 2) & 255, b = (item >> 10) & 1, kvh = item >> 11, hq = kvh * 4 + (item & 3);
    LAS unsigned char* vl = c.lds + c.wave * WAVE_LDS;
    const int i0 = 32 * qb, qi = i0 + j, qrow = b * SEQ + qi;
    bf16x8 qf[4]; load_frags(qf, P + (size_t)qrow * PWP + SW_Q + hq * 64, half);
    AttnAcc a; attn_init(a);
    const int m_lo = max(0, 4 - qb), m_hi = min(9, 260 - qb), nw = m_hi - m_lo, nt = nw + 8;
    auto load = [&](KV& kv, int t) {
        const int base = t < nw ? b * SEQ + i0 - 128 + 32 * (m_lo + t) : NLAT + b * CTXL + 32 * (t - nw);
        attn_load(kv, P, [&](int i) { return base + i; }, SW_K + kvh * 64, SW_V + kvh * 64, lane); };
    auto compute = [&](KV& kv, int t) {
        const int m = m_lo + t; const bool edge = t < nw && (m == 0 || m == 8);
        if (edge) { const int j0 = i0 - 128 + 32 * m;
            attn_tile(a, qf, kv.k, kv.v, vl, lane, [&](int, int i, float raw) { const int dlt = j0 + i - qi; return ((dlt >= -128) && (dlt <= 128)) ? raw * QK_SCALE_L2 : -INFINITY; }); }
        else attn_tile(a, qf, kv.k, kv.v, vl, lane, [&](int, int, float raw) { return raw * QK_SCALE_L2; }); };
    KV A, B; load(A, 0);
    for (int t = 0; t < nt; t += 2) {
        if (t + 1 < nt) load(B, t + 1);
        compute(A, t);
        if (t + 1 < nt) { if (t + 2 < nt) load(A, t + 2); compute(B, t + 1); }
    }
    const float sink = inp(c, 12)[c.L * 8 + hq];
    a.l += __builtin_amdgcn_exp2f(sink * LOG2E - a.m);
    attn_store(a, Y + (size_t)(qrow - j) * D + 1536 + hq * 64, vl, lane);
}

DI void ctx_attn_item(const Ctx& c, int item) {
    const bf16* P = (const bf16*)(c.ws + WS_P); unsigned char* Y = (unsigned char*)(c.ws + WS_YMIX);
    const int lane = c.lane, half = lane >> 5, j = lane & 31;
    const int h = item & 7, qb = (item >> 3) & 7, b = (item >> 6) & 1, kind = item >> 7;
    LAS unsigned char* vl = c.lds + c.wave * WAVE_LDS;
    const int qcol = kind == 0 ? NA_Q + h * 64 : SW_Q + h * 64;
    const int kcol = kind == 0 ? NA_K + h * 64 : SW_K + (h >> 2) * 64;
    const int vcol = kind == 0 ? NA_V + h * 64 : SW_V + (h >> 2) * 64;
    const int qrow = NLAT + b * CTXL + 32 * qb + j;
    bf16x8 qf[4]; load_frags(qf, P + (size_t)qrow * PWP + qcol, half);
    AttnAcc a; attn_init(a);
    auto load = [&](KV& kv, int t) { const int base = NLAT + b * CTXL + 32 * t;
        attn_load(kv, P, [&](int i) { return base + i; }, kcol, vcol, lane); };
    KV A, B; load(A, 0);
    for (int t = 0; t < 8; t += 2) {
        load(B, t + 1);
        attn_tile(a, qf, A.k, A.v, vl, lane, [&](int, int, float raw) { return raw * QK_SCALE_L2; });
        if (t + 2 < 8) load(A, t + 2);
        attn_tile(a, qf, B.k, B.v, vl, lane, [&](int, int, float raw) { return raw * QK_SCALE_L2; });
    }
    if (kind == 1) a.l += __builtin_amdgcn_exp2f(inp(c, 12)[c.L * 8 + h] * LOG2E - a.m);
    attn_store(a, Y + (size_t)(qrow - j) * D + (kind == 0 ? 0 : 1536) + h * 64, vl, lane);
}

DI void conv_rows4(const Ctx& c, int row0, int stride, int nrows) {
    const bf16* P = (const bf16*)(c.ws + WS_P); unsigned char* Y = (unsigned char*)(c.ws + WS_YMIX);
    const int lane = c.lane, ch = 8 * lane;
    const float* w = inp(c, 8) + (size_t)c.L * 3 * 512;
    f32x4 wv[3][2];
#pragma unroll
    for (int t = 0; t < 3; ++t) { wv[t][0] = *(const f32x4*)(w + t * 512 + ch); wv[t][1] = *(const f32x4*)(w + t * 512 + ch + 4); }
    bf16x8 u[4][3], g[4][3], gb[4]; bool ok[4][3]; int rows[4];
#pragma unroll
    for (int r = 0; r < 4; ++r) {
        const int row = row0 + r * stride; rows[r] = row;
        const bool live = row < nrows; const int rr = live ? row : 0;
        int pos, len; if (rr < NLAT) { pos = rr % SEQ; len = SEQ; } else { pos = (rr - NLAT) % CTXL; len = CTXL; }
#pragma unroll
        for (int t = 0; t < 3; ++t) { const int q = pos + t - 1; ok[r][t] = live && q >= 0 && q < len; const bf16* pr = P + (size_t)(ok[r][t] ? rr + t - 1 : rr) * PWP;
            u[r][t] = *(const bf16x8*)(pr + SC_U + ch); g[r][t] = *(const bf16x8*)(pr + SC_C + ch); }
        gb[r] = *(const bf16x8*)(P + (size_t)rr * PWP + SC_B + ch);
    }
#pragma unroll
    for (int r = 0; r < 4; ++r) {
        if (rows[r] >= nrows) continue;
        float acc[8];
#pragma unroll
        for (int e = 0; e < 8; ++e) acc[e] = 0.f;
#pragma unroll
        for (int t = 0; t < 3; ++t) { float uf[8], gf[8]; unpack8(u[r][t], uf); unpack8(g[r][t], gf);
            const float wf[8] = {wv[t][0].x, wv[t][0].y, wv[t][0].z, wv[t][0].w, wv[t][1].x, wv[t][1].y, wv[t][1].z, wv[t][1].w};
            const float m = ok[r][t] ? 1.f : 0.f;
#pragma unroll
            for (int e = 0; e < 8; ++e) acc[e] += m * wf[e] * (gf[e] * uf[e]); }
        float bf_[8]; unpack8(gb[r], bf_);
        u32x2 o; o.x = pk4_fp8(bf_[0] * acc[0], bf_[1] * acc[1], bf_[2] * acc[2], bf_[3] * acc[3]); o.y = pk4_fp8(bf_[4] * acc[4], bf_[5] * acc[5], bf_[6] * acc[6], bf_[7] * acc[7]);
        *(u32x2*)(Y + (size_t)rows[r] * D + 512 + ch) = o;
    }
}
constexpr int KSTR = 144, V2STR = 272;
DI int gla_row0(int b, int ck) { return ck < 8 ? NLAT + b * CTXL + 32 * ck : b * SEQ + 32 * (ck - 8); }
DI int gla_chain_pos(int dir, int ck) { return ck < 8 ? (dir == 0 ? ck : 7 - ck) : (dir == 0 ? ck : 8 + 255 - (ck - 8)); }

struct GlaGate { float w[16]; float bias; };
template <int DIR>
DI void gla_gate_load(const Ctx& c, int h, GlaGate& g) {
    const float* w2 = inp(c, 9) + (size_t)((c.L * 2 + DIR) * 16) * 256 + h * 64 + c.lane;
#pragma unroll
    for (int i = 0; i < 16; ++i) g.w[i] = w2[i * 256];
    g.bias = inp(c, 10)[(c.L * 2 + DIR) * 256 + h * 64 + c.lane];
}
DI void gla_stage_z(const bf16* P, int row0, LAS unsigned char* zl, int lane) {
    const u32x4 v0 = *(const u32x4*)(P + (size_t)(row0 + (lane >> 2)) * PWP + GL_Z + (lane & 3) * 8);
    const u32x4 v1 = *(const u32x4*)(P + (size_t)(row0 + 16 + (lane >> 2)) * PWP + GL_Z + (lane & 3) * 8);
    *(LAS u32x4*)(zl + (lane >> 2) * 64 + (lane & 3) * 16) = v0; *(LAS u32x4*)(zl + (16 + (lane >> 2)) * 64 + (lane & 3) * 16) = v1;
}
template <int DIR>
DI float gla_la(const GlaGate& g, const LAS unsigned char* zl, int t) {
    const LAS unsigned char* zr = zl + t * 64 + DIR * 32;
    float a[8], bq[8]; unpack8(*(const LAS bf16x8*)zr, a); unpack8(*(const LAS bf16x8*)(zr + 16), bq);
    float x = g.bias;
#pragma unroll
    for (int i = 0; i < 8; ++i) x += a[i] * g.w[i];
#pragma unroll
    for (int i = 0; i < 8; ++i) x += bq[i] * g.w[8 + i];
    return (fminf(x, 0.f) - __logf(1.f + __expf(-fabsf(x)))) * (1.f / 16.f);
}
DI void gla_stage_v(const bf16* P, int row0, int h, LAS unsigned char* vl, int lane) {
#pragma unroll
    for (int i = 0; i < 8; ++i) { const int idx = lane + 64 * i, t = idx >> 4, ch = idx & 15;
        *(LAS u32x4*)(vl + t * V2STR + ch * 16) = *(const u32x4*)(P + (size_t)(row0 + t) * PWP + GL_V + h * 128 + ch * 8); }
}
DI void gla_load_qk(u32x4 (&r)[4], const bf16* P, int row0, int col, int lane) {
#pragma unroll
    for (int i = 0; i < 4; ++i) r[i] = *(const u32x4*)(P + (size_t)(row0 + 8 * i + (lane >> 3)) * PWP + col + (lane & 7) * 8);
}
DI void gla_put_qk(const u32x4 (&r)[4], LAS unsigned char* l, int lane) {
    LAS unsigned char* d = l + (lane >> 3) * KSTR + (lane & 7) * 16;
#pragma unroll
    for (int i = 0; i < 4; ++i) *(LAS u32x4*)(d + 8 * i * KSTR) = r[i];
}

template <int DIR>
DI void gla_g1(const Ctx& c, int b, int h, int ck) {
    const bf16* P = (const bf16*)(c.ws + WS_P);
    const int lane = c.lane, half = lane >> 5;
    LAS unsigned char* kl = c.lds + c.wave * WAVE_LDS; LAS unsigned char* vl = kl + 32 * KSTR; LAS unsigned char* zl = vl + 32 * V2STR;
    const int row0 = gla_row0(b, ck), n = gla_chain_pos(DIR, ck);
    const size_t chain = (size_t)((b * 2 + DIR) * 4 + h) * NCH + n;
    u32x4 kr[4]; gla_load_qk(kr, P, row0, GL_K + h * 64, lane);
    GlaGate gate; gla_gate_load<DIR>(c, h, gate);
    gla_stage_z(P, row0, zl, lane);
    gla_stage_v(P, row0, h, vl, lane);
    gla_put_qk(kr, kl, lane);
    bf16* erp = (bf16*)(c.ws + WS_ER) + chain * 2048;
    float rev = 0.f;
#pragma unroll
    for (int tt = 31; tt >= 0; --tt) {
        const int t = DIR ? 31 - tt : tt;
        LAS bf16* kp = (LAS bf16*)(kl + t * KSTR + 2 * lane);
        const float er = __expf(rev);
        *kp = f2bf(bf2f(*kp) * er);
        erp[t * 64 + lane] = f2bf(er);
        rev += gla_la<DIR>(gate, zl, t);
    }
    ((float*)(c.ws + WS_GDEC))[chain * 64 + lane] = __expf(rev);
    const int q = (lane & 15) >> 2, pp = lane & 3, blk = (lane >> 4) & 1;
    bf16* ut = (bf16*)(c.ws + WS_UT) + chain * 8192;
    bf16x8 Kf[2][2];
#pragma unroll
    for (int nt = 0; nt < 2; ++nt)
#pragma unroll
        for (int s = 0; s < 2; ++s) { LAS unsigned char* a = kl + (16 * s + 8 * half + q) * KSTR + (32 * nt + 16 * blk + 4 * pp) * 2; Kf[nt][s] = cat4(tr_read(a), tr_read(a + 4 * KSTR)); }
#pragma unroll
    for (int mt = 0; mt < 4; ++mt) {
        bf16x8 Vf[2];
#pragma unroll
        for (int s = 0; s < 2; ++s) { LAS unsigned char* a = vl + (16 * s + 8 * half + q) * V2STR + (32 * mt + 16 * blk + 4 * pp) * 2; Vf[s] = cat4(tr_read(a), tr_read(a + 4 * V2STR)); }
#pragma unroll
        for (int nt = 0; nt < 2; ++nt) {
            f32x16 acc = zero16();
            acc = MFMA32(Kf[nt][0], Vf[0], acc); acc = MFMA32(Kf[nt][1], Vf[1], acc);
            LAS unsigned char* ud = kl + (lane & 31) * KSTR + 64 * nt + 8 * half;
#pragma unroll
            for (int g4 = 0; g4 < 4; ++g4) { u32x2 w; w.x = pk2(acc[4 * g4], acc[4 * g4 + 1]); w.y = pk2(acc[4 * g4 + 2], acc[4 * g4 + 3]); *(LAS u32x2*)(ud + 16 * g4) = w; }
        }
#pragma unroll
        for (int i = 0; i < 4; ++i) { const int vr = 8 * i + (lane >> 3);
            *(u32x4*)(ut + (size_t)(32 * mt + vr) * 64 + (lane & 7) * 8) = *(const LAS u32x4*)(kl + vr * KSTR + (lane & 7) * 16); }
    }
}

DI void gla_scan(const Ctx& c) {

    const bf16* ut = (const bf16*)(c.ws + WS_UT); bf16* sin = (bf16*)(c.ws + WS_SIN); const float* gd = (const float*)(c.ws + WS_GDEC);
    for (int e = c.bid * 512 + c.tid; e < 16 * 8192; e += c.nblk * 512) {
        const int chain = e >> 13, el = e & 8191, k = el & 63;
        const size_t base = (size_t)chain * NCH * 8192 + el;
        const float* g = gd + (size_t)chain * NCH * 64 + k;
        float st = 0.f;
        for (int n0 = 0; n0 < NCH; n0 += 88) {
            float u[88], gg[88];
#pragma unroll
            for (int i = 0; i < 88; ++i) { u[i] = bf2f(ut[base + (size_t)(n0 + i) * 8192]); gg[i] = g[(n0 + i) * 64]; }
#pragma unroll
            for (int i = 0; i < 88; ++i) { sin[base + (size_t)(n0 + i) * 8192] = f2bf(st); st = gg[i] * st + u[i]; }
        }
    }
}

template <int DIR>
DI void gla_g3_dir(const Ctx& c, int b, int h, int ck, const unsigned (&qc)[16], const unsigned (&kc)[16], LAS unsigned char* ql, LAS unsigned char* kl, LAS unsigned char* vl, LAS unsigned char* zl, f32x16 (&o)[4]) {
    const int lane = c.lane, half = lane >> 5, j = lane & 31;
    const size_t chain = (size_t)((b * 2 + DIR) * 4 + h) * NCH + gla_chain_pos(DIR, ck);
    const bf16* sin = (const bf16*)(c.ws + WS_SIN) + chain * 8192;
    bf16x8 sf[2][4], sg[2][4];
#pragma unroll
    for (int mt = 0; mt < 2; ++mt)
#pragma unroll
        for (int s = 0; s < 4; ++s) sf[mt][s] = *(const bf16x8*)(sin + (size_t)(32 * mt + j) * 64 + 16 * s + 8 * half);
    { const float gd = ((const float*)(c.ws + WS_GDEC))[chain * 64 + lane];
      const bf16* erp = (const bf16*)(c.ws + WS_ER) + chain * 2048;
      bf16 er[32];
#pragma unroll
      for (int t = 0; t < 32; ++t) er[t] = erp[t * 64 + lane];
#pragma unroll
      for (int t = 0; t < 32; ++t) {
        const float e1 = gd * __builtin_amdgcn_rcpf(bf2f(er[t]));
        const float qv = (t & 1) ? hi16(qc[t >> 1]) : lo16(qc[t >> 1]), kv = (t & 1) ? hi16(kc[t >> 1]) : lo16(kc[t >> 1]);
        *(LAS bf16*)(ql + t * KSTR + 2 * lane) = f2bf(qv * e1 * 0.125f);
        *(LAS bf16*)(kl + t * KSTR + 2 * lane) = f2bf(kv * __builtin_amdgcn_rcpf(e1));
      } }
#pragma unroll
    for (int mt = 0; mt < 2; ++mt)
#pragma unroll
        for (int s = 0; s < 4; ++s) sg[mt][s] = *(const bf16x8*)(sin + (size_t)(32 * (mt + 2) + j) * 64 + 16 * s + 8 * half);
    bf16x8 qf[4], kf[4];
#pragma unroll
    for (int s = 0; s < 4; ++s) { qf[s] = *(const LAS bf16x8*)(ql + j * KSTR + (16 * s + 8 * half) * 2); kf[s] = *(const LAS bf16x8*)(kl + j * KSTR + (16 * s + 8 * half) * 2); }
    f32x16 at = zero16();
#pragma unroll
    for (int s = 0; s < 4; ++s) at = MFMA32(kf[s], qf[s], at);
    float a[16];
#pragma unroll
    for (int r = 0; r < 16; ++r) { const int s = crow(r, half); const bool ok = DIR ? (s >= j) : (s <= j); a[r] = ok ? at[r] : 0.f; }
    const bf16x8 pb0 = pack8(a[0], a[1], a[2], a[3], a[4], a[5], a[6], a[7]), pb1 = pack8(a[8], a[9], a[10], a[11], a[12], a[13], a[14], a[15]);
    const int q = (lane & 15) >> 2, pp = lane & 3, blk = (lane >> 4) & 1;
#pragma unroll
    for (int mt = 0; mt < 4; ++mt) {
        LAS unsigned char* vb = vl + (4 * half + q) * V2STR + (32 * mt + 16 * blk + 4 * pp) * 2;
        o[mt] = MFMA32(cat4(tr_read(vb), tr_read(vb + 8 * V2STR)), pb0, o[mt]);
        o[mt] = MFMA32(cat4(tr_read(vb + 16 * V2STR), tr_read(vb + 24 * V2STR)), pb1, o[mt]);
#pragma unroll
        for (int s = 0; s < 4; ++s) o[mt] = MFMA32(mt < 2 ? sf[mt & 1][s] : sg[mt & 1][s], qf[s], o[mt]);
    }
}
DI void gla_g3(const Ctx& c, int b, int h, int ck) {
    const bf16* P = (const bf16*)(c.ws + WS_P); unsigned char* Y = (unsigned char*)(c.ws + WS_YMIX);
    const int lane = c.lane, half = lane >> 5, j = lane & 31;
    LAS unsigned char* ql = c.lds + c.wave * WAVE_LDS; LAS unsigned char* kl = ql + 32 * KSTR; LAS unsigned char* vl = kl + 32 * KSTR; LAS unsigned char* zl = vl + 32 * V2STR;
    const int row0 = gla_row0(b, ck);
    { u32x4 qr[4], kr[4]; gla_load_qk(qr, P, row0, GL_Q + h * 64, lane); gla_load_qk(kr, P, row0, GL_K + h * 64, lane);
      gla_stage_v(P, row0, h, vl, lane);
      gla_put_qk(qr, ql, lane); gla_put_qk(kr, kl, lane); }
    unsigned qc[16], kc[16];
#pragma unroll
    for (int i = 0; i < 16; ++i) {
        qc[i] = (unsigned)*(const LAS bf16*)(ql + (2 * i) * KSTR + 2 * lane) | ((unsigned)*(const LAS bf16*)(ql + (2 * i + 1) * KSTR + 2 * lane) << 16);
        kc[i] = (unsigned)*(const LAS bf16*)(kl + (2 * i) * KSTR + 2 * lane) | ((unsigned)*(const LAS bf16*)(kl + (2 * i + 1) * KSTR + 2 * lane) << 16); }
    f32x16 o[4];
#pragma unroll
    for (int mt = 0; mt < 4; ++mt) o[mt] = zero16();
    gla_g3_dir<0>(c, b, h, ck, qc, kc, ql, kl, vl, zl, o);
    gla_g3_dir<1>(c, b, h, ck, qc, kc, ql, kl, vl, zl, o);
    float ss = 0.f;
#pragma unroll
    for (int mt = 0; mt < 4; ++mt)
#pragma unroll
        for (int r = 0; r < 16; ++r) ss += o[mt][r] * o[mt][r];
    ss += bperm_f(lane ^ 32, ss);
    const float rstd = 1.f / sqrtf(ss * (1.f / 128.f) + LN_EPS);
    const float* gain = inp(c, 11) + (size_t)c.L * 128;
    const int row = row0 + j;
#pragma unroll
    for (int mt = 0; mt < 4; ++mt)
#pragma unroll
        for (int g4 = 0; g4 < 4; ++g4) {
            const int v0 = 32 * mt + 8 * g4 + 4 * half;
            const u32x2 gr = *(const u32x2*)(P + (size_t)row * PWP + GL_G + h * 128 + v0);
            const float gv[4] = {lo16(gr.x), hi16(gr.x), lo16(gr.y), hi16(gr.y)};
            const f32x4 gn = *(const f32x4*)(gain + v0);
            float y[4];
#pragma unroll
            for (int e = 0; e < 4; ++e) { const float on = o[mt][4 * g4 + e] * rstd * gn[e]; y[e] = on * (gv[e] / (1.f + __expf(-gv[e]))); }
            *(unsigned*)(Y + (size_t)row * D + 1024 + h * 128 + v0) = pk4_fp8(y[0], y[1], y[2], y[3]); }
}
template <int NT>
DI void router_phase(const Ctx& c, int rows_per_chunk, int nchunks) {
    const int L = c.L, lane = c.lane, r16 = lane & 15, q = lane >> 4, w = c.wave;
    const unsigned char* xq = (const unsigned char*)(c.ws + WS_XQ); const bf16* xl = (const bf16*)(c.ws + WS_XL); const bf16* rw = (const bf16*)(c.ws + WS_ROUTW);
    const float* rb = inp(c, 17) + (size_t)L * NEXP;
    int* eidx = (int*)(c.ws + WS_EIDX); int* rank = (int*)(c.ws + WS_RANK); float* wts = (float*)(c.ws + WS_WTS);
    unsigned* cnt = (unsigned*)(c.ws + WS_CTL) + CW_CNT + L * 64;
    LAS float* part = (LAS float*)c.lds;
    LAS float* sc = (LAS float*)(c.lds + 98304);
    LAS float* sl = sc + 5 * 16 * 65;
    LAS unsigned* lcnt = (LAS unsigned*)(c.lds + LDS_MISC + 256);
    LAS unsigned* lbase = lcnt + 64;
    for (int chunk = c.bid; chunk < nchunks; chunk += c.nblk) {
        const int row0 = chunk * rows_per_chunk, rowlast = row0 + rows_per_chunk - 1;
        if (c.tid < 64) lcnt[c.tid] = 0u;
        f32x4 acc[NT][4];
#pragma unroll
        for (int t = 0; t < NT; ++t)
#pragma unroll
            for (int nt = 0; nt < 4; ++nt) acc[t][nt] = (f32x4){0.f, 0.f, 0.f, 0.f};
#pragma unroll 2
        for (int ks = 0; ks < 8; ++ks) {
            const int k0 = 256 * w + 32 * ks + 8 * q;
            bf16x8 bh[4], bl[4];
#pragma unroll
            for (int nt = 0; nt < 4; ++nt) { bh[nt] = *(const bf16x8*)(rw + (size_t)(16 * nt + r16) * D + k0); bl[nt] = *(const bf16x8*)(rw + (size_t)(64 + 16 * nt + r16) * D + k0); }
#pragma unroll
            for (int t = 0; t < NT; ++t) {
                const int row = min(row0 + 16 * t + r16, rowlast);
                const u32x2 aq = *(const u32x2*)(xq + (size_t)row * D + k0); const bf16x8 al = *(const bf16x8*)(xl + (size_t)row * D + k0);
                const f32x2 q0 = __builtin_amdgcn_cvt_pk_f32_fp8((int)aq.x, false), q1 = __builtin_amdgcn_cvt_pk_f32_fp8((int)aq.x, true), q2 = __builtin_amdgcn_cvt_pk_f32_fp8((int)aq.y, false), q3 = __builtin_amdgcn_cvt_pk_f32_fp8((int)aq.y, true);
                const bf16x8 ah = pack8(q0.x, q0.y, q1.x, q1.y, q2.x, q2.y, q3.x, q3.y);
#pragma unroll
                for (int nt = 0; nt < 4; ++nt) { acc[t][nt] = MFMA16(ah, bh[nt], acc[t][nt]); acc[t][nt] = MFMA16(al, bh[nt], acc[t][nt]); acc[t][nt] = MFMA16(ah, bl[nt], acc[t][nt]); }
            }
        }
#pragma unroll
        for (int g = 0; g < 2; ++g) {
            const int t0 = 3 * g, tn = (g == 0) ? (NT < 3 ? NT : 3) : NT - 3;
            __syncthreads();
#pragma unroll
            for (int tt = 0; tt < 3; ++tt) if (tt < tn)
#pragma unroll
                for (int nt = 0; nt < 4; ++nt)
#pragma unroll
                    for (int r = 0; r < 4; ++r) part[(w * 3 + tt) * 1024 + (4 * q + r) * 64 + 16 * nt + r16] = acc[t0 + tt][nt][r];
            __syncthreads();
            for (int e = c.tid; e < tn * 1024; e += 512) {
                const int tt = e >> 10, el = e & 1023, tok = el >> 6, ex = el & 63;
                float sum = 0.f;
#pragma unroll
                for (int ww = 0; ww < 8; ++ww) sum += part[(ww * 3 + tt) * 1024 + el];
                const float sg = 1.f / (1.f + __expf(-sum));
                sc[((t0 + tt) * 16 + tok) * 65 + ex] = sg; sl[((t0 + tt) * 16 + tok) * 65 + ex] = sg + rb[ex];
            }
        }
        __syncthreads();
        int e0 = 0, e1 = 0, li0 = 0, li1 = 0; float w0 = 0.f, w1 = 0.f;
        const int tk = lane >> 2, s4 = lane & 3;
        const int tokrow = row0 + 16 * w + tk;
        const bool act = (w < NT) && (tokrow <= rowlast);
        if (act) {
            const LAS float* slt = sl + (w * 16 + tk) * 65; const LAS float* sct = sc + (w * 16 + tk) * 65;
            float v[16];
#pragma unroll
            for (int i = 0; i < 16; ++i) v[i] = slt[16 * s4 + i];
            float ga, gb;
            { float m1 = -INFINITY, m2 = -INFINITY;
#pragma unroll
              for (int i = 0; i < 8; ++i) { if (v[i] > m1) { m2 = m1; m1 = v[i]; } else if (v[i] > m2) m2 = v[i]; }
              ga = m1 + m2; m1 = -INFINITY; m2 = -INFINITY;
#pragma unroll
              for (int i = 8; i < 16; ++i) { if (v[i] > m1) { m2 = m1; m1 = v[i]; } else if (v[i] > m2) m2 = v[i]; }
              gb = m1 + m2; }
            float gs[8];
#pragma unroll
            for (int s2 = 0; s2 < 4; ++s2) { gs[2 * s2] = bperm_f((lane & ~3) | s2, ga); gs[2 * s2 + 1] = bperm_f((lane & ~3) | s2, gb); }
            unsigned gmask = 0u;
#pragma unroll
            for (int it = 0; it < 4; ++it) { float best = -INFINITY; int bi = 0;
#pragma unroll
                for (int g = 0; g < 8; ++g) { const bool fr = ((gmask >> g) & 1u) == 0u; if (fr && gs[g] > best) { best = gs[g]; bi = g; } }
                gmask |= 1u << bi; }
            const bool oka = (gmask >> (2 * s4)) & 1u, okb = (gmask >> (2 * s4 + 1)) & 1u;
#pragma unroll
            for (int i = 0; i < 16; ++i) v[i] = ((i < 8) ? oka : okb) ? v[i] : -INFINITY;
            float wsum = 0.f;
#pragma unroll
            for (int rd = 0; rd < 8; ++rd) {
                float best = -INFINITY; int bi = 16 * s4;
#pragma unroll
                for (int i = 0; i < 16; ++i) if (v[i] > best) { best = v[i]; bi = 16 * s4 + i; }
#pragma unroll
                for (int o = 1; o < 4; o <<= 1) { const float ob = bperm_f(lane ^ o, best); const int oi = bperm_i(lane ^ o, bi); if (ob > best || (ob == best && oi < bi)) { best = ob; bi = oi; } }
                const float wv = sct[bi]; wsum += wv;
                if ((bi >> 4) == s4) {
#pragma unroll
                    for (int i = 0; i < 16; ++i) v[i] = (i == (bi & 15)) ? -INFINITY : v[i]; }
                if ((rd & 3) == s4) { if (rd < 4) { e0 = bi; w0 = wv; } else { e1 = bi; w1 = wv; } }
            }
            const float sc25 = 2.5f / wsum; w0 *= sc25; w1 *= sc25;
            li0 = (int)__hip_atomic_fetch_add((unsigned*)(lcnt + e0), 1u, __ATOMIC_RELAXED, __HIP_MEMORY_SCOPE_WORKGROUP); li1 = (int)__hip_atomic_fetch_add((unsigned*)(lcnt + e1), 1u, __ATOMIC_RELAXED, __HIP_MEMORY_SCOPE_WORKGROUP);
        }
        __syncthreads();
        if (c.tid < 64) { const unsigned n = lcnt[c.tid]; lbase[c.tid] = n ? atomicAdd(cnt + c.tid, n) : 0u; }
        __syncthreads();
        if (act) {
            eidx[tokrow * 8 + s4] = e0; wts[tokrow * 8 + s4] = w0; rank[tokrow * 8 + s4] = (int)lbase[e0] + li0;
            eidx[tokrow * 8 + s4 + 4] = e1; wts[tokrow * 8 + s4 + 4] = w1; rank[tokrow * 8 + s4 + 4] = (int)lbase[e1] + li1;
        }
        __syncthreads();
    }
}

DI void phase9(const Ctx& c) {
    const int L = c.L;
    const int nmoe = L == 0 ? NTOK : NLAT;
    LAS int* ts = (LAS int*)c.lds;
    const unsigned* cnt = (const unsigned*)(c.ws + WS_CTL) + CW_CNT + L * 64;
    if (c.tid == 0) { int acc = 0; for (int e = 0; e < 64; ++e) { ts[e] = acc; acc += ((int)cnt[e] + 255) >> 8; } ts[64] = acc; ts[65] = acc + nmoe / 256; }
    __syncthreads();
    int* toks = (int*)(c.ws + WS_TOKS); int* pos = (int*)(c.ws + WS_POS); int* tile_e = (int*)(c.ws + WS_TILEE);
    const int* eidx = (const int*)(c.ws + WS_EIDX); const int* rank = (const int*)(c.ws + WS_RANK);
    const int gt = c.bid * 512 + c.tid, ngt = c.nblk * 512;
    for (int i = gt; i < nmoe * 8; i += ngt) { const int e = eidx[i]; const int slot = ts[e] * 256 + rank[i]; toks[slot] = i >> 3; pos[i] = slot; }
    for (int i = gt; i < nmoe; i += ngt) toks[ts[64] * 256 + i] = i;
    for (int e = c.bid; e < 65; e += c.nblk) {
        for (int t = ts[e] + c.tid; t < ts[e + 1]; t += 512) tile_e[t] = e;
        if (e < 64) { const int n = (int)cnt[e]; for (int s = n + c.tid; s < (ts[e + 1] - ts[e]) * 256; s += 512) toks[ts[e] * 256 + s] = 0; }
    }
    if (c.bid == 0 && c.tid == 0) { int* nt = (int*)(c.ws + WS_CTL) + CW_NT + L * 64; nt[0] = ts[65]; nt[1] = ts[64]; }
    __syncthreads();
}

DI void phase12(const Ctx& c) {
    const int L = c.L;
    const int nmoe = L == 0 ? NTOK : NLAT;
    const unsigned char* Yb = (const unsigned char*)(c.ws + WS_Y); const bf16* x1 = (const bf16*)(c.ws + WS_X1);
    const int* pos = (const int*)(c.ws + WS_POS); const float* wts = (const float*)(c.ws + WS_WTS);
    const int sh_tile0 = ((const int*)(c.ws + WS_CTL))[CW_NT + L * 64 + 1];
    const float* lg = inp(c, 24) + (size_t)L * D; const float* lb = inp(c, 25) + (size_t)L * D;
    int4 ns0 = {0, 0, 0, 0}, ns1 = {0, 0, 0, 0}; f32x4 nq0 = {0.f, 0.f, 0.f, 0.f}, nq1 = {0.f, 0.f, 0.f, 0.f};
    if (c.gw < nmoe) { ns0 = *(const int4*)(pos + c.gw * 8); ns1 = *(const int4*)(pos + c.gw * 8 + 4); nq0 = *(const f32x4*)(wts + c.gw * 8); nq1 = *(const f32x4*)(wts + c.gw * 8 + 4); }
    for (int row = c.gw; row < nmoe; row += c.ngw) {
        const float* mod = mod_row(c, row);
        f32x4 f[8];
        int slot[8]; float w[8];
        { const int4 s0 = ns0, s1 = ns1; const f32x4 q0 = nq0, q1 = nq1;
          slot[0] = s0.x; slot[1] = s0.y; slot[2] = s0.z; slot[3] = s0.w; slot[4] = s1.x; slot[5] = s1.y; slot[6] = s1.z; slot[7] = s1.w;
          w[0] = q0.x; w[1] = q0.y; w[2] = q0.z; w[3] = q0.w; w[4] = q1.x; w[5] = q1.y; w[6] = q1.z; w[7] = q1.w; }
        { const int nr = row + c.ngw; if (nr < nmoe) { ns0 = *(const int4*)(pos + nr * 8); ns1 = *(const int4*)(pos + nr * 8 + 4); nq0 = *(const f32x4*)(wts + nr * 8); nq1 = *(const f32x4*)(wts + nr * 8 + 4); } }
        {
            u32x4 y[9][2];
#pragma unroll
            for (int k = 0; k < 9; ++k) { const unsigned char* yr = Yb + (size_t)(k == 8 ? sh_tile0 * 256 + row : slot[k]) * D + 16 * c.lane;
                y[k][0] = *(const u32x4*)yr; y[k][1] = *(const u32x4*)(yr + 1024); }
#pragma unroll
            for (int j = 0; j < 2; ++j)
#pragma unroll
                for (int q = 0; q < 4; ++q) {
                    { const int d = (int)y[8][j][q]; const f32x2 a = __builtin_amdgcn_cvt_pk_f32_fp8(d, false), b2 = __builtin_amdgcn_cvt_pk_f32_fp8(d, true); f[4 * j + q] = (f32x4){a.x, a.y, b2.x, b2.y}; }
#pragma unroll
                    for (int k = 0; k < 8; ++k) { const int d = (int)y[k][j][q]; const f32x2 a = __builtin_amdgcn_cvt_pk_f32_fp8(d, false), b2 = __builtin_amdgcn_cvt_pk_f32_fp8(d, true); f[4 * j + q] += (f32x4){a.x, a.y, b2.x, b2.y} * w[k]; }
                    f[4 * j + q] = f[4 * j + q] * 0.125f; }
        }
        f32x4 v[8];
#pragma unroll
        for (int j = 0; j < 2; ++j) { const int cb = 1024 * j + 16 * c.lane;
            const u32x4 ta = *(const u32x4*)(x1 + (size_t)row * D + cb), tb = *(const u32x4*)(x1 + (size_t)row * D + cb + 8);
            const f32x4 xa[4] = {(f32x4){lo16(ta.x), hi16(ta.x), lo16(ta.y), hi16(ta.y)}, (f32x4){lo16(ta.z), hi16(ta.z), lo16(ta.w), hi16(ta.w)},
                                 (f32x4){lo16(tb.x), hi16(tb.x), lo16(tb.y), hi16(tb.y)}, (f32x4){lo16(tb.z), hi16(tb.z), lo16(tb.w), hi16(tb.w)}};
#pragma unroll
            for (int q = 0; q < 4; ++q) v[4 * j + q] = xa[q] * DN_ALPHA + *(const f32x4*)(mod + 5 * D + cb + 4 * q) * f[4 * j + q]; }
        float mean, rstd; row_stats(v, mean, rstd);
#pragma unroll
        for (int j = 0; j < 2; ++j)
#pragma unroll
            for (int q = 0; q < 4; ++q) { const int col = 1024 * j + 16 * c.lane + 4 * q; v[4 * j + q] = (v[4 * j + q] - mean) * rstd * *(const f32x4*)(lg + col) + *(const f32x4*)(lb + col); }
        if (L == 1) {
            float* orow = outp(c) + (size_t)row * D;
#pragma unroll
            for (int j = 0; j < 2; ++j)
#pragma unroll
                for (int q = 0; q < 4; ++q) *(f32x4*)(orow + 1024 * j + 16 * c.lane + 4 * q) = v[4 * j + q];
        } else if (row < NLAT) {
            bf16* xb = (bf16*)(c.ws + WS_XB);
#pragma unroll
            for (int j = 0; j < 2; ++j) { u32x4 oa, ob;
                oa.x = pk2(v[4 * j][0], v[4 * j][1]); oa.y = pk2(v[4 * j][2], v[4 * j][3]); oa.z = pk2(v[4 * j + 1][0], v[4 * j + 1][1]); oa.w = pk2(v[4 * j + 1][2], v[4 * j + 1][3]);
                ob.x = pk2(v[4 * j + 2][0], v[4 * j + 2][1]); ob.y = pk2(v[4 * j + 2][2], v[4 * j + 2][3]); ob.z = pk2(v[4 * j + 3][0], v[4 * j + 3][1]); ob.w = pk2(v[4 * j + 3][2], v[4 * j + 3][3]);
                *(u32x4*)(xb + (size_t)row * D + 1024 * j + 16 * c.lane) = oa; *(u32x4*)(xb + (size_t)row * D + 1024 * j + 16 * c.lane + 8) = ob; }
        }
        if (L == 0) {
            const float* mod1 = mod_row_l(c, row, 1); unsigned char* xn = (unsigned char*)(c.ws + WS_XN);
            row_stats(v, mean, rstd);
#pragma unroll
            for (int j = 0; j < 2; ++j) { const int cb = 1024 * j + 16 * c.lane; u32x4 o;
#pragma unroll
                for (int q = 0; q < 4; ++q) { const f32x4 sh = *(const f32x4*)(mod1 + cb + 4 * q), sc = *(const f32x4*)(mod1 + D + cb + 4 * q);
                    const f32x4 yv = (v[4 * j + q] - mean) * rstd * (sc + 1.f) + sh; o[q] = pk4_fp8(yv.x, yv.y, yv.z, yv.w); }
                *(u32x4*)(xn + (size_t)row * D + cb) = o; }
        }
    }
}

DI int xcd_vid(int G, int bx) { return (G % 8 == 0) ? (bx % 8) * (G / 8) + bx / 8 : bx; }
__global__ void __launch_bounds__(512, 2) fwd(Params prm) {
    extern __shared__ __attribute__((aligned(16))) unsigned char lds_raw[];
    const int wave_s = __builtin_amdgcn_readfirstlane(threadIdx.x >> 6);
    Ctx c; c.lds = (LAS unsigned char*)lds_raw; c.tid = threadIdx.x; c.lane = c.tid & 63; c.wave = __builtin_amdgcn_readfirstlane(c.tid >> 6);
    c.gw = blockIdx.x * 8 + c.wave; c.ngw = gridDim.x * 8; c.bid = blockIdx.x; c.nblk = gridDim.x; c.p = (CParams*)__builtin_amdgcn_kernarg_segment_ptr(); c.L = 0;
    volatile LAS unsigned* misc = (volatile LAS unsigned*)(c.lds + LDS_MISC);
    if (c.tid < 64) misc[c.tid] = 0u;
    __syncthreads();
    unsigned char* ws = (unsigned char*)prm.ws; c.ws = ws;
    XcdBarrier bar = xcd_barrier_post((unsigned*)(ws + WS_CTL) + CW_BAR, misc + 8);
    const int lo = prm.ph_lo, hi = prm.ph_hi;
    int gdim = gridDim.x, bidx = blockIdx.x;
#ifndef ONLY_PH
#define ONLY_PH -1
#endif
#ifndef STAGGER_US
#define STAGGER_US 0
#endif
#ifndef CVQ_P2
#define CVQ_P2 3
#define CVQ_P6 3
#define CVQ_P10 2
#define CVQ_P11 1
#define CVQ_P5 2
#endif
#ifndef PROBE_BARRIERS
#define PROBE_BARRIERS 0
#endif
#ifndef DUPMASK
#define DUPMASK 0
#endif
#ifndef PHMASK
#define PHMASK 0x1fff
#endif
#define IN(k) (lo <= (k) && (k) < hi && (ONLY_PH < 0 || ((k) % NPH) == ONLY_PH) && ((PHMASK >> ((k) % NPH)) & 1))
#define REFRESH() do { { CParams* kp_ = (CParams*)__builtin_amdgcn_kernarg_segment_ptr(); asm volatile("" : "+s"(kp_)); c.p = kp_; } ws = fresh(c.p->ws); c.ws = ws; int w_ = wave_s; asm volatile("" : "+s"(w_)); const int t_ = w_ * 64 + lane_id_fresh(); c.tid = t_; c.lane = t_ & 63; c.wave = w_; gdim = gridDim.x; bidx = blockIdx.x; asm volatile("" : "+s"(gdim), "+s"(bidx)); c.gw = bidx * 8 + c.wave; c.ngw = gdim * 8; c.bid = bidx; c.nblk = gdim; } while (0)
#define SEAM(k) do { if (IN(k) && IN((k) + 1)) xcd_barrier(bar); } while (0)
    for (int L = 0; L < 2; ++L) {
        c.L = L; const int pb = L * NPH;
        if (IN(pb + 0)) { for (int rep_ = 0; rep_ <= ((DUPMASK >> 0) & 1); ++rep_) { if (rep_) xcd_barrier(bar); REFRESH(); phase0(c); __syncthreads(); } } SEAM(pb + 0);
        if (IN(pb + 1)) { for (int rep_ = 0; rep_ <= ((DUPMASK >> 1) & 1); ++rep_) { if (rep_) xcd_barrier(bar); REFRESH(); if (L == 0) phase1(c); } } if (L == 0) SEAM(pb + 1);
        if (IN(pb + 2)) { for (int rep_ = 0; rep_ <= ((DUPMASK >> 2) & 1); ++rep_) { if (rep_) xcd_barrier(bar); REFRESH();
            pg8::Gemm g{(const bf16*)(ws + WS_XN), (const bf16*)(ws + WS_WIN), D / 2}; pg8::StaticOrder S; S.init(NTOK, PWP, gdim, bidx);
            pg8::EpiBf16 E{(bf16*)(ws + WS_P), PWP, 1.f / 64.f, rep_};
            pg8::gemm_phase<pg8::EpiBf16, pg8::StaticOrder, false, true>(c.lds, g, S, E, nullptr, c.tid);
            if (L == 0 && S.short_deal()) { REFRESH(); cv_steal(c, CVQ_P2); }
        } } SEAM(pb + 2);
        if (IN(pb + 2) && IN(pb + 3)) { REFRESH(); rope_prepass(c); xcd_barrier(bar); }
        if (IN(pb + 3)) { for (int rep_ = 0; rep_ <= ((DUPMASK >> 3) & 1); ++rep_) { if (rep_) xcd_barrier(bar); REFRESH();
            const int gw1 = (c.gw + c.ngw / 2) % c.ngw, gw2 = (c.gw + 3 * (c.ngw / 4)) % c.ngw, gw3 = (c.gw + c.ngw / 4) % c.ngw;
            for (int it = c.gw; it < 4096; it += c.ngw) na_item(c, it);
            { const int gwv = xcd_vid(gdim, bidx) * 8 + c.wave;
              for (int it = gwv; it < 4096; it += c.ngw) swa_item(c, it); }
            for (int it = gw1; it < 16 * NCH; it += c.ngw) { const int ck = it % NCH, h = (it / NCH) & 3, dir = (it / (NCH * 4)) & 1, b = it / (NCH * 8);
                if (dir == 0) gla_g1<0>(c, b, h, ck); else gla_g1<1>(c, b, h, ck); }
            if (L == 0) for (int it = gw2; it < 256; it += c.ngw) ctx_attn_item(c, it);
            for (int row = gw3; row < (L == 0 ? NTOK : NLAT); row += 4 * c.ngw) conv_rows4(c, row, c.ngw, L == 0 ? NTOK : NLAT);
        } } SEAM(pb + 3);
        if (PROBE_BARRIERS && IN(pb + 4)) { for (int i_ = 0; i_ < PROBE_BARRIERS; ++i_) xcd_barrier(bar); }
        if (IN(pb + 4)) { for (int rep_ = 0; rep_ <= ((DUPMASK >> 4) & 1); ++rep_) { if (rep_) xcd_barrier(bar); REFRESH(); gla_scan(c); } } SEAM(pb + 4);
        if (IN(pb + 5)) { for (int rep_ = 0; rep_ <= ((DUPMASK >> 5) & 1); ++rep_) { if (rep_) xcd_barrier(bar); REFRESH();
            for (int it = c.gw; it < 8 * NCH; it += c.ngw) { const int ck = it % NCH, h = (it / NCH) & 3, b = it / (NCH * 4);
                if (ck < 8 && L != 0) continue;
                gla_g3(c, b, h, ck); }
            if (L == 0 && c.gw + c.ngw >= 8 * NCH) cv_steal(c, CVQ_P5);
        } } SEAM(pb + 5);
        if (IN(pb + 6)) { for (int rep_ = 0; rep_ <= ((DUPMASK >> 6) & 1); ++rep_) { if (rep_) xcd_barrier(bar); REFRESH();
            pg8::Gemm g{(const bf16*)(ws + WS_YMIX), (const bf16*)(ws + WS_WOUT), D / 2};
            pg8::StaticOrder S; S.init(L == 0 ? NTOK : NLAT, D, gdim, bidx);
            pg8::EpiBf16 E{(bf16*)(ws + WS_T), D, 1.f / 64.f, rep_};
            pg8::gemm_phase<pg8::EpiBf16, pg8::StaticOrder, false, true>(c.lds, g, S, E, nullptr, c.tid);
            if (L == 0 && S.short_deal()) { REFRESH(); cv_steal(c, CVQ_P6); }
        } } SEAM(pb + 6);
        if (IN(pb + 7)) { for (int rep_ = 0; rep_ <= ((DUPMASK >> 7) & 1); ++rep_) { if (rep_) xcd_barrier(bar); REFRESH(); phase7(c); } } SEAM(pb + 7);
        if (IN(pb + 8)) { for (int rep_ = 0; rep_ <= ((DUPMASK >> 8) & 1); ++rep_) { if (rep_) { xcd_barrier(bar); if (blockIdx.x == 0 && c.tid < 64) ((unsigned*)(ws + WS_CTL))[CW_CNT + L * 64 + c.tid] = 0u; xcd_barrier(bar); } REFRESH(); if (L == 0) router_phase<5>(c, 66, 256); else router_phase<4>(c, 64, 256); } } SEAM(pb + 8);
        if (IN(pb + 9)) { for (int rep_ = 0; rep_ <= ((DUPMASK >> 9) & 1); ++rep_) { if (rep_) xcd_barrier(bar); REFRESH(); phase9(c); } } SEAM(pb + 9);
        if (IN(pb + 10)) { for (int rep_ = 0; rep_ <= ((DUPMASK >> 10) & 1); ++rep_) { if (rep_) xcd_barrier(bar); REFRESH();
            const int* ntp = (const int*)(ws + WS_CTL) + CW_NT + L * 64;
            pg8::Gemm g{(const bf16*)(ws + WS_XQ), (const bf16*)(ws + (L == 0 ? WS_WGU : WS_WGU1)), D / 2};
            int nu_ = __builtin_amdgcn_readfirstlane(ntp[0]) * 4; asm volatile("" : "+s"(nu_)); pg8::GroupOrder S{(const int*)(ws + WS_TILEE), nu_, 4, gdim, xcd_vid(gdim, bidx), (LAS int*)(c.lds + pg8::STAGE_BYTES + 24 * pg8::BM * 4)};
            pg8::EpiSwiglu8 E{(unsigned char*)(ws + WS_H)};
            pg8::gemm_phase<pg8::EpiSwiglu8, pg8::GroupOrder, true, true>(c.lds, g, S, E, (const int*)(ws + WS_TOKS), c.tid);
            if (L == 0 && S.short_deal()) { REFRESH(); cv_steal(c, CVQ_P10); }
        } } SEAM(pb + 10);
        if (IN(pb + 11)) { for (int rep_ = 0; rep_ <= ((DUPMASK >> 11) & 1); ++rep_) { if (rep_) xcd_barrier(bar); REFRESH();
            const int* ntp = (const int*)(ws + WS_CTL) + CW_NT + L * 64;
            if (STAGGER_US > 0 && (bidx & 1)) { const unsigned long long t0 = __builtin_amdgcn_s_memrealtime(); while (__builtin_amdgcn_s_memrealtime() - t0 < (unsigned long long)(STAGGER_US * 100)) __builtin_amdgcn_s_sleep(8); }
            pg8::Gemm g{(const bf16*)(ws + WS_H), (const bf16*)(ws + (L == 0 ? WS_WD : WS_WD1)), DEXP / 2};
            int nu_ = __builtin_amdgcn_readfirstlane(ntp[0]) * 8; asm volatile("" : "+s"(nu_)); pg8::GroupOrder S{(const int*)(ws + WS_TILEE), nu_, 8, gdim, xcd_vid(gdim, bidx), (LAS int*)(c.lds + pg8::STAGE_BYTES + 24 * pg8::BM * 4)};
            pg8::EpiFp8 E{(unsigned char*)(ws + WS_Y), D, 8.f / 64.f, rep_};
            pg8::gemm_phase<pg8::EpiFp8, pg8::GroupOrder, false, true>(c.lds, g, S, E, nullptr, c.tid);
            if (L == 0 && S.short_deal()) { REFRESH(); cv_steal(c, CVQ_P11); }
        } } SEAM(pb + 11);
        if (IN(pb + 12)) { for (int rep_ = 0; rep_ <= ((DUPMASK >> 12) & 1); ++rep_) { if (rep_) xcd_barrier(bar); REFRESH(); phase12(c); } }
    }
#undef IN
#undef SEAM
}

#ifndef MK_ONE_LAUNCH
#define MK_ONE_LAUNCH 1
#endif
extern "C" void kernel_launch(void* const* d_in, const int* in_sizes, int n_in, void* d_out, int out_size, void* d_ws, size_t ws_size, hipStream_t stream) {
    static int grid = 0;
    if (grid == 0) {
        if (n_in != 26 || out_size != NLAT * D || ws_size < WS_END) { fprintf(stderr, "kernel_launch: unexpected shapes (n_in %d out %d ws %zu)\n", n_in, out_size, ws_size); grid = -1; return; }
        int dev = 0, cus = 0;
        if (hipGetDevice(&dev) != hipSuccess || hipDeviceGetAttribute(&cus, hipDeviceAttributeMultiprocessorCount, dev) != hipSuccess) { grid = -1; return; }
        if (hipFuncSetAttribute((const void*)fwd, hipFuncAttributeMaxDynamicSharedMemorySize, LDS_BYTES) != hipSuccess) { fprintf(stderr, "kernel_launch: hipFuncSetAttribute failed\n"); grid = -1; return; }
        int per_cu = 0;
        if (hipOccupancyMaxActiveBlocksPerMultiprocessor(&per_cu, (const void*)fwd, 512, LDS_BYTES) != hipSuccess || per_cu < 1) fprintf(stderr, "kernel_launch: occupancy query reports %d\n", per_cu);
        (void)hipGetLastError();
        grid = cus;
    }
    if (grid < 0) return;
    hipMemsetAsync((char*)d_ws + WS_CTL, 0, (size_t)(CW_BAR + XCD_BAR_WORDS) * 4, stream);
    Params prm{};
    for (int i = 0; i < 26; ++i) prm.in[i] = (const GAS float*)d_in[i];
    prm.out = (GAS float*)d_out; prm.ws = (GAS unsigned char*)d_ws;
#if MK_ONE_LAUNCH
    prm.ph_lo = 0; prm.ph_hi = 2 * NPH;
    hipLaunchKernelGGL(fwd, dim3(grid), dim3(512), LDS_BYTES, stream, prm);
#else
    for (int ph = 0; ph < 2 * NPH; ++ph) { prm.ph_lo = ph; prm.ph_hi = ph + 1; hipLaunchKernelGGL(fwd, dim3(grid), dim3(512), LDS_BYTES, stream, prm); }
#endif
}
```

```cpp
#include <hip/hip_runtime.h>
#include <cstdio>

#define DI __device__ __forceinline__
#define LAS __attribute__((address_space(3)))
#if defined(__HIP_DEVICE_COMPILE__)
#define GAS __attribute__((address_space(1)))
#else
#define GAS
#endif
typedef unsigned short bf16;
typedef short bf16x8 __attribute__((ext_vector_type(8)));
typedef short s16x4 __attribute__((ext_vector_type(4)));
typedef float f32x2 __attribute__((ext_vector_type(2)));
typedef float f32x4 __attribute__((ext_vector_type(4)));
typedef float f32x8 __attribute__((ext_vector_type(8)));
typedef float f32x16 __attribute__((ext_vector_type(16)));
typedef unsigned u32x2 __attribute__((ext_vector_type(2)));
typedef unsigned u32x4 __attribute__((ext_vector_type(4)));
typedef __bf16 hbf16x2 __attribute__((ext_vector_type(2)));

constexpr int D = 2048, SEQ = 8192, CTXL = 256, NB = 2;
constexpr int NLAT = NB * SEQ, NCTX = NB * CTXL, NTOK = NLAT + NCTX;
constexpr int PW = 5408, PWP = 5632;
constexpr int NA_Q = 0, NA_K = 512, NA_V = 1024, SC_U = 1536, SC_B = 2048, SC_C = 2560, GL_Q = 3072, GL_K = 3328, GL_V = 3584, GL_G = 4096, GL_Z = 4608, SW_Q = 4640, SW_K = 5152, SW_V = 5280;
constexpr int NEXP = 64, DEXP = 512, NCH = 264;
constexpr int MAXTILES = 658;
constexpr float LN_EPS = 1e-6f, DN_ALPHA = 1.41421356237f;

constexpr size_t MiB = 1u << 20;
constexpr size_t WS_CTL = 0, CTL_BYTES = MiB;
constexpr size_t WS_MOD = 1 * MiB, WS_ROPE = 1 * MiB + 512 * 1024, WS_STATS = 2 * MiB, WS_ROUTW = 3 * MiB, WS_EIDX = 4 * MiB, WS_RANK = 5 * MiB, WS_WTS = 6 * MiB, WS_POS = 7 * MiB,
                 WS_TOKS = 8 * MiB, WS_TILEE = 9 * MiB, WS_GDEC = 10 * MiB, WS_HCTX = 12 * MiB, WS_WIN = 16 * MiB, WS_WOUT = 38 * MiB, WS_WGU = 46 * MiB, WS_WD = 306 * MiB,
                 WS_X1 = 436 * MiB, WS_XN = 568 * MiB, WS_YMIX = 634 * MiB, WS_H = 700 * MiB, WS_UT = WS_H, WS_SIN = WS_H + 66 * MiB, WS_ER = WS_H + 132 * MiB, WS_Y = 865 * MiB, WS_P = WS_Y, WS_XL = WS_Y, WS_XQ = WS_YMIX, WS_XB = WS_X1 + 66 * MiB, WS_T = WS_Y + 192 * MiB,
                 WS_WGU1 = 1523 * MiB, WS_WD1 = 1653 * MiB,
                 WS_END = 1783 * MiB;
constexpr int CW_CNT = 1024, CW_NT = 2048, CW_CV = 3072, CW_BAR = 4096;

DI float bf2f(unsigned v) { return __uint_as_float(v << 16); }
DI unsigned pk2(float a, float b) { hbf16x2 v = __builtin_convertvector((f32x2){a, b}, hbf16x2); return __builtin_bit_cast(unsigned, v); }
DI bf16 f2bf(float a) { return (bf16)(pk2(a, 0.f) & 0xffffu); }
DI float lo16(unsigned u) { return __uint_as_float(u << 16); }
DI float hi16(unsigned u) { return __uint_as_float(u & 0xffff0000u); }
DI bf16x8 pack8(float a0, float a1, float a2, float a3, float a4, float a5, float a6, float a7) {
    u32x4 p; p.x = pk2(a0, a1); p.y = pk2(a2, a3); p.z = pk2(a4, a5); p.w = pk2(a6, a7); return __builtin_bit_cast(bf16x8, p); }
DI void unpack8(bf16x8 v, float (&f)[8]) { u32x4 p = __builtin_bit_cast(u32x4, v); f[0] = lo16(p.x); f[1] = hi16(p.x); f[2] = lo16(p.y); f[3] = hi16(p.y); f[4] = lo16(p.z); f[5] = hi16(p.z); f[6] = lo16(p.w); f[7] = hi16(p.w); }
DI unsigned pk4_fp8(float a, float b, float c, float d) { int p = __builtin_amdgcn_cvt_pk_fp8_f32(a, b, 0, false); p = __builtin_amdgcn_cvt_pk_fp8_f32(c, d, p, true); return (unsigned)p; }
DI int lane_id_fresh() { int l; asm volatile("v_mbcnt_lo_u32_b32 %0, -1, 0\n\tv_mbcnt_hi_u32_b32 %0, -1, %0" : "=v"(l)); return l; }
DI float bperm_f(int srclane, float v) { return __int_as_float(__builtin_amdgcn_ds_bpermute(srclane << 2, __float_as_int(v))); }
DI int bperm_i(int srclane, int v) { return __builtin_amdgcn_ds_bpermute(srclane << 2, v); }
DI float wave_sum(float v) {
    const int l = lane_id_fresh();
#pragma unroll
    for (int o = 1; o < 64; o <<= 1) v += bperm_f(l ^ o, v);
    return v; }
DI int crow(int reg, int h) { return (reg & 3) + 8 * (reg >> 2) + 4 * h; }
#define MFMA32(a, b, c) __builtin_amdgcn_mfma_f32_32x32x16_bf16((a), (b), (c), 0, 0, 0)
#define MFMA16(a, b, c) __builtin_amdgcn_mfma_f32_16x16x32_bf16((a), (b), (c), 0, 0, 0)
DI s16x4 tr_read(LAS unsigned char* p) { return __builtin_amdgcn_ds_read_tr16_b64_v4i16((LAS s16x4*)p); }
DI bf16x8 cat4(s16x4 lo, s16x4 hi) { return __builtin_shufflevector(lo, hi, 0, 1, 2, 3, 4, 5, 6, 7); }
DI f32x16 zero16() { f32x16 z;
#pragma unroll
    for (int i = 0; i < 16; ++i) z[i] = 0.f; return z; }

#ifndef EMU_FP8
#define EMU_FP8 0
#endif
DI float q8(float x) { const int p = __builtin_amdgcn_cvt_pk_fp8_f32(x, x, 0, false); return __builtin_amdgcn_cvt_f32_fp8(p, 0); }
#define XB_TMO      128
#define XB_XCNT(j)  (256  + 64 * (j))
#define XB_XSUB(j)  (1280 + 64 * (j))
#define XB_XGEN(j)  (2304 + 64 * (j))
#define XB_TOP      3328
#define XB_TOPGEN   3392
#define XCD_BAR_WORDS 3456
#define XB_SPIN_CAP (1u << 18)

__device__ __forceinline__ unsigned xb_ld(unsigned* p)              { return __hip_atomic_load(p, __ATOMIC_RELAXED, __HIP_MEMORY_SCOPE_AGENT); }
__device__ __forceinline__ unsigned xb_add(unsigned* p, unsigned v) { return __hip_atomic_fetch_add(p, v, __ATOMIC_RELAXED, __HIP_MEMORY_SCOPE_AGENT); }
__device__ __forceinline__ unsigned xb_xcc_id() { return (unsigned)__builtin_amdgcn_s_getreg((3 << 11) | 20) & 0xFu; }
#define XB_SPIN(cond, bar) do { unsigned _sp = 0; while (cond) { __builtin_amdgcn_s_sleep(1); \
    if ((++_sp & 255u) == 0u) { if (xb_ld(&(bar)[XB_TMO])) break; if (_sp > XB_SPIN_CAP) { atomicAdd(&(bar)[XB_TMO], 1u); break; } } } } while (0)

struct XcdBarrier { unsigned* bar; unsigned x; volatile LAS unsigned* st; unsigned w0; };
__device__ __forceinline__ bool xb_thread0(const XcdBarrier& b) { return b.w0 != 0u && lane_id_fresh() == 0; }

__device__ __forceinline__ XcdBarrier xcd_barrier_post(unsigned* bar, volatile LAS unsigned* st) {
    XcdBarrier b; b.bar = bar; b.x = xb_xcc_id(); b.st = st; b.w0 = (__builtin_amdgcn_readfirstlane(threadIdx.x >> 6) == 0) ? 1u : 0u;
    if (threadIdx.x == 0) (void)xb_add(&bar[XB_XCNT(b.x)], 1u);
    return b;
}
__device__ __forceinline__ void xcd_barrier_complete(unsigned* bar, unsigned x, unsigned& nloc, unsigned& nx) {
    const unsigned G = gridDim.x * gridDim.y * gridDim.z;
    unsigned sum, cnt, mine, sp = 0u;
    for (;;) {
        sum = 0u; cnt = 0u; mine = 0u;
#pragma unroll
        for (unsigned j = 0; j < 16; ++j) { const unsigned c = xb_ld(&bar[XB_XCNT(j)]); sum += c; cnt += (c > 0u) ? 1u : 0u; mine = (j == x) ? c : mine; }
        if (sum == G) break;
        __builtin_amdgcn_s_sleep(1);
        if ((++sp & 255u) == 0u) { if (xb_ld(&bar[XB_TMO])) break; if (sp > XB_SPIN_CAP) { atomicAdd(&bar[XB_TMO], 1u); break; } }
    }
    nloc = mine > 0u ? mine : 1u; nx = cnt > 0u ? cnt : 1u;
}
__device__ __forceinline__ void xcd_barrier(const XcdBarrier& b) {
    asm volatile("s_waitcnt vmcnt(0)" ::: "memory");
    __syncthreads();
    if (xb_thread0(b)) {
        unsigned* bar = b.bar;
        __builtin_amdgcn_s_waitcnt(0);
        unsigned nloc = b.st[0], nx = b.st[1];
        if (nloc == 0u) { xcd_barrier_complete(bar, b.x, nloc, nx); b.st[0] = nloc; b.st[1] = nx; }
        const unsigned old = xb_add(&bar[XB_XSUB(b.x)], 1u);
        const unsigned gen = old / nloc;
        if (old + 1u == (gen + 1u) * nloc) {
            __builtin_amdgcn_fence(__ATOMIC_RELEASE, "agent");
            asm volatile("s_waitcnt vmcnt(0)" ::: "memory");
            const unsigned og = xb_add(&bar[XB_TOP], 1u);
            const unsigned tg = og / nx;
            if (og + 1u == (tg + 1u) * nx) xb_add(&bar[XB_TOPGEN], 1u);
            else XB_SPIN(xb_ld(&bar[XB_TOPGEN]) == tg, bar);
            __builtin_amdgcn_fence(__ATOMIC_ACQUIRE, "agent");
            xb_add(&bar[XB_XGEN(b.x)], 1u);
            asm volatile("s_waitcnt vmcnt(0)" ::: "memory");
        } else {
            XB_SPIN(xb_ld(&bar[XB_XGEN(b.x)]) == gen, bar);
            __builtin_amdgcn_fence(__ATOMIC_ACQUIRE, "agent");
            asm volatile("s_waitcnt vmcnt(0)" ::: "memory");
        }
    }
    __syncthreads();
}

#ifndef PROBE_SKIP_STORES
#define PROBE_SKIP_STORES 0
#endif
namespace pg8 {
constexpr int BM = 256, BK = 64, HALF = 128, HTB = HALF * BK * 2, STAGE_BYTES = 8 * HTB, NXCD = 8, WGM = 8;
__host__ __device__ __forceinline__ int lds_byte(int r, int c) { const int st = (r >> 4) * 2 + (c >> 5), rr = r & 15, cc = c & 31, ob = rr * 64 + cc * 2; return st * 1024 + (ob ^ (((ob >> 9) & 1) << 5)); }
__host__ __device__ __forceinline__ void stage_rc(int b, int& R, int& C) { const int st = b / 1024, sb = b % 1024, swz = sb ^ (((sb >> 9) & 1) << 5); R = (st >> 1) * 16 + swz / 64; C = (st & 1) * 32 + (swz % 64) / 2; }
__host__ __device__ __forceinline__ int perm32(int rho) { const int n = rho >> 4, i = rho & 15; return 8 * (i >> 2) + 4 * n + (i & 3); }

typedef int i32x8 __attribute__((ext_vector_type(8)));
typedef int i32x4 __attribute__((ext_vector_type(4)));
__device__ __forceinline__ i32x8 cat8(bf16x8 a, bf16x8 b) { return __builtin_shufflevector(__builtin_bit_cast(i32x4, a), __builtin_bit_cast(i32x4, b), 0, 1, 2, 3, 4, 5, 6, 7); }
struct Unit { int pm, pn, pc; };
struct Gemm { const bf16* A; const bf16* Bt; int K; };

struct StaticOrder {
    int nM, nN, nwg, G, c;
    __device__ void init(int M, int N, int G_, int c_) { nM = M / BM; nN = N / BM; nwg = nM * nN; G = G_; c = c_; }
    __device__ bool next(int i, Unit& u) const {
        const int L = i * G + c; if (L >= nwg) return false;
        int wgid = L; { const int q = nwg / NXCD, r = nwg % NXCD, xcd = wgid % NXCD, off = wgid / NXCD; wgid = (xcd < r ? xcd * (q + 1) : r * (q + 1) + (xcd - r) * q) + off; }
        const int nig = WGM * nN, gid = wgid / nig, fm = gid * WGM, gsz = (nM - fm) < WGM ? (nM - fm) : WGM;
        u.pm = fm + ((wgid % nig) % gsz); u.pn = (wgid % nig) / gsz; u.pc = u.pn; return true;
    }
    __device__ bool short_deal() const { const int rem = nwg % G; return rem != 0 && c >= rem; }
    static constexpr bool PRELOAD = false;
    __device__ void preload(int) const {}
    __device__ int row_tile(int i) const { Unit u; return next(i, u) ? u.pm : -1; }
};
struct GroupOrder {
    const int* tile_e; int nU, nN, G, c; LAS int* te;
    static constexpr bool PRELOAD = true;
    __device__ void preload(int tid) const { if (tid < 24) { const int L = tid * G + c; te[tid] = L < nU ? tile_e[L / nN] : 0; } }
    __device__ bool next(int i, Unit& u) const {
        const int L = i * G + c; if (L >= nU) return false;
        const int tile = L / nN, j = L % nN;
        u.pm = tile; u.pc = j; u.pn = __builtin_amdgcn_readfirstlane(te[i]) * nN + j; return true;
    }
    __device__ bool short_deal() const { const int rem = nU % G; return rem != 0 && c >= rem; }
    __device__ int row_tile(int i) const { const int L = i * G + c; return L < nU ? L / nN : -1; }
};

struct EpiBf16 {
    static constexpr bool P64 = true; static constexpr int NS = 16;
    bf16* O; int ldc; float scale; int skip;
    __device__ __forceinline__ void operator()(const f32x4 (&acc)[2][2][4][2], const Unit& u, int wr, int wc, int fr, int fq) const {
        if (PROBE_SKIP_STORES && skip) return;
        const int row0 = u.pm * BM + wr * 64 + fr, col0 = u.pc * BM + wc * 64 + 16 * fq;
#pragma unroll
        for (int ai = 0; ai < 2; ++ai)
#pragma unroll
            for (int m = 0; m < 4; ++m) { bf16* rowp = O + (size_t)(row0 + ai * HALF + m * 16) * ldc + col0;
#pragma unroll
                for (int bj = 0; bj < 2; ++bj) { const f32x4 v0 = acc[ai][bj][m][0] * scale, v1 = acc[ai][bj][m][1] * scale;
                    u32x4 w; w.x = pk2(v0[0], v0[1]); w.y = pk2(v0[2], v0[3]); w.z = pk2(v1[0], v1[1]); w.w = pk2(v1[2], v1[3]);
                    *(u32x4*)(rowp + 8 * bj) = w; } }
    }
};
struct EpiFp8 {
    static constexpr bool P64 = true; static constexpr int NS = 8;
    unsigned char* O; int ldc; float scale; int skip;
    __device__ __forceinline__ void operator()(const f32x4 (&acc)[2][2][4][2], const Unit& u, int wr, int wc, int fr, int fq) const {
        if (PROBE_SKIP_STORES && skip) return;
        const int row0 = u.pm * BM + wr * 64 + fr, col0 = u.pc * BM + wc * 64 + 16 * fq;
#pragma unroll
        for (int ai = 0; ai < 2; ++ai)
#pragma unroll
            for (int m = 0; m < 4; ++m) { unsigned char* rowp = O + (size_t)(row0 + ai * HALF + m * 16) * ldc + col0;
                u32x4 w;
#pragma unroll
                for (int bj = 0; bj < 2; ++bj) { const f32x4 v0 = acc[ai][bj][m][0] * scale, v1 = acc[ai][bj][m][1] * scale;
                    w[2 * bj] = pk4_fp8(v0[0], v0[1], v0[2], v0[3]); w[2 * bj + 1] = pk4_fp8(v1[0], v1[1], v1[2], v1[3]); }
                *(u32x4*)rowp = w; }
    }
};
struct EpiSwiglu8 {
    static constexpr bool P64 = false; static constexpr int NS = 8;
    unsigned char* O;
    __device__ __forceinline__ void operator()(const f32x4 (&acc)[2][2][4][2], const Unit& u, int wr, int wc, int fr, int fq) const {
        const int row0 = u.pm * BM + wr * 64 + fr, col0 = u.pc * HALF + wc * 32 + 8 * fq;
#pragma unroll
        for (int ai = 0; ai < 2; ++ai)
#pragma unroll
            for (int m = 0; m < 4; ++m) { unsigned char* rowp = O + (size_t)(row0 + ai * HALF + m * 16) * DEXP + col0;
                float h[8];
#pragma unroll
                for (int n = 0; n < 2; ++n)
#pragma unroll
                    for (int j = 0; j < 4; ++j) { const float g = acc[ai][0][m][n][j], up = acc[ai][1][m][n][j];
                        h[n * 4 + j] = (g * up) * __builtin_amdgcn_rcpf(__builtin_fmaf(__builtin_amdgcn_exp2f(g * (-1.4426950408889634f / 64.f)), 4096.f, 4096.f)); }
                u32x2 w; int p0 = __builtin_amdgcn_cvt_pk_fp8_f32(h[0], h[1], 0, false); p0 = __builtin_amdgcn_cvt_pk_fp8_f32(h[2], h[3], p0, true);
                int p1 = __builtin_amdgcn_cvt_pk_fp8_f32(h[4], h[5], 0, false); p1 = __builtin_amdgcn_cvt_pk_fp8_f32(h[6], h[7], p1, true);
                w.x = (unsigned)p0; w.y = (unsigned)p1;
                *(u32x2*)rowp = w; }
    }
};

template <class Epi, class Sched, bool GATHER, bool FP8 = false>
__device__ __forceinline__ void gemm_phase(LAS unsigned char* lds, const Gemm g, const Sched& S, const Epi& E, const int* toks, int tid_in) {
    int tid_ = tid_in; asm volatile("" : "+v"(tid_));
    const int tid = tid_, wid = __builtin_amdgcn_readfirstlane(tid >> 6), lane = tid & 63, wr = wid >> 2, wc = wid & 3, fr = lane & 15, fq = lane >> 4;
    int K_ = g.K; asm volatile("" : "+s"(K_));
    const int K = K_, nt = K / BK;
    unsigned voffA[2], voffB[2];
#pragma unroll
    for (int i = 0; i < 2; ++i) { int R, C; stage_rc(tid * 16 + i * 8192, R, C);
        const int rho_ = R & 31, Rb = Epi::P64 ? 64 * (R >> 5) + 16 * ((rho_ & 15) >> 2) + 4 * (rho_ >> 4) + (rho_ & 3) : (R & ~31) + perm32(rho_);
        voffA[i] = (unsigned)(R * K + C) * 2u; voffB[i] = (unsigned)(Rb * K + C) * 2u; }
    const size_t kstep = (size_t)(BK * 2);
    const size_t hstep = (size_t)HALF * K * 2;
    const size_t tstep = 2 * hstep;
    const size_t bstep = Epi::P64 ? (size_t)16 * K : hstep;
    const unsigned ldsw = (unsigned)wid * 1024u;
    const int aoff = lds_byte(wr * 64 + fr, fq * 8), boff = lds_byte(wc * 32 + fr, fq * 8);
#define PG8_SA(b, h) (((b) * 2 + (h)) * HTB)
#define PG8_SB(b, h) ((4 + (b) * 2 + (h)) * HTB)
#define PG8_STAGE(bufoff, gbase, voff) do { _Pragma("unroll") for (int _i = 0; _i < 2; ++_i) \
        __builtin_amdgcn_global_load_lds((const unsigned*)((const char*)(gbase) + (voff)[_i]), (LAS unsigned*)(lds + (bufoff) + ldsw + _i * 8192), 16, 0, 0); } while (0)
#define PG8_STAGEA(bufoff, kb, vo, ub, h) do { _Pragma("unroll") for (int _i = 0; _i < 2; ++_i) \
        __builtin_amdgcn_global_load_lds((const unsigned*)(GATHER ? (const char*)g.A + (kb) + (vo)[h][_i] : (ub) + (kb) + (h) * hstep + voffA[_i]), (LAS unsigned*)(lds + (bufoff) + ldsw + _i * 8192), 16, 0, 0); } while (0)
#define PG8_LDA(dst, b, h) do { _Pragma("unroll") for (int m = 0; m < 4; ++m) _Pragma("unroll") for (int k = 0; k < 2; ++k) dst[m][k] = *(const LAS bf16x8*)(lds + PG8_SA(b, h) + aoff + m * 2048 + k * 1024); } while (0)
#define PG8_LDB(dst, b, h) do { _Pragma("unroll") for (int n = 0; n < 2; ++n) _Pragma("unroll") for (int k = 0; k < 2; ++k) dst[n][k] = *(const LAS bf16x8*)(lds + PG8_SB(b, h) + boff + n * 2048 + k * 1024); } while (0)
#define PG8_MMA(ai, bj, At, Bt) do { __builtin_amdgcn_s_setprio(1); _Pragma("unroll") for (int m = 0; m < 4; ++m) _Pragma("unroll") for (int n = 0; n < 2; ++n) { \
        if (FP8) { asm volatile("v_mfma_f32_16x16x128_f8f6f4 %0, %1, %2, %0" : "+v"(acc[ai][bj][m][n]) : "v"(cat8(Bt[n][0], Bt[n][1])), "v"(cat8(At[m][0], At[m][1]))); }   \
        else { _Pragma("unroll") for (int k = 0; k < 2; ++k) acc[ai][bj][m][n] = __builtin_amdgcn_mfma_f32_16x16x32_bf16(Bt[n][k], At[m][k], acc[ai][bj][m][n], 0, 0, 0); } } \
        __builtin_amdgcn_s_setprio(0); } while (0)
#define PG8_WAIT_V(n) asm volatile("s_waitcnt vmcnt(" #n ")" ::: "memory")
#define PG8_WAIT_L(n) asm volatile("s_waitcnt lgkmcnt(" #n ")" ::: "memory")
#define PG8_BAR __builtin_amdgcn_s_barrier()
#define PG8_SCHED __builtin_amdgcn_sched_barrier(0)
    LAS int* ids = (LAS int*)(lds + STAGE_BYTES);
#define PG8_VOA(dst, uidx, un) do { if (GATHER) { _Pragma("unroll") for (int _h = 0; _h < 2; ++_h) _Pragma("unroll") for (int _i = 0; _i < 2; ++_i) { int _t = tid; asm volatile("" : "+v"(_t)); int _R, _C; stage_rc(_t * 16 + _i * 8192, _R, _C); \
        const int _row = ids[(uidx) * BM + _h * HALF + _R]; dst[_h][_i] = (unsigned)(_row * K + _C) * 2u; } } } while (0)
    if (Sched::PRELOAD) { S.preload(tid); __syncthreads(); }
    if (GATHER) {
        const int hi = tid >> 8, r = tid & 255;
        for (int i0 = 0; i0 < 24; i0 += 12) {
            int v[6];
#pragma unroll
            for (int k = 0; k < 6; ++k) { const int pm = S.row_tile(i0 + 2 * k + hi); v[k] = pm >= 0 ? toks[pm * BM + r] : 0; }
#pragma unroll
            for (int k = 0; k < 6; ++k) ids[(i0 + 2 * k + hi) * BM + r] = v[k];
            if (S.row_tile(i0 + 12) < 0) break;
        }
        __syncthreads();
    }
    Unit cur, nxt; int ui = 0;
    if (!S.next(0, cur)) return;
    f32x4 acc[2][2][4][2];
#pragma unroll
    for (int a = 0; a < 2; ++a)
#pragma unroll
        for (int b = 0; b < 2; ++b)
#pragma unroll
            for (int m = 0; m < 4; ++m)
#pragma unroll
                for (int n = 0; n < 2; ++n) acc[a][b][m][n] = (f32x4){0.f, 0.f, 0.f, 0.f};
    bf16x8 At[4][2], B0[2][2], B1[2][2];
    unsigned voA[2][2] = {{0u, 0u}, {0u, 0u}}, voN[2][2] = {{0u, 0u}, {0u, 0u}};
    PG8_VOA(voA, 0, cur);
    const char* cA = (const char*)g.A + (size_t)cur.pm * tstep;
    const char* cB = (const char*)g.Bt + (size_t)cur.pn * tstep;
    PG8_STAGE(PG8_SB(0, 0), cB, voffB); PG8_STAGEA(PG8_SA(0, 0), 0, voA, cA, 0); PG8_STAGE(PG8_SB(0, 1), cB + bstep, voffB); PG8_STAGEA(PG8_SA(0, 1), 0, voA, cA, 1);
    if (wr == 1) PG8_BAR;
    PG8_WAIT_V(4); PG8_BAR;
    PG8_STAGE(PG8_SB(1, 0), cB + kstep, voffB); PG8_STAGEA(PG8_SA(1, 0), kstep, voA, cA, 0); PG8_STAGE(PG8_SB(1, 1), cB + bstep + kstep, voffB);
    PG8_WAIT_V(6); PG8_BAR;
    for (;;) {
        const bool has_next = S.next(ui + 1, nxt);
        if (has_next) { PG8_VOA(voN, ui + 1, nxt); }
        else if (GATHER) {
#pragma unroll
            for (int _h = 0; _h < 2; ++_h)
#pragma unroll
                for (int _i = 0; _i < 2; ++_i) voN[_h][_i] = voA[_h][_i]; }
        const char* nA = has_next ? (const char*)g.A + (size_t)nxt.pm * tstep : cA;
        const char* nB = has_next ? (const char*)g.Bt + (size_t)nxt.pn * tstep : cB;
        for (int t = 0; t < nt; t += 2) {
            const bool last = (t == nt - 2);
            const size_t k1 = (size_t)(t + 1) * kstep;
            const size_t k2 = last ? 0 : (size_t)(t + 2) * kstep, k3 = k2 + kstep;
            const char* b2 = last ? nB : cB + (size_t)(t + 2) * kstep; const char* b3 = b2 + kstep;
            unsigned vo2[2][2] = {{0u, 0u}, {0u, 0u}};
            if (GATHER) {
#pragma unroll
                for (int _h = 0; _h < 2; ++_h)
#pragma unroll
                    for (int _i = 0; _i < 2; ++_i) vo2[_h][_i] = last ? voN[_h][_i] : voA[_h][_i]; }
            const char* a2 = last ? nA : cA;
            const bool pre = (ui > 0) && (t == 0);
            PG8_LDB(B0, 0, 0); PG8_SCHED; PG8_LDA(At, 0, 0); if (!pre) PG8_STAGEA(PG8_SA(1, 1), k1, voA, cA, 1);
            PG8_WAIT_L(8); PG8_BAR; PG8_WAIT_L(0); PG8_MMA(0, 0, At, B0); PG8_BAR; PG8_SCHED;
            PG8_LDB(B1, 0, 1); PG8_STAGE(PG8_SB(0, 0), b2, voffB);
            PG8_BAR; PG8_WAIT_L(0); PG8_MMA(0, 1, At, B1); PG8_BAR;
            PG8_LDA(At, 0, 1); PG8_STAGEA(PG8_SA(0, 0), k2, vo2, a2, 0);
            PG8_BAR; PG8_WAIT_L(0); PG8_MMA(1, 0, At, B0); PG8_BAR; PG8_SCHED;
            PG8_STAGE(PG8_SB(0, 1), b2 + bstep, voffB);
            if (pre) asm volatile("s_waitcnt vmcnt(%0)" :: "n"(6 + Epi::NS) : "memory");
            else PG8_WAIT_V(6);
            PG8_BAR; PG8_MMA(1, 1, At, B1); PG8_BAR;
            PG8_LDB(B0, 1, 0); PG8_SCHED; PG8_LDA(At, 1, 0); PG8_STAGEA(PG8_SA(0, 1), k2, vo2, a2, 1);
            PG8_WAIT_L(8); PG8_BAR; PG8_WAIT_L(0); PG8_MMA(0, 0, At, B0); PG8_BAR; PG8_SCHED;
            PG8_LDB(B1, 1, 1); PG8_STAGE(PG8_SB(1, 0), b3, voffB);
            PG8_BAR; PG8_WAIT_L(0); PG8_MMA(0, 1, At, B1); PG8_BAR;
            PG8_LDA(At, 1, 1); PG8_STAGEA(PG8_SA(1, 0), k3, vo2, a2, 0);
            PG8_BAR; PG8_WAIT_L(0); PG8_MMA(1, 0, At, B0); PG8_BAR; PG8_SCHED;
            PG8_STAGE(PG8_SB(1, 1), b3 + bstep, voffB);
            PG8_WAIT_V(6); PG8_BAR; PG8_MMA(1, 1, At, B1); PG8_BAR;
        }
        if (has_next) PG8_STAGEA(PG8_SA(1, 1), kstep, voN, nA, 1);
        if (FP8) asm volatile("s_nop 15\n\ts_nop 15" ::: "memory");
        E(acc, cur, wr, wc, fr, fq);
        if (!has_next) break;
#pragma unroll
        for (int a = 0; a < 2; ++a)
#pragma unroll
            for (int b = 0; b < 2; ++b)
#pragma unroll
                for (int m = 0; m < 4; ++m)
#pragma unroll
                    for (int n = 0; n < 2; ++n) acc[a][b][m][n] = (f32x4){0.f, 0.f, 0.f, 0.f};
        cur = nxt; cA = nA; cB = nB; ++ui;
        if (GATHER) {
#pragma unroll
            for (int _h = 0; _h < 2; ++_h)
#pragma unroll
                for (int _i = 0; _i < 2; ++_i) voA[_h][_i] = voN[_h][_i]; }
    }
    PG8_WAIT_V(0);
    if (wr == 0) PG8_BAR;
    PG8_BAR;
#undef PG8_SA
#undef PG8_SB
#undef PG8_STAGE
#undef PG8_STAGEA
#undef PG8_LDA
#undef PG8_LDB
#undef PG8_MMA
#undef PG8_WAIT_V
#undef PG8_WAIT_L
#undef PG8_BAR
#undef PG8_SCHED
#undef PG8_VOA
}
}
struct Params {
    const GAS float* in[26];
    GAS float* out;
    GAS unsigned char* ws;
    int ph_lo, ph_hi;
};
typedef const Params __attribute__((address_space(4))) CParams;
constexpr int NPH = 13;
constexpr int WAVE_LDS = 19968;
constexpr int LDS_MISC = 8 * WAVE_LDS;
constexpr int LDS_BYTES = LDS_MISC + 1024;

struct Ctx {
    LAS unsigned char* lds; int tid, lane, wave, gw, ngw, L, bid, nblk;
    CParams* p;
    unsigned char* ws;
};
DI unsigned char* fresh(GAS unsigned char* q) { asm volatile("" : "+s"(q)); return (unsigned char*)q; }
#define inp(c, k) ((const float*)(c).p->in[k])
#define outp(c) ((float*)(c).p->out)

DI void transpose_item(const float* W, int K, int N, bf16* WT, int drow0, LAS float* scr, int kb, int nb, int lane, bool lo_part, float qs = 0.f) {
    const int k0 = 64 * kb, n0 = 32 * nb;
#pragma unroll 8
    for (int i = 0; i < 32; ++i) { const int kk = 2 * i + (lane >> 5); scr[kk * 33 + (lane & 31)] = W[(size_t)(k0 + kk) * N + n0 + (lane & 31)]; }
    asm volatile("s_waitcnt lgkmcnt(0)" ::: "memory");
    const int c = lane & 7;
#pragma unroll
    for (int j = 0; j < 4; ++j) { const int n = (lane >> 3) + 8 * j; const LAS float* s = scr + (8 * c) * 33 + n;
        float v[8];
#pragma unroll
        for (int q = 0; q < 8; ++q) { v[q] = s[q * 33]; if (lo_part) v[q] = v[q] - bf2f(f2bf(v[q])); if (EMU_FP8 && qs != 0.f) v[q] = q8(v[q] * qs) / qs; }
        u32x4 o; o.x = pk2(v[0], v[1]); o.y = pk2(v[2], v[3]); o.z = pk2(v[4], v[5]); o.w = pk2(v[6], v[7]);
        *(u32x4*)(WT + (size_t)(drow0 + n) * K + k0 + 8 * c) = o; }
    asm volatile("s_waitcnt lgkmcnt(0)" ::: "memory");
}

DI void transpose_item8(const float* W, int K, int N, unsigned char* WT, int drow0, LAS float* scr, int kb, int nb, int lane) {
    const int k0 = 64 * kb, n0 = 64 * nb;
    f32x4 v[16];
    const int ncol = min(n0 + 4 * (lane & 15), N - 4);
#pragma unroll
    for (int i = 0; i < 16; ++i) v[i] = *(const f32x4*)(W + (size_t)(k0 + 4 * i + (lane >> 4)) * N + ncol);
#pragma unroll
    for (int i = 0; i < 16; ++i) { LAS float* d = scr + (4 * i + (lane >> 4)) * 65 + 4 * (lane & 15); d[0] = v[i].x; d[1] = v[i].y; d[2] = v[i].z; d[3] = v[i].w; }
    asm volatile("s_waitcnt lgkmcnt(0)" ::: "memory");
    const int c = lane & 7;
#pragma unroll
    for (int j = 0; j < 8; ++j) { const int n = (lane >> 3) + 8 * j; const LAS float* s = scr + (8 * c) * 65 + n;
        float q[8];
#pragma unroll
        for (int e = 0; e < 8; ++e) q[e] = s[e * 65] * 64.f;
        int p0 = __builtin_amdgcn_cvt_pk_fp8_f32(q[0], q[1], 0, false); p0 = __builtin_amdgcn_cvt_pk_fp8_f32(q[2], q[3], p0, true);
        int p1 = __builtin_amdgcn_cvt_pk_fp8_f32(q[4], q[5], 0, false); p1 = __builtin_amdgcn_cvt_pk_fp8_f32(q[6], q[7], p1, true);
        u32x2 o; o.x = (unsigned)p0; o.y = (unsigned)p1;
        *(u32x2*)(WT + (size_t)(drow0 + n) * K + k0 + 8 * c) = o; }
    asm volatile("s_waitcnt lgkmcnt(0)" ::: "memory");
}

struct CvItem { const float* src; unsigned char* dst; int K, N; };
DI bool cv_decode(const Ctx& c, int L, int r, CvItem& it) {
    constexpr int I_E = 768;
    if (r >= 65 * I_E) return false;
    unsigned char* ws = c.ws; const size_t wgu_off = L == 0 ? WS_WGU : WS_WGU1, wd_off = L == 0 ? WS_WD : WS_WD1;
    const int e = r / I_E, q = r % I_E, which = q / 256, idx = q % 256;
    if (which < 2) {
        const float* W = e < 64 ? inp(c, which == 0 ? 18 : 19) + ((size_t)(L * 64 + e)) * D * DEXP : inp(c, which == 0 ? 21 : 22) + (size_t)L * D * DEXP;
        const int kb = idx / 8, nb = idx % 8, n0 = 64 * nb, k0 = 64 * kb;
        it.K = D; it.N = DEXP; it.src = W + (size_t)k0 * DEXP + n0;
        it.dst = (unsigned char*)(ws + wgu_off) + (size_t)(e * 1024 + (n0 / 128) * 256 + which * 128 + (n0 % 128)) * D + k0;
    } else {
        const float* W = e < 64 ? inp(c, 20) + ((size_t)(L * 64 + e)) * DEXP * D : inp(c, 23) + (size_t)L * DEXP * D;
        const int kb = idx / 32, nb = idx % 32, n0 = 64 * nb, k0 = 64 * kb;
        it.K = DEXP; it.N = D; it.src = W + (size_t)k0 * D + n0;
        it.dst = (unsigned char*)(ws + wd_off) + (size_t)(e * 2048 + n0) * DEXP + k0;
    }
    return true;
}
DI void cv_load(const CvItem& it, f32x4 (&v)[16], int lane) {
#pragma unroll
    for (int i = 0; i < 16; ++i) v[i] = __builtin_nontemporal_load((const f32x4*)(it.src + (size_t)(4 * i + (lane >> 4)) * it.N + 4 * (lane & 15)));
}
DI void cv_store(const CvItem& it, const f32x4 (&v)[16], LAS float* scr, int lane) {
#pragma unroll
    for (int i = 0; i < 16; ++i) { LAS float* d = scr + (4 * i + (lane >> 4)) * 65 + 4 * (lane & 15); d[0] = v[i].x; d[1] = v[i].y; d[2] = v[i].z; d[3] = v[i].w; }
    asm volatile("s_waitcnt lgkmcnt(0)" ::: "memory");
    const int c8 = lane & 7;
#pragma unroll
    for (int j = 0; j < 8; ++j) { const int n = (lane >> 3) + 8 * j; const LAS float* s = scr + (8 * c8) * 65 + n;
        float q[8];
#pragma unroll
        for (int e = 0; e < 8; ++e) q[e] = s[e * 65] * 64.f;
        u32x2 o; o.x = pk4_fp8(q[0], q[1], q[2], q[3]); o.y = pk4_fp8(q[4], q[5], q[6], q[7]);
        *(u32x2*)(it.dst + (size_t)n * it.K + 8 * c8) = o; }
    asm volatile("s_waitcnt lgkmcnt(0)" ::: "memory");
}
DI void convert_experts(const Ctx& c, int L, int it0, int step) {
    LAS float* scr = (LAS float*)(c.lds + c.wave * WAVE_LDS);
    CvItem ia, ib; f32x4 va[16], vb[16];
    int r = it0;
    bool ha = cv_decode(c, L, r, ia); if (ha) cv_load(ia, va, c.lane);
    while (ha) {
        const bool hb = cv_decode(c, L, r + step, ib); if (hb) cv_load(ib, vb, c.lane);
        cv_store(ia, va, scr, c.lane);
        if (!hb) break;
        ha = cv_decode(c, L, r + 2 * step, ia); if (ha) cv_load(ia, va, c.lane);
        cv_store(ib, vb, scr, c.lane);
        r += 2 * step;
    }
}
DI void cv_steal(const Ctx& c, int npairs) {
    LAS float* scr = (LAS float*)(c.lds + c.wave * WAVE_LDS);
    unsigned* ctr = (unsigned*)(c.ws + WS_CTL) + CW_CV;
    for (int i = 0; i < npairs; ++i) {
        unsigned idx = 0u;
        if (c.lane == 0) idx = __hip_atomic_fetch_add(ctr, 2u, __ATOMIC_RELAXED, __HIP_MEMORY_SCOPE_AGENT);
        const int r = __builtin_amdgcn_readfirstlane((int)idx);
        CvItem ia, ib; f32x4 va[16], vb[16];
        const bool ha = cv_decode(c, 1, r, ia); if (!ha) break;
        cv_load(ia, va, c.lane);
        const bool hb = cv_decode(c, 1, r + 1, ib); if (hb) cv_load(ib, vb, c.lane);
        cv_store(ia, va, scr, c.lane);
        if (hb) cv_store(ib, vb, scr, c.lane);
    }
}

DI void phase0(const Ctx& c) {
    const int L = c.L;
    unsigned char* ws = c.ws;
    if (L == 0) {
        LAS float* sc = (LAS float*)c.lds;
        LAS float* part = (LAS float*)(c.lds + 32768);
        for (int i = c.tid; i < 3 * D; i += 512) { const int r = i / D, k = i % D; const float v = r < 2 ? inp(c, 1)[r * D + k] : inp(c, 3)[k]; sc[i] = v / (1.f + __expf(-v)); }
        __syncthreads();
        for (int cb = c.bid; cb < 512; cb += c.nblk) {
            const int Lm = cb >> 8, n0 = (cb & 255) * 48;
            const float* wa = inp(c, 4) + (size_t)Lm * D * 6 * D; const float* ba = inp(c, 5) + (size_t)Lm * 6 * D;
            float* mod = (float*)(ws + WS_MOD) + (size_t)Lm * 3 * 6 * D;
            float a0 = 0.f, a1 = 0.f, a2 = 0.f;
            if (c.lane < 48) {
                const float* wp = wa + (size_t)(c.wave * 256) * (6 * D) + n0 + c.lane;
                for (int k0 = 0; k0 < 256; k0 += 32) {
                    float wv[32];
#pragma unroll
                    for (int k = 0; k < 32; ++k) wv[k] = wp[(size_t)(k0 + k) * (6 * D)];
#pragma unroll
                    for (int k = 0; k < 32; ++k) { const int kk = c.wave * 256 + k0 + k; a0 += sc[kk] * wv[k]; a1 += sc[D + kk] * wv[k]; a2 += sc[2 * D + kk] * wv[k]; }
                }
                part[(c.wave * 3 + 0) * 48 + c.lane] = a0; part[(c.wave * 3 + 1) * 48 + c.lane] = a1; part[(c.wave * 3 + 2) * 48 + c.lane] = a2;
            }
            __syncthreads();
            if (c.tid < 144) { const int r = c.tid / 48, j = c.tid % 48; float s = 0.f;
#pragma unroll
                for (int w = 0; w < 8; ++w) s += part[(w * 3 + r) * 48 + j];
                mod[r * 6 * D + n0 + j] = s + ba[n0 + j]; }
            __syncthreads();
        }
    }
    __syncthreads();
    {
        LAS float* scr = (LAS float*)(c.lds + c.wave * WAVE_LDS);
        constexpr int I_IN = 32 * ((PW + 63) / 64), I_OUT = 32 * 32, I_R = 64;
        constexpr int NIT = I_IN + I_OUT + 2 * I_R;
        bf16* win = (bf16*)(ws + WS_WIN); bf16* wout = (bf16*)(ws + WS_WOUT); bf16* rw = (bf16*)(ws + WS_ROUTW);
        for (int it = c.gw; it < NIT; it += c.ngw) {
            int r = it;
            if (r < I_IN) { const int nblk = (PW + 63) / 64; transpose_item8(inp(c, 6) + (size_t)L * D * PW, D, PW, (unsigned char*)win, 64 * (r % nblk), scr, r / nblk, r % nblk, c.lane); continue; } r -= I_IN;
            if (r < I_OUT) { transpose_item8(inp(c, 13) + (size_t)L * D * D, D, D, (unsigned char*)wout, 64 * (r % 32), scr, r / 32, r % 32, c.lane); continue; } r -= I_OUT;
            { const int lo = r / I_R, idx = r % I_R, kb = idx / 2, nb = idx % 2;
              transpose_item(inp(c, 16) + (size_t)L * D * NEXP, D, NEXP, rw, lo * 64 + 32 * nb, scr, kb, nb, c.lane, lo != 0); }
        }
    }
    if (L == 0) convert_experts(c, 0, c.gw, c.ngw);
    else { const int r0 = (int)__hip_atomic_load((unsigned*)(c.ws + WS_CTL) + CW_CV, __ATOMIC_RELAXED, __HIP_MEMORY_SCOPE_AGENT);
           convert_experts(c, 1, r0 + c.gw, c.ngw); }
    if (L == 0) {
        float* rope = (float*)(ws + WS_ROPE);
        for (int i = c.bid * 512 + c.tid; i < 128 * 16; i += c.nblk * 512) {
            const int pos = i / 16, f = i % 16;
            const float inv = exp2f(-(float)f * (13.287712379549449f / 16.f));
            const float ang = (float)pos * inv;
            const float n = rintf(ang * 0.15915494309189535f);
            float rr = fmaf(-n, 6.28125f, ang); rr = fmaf(-n, 1.9353071795864769e-3f, rr);
            rope[2 * i] = __cosf(rr); rope[2 * i + 1] = __sinf(rr);
        }
    }
}

DI void row_stats(const f32x4 (&v)[8], float& mean, float& rstd) {
    float s = 0.f;
#pragma unroll
    for (int j = 0; j < 8; ++j) s += (v[j].x + v[j].y) + (v[j].z + v[j].w);
    mean = wave_sum(s) * (1.f / D);
    float q = 0.f;
#pragma unroll
    for (int j = 0; j < 8; ++j) { const f32x4 d = v[j] - mean; q += (d.x * d.x + d.y * d.y) + (d.z * d.z + d.w * d.w); }
    rstd = 1.f / sqrtf(wave_sum(q) * (1.f / D) + LN_EPS);
}
DI const float* mod_row_l(const Ctx& c, int row, int l) { return (const float*)(c.ws + WS_MOD) + (size_t)(l * 3 + (row < NLAT ? row / SEQ : 2)) * 6 * D; }
DI const float* mod_row(const Ctx& c, int row) { return mod_row_l(c, row, c.L); }
DI const float* x_in_row(const Ctx& c, int row) {

    if (row < NLAT) return inp(c, 0) + (size_t)row * D;
    return inp(c, 2) + (size_t)(row - NLAT) * D;
}

DI void phase1(const Ctx& c) {
    unsigned char* xn = (unsigned char*)(c.ws + WS_XN);
    for (int r2 = c.gw; r2 < NTOK / 2; r2 += c.ngw) {
        f32x4 v[2][8]; float mean[2], rstd[2];
#pragma unroll
        for (int u = 0; u < 2; ++u) { const float* xr = x_in_row(c, 2 * r2 + u);
#pragma unroll
            for (int j = 0; j < 8; ++j) v[u][j] = *(const f32x4*)(xr + 4 * c.lane + 256 * j); }
#pragma unroll
        for (int u = 0; u < 2; ++u) row_stats(v[u], mean[u], rstd[u]);
        const float* mod = mod_row(c, 2 * r2);
#pragma unroll
        for (int j = 0; j < 8; ++j) { const int col = 4 * c.lane + 256 * j;
            const f32x4 sh = *(const f32x4*)(mod + col), sc = *(const f32x4*)(mod + D + col);
#pragma unroll
            for (int u = 0; u < 2; ++u) { const f32x4 y = (v[u][j] - mean[u]) * rstd[u] * (sc + 1.f) + sh;
                *(unsigned*)(xn + (size_t)(2 * r2 + u) * D + col) = pk4_fp8(y.x, y.y, y.z, y.w); } }
    }
}

DI void phase7(const Ctx& c) {
    const int L = c.L;
    bf16* xl = (bf16*)(c.ws + WS_XL); const bf16* T = (const bf16*)(c.ws + WS_T); bf16* x1 = (bf16*)(c.ws + WS_X1);
    const bf16* xb = (const bf16*)(c.ws + WS_XB);
    const float* lg = inp(c, 14) + (size_t)L * D; const float* lb = inp(c, 15) + (size_t)L * D;
    const int nrows = L == 0 ? NTOK : NLAT;
    for (int r2 = c.gw; r2 < nrows / 2; r2 += c.ngw) {
        const float* mod = mod_row(c, 2 * r2);
        f32x4 v[2][8]; float mean[2], rstd[2];
#pragma unroll
        for (int u = 0; u < 2; ++u) { const int row = 2 * r2 + u;
            if (L == 0) { const float* xr = x_in_row(c, row);
#pragma unroll
                for (int j = 0; j < 8; ++j) v[u][j] = *(const f32x4*)(xr + 4 * c.lane + 256 * j); }
            else {
#pragma unroll
                for (int j = 0; j < 8; ++j) { const u32x2 t = *(const u32x2*)(xb + (size_t)row * D + 4 * c.lane + 256 * j); v[u][j] = (f32x4){lo16(t.x), hi16(t.x), lo16(t.y), hi16(t.y)}; } }
#pragma unroll
            for (int j = 0; j < 8; ++j) { const int col = 4 * c.lane + 256 * j;
                const f32x4 g = *(const f32x4*)(mod + 2 * D + col);
                const u32x2 t = *(const u32x2*)(T + (size_t)row * D + col);
                v[u][j] = v[u][j] * DN_ALPHA + g * (f32x4){lo16(t.x), hi16(t.x), lo16(t.y), hi16(t.y)}; } }
#pragma unroll
        for (int u = 0; u < 2; ++u) row_stats(v[u], mean[u], rstd[u]);
#pragma unroll
        for (int j = 0; j < 8; ++j) { const int col = 4 * c.lane + 256 * j; const f32x4 gg = *(const f32x4*)(lg + col), bb = *(const f32x4*)(lb + col);
#pragma unroll
            for (int u = 0; u < 2; ++u) { v[u][j] = (v[u][j] - mean[u]) * rstd[u] * gg + bb; u32x2 o; o.x = pk2(v[u][j].x, v[u][j].y); o.y = pk2(v[u][j].z, v[u][j].w); *(u32x2*)(x1 + (size_t)(2 * r2 + u) * D + col) = o; } }
#pragma unroll
        for (int u = 0; u < 2; ++u) row_stats(v[u], mean[u], rstd[u]);
#pragma unroll
        for (int j = 0; j < 8; ++j) { const int col = 4 * c.lane + 256 * j;
            const f32x4 sh = *(const f32x4*)(mod + 3 * D + col), sc = *(const f32x4*)(mod + 4 * D + col);
#pragma unroll
            for (int u = 0; u < 2; ++u) { const f32x4 y = (v[u][j] - mean[u]) * rstd[u] * (sc + 1.f) + sh;
                int pq = __builtin_amdgcn_cvt_pk_fp8_f32(y.x, y.y, 0, false); pq = __builtin_amdgcn_cvt_pk_fp8_f32(y.z, y.w, pq, true);
                const f32x2 qa = __builtin_amdgcn_cvt_pk_f32_fp8(pq, false), qb = __builtin_amdgcn_cvt_pk_f32_fp8(pq, true);
                u32x2 ol; ol.x = pk2(y.x - qa.x, y.y - qa.y); ol.y = pk2(y.z - qb.x, y.w - qb.y);
                *(u32x2*)(xl + (size_t)(2 * r2 + u) * D + col) = ol;
                *(int*)((unsigned char*)(c.ws + WS_XQ) + (size_t)(2 * r2 + u) * D + col) = pq; } }
    }
}
constexpr float QK_SCALE_L2 = 0.125f * 1.4426950408889634f, LOG2E = 1.4426950408889634f;
constexpr int VSTR = 144;
struct AttnAcc { f32x16 o0, o1; float m, l; };
DI void attn_init(AttnAcc& a) { a.o0 = zero16(); a.o1 = zero16(); a.m = -INFINITY; a.l = 0.f; }

constexpr int KLOFF = 12288;
struct KV { u32x4 k[4]; u32x4 v[4]; };
template <class RowF>
DI void attn_load(KV& t, const bf16* P, RowF rowf, int kcol, int vcol, int lane) {
#pragma unroll
    for (int i = 0; i < 4; ++i) { const bf16* rp = P + (size_t)rowf((lane >> 3) + 8 * i) * PWP + (lane & 7) * 8; t.k[i] = *(const u32x4*)(rp + kcol); t.v[i] = *(const u32x4*)(rp + vcol); }
}
struct PlainScore {};
template <class ScoreF>
DI void attn_tile(AttnAcc& a, const bf16x8 (&qf)[4], const u32x4 (&kr)[4], const u32x4 (&vr)[4], LAS unsigned char* vl, int lane, ScoreF sf) {
    const int half = lane >> 5;
    bf16x8 kf[4];
    {
        LAS unsigned char* d = vl + (lane >> 3) * VSTR + (lane & 7) * 16;
#pragma unroll
        for (int i = 0; i < 4; ++i) { *(LAS u32x4*)(d + KLOFF + 8 * i * VSTR) = kr[i]; *(LAS u32x4*)(d + 8 * i * VSTR) = vr[i]; }
        const LAS unsigned char* ks = vl + KLOFF + (lane & 31) * VSTR + 16 * half;
#pragma unroll
        for (int s = 0; s < 4; ++s) kf[s] = *(const LAS bf16x8*)(ks + 32 * s);
    }
    f32x16 st = zero16();
#pragma unroll
    for (int s = 0; s < 4; ++s) st = MFMA32(kf[s], qf[s], st);
    float sc[16]; float mx = -INFINITY;
    constexpr bool PLAIN = __is_same(ScoreF, PlainScore);
    if constexpr (PLAIN) {
#pragma unroll
        for (int r = 0; r < 16; ++r) mx = fmaxf(mx, st[r]);
        mx = fmaxf(mx, bperm_f(lane ^ 32, mx)) * QK_SCALE_L2;
    } else {
#pragma unroll
        for (int r = 0; r < 16; ++r) { sc[r] = sf(r, crow(r, half), st[r]); mx = fmaxf(mx, sc[r]); }
        mx = fmaxf(mx, bperm_f(lane ^ 32, mx));
    }
    const float mnew = fmaxf(a.m, mx);
    const float muse = (mnew == -INFINITY) ? 0.f : mnew;
    float ps = 0.f;
#pragma unroll
    for (int r = 0; r < 16; ++r) { if constexpr (PLAIN) sc[r] = __builtin_amdgcn_exp2f(__builtin_fmaf(st[r], QK_SCALE_L2, -muse)); else sc[r] = __builtin_amdgcn_exp2f(sc[r] - muse); ps += sc[r]; }
    ps += bperm_f(lane ^ 32, ps);
    if (__any(mnew != a.m)) {
        const float corr = __builtin_amdgcn_exp2f(a.m - muse);
        a.l *= corr;
#pragma unroll
        for (int r = 0; r < 16; ++r) { a.o0[r] *= corr; a.o1[r] *= corr; }
    }
    a.l += ps; a.m = mnew;
    const bf16x8 pb0 = pack8(sc[0], sc[1], sc[2], sc[3], sc[4], sc[5], sc[6], sc[7]);
    const bf16x8 pb1 = pack8(sc[8], sc[9], sc[10], sc[11], sc[12], sc[13], sc[14], sc[15]);
    const int q = (lane & 15) >> 2, pp = lane & 3, blk = (lane >> 4) & 1;
    LAS unsigned char* vb = vl + (4 * half + q) * VSTR + (16 * blk + 4 * pp) * 2;
    { const bf16x8 A = cat4(tr_read(vb), tr_read(vb + 8 * VSTR)); a.o0 = MFMA32(A, pb0, a.o0); }
    { const bf16x8 A = cat4(tr_read(vb + 64), tr_read(vb + 8 * VSTR + 64)); a.o1 = MFMA32(A, pb0, a.o1); }
    { const bf16x8 A = cat4(tr_read(vb + 16 * VSTR), tr_read(vb + 24 * VSTR)); a.o0 = MFMA32(A, pb1, a.o0); }
    { const bf16x8 A = cat4(tr_read(vb + 16 * VSTR + 64), tr_read(vb + 24 * VSTR + 64)); a.o1 = MFMA32(A, pb1, a.o1); }
}
DI void attn_store(const AttnAcc& a, unsigned char* y0, LAS unsigned char* ol, int lane) {
    const int half = lane >> 5; const float inv = 1.f / a.l;
    LAS unsigned char* d = ol + (lane & 31) * 80 + 4 * half;
#pragma unroll
    for (int g = 0; g < 4; ++g) {
        *(LAS unsigned*)(d + 8 * g) = pk4_fp8(a.o0[4 * g] * inv, a.o0[4 * g + 1] * inv, a.o0[4 * g + 2] * inv, a.o0[4 * g + 3] * inv);
        *(LAS unsigned*)(d + 32 + 8 * g) = pk4_fp8(a.o1[4 * g] * inv, a.o1[4 * g + 1] * inv, a.o1[4 * g + 2] * inv, a.o1[4 * g + 3] * inv); }
#pragma unroll
    for (int i = 0; i < 2; ++i) { const int row = 16 * i + (lane >> 2);
        *(u32x4*)(y0 + (size_t)row * D + (lane & 3) * 16) = *(const LAS u32x4*)(ol + row * 80 + (lane & 3) * 16); }
}
DI void load_frags(bf16x8 (&f)[4], const bf16* row, int half) {
#pragma unroll
    for (int s = 0; s < 4; ++s) f[s] = *(const bf16x8*)(row + 16 * s + 8 * half);
}
DI void rope_frags(bf16x8 (&f)[4], int posr, int posc, int half, const float* rope) {
#pragma unroll
    for (int pr = 0; pr < 2; ++pr) {
        const int pos = pr == 0 ? posr : posc;
        const f32x4* t = (const f32x4*)(rope + (size_t)(pos * 16 + 8 * half) * 2);
        const f32x4 t0 = t[0], t1 = t[1], t2 = t[2], t3 = t[3];
        const float cs[16] = {t0.x, t0.y, t0.z, t0.w, t1.x, t1.y, t1.z, t1.w, t2.x, t2.y, t2.z, t2.w, t3.x, t3.y, t3.z, t3.w};
        float x1[8], x2[8]; unpack8(f[2 * pr], x1); unpack8(f[2 * pr + 1], x2);
        float y1[8], y2[8];
#pragma unroll
        for (int e = 0; e < 8; ++e) { const float co = cs[2 * e], si = cs[2 * e + 1]; y1[e] = x1[e] * co - x2[e] * si; y2[e] = x2[e] * co + x1[e] * si; }
        f[2 * pr] = pack8(y1[0], y1[1], y1[2], y1[3], y1[4], y1[5], y1[6], y1[7]);
        f[2 * pr + 1] = pack8(y2[0], y2[1], y2[2], y2[3], y2[4], y2[5], y2[6], y2[7]);
    }
}

DI void na_item(const Ctx& c, int item) {
    const bf16* P = (const bf16*)(c.ws + WS_P); unsigned char* Y = (unsigned char*)(c.ws + WS_YMIX);
    const int lane = c.lane, half = lane >> 5, j = lane & 31;
    const int cc = item & 1, g_ = item >> 3, h = (g_ >> 3) & 7, r = (((g_ & 7) | (((g_ >> 6) & 3) << 3)) << 2) | ((item >> 1) & 3), b = g_ >> 8;
    const float* rpb = inp(c, 7) + (size_t)(c.L * 8 + h) * 15 * 31;
    LAS unsigned char* vl = c.lds + c.wave * WAVE_LDS; LAS float* tbl = (LAS float*)(vl + 32 * VSTR);
#pragma unroll
    for (int i = 0; i < 8; ++i) { const int e = lane + 64 * i; if (e < 15 * 31) tbl[(e / 31) * 128 + 48 + (e % 31)] = rpb[e] * LOG2E; }
    const int qrow = b * SEQ + r * 64 + 32 * cc + j;
    bf16x8 qf[4]; load_frags(qf, P + (size_t)qrow * PWP + NA_Q + h * 64, half);
    const int qc = 32 * cc + j, cstart = min(max(qc - 8, 0), 48);
    const int rs = min(max(r - 4, 0), 120);
    const int cb8 = cc ? 24 : 32;
    unsigned okf = 0u, okp = 0u;
#pragma unroll
    for (int rr = 0; rr < 16; ++rr) { const int kf = 32 * cc + crow(rr, half), kp = cb8 + (rr & 3) + 4 * half;
        okf |= ((kf >= cstart) && (kf < cstart + 16)) ? (1u << rr) : 0u; okp |= ((kp >= cstart) && (kp < cstart + 16)) ? (1u << rr) : 0u; }
    AttnAcc a; attn_init(a);
    auto key_row = [&](int t, int i) {
        if (t < 8) return b * SEQ + (rs + t) * 64 + 32 * cc + i;
        if (t < 10) return b * SEQ + (rs + 4 * (t - 8) + (i >> 3)) * 64 + cb8 + (i & 7);
        return NLAT + b * CTXL + 32 * (t - 10) + i; };
    auto load = [&](KV& kv, int t) { attn_load(kv, P, [&](int i) { return key_row(t, i); }, NA_K + h * 64, NA_V + h * 64, lane); };
    auto full = [&](KV& kv, int t) {
        const LAS float* bp = tbl + (rs + t - r + 7) * 128 + 32 * cc - qc + 63 + 4 * half;
        attn_tile(a, qf, kv.k, kv.v, vl, lane, [&](int rr, int, float raw) { const float sb = raw * QK_SCALE_L2 + bp[crow(rr, 0)]; return ((okf >> rr) & 1u) ? sb : -INFINITY; }); };
    auto packed = [&](KV& kv, int t) {
        const LAS float* bp = tbl + (rs + 4 * (t - 8) - r + 7) * 128 + cb8 - qc + 63 + 4 * half;
        attn_tile(a, qf, kv.k, kv.v, vl, lane, [&](int rr, int, float raw) { const float sb = raw * QK_SCALE_L2 + bp[(rr >> 2) * 128 + (rr & 3)]; return ((okp >> rr) & 1u) ? sb : -INFINITY; }); };
    auto ctx = [&](KV& kv) { attn_tile(a, qf, kv.k, kv.v, vl, lane, PlainScore{}); };
    KV A, B; load(A, 0);
    for (int t = 0; t < 8; t += 2) { load(B, t + 1); full(A, t); load(A, t + 2); full(B, t + 1); }
    { load(B, 9); packed(A, 8); load(A, 10); packed(B, 9); }
    for (int t = 10; t < 18; t += 2) { load(B, t + 1); ctx(A); if (t + 2 < 18) load(A, t + 2); ctx(B); }
    attn_store(a, Y + (size_t)(qrow - j) * D + h * 64, vl, lane);
}

DI void rope_prepass(const Ctx& c) {
    bf16* P = (bf16*)(c.ws + WS_P); const float* rope = (const float*)(c.ws + WS_ROPE);
    for (int r0 = c.gw * 8; r0 < NLAT; r0 += c.ngw * 8) {
        u32x4 xa[5], xb[5]; f32x4 cs[5][4]; bf16* bp[5];
#pragma unroll
        for (int i = 0; i < 5; ++i) {
            const int q = c.lane + 64 * i, rk = q / 40, u = q - 40 * rk, row = r0 + rk, t = row % SEQ, pr = t >> 6, pc = t & 63;
            const int head = u >> 2, hs = (u >> 1) & 1, g = u & 1;
            bp[i] = P + (size_t)row * PWP + SW_Q + head * 64 + 32 * hs + 8 * g;
            xa[i] = *(const u32x4*)bp[i]; xb[i] = *(const u32x4*)(bp[i] + 16);
            const f32x4* tp = (const f32x4*)(rope + (size_t)((hs ? pc : pr) * 16 + 8 * g) * 2);
            cs[i][0] = tp[0]; cs[i][1] = tp[1]; cs[i][2] = tp[2]; cs[i][3] = tp[3];
        }
#pragma unroll
        for (int i = 0; i < 5; ++i) {
            float x1[8], x2[8], y1[8], y2[8]; unpack8(__builtin_bit_cast(bf16x8, xa[i]), x1); unpack8(__builtin_bit_cast(bf16x8, xb[i]), x2);
#pragma unroll
            for (int e = 0; e < 8; ++e) { const float co = cs[i][e >> 1][2 * (e & 1)], si = cs[i][e >> 1][2 * (e & 1) + 1]; y1[e] = x1[e] * co - x2[e] * si; y2[e] = x2[e] * co + x1[e] * si; }
            *(bf16x8*)bp[i] = pack8(y1[0], y1[1], y1[2], y1[3], y1[4], y1[5], y1[6], y1[7]);
            *(bf16x8*)(bp[i] + 16) = pack8(y2[0], y2[1], y2[2], y2[3], y2[4], y2[5], y2[6], y2[7]);
        }
    }
}

DI void swa_item(const Ctx& c, int item) {
    const bf16* P = (const bf16*)(c.ws + WS_P); unsigned char* Y = (unsigned char*)(c.ws + WS_YMIX);
    const int lane = c.lane, half = lane >> 5, j = lane & 31;
    const int hq = item & 7, qb = (item >> 3) & 255, b = item >> 11, kvh = hq >> 2;
    LAS unsigned char* vl = c.lds + c.wave * WAVE_LDS;
    const int i0 = 32 * qb, qi = i0 + j, qrow = b * SEQ + qi;
    bf16x8 qf[4]; load_frags(qf, P + (size_t)qrow * PWP + SW_Q + hq * 64, half);
    AttnAcc a; attn_init(a);
    const int m_lo = max(0, 4 - qb), m_hi = min(9, 260 - qb), nw = m_hi - m_lo, nt = nw + 8;
    auto load = [&](KV& kv, int t) {
        const int base = t < nw ? b * SEQ + i0 - 128 + 32 * (m_lo + t) : NLAT + b * CTXL + 32 * (t - nw);
        attn_load(kv, P, [&](int i) { return base + i; }, SW_K + kvh * 64, SW_V + kvh * 64, lane); };
    auto compute = [&](KV& kv, int t) {
        const int m = m_lo + t; const bool edge = t < nw && (m == 0 || m == 8);
        if (edge) { const int j0 = i0 - 128 + 32 * m;
            attn_tile(a, qf, kv.k, kv.v, vl, lane, [&](int, int i, float raw) { const int dlt = j0 + i - qi; return ((dlt >= -128) && (dlt <= 128)) ? raw * QK_SCALE_L2 : -INFINITY; }); }
        else attn_tile(a, qf, kv.k, kv.v, vl, lane, PlainScore{}); };
    KV A, B; load(A, 0);
    for (int t = 0; t < nt; t += 2) {
        if (t + 1 < nt) load(B, t + 1);
        compute(A, t);
        if (t + 1 < nt) { if (t + 2 < nt) load(A, t + 2); compute(B, t + 1); }
    }
    const float sink = inp(c, 12)[c.L * 8 + hq];
    a.l += __builtin_amdgcn_exp2f(sink * LOG2E - a.m);
    attn_store(a, Y + (size_t)(qrow - j) * D + 1536 + hq * 64, vl, lane);
}

DI void ctx_attn_item(const Ctx& c, int item) {
    const bf16* P = (const bf16*)(c.ws + WS_P); unsigned char* Y = (unsigned char*)(c.ws + WS_YMIX);
    const int lane = c.lane, half = lane >> 5, j = lane & 31;
    const int h = item & 7, qb = (item >> 3) & 7, b = (item >> 6) & 1, kind = item >> 7;
    LAS unsigned char* vl = c.lds + c.wave * WAVE_LDS;
    const int qcol = kind == 0 ? NA_Q + h * 64 : SW_Q + h * 64;
    const int kcol = kind == 0 ? NA_K + h * 64 : SW_K + (h >> 2) * 64;
    const int vcol = kind == 0 ? NA_V + h * 64 : SW_V + (h >> 2) * 64;
    const int qrow = NLAT + b * CTXL + 32 * qb + j;
    bf16x8 qf[4]; load_frags(qf, P + (size_t)qrow * PWP + qcol, half);
    AttnAcc a; attn_init(a);
    auto load = [&](KV& kv, int t) { const int base = NLAT + b * CTXL + 32 * t;
        attn_load(kv, P, [&](int i) { return base + i; }, kcol, vcol, lane); };
    KV A, B; load(A, 0);
    for (int t = 0; t < 8; t += 2) {
        load(B, t + 1);
        attn_tile(a, qf, A.k, A.v, vl, lane, PlainScore{});
        if (t + 2 < 8) load(A, t + 2);
        attn_tile(a, qf, B.k, B.v, vl, lane, PlainScore{});
    }
    if (kind == 1) a.l += __builtin_amdgcn_exp2f(inp(c, 12)[c.L * 8 + h] * LOG2E - a.m);
    attn_store(a, Y + (size_t)(qrow - j) * D + (kind == 0 ? 0 : 1536) + h * 64, vl, lane);
}

DI void conv_rows4(const Ctx& c, int row0, int stride, int nrows) {
    const bf16* P = (const bf16*)(c.ws + WS_P); unsigned char* Y = (unsigned char*)(c.ws + WS_YMIX);
    const int lane = c.lane, ch = 8 * lane;
    const float* w = inp(c, 8) + (size_t)c.L * 3 * 512;
    f32x4 wv[3][2];
#pragma unroll
    for (int t = 0; t < 3; ++t) { wv[t][0] = *(const f32x4*)(w + t * 512 + ch); wv[t][1] = *(const f32x4*)(w + t * 512 + ch + 4); }
    bf16x8 u[4][3], g[4][3], gb[4]; bool ok[4][3]; int rows[4];
#pragma unroll
    for (int r = 0; r < 4; ++r) {
        const int row = row0 + r * stride; rows[r] = row;
        const bool live = row < nrows; const int rr = live ? row : 0;
        int pos, len; if (rr < NLAT) { pos = rr % SEQ; len = SEQ; } else { pos = (rr - NLAT) % CTXL; len = CTXL; }
#pragma unroll
        for (int t = 0; t < 3; ++t) { const int q = pos + t - 1; ok[r][t] = live && q >= 0 && q < len; const bf16* pr = P + (size_t)(ok[r][t] ? rr + t - 1 : rr) * PWP;
            u[r][t] = *(const bf16x8*)(pr + SC_U + ch); g[r][t] = *(const bf16x8*)(pr + SC_C + ch); }
        gb[r] = *(const bf16x8*)(P + (size_t)rr * PWP + SC_B + ch);
    }
#pragma unroll
    for (int r = 0; r < 4; ++r) {
        if (rows[r] >= nrows) continue;
        float acc[8];
#pragma unroll
        for (int e = 0; e < 8; ++e) acc[e] = 0.f;
#pragma unroll
        for (int t = 0; t < 3; ++t) { float uf[8], gf[8]; unpack8(u[r][t], uf); unpack8(g[r][t], gf);
            const float wf[8] = {wv[t][0].x, wv[t][0].y, wv[t][0].z, wv[t][0].w, wv[t][1].x, wv[t][1].y, wv[t][1].z, wv[t][1].w};
            const float m = ok[r][t] ? 1.f : 0.f;
#pragma unroll
            for (int e = 0; e < 8; ++e) acc[e] += m * wf[e] * (gf[e] * uf[e]); }
        float bf_[8]; unpack8(gb[r], bf_);
        u32x2 o; o.x = pk4_fp8(bf_[0] * acc[0], bf_[1] * acc[1], bf_[2] * acc[2], bf_[3] * acc[3]); o.y = pk4_fp8(bf_[4] * acc[4], bf_[5] * acc[5], bf_[6] * acc[6], bf_[7] * acc[7]);
        *(u32x2*)(Y + (size_t)rows[r] * D + 512 + ch) = o;
    }
}
constexpr int KSTR = 144, V2STR = 272;
DI int gla_row0(int b, int ck) { return ck < 8 ? NLAT + b * CTXL + 32 * ck : b * SEQ + 32 * (ck - 8); }
DI int gla_chain_pos(int dir, int ck) { return ck < 8 ? (dir == 0 ? ck : 7 - ck) : (dir == 0 ? ck : 8 + 255 - (ck - 8)); }

struct GlaGate { float w[16]; float bias; };
template <int DIR>
DI void gla_gate_load(const Ctx& c, int h, GlaGate& g) {
    const float* w2 = inp(c, 9) + (size_t)((c.L * 2 + DIR) * 16) * 256 + h * 64 + c.lane;
#pragma unroll
    for (int i = 0; i < 16; ++i) g.w[i] = w2[i * 256];
    g.bias = inp(c, 10)[(c.L * 2 + DIR) * 256 + h * 64 + c.lane];
}
DI void gla_stage_z(const bf16* P, int row0, LAS unsigned char* zl, int lane) {
    const u32x4 v0 = *(const u32x4*)(P + (size_t)(row0 + (lane >> 2)) * PWP + GL_Z + (lane & 3) * 8);
    const u32x4 v1 = *(const u32x4*)(P + (size_t)(row0 + 16 + (lane >> 2)) * PWP + GL_Z + (lane & 3) * 8);
    *(LAS u32x4*)(zl + (lane >> 2) * 64 + (lane & 3) * 16) = v0; *(LAS u32x4*)(zl + (16 + (lane >> 2)) * 64 + (lane & 3) * 16) = v1;
}
template <int DIR>
DI float gla_la(const GlaGate& g, const LAS unsigned char* zl, int t) {
    const LAS unsigned char* zr = zl + t * 64 + DIR * 32;
    float a[8], bq[8]; unpack8(*(const LAS bf16x8*)zr, a); unpack8(*(const LAS bf16x8*)(zr + 16), bq);
    float x = g.bias;
#pragma unroll
    for (int i = 0; i < 8; ++i) x += a[i] * g.w[i];
#pragma unroll
    for (int i = 0; i < 8; ++i) x += bq[i] * g.w[8 + i];
    return (fminf(x, 0.f) - __logf(1.f + __expf(-fabsf(x)))) * (1.f / 16.f);
}
DI void gla_stage_v(const bf16* P, int row0, int h, LAS unsigned char* vl, int lane) {
#pragma unroll
    for (int i = 0; i < 8; ++i) { const int idx = lane + 64 * i, t = idx >> 4, ch = idx & 15;
        *(LAS u32x4*)(vl + t * V2STR + ch * 16) = *(const u32x4*)(P + (size_t)(row0 + t) * PWP + GL_V + h * 128 + ch * 8); }
}
DI void gla_load_qk(u32x4 (&r)[4], const bf16* P, int row0, int col, int lane) {
#pragma unroll
    for (int i = 0; i < 4; ++i) r[i] = *(const u32x4*)(P + (size_t)(row0 + 8 * i + (lane >> 3)) * PWP + col + (lane & 7) * 8);
}
DI void gla_put_qk(const u32x4 (&r)[4], LAS unsigned char* l, int lane) {
    LAS unsigned char* d = l + (lane >> 3) * KSTR + (lane & 7) * 16;
#pragma unroll
    for (int i = 0; i < 4; ++i) *(LAS u32x4*)(d + 8 * i * KSTR) = r[i];
}

template <int DIR>
DI void gla_g1(const Ctx& c, int b, int h, int ck) {
    const bf16* P = (const bf16*)(c.ws + WS_P);
    const int lane = c.lane, half = lane >> 5;
    LAS unsigned char* kl = c.lds + c.wave * WAVE_LDS; LAS unsigned char* vl = kl + 32 * KSTR; LAS unsigned char* zl = vl + 32 * V2STR;
    const int row0 = gla_row0(b, ck), n = gla_chain_pos(DIR, ck);
    const size_t chain = (size_t)((b * 2 + DIR) * 4 + h) * NCH + n;
    u32x4 kr[4]; gla_load_qk(kr, P, row0, GL_K + h * 64, lane);
    GlaGate gate; gla_gate_load<DIR>(c, h, gate);
    gla_stage_z(P, row0, zl, lane);
    gla_stage_v(P, row0, h, vl, lane);
    gla_put_qk(kr, kl, lane);
    bf16* erp = (bf16*)(c.ws + WS_ER) + chain * 2048;
    float rev = 0.f;
#pragma unroll
    for (int tt = 31; tt >= 0; --tt) {
        const int t = DIR ? 31 - tt : tt;
        LAS bf16* kp = (LAS bf16*)(kl + t * KSTR + 2 * lane);
        const float er = __expf(rev);
        *kp = f2bf(bf2f(*kp) * er);
        erp[t * 64 + lane] = f2bf(er);
        rev += gla_la<DIR>(gate, zl, t);
    }
    ((float*)(c.ws + WS_GDEC))[chain * 64 + lane] = __expf(rev);
    const int q = (lane & 15) >> 2, pp = lane & 3, blk = (lane >> 4) & 1;
    bf16* ut = (bf16*)(c.ws + WS_UT) + chain * 8192;
    bf16x8 Kf[2][2];
#pragma unroll
    for (int nt = 0; nt < 2; ++nt)
#pragma unroll
        for (int s = 0; s < 2; ++s) { LAS unsigned char* a = kl + (16 * s + 8 * half + q) * KSTR + (32 * nt + 16 * blk + 4 * pp) * 2; Kf[nt][s] = cat4(tr_read(a), tr_read(a + 4 * KSTR)); }
#pragma unroll
    for (int mt = 0; mt < 4; ++mt) {
        bf16x8 Vf[2];
#pragma unroll
        for (int s = 0; s < 2; ++s) { LAS unsigned char* a = vl + (16 * s + 8 * half + q) * V2STR + (32 * mt + 16 * blk + 4 * pp) * 2; Vf[s] = cat4(tr_read(a), tr_read(a + 4 * V2STR)); }
#pragma unroll
        for (int nt = 0; nt < 2; ++nt) {
            f32x16 acc = zero16();
            acc = MFMA32(Kf[nt][0], Vf[0], acc); acc = MFMA32(Kf[nt][1], Vf[1], acc);
            LAS unsigned char* ud = kl + (lane & 31) * KSTR + 64 * nt + 8 * half;
#pragma unroll
            for (int g4 = 0; g4 < 4; ++g4) { u32x2 w; w.x = pk2(acc[4 * g4], acc[4 * g4 + 1]); w.y = pk2(acc[4 * g4 + 2], acc[4 * g4 + 3]); *(LAS u32x2*)(ud + 16 * g4) = w; }
        }
#pragma unroll
        for (int i = 0; i < 4; ++i) { const int vr = 8 * i + (lane >> 3);
            *(u32x4*)(ut + (size_t)(32 * mt + vr) * 64 + (lane & 7) * 8) = *(const LAS u32x4*)(kl + vr * KSTR + (lane & 7) * 16); }
    }
}

DI void gla_scan(const Ctx& c) {

    const bf16* ut = (const bf16*)(c.ws + WS_UT); bf16* sin = (bf16*)(c.ws + WS_SIN); const float* gd = (const float*)(c.ws + WS_GDEC);
    for (int e = c.bid * 512 + c.tid; e < 16 * 8192; e += c.nblk * 512) {
        const int chain = e >> 13, el = e & 8191, k = el & 63;
        const size_t base = (size_t)chain * NCH * 8192 + el;
        const float* g = gd + (size_t)chain * NCH * 64 + k;
        float st = 0.f;
        for (int n0 = 0; n0 < NCH; n0 += 88) {
            float u[88], gg[88];
#pragma unroll
            for (int i = 0; i < 88; ++i) { u[i] = bf2f(ut[base + (size_t)(n0 + i) * 8192]); gg[i] = g[(n0 + i) * 64]; }
#pragma unroll
            for (int i = 0; i < 88; ++i) { sin[base + (size_t)(n0 + i) * 8192] = f2bf(st); st = gg[i] * st + u[i]; }
        }
    }
}

template <int DIR>
DI void gla_g3_dir(const Ctx& c, int b, int h, int ck, const unsigned (&qc)[16], const unsigned (&kc)[16], LAS unsigned char* ql, LAS unsigned char* kl, LAS unsigned char* vl, LAS unsigned char* zl, f32x16 (&o)[4]) {
    const int lane = c.lane, half = lane >> 5, j = lane & 31;
    const size_t chain = (size_t)((b * 2 + DIR) * 4 + h) * NCH + gla_chain_pos(DIR, ck);
    const bf16* sin = (const bf16*)(c.ws + WS_SIN) + chain * 8192;
    bf16x8 sf[2][4], sg[2][4];
#pragma unroll
    for (int mt = 0; mt < 2; ++mt)
#pragma unroll
        for (int s = 0; s < 4; ++s) sf[mt][s] = *(const bf16x8*)(sin + (size_t)(32 * mt + j) * 64 + 16 * s + 8 * half);
    { const float gd = ((const float*)(c.ws + WS_GDEC))[chain * 64 + lane];
      const bf16* erp = (const bf16*)(c.ws + WS_ER) + chain * 2048;
      bf16 er[32];
#pragma unroll
      for (int t = 0; t < 32; ++t) er[t] = erp[t * 64 + lane];
#pragma unroll
      for (int t = 0; t < 32; ++t) {
        const float e1 = gd * __builtin_amdgcn_rcpf(bf2f(er[t]));
        const float qv = (t & 1) ? hi16(qc[t >> 1]) : lo16(qc[t >> 1]), kv = (t & 1) ? hi16(kc[t >> 1]) : lo16(kc[t >> 1]);
        *(LAS bf16*)(ql + t * KSTR + 2 * lane) = f2bf(qv * e1 * 0.125f);
        *(LAS bf16*)(kl + t * KSTR + 2 * lane) = f2bf(kv * __builtin_amdgcn_rcpf(e1));
      } }
#pragma unroll
    for (int mt = 0; mt < 2; ++mt)
#pragma unroll
        for (int s = 0; s < 4; ++s) sg[mt][s] = *(const bf16x8*)(sin + (size_t)(32 * (mt + 2) + j) * 64 + 16 * s + 8 * half);
    bf16x8 qf[4], kf[4];
#pragma unroll
    for (int s = 0; s < 4; ++s) { qf[s] = *(const LAS bf16x8*)(ql + j * KSTR + (16 * s + 8 * half) * 2); kf[s] = *(const LAS bf16x8*)(kl + j * KSTR + (16 * s + 8 * half) * 2); }
    f32x16 at = zero16();
#pragma unroll
    for (int s = 0; s < 4; ++s) at = MFMA32(kf[s], qf[s], at);
    float a[16];
#pragma unroll
    for (int r = 0; r < 16; ++r) { const int s = crow(r, half); const bool ok = DIR ? (s >= j) : (s <= j); a[r] = ok ? at[r] : 0.f; }
    const bf16x8 pb0 = pack8(a[0], a[1], a[2], a[3], a[4], a[5], a[6], a[7]), pb1 = pack8(a[8], a[9], a[10], a[11], a[12], a[13], a[14], a[15]);
    const int q = (lane & 15) >> 2, pp = lane & 3, blk = (lane >> 4) & 1;
#pragma unroll
    for (int mt = 0; mt < 4; ++mt) {
        LAS unsigned char* vb = vl + (4 * half + q) * V2STR + (32 * mt + 16 * blk + 4 * pp) * 2;
        o[mt] = MFMA32(cat4(tr_read(vb), tr_read(vb + 8 * V2STR)), pb0, o[mt]);
        o[mt] = MFMA32(cat4(tr_read(vb + 16 * V2STR), tr_read(vb + 24 * V2STR)), pb1, o[mt]);
#pragma unroll
        for (int s = 0; s < 4; ++s) o[mt] = MFMA32(mt < 2 ? sf[mt & 1][s] : sg[mt & 1][s], qf[s], o[mt]);
    }
}
DI void gla_g3(const Ctx& c, int b, int h, int ck) {
    const bf16* P = (const bf16*)(c.ws + WS_P); unsigned char* Y = (unsigned char*)(c.ws + WS_YMIX);
    const int lane = c.lane, half = lane >> 5, j = lane & 31;
    LAS unsigned char* ql = c.lds + c.wave * WAVE_LDS; LAS unsigned char* kl = ql + 32 * KSTR; LAS unsigned char* vl = kl + 32 * KSTR; LAS unsigned char* zl = vl + 32 * V2STR;
    const int row0 = gla_row0(b, ck);
    { u32x4 qr[4], kr[4]; gla_load_qk(qr, P, row0, GL_Q + h * 64, lane); gla_load_qk(kr, P, row0, GL_K + h * 64, lane);
      gla_stage_v(P, row0, h, vl, lane);
      gla_put_qk(qr, ql, lane); gla_put_qk(kr, kl, lane); }
    unsigned qc[16], kc[16];
#pragma unroll
    for (int i = 0; i < 16; ++i) {
        qc[i] = (unsigned)*(const LAS bf16*)(ql + (2 * i) * KSTR + 2 * lane) | ((unsigned)*(const LAS bf16*)(ql + (2 * i + 1) * KSTR + 2 * lane) << 16);
        kc[i] = (unsigned)*(const LAS bf16*)(kl + (2 * i) * KSTR + 2 * lane) | ((unsigned)*(const LAS bf16*)(kl + (2 * i + 1) * KSTR + 2 * lane) << 16); }
    f32x16 o[4];
#pragma unroll
    for (int mt = 0; mt < 4; ++mt) o[mt] = zero16();
    gla_g3_dir<0>(c, b, h, ck, qc, kc, ql, kl, vl, zl, o);
    gla_g3_dir<1>(c, b, h, ck, qc, kc, ql, kl, vl, zl, o);
    float ss = 0.f;
#pragma unroll
    for (int mt = 0; mt < 4; ++mt)
#pragma unroll
        for (int r = 0; r < 16; ++r) ss += o[mt][r] * o[mt][r];
    ss += bperm_f(lane ^ 32, ss);
    const float rstd = 1.f / sqrtf(ss * (1.f / 128.f) + LN_EPS);
    const float* gain = inp(c, 11) + (size_t)c.L * 128;
    const int row = row0 + j;
#pragma unroll
    for (int mt = 0; mt < 4; ++mt)
#pragma unroll
        for (int g4 = 0; g4 < 4; ++g4) {
            const int v0 = 32 * mt + 8 * g4 + 4 * half;
            const u32x2 gr = *(const u32x2*)(P + (size_t)row * PWP + GL_G + h * 128 + v0);
            const float gv[4] = {lo16(gr.x), hi16(gr.x), lo16(gr.y), hi16(gr.y)};
            const f32x4 gn = *(const f32x4*)(gain + v0);
            float y[4];
#pragma unroll
            for (int e = 0; e < 4; ++e) { const float on = o[mt][4 * g4 + e] * rstd * gn[e]; y[e] = on * (gv[e] / (1.f + __expf(-gv[e]))); }
            *(unsigned*)(Y + (size_t)row * D + 1024 + h * 128 + v0) = pk4_fp8(y[0], y[1], y[2], y[3]); }
}
template <int NT>
DI void router_phase(const Ctx& c, int rows_per_chunk, int nchunks) {
    const int L = c.L, lane = c.lane, r16 = lane & 15, q = lane >> 4, w = c.wave;
    const unsigned char* xq = (const unsigned char*)(c.ws + WS_XQ); const bf16* xl = (const bf16*)(c.ws + WS_XL); const bf16* rw = (const bf16*)(c.ws + WS_ROUTW);
    const float* rb = inp(c, 17) + (size_t)L * NEXP;
    int* eidx = (int*)(c.ws + WS_EIDX); int* rank = (int*)(c.ws + WS_RANK); float* wts = (float*)(c.ws + WS_WTS);
    unsigned* cnt = (unsigned*)(c.ws + WS_CTL) + CW_CNT + L * 64;
    LAS float* part = (LAS float*)c.lds;
    LAS float* sc = (LAS float*)(c.lds + 98304);
    LAS float* sl = sc + 5 * 16 * 65;
    LAS unsigned* lcnt = (LAS unsigned*)(c.lds + LDS_MISC + 256);
    LAS unsigned* lbase = lcnt + 64;
    for (int chunk = c.bid; chunk < nchunks; chunk += c.nblk) {
        const int row0 = chunk * rows_per_chunk, rowlast = row0 + rows_per_chunk - 1;
        if (c.tid < 64) lcnt[c.tid] = 0u;
        f32x4 acc[NT][4];
#pragma unroll
        for (int t = 0; t < NT; ++t)
#pragma unroll
            for (int nt = 0; nt < 4; ++nt) acc[t][nt] = (f32x4){0.f, 0.f, 0.f, 0.f};
#pragma unroll 2
        for (int ks = 0; ks < 8; ++ks) {
            const int k0 = 256 * w + 32 * ks + 8 * q;
            bf16x8 bh[4], bl[4];
#pragma unroll
            for (int nt = 0; nt < 4; ++nt) { bh[nt] = *(const bf16x8*)(rw + (size_t)(16 * nt + r16) * D + k0); bl[nt] = *(const bf16x8*)(rw + (size_t)(64 + 16 * nt + r16) * D + k0); }
#pragma unroll
            for (int t = 0; t < NT; ++t) {
                const int row = min(row0 + 16 * t + r16, rowlast);
                const u32x2 aq = *(const u32x2*)(xq + (size_t)row * D + k0); const bf16x8 al = *(const bf16x8*)(xl + (size_t)row * D + k0);
                const f32x2 q0 = __builtin_amdgcn_cvt_pk_f32_fp8((int)aq.x, false), q1 = __builtin_amdgcn_cvt_pk_f32_fp8((int)aq.x, true), q2 = __builtin_amdgcn_cvt_pk_f32_fp8((int)aq.y, false), q3 = __builtin_amdgcn_cvt_pk_f32_fp8((int)aq.y, true);
                const bf16x8 ah = pack8(q0.x, q0.y, q1.x, q1.y, q2.x, q2.y, q3.x, q3.y);
#pragma unroll
                for (int nt = 0; nt < 4; ++nt) { acc[t][nt] = MFMA16(ah, bh[nt], acc[t][nt]); acc[t][nt] = MFMA16(al, bh[nt], acc[t][nt]); acc[t][nt] = MFMA16(ah, bl[nt], acc[t][nt]); }
            }
        }
#pragma unroll
        for (int g = 0; g < 2; ++g) {
            const int t0 = 3 * g, tn = (g == 0) ? (NT < 3 ? NT : 3) : NT - 3;
            __syncthreads();
#pragma unroll
            for (int tt = 0; tt < 3; ++tt) if (tt < tn)
#pragma unroll
                for (int nt = 0; nt < 4; ++nt)
#pragma unroll
                    for (int r = 0; r < 4; ++r) part[(w * 3 + tt) * 1024 + (4 * q + r) * 64 + 16 * nt + r16] = acc[t0 + tt][nt][r];
            __syncthreads();
            for (int e = c.tid; e < tn * 1024; e += 512) {
                const int tt = e >> 10, el = e & 1023, tok = el >> 6, ex = el & 63;
                float sum = 0.f;
#pragma unroll
                for (int ww = 0; ww < 8; ++ww) sum += part[(ww * 3 + tt) * 1024 + el];
                const float sg = 1.f / (1.f + __expf(-sum));
                sc[((t0 + tt) * 16 + tok) * 65 + ex] = sg; sl[((t0 + tt) * 16 + tok) * 65 + ex] = sg + rb[ex];
            }
        }
        __syncthreads();
        int e0 = 0, e1 = 0, li0 = 0, li1 = 0; float w0 = 0.f, w1 = 0.f;
        const int tk = lane >> 2, s4 = lane & 3;
        const int tokrow = row0 + 16 * w + tk;
        const bool act = (w < NT) && (tokrow <= rowlast);
        if (act) {
            const LAS float* slt = sl + (w * 16 + tk) * 65; const LAS float* sct = sc + (w * 16 + tk) * 65;
            float v[16];
#pragma unroll
            for (int i = 0; i < 16; ++i) v[i] = slt[16 * s4 + i];
            float ga, gb;
            { float m1 = -INFINITY, m2 = -INFINITY;
#pragma unroll
              for (int i = 0; i < 8; ++i) { if (v[i] > m1) { m2 = m1; m1 = v[i]; } else if (v[i] > m2) m2 = v[i]; }
              ga = m1 + m2; m1 = -INFINITY; m2 = -INFINITY;
#pragma unroll
              for (int i = 8; i < 16; ++i) { if (v[i] > m1) { m2 = m1; m1 = v[i]; } else if (v[i] > m2) m2 = v[i]; }
              gb = m1 + m2; }
            float gs[8];
#pragma unroll
            for (int s2 = 0; s2 < 4; ++s2) { gs[2 * s2] = bperm_f((lane & ~3) | s2, ga); gs[2 * s2 + 1] = bperm_f((lane & ~3) | s2, gb); }
            unsigned gmask = 0u;
#pragma unroll
            for (int it = 0; it < 4; ++it) { float best = -INFINITY; int bi = 0;
#pragma unroll
                for (int g = 0; g < 8; ++g) { const bool fr = ((gmask >> g) & 1u) == 0u; if (fr && gs[g] > best) { best = gs[g]; bi = g; } }
                gmask |= 1u << bi; }
            const bool oka = (gmask >> (2 * s4)) & 1u, okb = (gmask >> (2 * s4 + 1)) & 1u;
#pragma unroll
            for (int i = 0; i < 16; ++i) v[i] = ((i < 8) ? oka : okb) ? v[i] : -INFINITY;
            float wsum = 0.f;
#pragma unroll
            for (int rd = 0; rd < 8; ++rd) {
                float best = -INFINITY; int bi = 16 * s4;
#pragma unroll
                for (int i = 0; i < 16; ++i) if (v[i] > best) { best = v[i]; bi = 16 * s4 + i; }
#pragma unroll
                for (int o = 1; o < 4; o <<= 1) { const float ob = bperm_f(lane ^ o, best); const int oi = bperm_i(lane ^ o, bi); if (ob > best || (ob == best && oi < bi)) { best = ob; bi = oi; } }
                const float wv = sct[bi]; wsum += wv;
                if ((bi >> 4) == s4) {
#pragma unroll
                    for (int i = 0; i < 16; ++i) v[i] = (i == (bi & 15)) ? -INFINITY : v[i]; }
                if ((rd & 3) == s4) { if (rd < 4) { e0 = bi; w0 = wv; } else { e1 = bi; w1 = wv; } }
            }
            const float sc25 = 2.5f / wsum; w0 *= sc25; w1 *= sc25;
            li0 = (int)__hip_atomic_fetch_add((unsigned*)(lcnt + e0), 1u, __ATOMIC_RELAXED, __HIP_MEMORY_SCOPE_WORKGROUP); li1 = (int)__hip_atomic_fetch_add((unsigned*)(lcnt + e1), 1u, __ATOMIC_RELAXED, __HIP_MEMORY_SCOPE_WORKGROUP);
        }
        __syncthreads();
        if (c.tid < 64) { const unsigned n = lcnt[c.tid]; lbase[c.tid] = n ? atomicAdd(cnt + c.tid, n) : 0u; }
        __syncthreads();
        if (act) {
            eidx[tokrow * 8 + s4] = e0; wts[tokrow * 8 + s4] = w0; rank[tokrow * 8 + s4] = (int)lbase[e0] + li0;
            eidx[tokrow * 8 + s4 + 4] = e1; wts[tokrow * 8 + s4 + 4] = w1; rank[tokrow * 8 + s4 + 4] = (int)lbase[e1] + li1;
        }
        __syncthreads();
    }
}

DI void phase9(const Ctx& c) {
    const int L = c.L;
    const int nmoe = L == 0 ? NTOK : NLAT;
    LAS int* ts = (LAS int*)c.lds;
    const unsigned* cnt = (const unsigned*)(c.ws + WS_CTL) + CW_CNT + L * 64;
    if (c.tid == 0) { int acc = 0; for (int e = 0; e < 64; ++e) { ts[e] = acc; acc += ((int)cnt[e] + 255) >> 8; } ts[64] = acc; ts[65] = acc + nmoe / 256; }
    __syncthreads();
    int* toks = (int*)(c.ws + WS_TOKS); int* pos = (int*)(c.ws + WS_POS); int* tile_e = (int*)(c.ws + WS_TILEE);
    const int* eidx = (const int*)(c.ws + WS_EIDX); const int* rank = (const int*)(c.ws + WS_RANK);
    const int gt = c.bid * 512 + c.tid, ngt = c.nblk * 512;
    for (int i = gt; i < nmoe * 8; i += ngt) { const int e = eidx[i]; const int slot = ts[e] * 256 + rank[i]; toks[slot] = i >> 3; pos[i] = slot; }
    for (int i = gt; i < nmoe; i += ngt) toks[ts[64] * 256 + i] = i;
    for (int e = c.bid; e < 65; e += c.nblk) {
        for (int t = ts[e] + c.tid; t < ts[e + 1]; t += 512) tile_e[t] = e;
        if (e < 64) { const int n = (int)cnt[e]; for (int s = n + c.tid; s < (ts[e + 1] - ts[e]) * 256; s += 512) toks[ts[e] * 256 + s] = 0; }
    }
    if (c.bid == 0 && c.tid == 0) { int* nt = (int*)(c.ws + WS_CTL) + CW_NT + L * 64; nt[0] = ts[65]; nt[1] = ts[64]; }
    __syncthreads();
}

DI void phase12(const Ctx& c) {
    const int L = c.L;
    const int nmoe = L == 0 ? NTOK : NLAT;
    const unsigned char* Yb = (const unsigned char*)(c.ws + WS_Y); const bf16* x1 = (const bf16*)(c.ws + WS_X1);
    const int* pos = (const int*)(c.ws + WS_POS); const float* wts = (const float*)(c.ws + WS_WTS);
    const int sh_tile0 = ((const int*)(c.ws + WS_CTL))[CW_NT + L * 64 + 1];
    const float* lg = inp(c, 24) + (size_t)L * D; const float* lb = inp(c, 25) + (size_t)L * D;
    int4 ns0 = {0, 0, 0, 0}, ns1 = {0, 0, 0, 0}; f32x4 nq0 = {0.f, 0.f, 0.f, 0.f}, nq1 = {0.f, 0.f, 0.f, 0.f};
    if (c.gw < nmoe) { ns0 = *(const int4*)(pos + c.gw * 8); ns1 = *(const int4*)(pos + c.gw * 8 + 4); nq0 = *(const f32x4*)(wts + c.gw * 8); nq1 = *(const f32x4*)(wts + c.gw * 8 + 4); }
    for (int row = c.gw; row < nmoe; row += c.ngw) {
        const float* mod = mod_row(c, row);
        f32x4 f[8];
        int slot[8]; float w[8];
        { const int4 s0 = ns0, s1 = ns1; const f32x4 q0 = nq0, q1 = nq1;
          slot[0] = s0.x; slot[1] = s0.y; slot[2] = s0.z; slot[3] = s0.w; slot[4] = s1.x; slot[5] = s1.y; slot[6] = s1.z; slot[7] = s1.w;
          w[0] = q0.x; w[1] = q0.y; w[2] = q0.z; w[3] = q0.w; w[4] = q1.x; w[5] = q1.y; w[6] = q1.z; w[7] = q1.w; }
        { const int nr = row + c.ngw; if (nr < nmoe) { ns0 = *(const int4*)(pos + nr * 8); ns1 = *(const int4*)(pos + nr * 8 + 4); nq0 = *(const f32x4*)(wts + nr * 8); nq1 = *(const f32x4*)(wts + nr * 8 + 4); } }
        {
            u32x4 y[9][2];
#pragma unroll
            for (int k = 0; k < 9; ++k) { const unsigned char* yr = Yb + (size_t)(k == 8 ? sh_tile0 * 256 + row : slot[k]) * D + 16 * c.lane;
                y[k][0] = *(const u32x4*)yr; y[k][1] = *(const u32x4*)(yr + 1024); }
#pragma unroll
            for (int j = 0; j < 2; ++j)
#pragma unroll
                for (int q = 0; q < 4; ++q) {
                    { const int d = (int)y[8][j][q]; const f32x2 a = __builtin_amdgcn_cvt_pk_f32_fp8(d, false), b2 = __builtin_amdgcn_cvt_pk_f32_fp8(d, true); f[4 * j + q] = (f32x4){a.x, a.y, b2.x, b2.y}; }
#pragma unroll
                    for (int k = 0; k < 8; ++k) { const int d = (int)y[k][j][q]; const f32x2 a = __builtin_amdgcn_cvt_pk_f32_fp8(d, false), b2 = __builtin_amdgcn_cvt_pk_f32_fp8(d, true); f[4 * j + q] += (f32x4){a.x, a.y, b2.x, b2.y} * w[k]; }
                    f[4 * j + q] = f[4 * j + q] * 0.125f; }
        }
        f32x4 v[8];
#pragma unroll
        for (int j = 0; j < 2; ++j) { const int cb = 1024 * j + 16 * c.lane;
            const u32x4 ta = *(const u32x4*)(x1 + (size_t)row * D + cb), tb = *(const u32x4*)(x1 + (size_t)row * D + cb + 8);
            const f32x4 xa[4] = {(f32x4){lo16(ta.x), hi16(ta.x), lo16(ta.y), hi16(ta.y)}, (f32x4){lo16(ta.z), hi16(ta.z), lo16(ta.w), hi16(ta.w)},
                                 (f32x4){lo16(tb.x), hi16(tb.x), lo16(tb.y), hi16(tb.y)}, (f32x4){lo16(tb.z), hi16(tb.z), lo16(tb.w), hi16(tb.w)}};
#pragma unroll
            for (int q = 0; q < 4; ++q) v[4 * j + q] = xa[q] * DN_ALPHA + *(const f32x4*)(mod + 5 * D + cb + 4 * q) * f[4 * j + q]; }
        float mean, rstd; row_stats(v, mean, rstd);
#pragma unroll
        for (int j = 0; j < 2; ++j)
#pragma unroll
            for (int q = 0; q < 4; ++q) { const int col = 1024 * j + 16 * c.lane + 4 * q; v[4 * j + q] = (v[4 * j + q] - mean) * rstd * *(const f32x4*)(lg + col) + *(const f32x4*)(lb + col); }
        if (L == 1) {
            float* orow = outp(c) + (size_t)row * D;
#pragma unroll
            for (int j = 0; j < 2; ++j)
#pragma unroll
                for (int q = 0; q < 4; ++q) *(f32x4*)(orow + 1024 * j + 16 * c.lane + 4 * q) = v[4 * j + q];
        } else if (row < NLAT) {
            bf16* xb = (bf16*)(c.ws + WS_XB);
#pragma unroll
            for (int j = 0; j < 2; ++j) { u32x4 oa, ob;
                oa.x = pk2(v[4 * j][0], v[4 * j][1]); oa.y = pk2(v[4 * j][2], v[4 * j][3]); oa.z = pk2(v[4 * j + 1][0], v[4 * j + 1][1]); oa.w = pk2(v[4 * j + 1][2], v[4 * j + 1][3]);
                ob.x = pk2(v[4 * j + 2][0], v[4 * j + 2][1]); ob.y = pk2(v[4 * j + 2][2], v[4 * j + 2][3]); ob.z = pk2(v[4 * j + 3][0], v[4 * j + 3][1]); ob.w = pk2(v[4 * j + 3][2], v[4 * j + 3][3]);
                *(u32x4*)(xb + (size_t)row * D + 1024 * j + 16 * c.lane) = oa; *(u32x4*)(xb + (size_t)row * D + 1024 * j + 16 * c.lane + 8) = ob; }
        }
        if (L == 0) {
            const float* mod1 = mod_row_l(c, row, 1); unsigned char* xn = (unsigned char*)(c.ws + WS_XN);
            row_stats(v, mean, rstd);
#pragma unroll
            for (int j = 0; j < 2; ++j) { const int cb = 1024 * j + 16 * c.lane; u32x4 o;
#pragma unroll
                for (int q = 0; q < 4; ++q) { const f32x4 sh = *(const f32x4*)(mod1 + cb + 4 * q), sc = *(const f32x4*)(mod1 + D + cb + 4 * q);
                    const f32x4 yv = (v[4 * j + q] - mean) * rstd * (sc + 1.f) + sh; o[q] = pk4_fp8(yv.x, yv.y, yv.z, yv.w); }
                *(u32x4*)(xn + (size_t)row * D + cb) = o; }
        }
    }
}

DI int xcd_vid(int G, int bx) { return (G % 8 == 0) ? (bx % 8) * (G / 8) + bx / 8 : bx; }
__global__ void __launch_bounds__(512, 2) fwd(Params prm) {
    extern __shared__ __attribute__((aligned(16))) unsigned char lds_raw[];
    const int wave_s = __builtin_amdgcn_readfirstlane(threadIdx.x >> 6);
    Ctx c; c.lds = (LAS unsigned char*)lds_raw; c.tid = threadIdx.x; c.lane = c.tid & 63; c.wave = __builtin_amdgcn_readfirstlane(c.tid >> 6);
    c.gw = blockIdx.x * 8 + c.wave; c.ngw = gridDim.x * 8; c.bid = blockIdx.x; c.nblk = gridDim.x; c.p = (CParams*)__builtin_amdgcn_kernarg_segment_ptr(); c.L = 0;
    volatile LAS unsigned* misc = (volatile LAS unsigned*)(c.lds + LDS_MISC);
    if (c.tid < 64) misc[c.tid] = 0u;
    __syncthreads();
    unsigned char* ws = (unsigned char*)prm.ws; c.ws = ws;
    XcdBarrier bar = xcd_barrier_post((unsigned*)(ws + WS_CTL) + CW_BAR, misc + 8);
    const int lo = prm.ph_lo, hi = prm.ph_hi;
    int gdim = gridDim.x, bidx = blockIdx.x;
#ifndef ONLY_PH
#define ONLY_PH -1
#endif
#ifndef STAGGER_US
#define STAGGER_US 0
#endif
#ifndef CVQ_P2
#define CVQ_P2 3
#define CVQ_P6 3
#define CVQ_P10 2
#define CVQ_P11 1
#define CVQ_P5 2
#endif
#ifndef PROBE_BARRIERS
#define PROBE_BARRIERS 0
#endif
#ifndef DUPMASK
#define DUPMASK 0
#endif
#ifndef PHMASK
#define PHMASK 0x1fff
#endif
#define IN(k) (lo <= (k) && (k) < hi && (ONLY_PH < 0 || ((k) % NPH) == ONLY_PH) && ((PHMASK >> ((k) % NPH)) & 1))
#define REFRESH() do { { CParams* kp_ = (CParams*)__builtin_amdgcn_kernarg_segment_ptr(); asm volatile("" : "+s"(kp_)); c.p = kp_; } ws = fresh(c.p->ws); c.ws = ws; int w_ = wave_s; asm volatile("" : "+s"(w_)); const int t_ = w_ * 64 + lane_id_fresh(); c.tid = t_; c.lane = t_ & 63; c.wave = w_; gdim = gridDim.x; bidx = blockIdx.x; asm volatile("" : "+s"(gdim), "+s"(bidx)); c.gw = bidx * 8 + c.wave; c.ngw = gdim * 8; c.bid = bidx; c.nblk = gdim; } while (0)
#define SEAM(k) do { if (IN(k) && IN((k) + 1)) xcd_barrier(bar); } while (0)
    for (int L = 0; L < 2; ++L) {
        c.L = L; const int pb = L * NPH;
        if (IN(pb + 0)) { for (int rep_ = 0; rep_ <= ((DUPMASK >> 0) & 1); ++rep_) { if (rep_) xcd_barrier(bar); REFRESH(); phase0(c); __syncthreads(); } } SEAM(pb + 0);
        if (IN(pb + 1)) { for (int rep_ = 0; rep_ <= ((DUPMASK >> 1) & 1); ++rep_) { if (rep_) xcd_barrier(bar); REFRESH(); if (L == 0) phase1(c); } } if (L == 0) SEAM(pb + 1);
        if (IN(pb + 2)) { for (int rep_ = 0; rep_ <= ((DUPMASK >> 2) & 1); ++rep_) { if (rep_) xcd_barrier(bar); REFRESH();
            pg8::Gemm g{(const bf16*)(ws + WS_XN), (const bf16*)(ws + WS_WIN), D / 2}; pg8::StaticOrder S; S.init(NTOK, PWP, gdim, bidx);
            pg8::EpiBf16 E{(bf16*)(ws + WS_P), PWP, 1.f / 64.f, rep_};
            pg8::gemm_phase<pg8::EpiBf16, pg8::StaticOrder, false, true>(c.lds, g, S, E, nullptr, c.tid);
            if (L == 0 && S.short_deal()) { REFRESH(); cv_steal(c, CVQ_P2); }
        } } SEAM(pb + 2);
        if (IN(pb + 2) && IN(pb + 3)) { REFRESH(); rope_prepass(c); xcd_barrier(bar); }
        if (IN(pb + 3)) { for (int rep_ = 0; rep_ <= ((DUPMASK >> 3) & 1); ++rep_) { if (rep_) xcd_barrier(bar); REFRESH();
            const int gw1 = (c.gw + c.ngw / 2) % c.ngw, gw2 = (c.gw + 3 * (c.ngw / 4)) % c.ngw, gw3 = (c.gw + c.ngw / 4) % c.ngw;
            for (int it = c.gw; it < 4096; it += c.ngw) na_item(c, it);
            for (int it = c.gw; it < 4096; it += c.ngw) swa_item(c, it);
            for (int it = gw1; it < 16 * NCH; it += c.ngw) { const int ck = it % NCH, h = (it / NCH) & 3, dir = (it / (NCH * 4)) & 1, b = it / (NCH * 8);
                if (dir == 0) gla_g1<0>(c, b, h, ck); else gla_g1<1>(c, b, h, ck); }
            if (L == 0) for (int it = gw2; it < 256; it += c.ngw) ctx_attn_item(c, it);
            for (int row = gw3; row < (L == 0 ? NTOK : NLAT); row += 4 * c.ngw) conv_rows4(c, row, c.ngw, L == 0 ? NTOK : NLAT);
        } } SEAM(pb + 3);
        if (PROBE_BARRIERS && IN(pb + 4)) { for (int i_ = 0; i_ < PROBE_BARRIERS; ++i_) xcd_barrier(bar); }
        if (IN(pb + 4)) { for (int rep_ = 0; rep_ <= ((DUPMASK >> 4) & 1); ++rep_) { if (rep_) xcd_barrier(bar); REFRESH(); gla_scan(c); } } SEAM(pb + 4);
        if (IN(pb + 5)) { for (int rep_ = 0; rep_ <= ((DUPMASK >> 5) & 1); ++rep_) { if (rep_) xcd_barrier(bar); REFRESH();
            for (int it = c.gw; it < 8 * NCH; it += c.ngw) { const int ck = it % NCH, h = (it / NCH) & 3, b = it / (NCH * 4);
                if (ck < 8 && L != 0) continue;
                gla_g3(c, b, h, ck); }
            if (L == 0 && c.gw + c.ngw >= 8 * NCH) cv_steal(c, CVQ_P5);
        } } SEAM(pb + 5);
        if (IN(pb + 6)) { for (int rep_ = 0; rep_ <= ((DUPMASK >> 6) & 1); ++rep_) { if (rep_) xcd_barrier(bar); REFRESH();
            pg8::Gemm g{(const bf16*)(ws + WS_YMIX), (const bf16*)(ws + WS_WOUT), D / 2};
            pg8::StaticOrder S; S.init(L == 0 ? NTOK : NLAT, D, gdim, bidx);
            pg8::EpiBf16 E{(bf16*)(ws + WS_T), D, 1.f / 64.f, rep_};
            pg8::gemm_phase<pg8::EpiBf16, pg8::StaticOrder, false, true>(c.lds, g, S, E, nullptr, c.tid);
            if (L == 0 && S.short_deal()) { REFRESH(); cv_steal(c, CVQ_P6); }
        } } SEAM(pb + 6);
        if (IN(pb + 7)) { for (int rep_ = 0; rep_ <= ((DUPMASK >> 7) & 1); ++rep_) { if (rep_) xcd_barrier(bar); REFRESH(); phase7(c); } } SEAM(pb + 7);
        if (IN(pb + 8)) { for (int rep_ = 0; rep_ <= ((DUPMASK >> 8) & 1); ++rep_) { if (rep_) { xcd_barrier(bar); if (blockIdx.x == 0 && c.tid < 64) ((unsigned*)(ws + WS_CTL))[CW_CNT + L * 64 + c.tid] = 0u; xcd_barrier(bar); } REFRESH(); if (L == 0) router_phase<5>(c, 66, 256); else router_phase<4>(c, 64, 256); } } SEAM(pb + 8);
        if (IN(pb + 9)) { for (int rep_ = 0; rep_ <= ((DUPMASK >> 9) & 1); ++rep_) { if (rep_) xcd_barrier(bar); REFRESH(); phase9(c); } } SEAM(pb + 9);
        if (IN(pb + 10)) { for (int rep_ = 0; rep_ <= ((DUPMASK >> 10) & 1); ++rep_) { if (rep_) xcd_barrier(bar); REFRESH();
            const int* ntp = (const int*)(ws + WS_CTL) + CW_NT + L * 64;
            pg8::Gemm g{(const bf16*)(ws + WS_XQ), (const bf16*)(ws + (L == 0 ? WS_WGU : WS_WGU1)), D / 2};
            int nu_ = __builtin_amdgcn_readfirstlane(ntp[0]) * 4; asm volatile("" : "+s"(nu_)); pg8::GroupOrder S{(const int*)(ws + WS_TILEE), nu_, 4, gdim, xcd_vid(gdim, bidx), (LAS int*)(c.lds + pg8::STAGE_BYTES + 24 * pg8::BM * 4)};
            pg8::EpiSwiglu8 E{(unsigned char*)(ws + WS_H)};
            pg8::gemm_phase<pg8::EpiSwiglu8, pg8::GroupOrder, true, true>(c.lds, g, S, E, (const int*)(ws + WS_TOKS), c.tid);
            if (L == 0 && S.short_deal()) { REFRESH(); cv_steal(c, CVQ_P10); }
        } } SEAM(pb + 10);
        if (IN(pb + 11)) { for (int rep_ = 0; rep_ <= ((DUPMASK >> 11) & 1); ++rep_) { if (rep_) xcd_barrier(bar); REFRESH();
            const int* ntp = (const int*)(ws + WS_CTL) + CW_NT + L * 64;
            if (STAGGER_US > 0 && (bidx & 1)) { const unsigned long long t0 = __builtin_amdgcn_s_memrealtime(); while (__builtin_amdgcn_s_memrealtime() - t0 < (unsigned long long)(STAGGER_US * 100)) __builtin_amdgcn_s_sleep(8); }
            pg8::Gemm g{(const bf16*)(ws + WS_H), (const bf16*)(ws + (L == 0 ? WS_WD : WS_WD1)), DEXP / 2};
            int nu_ = __builtin_amdgcn_readfirstlane(ntp[0]) * 8; asm volatile("" : "+s"(nu_)); pg8::GroupOrder S{(const int*)(ws + WS_TILEE), nu_, 8, gdim, xcd_vid(gdim, bidx), (LAS int*)(c.lds + pg8::STAGE_BYTES + 24 * pg8::BM * 4)};
            pg8::EpiFp8 E{(unsigned char*)(ws + WS_Y), D, 8.f / 64.f, rep_};
            pg8::gemm_phase<pg8::EpiFp8, pg8::GroupOrder, false, true>(c.lds, g, S, E, nullptr, c.tid);
            if (L == 0 && S.short_deal()) { REFRESH(); cv_steal(c, CVQ_P11); }
        } } SEAM(pb + 11);
        if (IN(pb + 12)) { for (int rep_ = 0; rep_ <= ((DUPMASK >> 12) & 1); ++rep_) { if (rep_) xcd_barrier(bar); REFRESH(); phase12(c); } }
    }
#undef IN
#undef SEAM
}

#ifndef MK_ONE_LAUNCH
#define MK_ONE_LAUNCH 1
#endif
extern "C" void kernel_launch(void* const* d_in, const int* in_sizes, int n_in, void* d_out, int out_size, void* d_ws, size_t ws_size, hipStream_t stream) {
    static int grid = 0;
    if (grid == 0) {
        if (n_in != 26 || out_size != NLAT * D || ws_size < WS_END) { fprintf(stderr, "kernel_launch: unexpected shapes (n_in %d out %d ws %zu)\n", n_in, out_size, ws_size); grid = -1; return; }
        int dev = 0, cus = 0;
        if (hipGetDevice(&dev) != hipSuccess || hipDeviceGetAttribute(&cus, hipDeviceAttributeMultiprocessorCount, dev) != hipSuccess) { grid = -1; return; }
        if (hipFuncSetAttribute((const void*)fwd, hipFuncAttributeMaxDynamicSharedMemorySize, LDS_BYTES) != hipSuccess) { fprintf(stderr, "kernel_launch: hipFuncSetAttribute failed\n"); grid = -1; return; }
        int per_cu = 0;
        if (hipOccupancyMaxActiveBlocksPerMultiprocessor(&per_cu, (const void*)fwd, 512, LDS_BYTES) != hipSuccess || per_cu < 1) fprintf(stderr, "kernel_launch: occupancy query reports %d\n", per_cu);
        (void)hipGetLastError();
        grid = cus;
    }
    if (grid < 0) return;
    hipMemsetAsync((char*)d_ws + WS_CTL, 0, (size_t)(CW_BAR + XCD_BAR_WORDS) * 4, stream);
    Params prm{};
    for (int i = 0; i < 26; ++i) prm.in[i] = (const GAS float*)d_in[i];
    prm.out = (GAS float*)d_out; prm.ws = (GAS unsigned char*)d_ws;
#if MK_ONE_LAUNCH
    prm.ph_lo = 0; prm.ph_hi = 2 * NPH;
    hipLaunchKernelGGL(fwd, dim3(grid), dim3(512), LDS_BYTES, stream, prm);
#else
    for (int ph = 0; ph < 2 * NPH; ++ph) { prm.ph_lo = ph; prm.ph_hi = ph + 1; hipLaunchKernelGGL(fwd, dim3(grid), dim3(512), LDS_BYTES, stream, prm); }
#endif
}
```

```cpp
#include <hip/hip_runtime.h>
#include <cstdio>

#define DI __device__ __forceinline__
#define LAS __attribute__((address_space(3)))
#if defined(__HIP_DEVICE_COMPILE__)
#define GAS __attribute__((address_space(1)))
#else
#define GAS
#endif
typedef unsigned short bf16;
typedef short bf16x8 __attribute__((ext_vector_type(8)));
typedef short s16x4 __attribute__((ext_vector_type(4)));
typedef float f32x2 __attribute__((ext_vector_type(2)));
typedef float f32x4 __attribute__((ext_vector_type(4)));
typedef float f32x8 __attribute__((ext_vector_type(8)));
typedef float f32x16 __attribute__((ext_vector_type(16)));
typedef unsigned u32x2 __attribute__((ext_vector_type(2)));
typedef unsigned u32x4 __attribute__((ext_vector_type(4)));
typedef __bf16 hbf16x2 __attribute__((ext_vector_type(2)));

constexpr int D = 2048, SEQ = 8192, CTXL = 256, NB = 2;
constexpr int NLAT = NB * SEQ, NCTX = NB * CTXL, NTOK = NLAT + NCTX;
constexpr int PW = 5408, PWP = 5632;
constexpr int NA_Q = 0, NA_K = 512, NA_V = 1024, SC_U = 1536, SC_B = 2048, SC_C = 2560, GL_Q = 3072, GL_K = 3328, GL_V = 3584, GL_G = 4096, GL_Z = 4608, SW_Q = 4640, SW_K = 5152, SW_V = 5280;
constexpr int NEXP = 64, DEXP = 512, NCH = 264;
constexpr int MAXTILES = 658;
constexpr float LN_EPS = 1e-6f, DN_ALPHA = 1.41421356237f;

constexpr size_t MiB = 1u << 20;
constexpr size_t WS_CTL = 0, CTL_BYTES = MiB;
constexpr size_t WS_MOD = 1 * MiB, WS_ROPE = 1 * MiB + 512 * 1024, WS_STATS = 2 * MiB, WS_ROUTW = 3 * MiB, WS_EIDX = 4 * MiB, WS_RANK = 5 * MiB, WS_WTS = 6 * MiB, WS_POS = 7 * MiB,
                 WS_TOKS = 8 * MiB, WS_TILEE = 9 * MiB, WS_GDEC = 10 * MiB, WS_HCTX = 12 * MiB, WS_WIN = 16 * MiB, WS_WOUT = 38 * MiB, WS_WGU = 46 * MiB, WS_WD = 306 * MiB,
                 WS_X1 = 436 * MiB, WS_XN = 568 * MiB, WS_YMIX = 634 * MiB, WS_H = 700 * MiB, WS_UT = WS_H, WS_SIN = WS_H + 66 * MiB, WS_ER = WS_H + 132 * MiB, WS_Y = 865 * MiB, WS_P = WS_Y, WS_XL = WS_Y, WS_XQ = WS_YMIX, WS_XB = WS_X1 + 66 * MiB, WS_T = WS_Y + 192 * MiB,
                 WS_WGU1 = 1523 * MiB, WS_WD1 = 1653 * MiB,
                 WS_END = 1783 * MiB;
constexpr int CW_CNT = 1024, CW_NT = 2048, CW_CV = 3072, CW_BAR = 4096;

DI float bf2f(unsigned v) { return __uint_as_float(v << 16); }
DI unsigned pk2(float a, float b) { hbf16x2 v = __builtin_convertvector((f32x2){a, b}, hbf16x2); return __builtin_bit_cast(unsigned, v); }
DI bf16 f2bf(float a) { return (bf16)(pk2(a, 0.f) & 0xffffu); }
DI float lo16(unsigned u) { return __uint_as_float(u << 16); }
DI float hi16(unsigned u) { return __uint_as_float(u & 0xffff0000u); }
DI bf16x8 pack8(float a0, float a1, float a2, float a3, float a4, float a5, float a6, float a7) {
    u32x4 p; p.x = pk2(a0, a1); p.y = pk2(a2, a3); p.z = pk2(a4, a5); p.w = pk2(a6, a7); return __builtin_bit_cast(bf16x8, p); }
DI void unpack8(bf16x8 v, float (&f)[8]) { u32x4 p = __builtin_bit_cast(u32x4, v); f[0] = lo16(p.x); f[1] = hi16(p.x); f[2] = lo16(p.y); f[3] = hi16(p.y); f[4] = lo16(p.z); f[5] = hi16(p.z); f[6] = lo16(p.w); f[7] = hi16(p.w); }
DI unsigned pk4_fp8(float a, float b, float c, float d) { int p = __builtin_amdgcn_cvt_pk_fp8_f32(a, b, 0, false); p = __builtin_amdgcn_cvt_pk_fp8_f32(c, d, p, true); return (unsigned)p; }
DI int lane_id_fresh() { int l; asm volatile("v_mbcnt_lo_u32_b32 %0, -1, 0\n\tv_mbcnt_hi_u32_b32 %0, -1, %0" : "=v"(l)); return l; }
DI float bperm_f(int srclane, float v) { return __int_as_float(__builtin_amdgcn_ds_bpermute(srclane << 2, __float_as_int(v))); }
DI int bperm_i(int srclane, int v) { return __builtin_amdgcn_ds_bpermute(srclane << 2, v); }
DI float wave_sum(float v) {
    const int l = lane_id_fresh();
#pragma unroll
    for (int o = 1; o < 64; o <<= 1) v += bperm_f(l ^ o, v);
    return v; }
DI int crow(int reg, int h) { return (reg & 3) + 8 * (reg >> 2) + 4 * h; }
#define MFMA32(a, b, c) __builtin_amdgcn_mfma_f32_32x32x16_bf16((a), (b), (c), 0, 0, 0)
#define MFMA16(a, b, c) __builtin_amdgcn_mfma_f32_16x16x32_bf16((a), (b), (c), 0, 0, 0)
DI s16x4 tr_read(LAS unsigned char* p) { return __builtin_amdgcn_ds_read_tr16_b64_v4i16((LAS s16x4*)p); }
DI bf16x8 cat4(s16x4 lo, s16x4 hi) { return __builtin_shufflevector(lo, hi, 0, 1, 2, 3, 4, 5, 6, 7); }
DI f32x16 zero16() { f32x16 z;
#pragma unroll
    for (int i = 0; i < 16; ++i) z[i] = 0.f; return z; }

#ifndef EMU_FP8
#define EMU_FP8 0
#endif
DI float q8(float x) { const int p = __builtin_amdgcn_cvt_pk_fp8_f32(x, x, 0, false); return __builtin_amdgcn_cvt_f32_fp8(p, 0); }
#define XB_TMO      128
#define XB_XCNT(j)  (256  + 64 * (j))
#define XB_XSUB(j)  (1280 + 64 * (j))
#define XB_XGEN(j)  (2304 + 64 * (j))
#define XB_TOP      3328
#define XB_TOPGEN   3392
#define XCD_BAR_WORDS 3456
#define XB_SPIN_CAP (1u << 18)

__device__ __forceinline__ unsigned xb_ld(unsigned* p)              { return __hip_atomic_load(p, __ATOMIC_RELAXED, __HIP_MEMORY_SCOPE_AGENT); }
__device__ __forceinline__ unsigned xb_add(unsigned* p, unsigned v) { return __hip_atomic_fetch_add(p, v, __ATOMIC_RELAXED, __HIP_MEMORY_SCOPE_AGENT); }
__device__ __forceinline__ unsigned xb_xcc_id() { return (unsigned)__builtin_amdgcn_s_getreg((3 << 11) | 20) & 0xFu; }
#define XB_SPIN(cond, bar) do { unsigned _sp = 0; while (cond) { __builtin_amdgcn_s_sleep(1); \
    if ((++_sp & 255u) == 0u) { if (xb_ld(&(bar)[XB_TMO])) break; if (_sp > XB_SPIN_CAP) { atomicAdd(&(bar)[XB_TMO], 1u); break; } } } } while (0)

struct XcdBarrier { unsigned* bar; unsigned x; volatile LAS unsigned* st; unsigned w0; };
__device__ __forceinline__ bool xb_thread0(const XcdBarrier& b) { return b.w0 != 0u && lane_id_fresh() == 0; }

__device__ __forceinline__ XcdBarrier xcd_barrier_post(unsigned* bar, volatile LAS unsigned* st) {
    XcdBarrier b; b.bar = bar; b.x = xb_xcc_id(); b.st = st; b.w0 = (__builtin_amdgcn_readfirstlane(threadIdx.x >> 6) == 0) ? 1u : 0u;
    if (threadIdx.x == 0) (void)xb_add(&bar[XB_XCNT(b.x)], 1u);
    return b;
}
__device__ __forceinline__ void xcd_barrier_complete(unsigned* bar, unsigned x, unsigned& nloc, unsigned& nx) {
    const unsigned G = gridDim.x * gridDim.y * gridDim.z;
    unsigned sum, cnt, mine, sp = 0u;
    for (;;) {
        sum = 0u; cnt = 0u; mine = 0u;
#pragma unroll
        for (unsigned j = 0; j < 16; ++j) { const unsigned c = xb_ld(&bar[XB_XCNT(j)]); sum += c; cnt += (c > 0u) ? 1u : 0u; mine = (j == x) ? c : mine; }
        if (sum == G) break;
        __builtin_amdgcn_s_sleep(1);
        if ((++sp & 255u) == 0u) { if (xb_ld(&bar[XB_TMO])) break; if (sp > XB_SPIN_CAP) { atomicAdd(&bar[XB_TMO], 1u); break; } }
    }
    nloc = mine > 0u ? mine : 1u; nx = cnt > 0u ? cnt : 1u;
}
__device__ __forceinline__ void xcd_barrier(const XcdBarrier& b) {
    asm volatile("s_waitcnt vmcnt(0)" ::: "memory");
    __syncthreads();
    if (xb_thread0(b)) {
        unsigned* bar = b.bar;
        __builtin_amdgcn_s_waitcnt(0);
        unsigned nloc = b.st[0], nx = b.st[1];
        if (nloc == 0u) { xcd_barrier_complete(bar, b.x, nloc, nx); b.st[0] = nloc; b.st[1] = nx; }
        const unsigned old = xb_add(&bar[XB_XSUB(b.x)], 1u);
        const unsigned gen = old / nloc;
        if (old + 1u == (gen + 1u) * nloc) {
            __builtin_amdgcn_fence(__ATOMIC_RELEASE, "agent");
            asm volatile("s_waitcnt vmcnt(0)" ::: "memory");
            const unsigned og = xb_add(&bar[XB_TOP], 1u);
            const unsigned tg = og / nx;
            if (og + 1u == (tg + 1u) * nx) xb_add(&bar[XB_TOPGEN], 1u);
            else XB_SPIN(xb_ld(&bar[XB_TOPGEN]) == tg, bar);
            __builtin_amdgcn_fence(__ATOMIC_ACQUIRE, "agent");
            xb_add(&bar[XB_XGEN(b.x)], 1u);
            asm volatile("s_waitcnt vmcnt(0)" ::: "memory");
        } else {
            XB_SPIN(xb_ld(&bar[XB_XGEN(b.x)]) == gen, bar);
            __builtin_amdgcn_fence(__ATOMIC_ACQUIRE, "agent");
            asm volatile("s_waitcnt vmcnt(0)" ::: "memory");
        }
    }
    __syncthreads();
}

#ifndef PROBE_SKIP_STORES
#define PROBE_SKIP_STORES 0
#endif
namespace pg8 {
constexpr int BM = 256, BK = 64, HALF = 128, HTB = HALF * BK * 2, STAGE_BYTES = 8 * HTB, NXCD = 8, WGM = 8;
__host__ __device__ __forceinline__ int lds_byte(int r, int c) { const int st = (r >> 4) * 2 + (c >> 5), rr = r & 15, cc = c & 31, ob = rr * 64 + cc * 2; return st * 1024 + (ob ^ (((ob >> 9) & 1) << 5)); }
__host__ __device__ __forceinline__ void stage_rc(int b, int& R, int& C) { const int st = b / 1024, sb = b % 1024, swz = sb ^ (((sb >> 9) & 1) << 5); R = (st >> 1) * 16 + swz / 64; C = (st & 1) * 32 + (swz % 64) / 2; }
__host__ __device__ __forceinline__ int perm32(int rho) { const int n = rho >> 4, i = rho & 15; return 8 * (i >> 2) + 4 * n + (i & 3); }

typedef int i32x8 __attribute__((ext_vector_type(8)));
typedef int i32x4 __attribute__((ext_vector_type(4)));
__device__ __forceinline__ i32x8 cat8(bf16x8 a, bf16x8 b) { return __builtin_shufflevector(__builtin_bit_cast(i32x4, a), __builtin_bit_cast(i32x4, b), 0, 1, 2, 3, 4, 5, 6, 7); }
struct Unit { int pm, pn, pc; };
struct Gemm { const bf16* A; const bf16* Bt; int K; };

struct StaticOrder {
    int nM, nN, nwg, G, c;
    __device__ void init(int M, int N, int G_, int c_) { nM = M / BM; nN = N / BM; nwg = nM * nN; G = G_; c = c_; }
    __device__ bool next(int i, Unit& u) const {
        const int L = i * G + c; if (L >= nwg) return false;
        int wgid = L; { const int q = nwg / NXCD, r = nwg % NXCD, xcd = wgid % NXCD, off = wgid / NXCD; wgid = (xcd < r ? xcd * (q + 1) : r * (q + 1) + (xcd - r) * q) + off; }
        const int nig = WGM * nN, gid = wgid / nig, fm = gid * WGM, gsz = (nM - fm) < WGM ? (nM - fm) : WGM;
        u.pm = fm + ((wgid % nig) % gsz); u.pn = (wgid % nig) / gsz; u.pc = u.pn; return true;
    }
    __device__ bool short_deal() const { const int rem = nwg % G; return rem != 0 && c >= rem; }
    static constexpr bool PRELOAD = false;
    __device__ void preload(int) const {}
    __device__ int row_tile(int i) const { Unit u; return next(i, u) ? u.pm : -1; }
};
struct GroupOrder {
    const int* tile_e; int nU, nN, G, c; LAS int* te;
    static constexpr bool PRELOAD = true;
    __device__ void preload(int tid) const { if (tid < 24) { const int L = tid * G + c; te[tid] = L < nU ? tile_e[L / nN] : 0; } }
    __device__ bool next(int i, Unit& u) const {
        const int L = i * G + c; if (L >= nU) return false;
        const int tile = L / nN, j = L % nN;
        u.pm = tile; u.pc = j; u.pn = __builtin_amdgcn_readfirstlane(te[i]) * nN + j; return true;
    }
    __device__ bool short_deal() const { const int rem = nU % G; return rem != 0 && c >= rem; }
    __device__ int row_tile(int i) const { const int L = i * G + c; return L < nU ? L / nN : -1; }
};

struct EpiBf16 {
    static constexpr bool P64 = true; static constexpr int NS = 16;
    bf16* O; int ldc; float scale; int skip;
    __device__ __forceinline__ void operator()(const f32x4 (&acc)[2][2][4][2], const Unit& u, int wr, int wc, int fr, int fq) const {
        if (PROBE_SKIP_STORES && skip) return;
        const int row0 = u.pm * BM + wr * 64 + fr, col0 = u.pc * BM + wc * 64 + 16 * fq;
#pragma unroll
        for (int ai = 0; ai < 2; ++ai)
#pragma unroll
            for (int m = 0; m < 4; ++m) { bf16* rowp = O + (size_t)(row0 + ai * HALF + m * 16) * ldc + col0;
#pragma unroll
                for (int bj = 0; bj < 2; ++bj) { const f32x4 v0 = acc[ai][bj][m][0] * scale, v1 = acc[ai][bj][m][1] * scale;
                    u32x4 w; w.x = pk2(v0[0], v0[1]); w.y = pk2(v0[2], v0[3]); w.z = pk2(v1[0], v1[1]); w.w = pk2(v1[2], v1[3]);
                    *(u32x4*)(rowp + 8 * bj) = w; } }
    }
};
struct EpiFp8 {
    static constexpr bool P64 = true; static constexpr int NS = 8;
    unsigned char* O; int ldc; float scale; int skip;
    __device__ __forceinline__ void operator()(const f32x4 (&acc)[2][2][4][2], const Unit& u, int wr, int wc, int fr, int fq) const {
        if (PROBE_SKIP_STORES && skip) return;
        const int row0 = u.pm * BM + wr * 64 + fr, col0 = u.pc * BM + wc * 64 + 16 * fq;
#pragma unroll
        for (int ai = 0; ai < 2; ++ai)
#pragma unroll
            for (int m = 0; m < 4; ++m) { unsigned char* rowp = O + (size_t)(row0 + ai * HALF + m * 16) * ldc + col0;
                u32x4 w;
#pragma unroll
                for (int bj = 0; bj < 2; ++bj) { const f32x4 v0 = acc[ai][bj][m][0] * scale, v1 = acc[ai][bj][m][1] * scale;
                    w[2 * bj] = pk4_fp8(v0[0], v0[1], v0[2], v0[3]); w[2 * bj + 1] = pk4_fp8(v1[0], v1[1], v1[2], v1[3]); }
                *(u32x4*)rowp = w; }
    }
};
struct EpiSwiglu8 {
    static constexpr bool P64 = false; static constexpr int NS = 8;
    unsigned char* O;
    __device__ __forceinline__ void operator()(const f32x4 (&acc)[2][2][4][2], const Unit& u, int wr, int wc, int fr, int fq) const {
        const int row0 = u.pm * BM + wr * 64 + fr, col0 = u.pc * HALF + wc * 32 + 8 * fq;
#pragma unroll
        for (int ai = 0; ai < 2; ++ai)
#pragma unroll
            for (int m = 0; m < 4; ++m) { unsigned char* rowp = O + (size_t)(row0 + ai * HALF + m * 16) * DEXP + col0;
                float h[8];
#pragma unroll
                for (int n = 0; n < 2; ++n)
#pragma unroll
                    for (int j = 0; j < 4; ++j) { const float g = acc[ai][0][m][n][j], up = acc[ai][1][m][n][j];
                        h[n * 4 + j] = (g * up) * __builtin_amdgcn_rcpf(__builtin_fmaf(__builtin_amdgcn_exp2f(g * (-1.4426950408889634f / 64.f)), 4096.f, 4096.f)); }
                u32x2 w; int p0 = __builtin_amdgcn_cvt_pk_fp8_f32(h[0], h[1], 0, false); p0 = __builtin_amdgcn_cvt_pk_fp8_f32(h[2], h[3], p0, true);
                int p1 = __builtin_amdgcn_cvt_pk_fp8_f32(h[4], h[5], 0, false); p1 = __builtin_amdgcn_cvt_pk_fp8_f32(h[6], h[7], p1, true);
                w.x = (unsigned)p0; w.y = (unsigned)p1;
                *(u32x2*)rowp = w; }
    }
};

template <class Epi, class Sched, bool GATHER, bool FP8 = false>
__device__ __forceinline__ void gemm_phase(LAS unsigned char* lds, const Gemm g, const Sched& S, const Epi& E, const int* toks, int tid_in) {
    int tid_ = tid_in; asm volatile("" : "+v"(tid_));
    const int tid = tid_, wid = __builtin_amdgcn_readfirstlane(tid >> 6), lane = tid & 63, wr = wid >> 2, wc = wid & 3, fr = lane & 15, fq = lane >> 4;
    int K_ = g.K; asm volatile("" : "+s"(K_));
    const int K = K_, nt = K / BK;
    unsigned voffA[2], voffB[2];
#pragma unroll
    for (int i = 0; i < 2; ++i) { int R, C; stage_rc(tid * 16 + i * 8192, R, C);
        const int rho_ = R & 31, Rb = Epi::P64 ? 64 * (R >> 5) + 16 * ((rho_ & 15) >> 2) + 4 * (rho_ >> 4) + (rho_ & 3) : (R & ~31) + perm32(rho_);
        voffA[i] = (unsigned)(R * K + C) * 2u; voffB[i] = (unsigned)(Rb * K + C) * 2u; }
    const size_t kstep = (size_t)(BK * 2);
    const size_t hstep = (size_t)HALF * K * 2;
    const size_t tstep = 2 * hstep;
    const size_t bstep = Epi::P64 ? (size_t)16 * K : hstep;
    const unsigned ldsw = (unsigned)wid * 1024u;
    const int aoff = lds_byte(wr * 64 + fr, fq * 8), boff = lds_byte(wc * 32 + fr, fq * 8);
#define PG8_SA(b, h) (((b) * 2 + (h)) * HTB)
#define PG8_SB(b, h) ((4 + (b) * 2 + (h)) * HTB)
#define PG8_STAGE(bufoff, gbase, voff) do { _Pragma("unroll") for (int _i = 0; _i < 2; ++_i) \
        __builtin_amdgcn_global_load_lds((const unsigned*)((const char*)(gbase) + (voff)[_i]), (LAS unsigned*)(lds + (bufoff) + ldsw + _i * 8192), 16, 0, 0); } while (0)
#define PG8_STAGEA(bufoff, kb, vo, ub, h) do { _Pragma("unroll") for (int _i = 0; _i < 2; ++_i) \
        __builtin_amdgcn_global_load_lds((const unsigned*)(GATHER ? (const char*)g.A + (kb) + (vo)[h][_i] : (ub) + (kb) + (h) * hstep + voffA[_i]), (LAS unsigned*)(lds + (bufoff) + ldsw + _i * 8192), 16, 0, 0); } while (0)
#define PG8_LDA(dst, b, h) do { _Pragma("unroll") for (int m = 0; m < 4; ++m) _Pragma("unroll") for (int k = 0; k < 2; ++k) dst[m][k] = *(const LAS bf16x8*)(lds + PG8_SA(b, h) + aoff + m * 2048 + k * 1024); } while (0)
#define PG8_LDB(dst, b, h) do { _Pragma("unroll") for (int n = 0; n < 2; ++n) _Pragma("unroll") for (int k = 0; k < 2; ++k) dst[n][k] = *(const LAS bf16x8*)(lds + PG8_SB(b, h) + boff + n * 2048 + k * 1024); } while (0)
#define PG8_MMA(ai, bj, At, Bt) do { __builtin_amdgcn_s_setprio(1); _Pragma("unroll") for (int m = 0; m < 4; ++m) _Pragma("unroll") for (int n = 0; n < 2; ++n) { \
        if (FP8) { asm volatile("v_mfma_f32_16x16x128_f8f6f4 %0, %1, %2, %0" : "+v"(acc[ai][bj][m][n]) : "v"(cat8(Bt[n][0], Bt[n][1])), "v"(cat8(At[m][0], At[m][1]))); }   \
        else { _Pragma("unroll") for (int k = 0; k < 2; ++k) acc[ai][bj][m][n] = __builtin_amdgcn_mfma_f32_16x16x32_bf16(Bt[n][k], At[m][k], acc[ai][bj][m][n], 0, 0, 0); } } \
        __builtin_amdgcn_s_setprio(0); } while (0)
#define PG8_WAIT_V(n) asm volatile("s_waitcnt vmcnt(" #n ")" ::: "memory")
#define PG8_WAIT_L(n) asm volatile("s_waitcnt lgkmcnt(" #n ")" ::: "memory")
#define PG8_BAR __builtin_amdgcn_s_barrier()
#define PG8_SCHED __builtin_amdgcn_sched_barrier(0)
    LAS int* ids = (LAS int*)(lds + STAGE_BYTES);
#define PG8_VOA(dst, uidx, un) do { if (GATHER) { _Pragma("unroll") for (int _h = 0; _h < 2; ++_h) _Pragma("unroll") for (int _i = 0; _i < 2; ++_i) { int _t = tid; asm volatile("" : "+v"(_t)); int _R, _C; stage_rc(_t * 16 + _i * 8192, _R, _C); \
        const int _row = ids[(uidx) * BM + _h * HALF + _R]; dst[_h][_i] = (unsigned)(_row * K + _C) * 2u; } } } while (0)
    if (Sched::PRELOAD) { S.preload(tid); if (!GATHER) __syncthreads(); }
    if (GATHER) {
        const int hi = tid >> 8, r = tid & 255;
        for (int i0 = 0; i0 < 24; i0 += 12) {
            int v[6];
#pragma unroll
            for (int k = 0; k < 6; ++k) { const int pm = S.row_tile(i0 + 2 * k + hi); v[k] = pm >= 0 ? toks[pm * BM + r] : 0; }
#pragma unroll
            for (int k = 0; k < 6; ++k) ids[(i0 + 2 * k + hi) * BM + r] = v[k];
            if (S.row_tile(i0 + 12) < 0) break;
        }
        __syncthreads();
    }
    Unit cur, nxt; int ui = 0;
    if (!S.next(0, cur)) return;
    f32x4 acc[2][2][4][2];
#pragma unroll
    for (int a = 0; a < 2; ++a)
#pragma unroll
        for (int b = 0; b < 2; ++b)
#pragma unroll
            for (int m = 0; m < 4; ++m)
#pragma unroll
                for (int n = 0; n < 2; ++n) acc[a][b][m][n] = (f32x4){0.f, 0.f, 0.f, 0.f};
    bf16x8 At[4][2], B0[2][2], B1[2][2];
    unsigned voA[2][2] = {{0u, 0u}, {0u, 0u}}, voN[2][2] = {{0u, 0u}, {0u, 0u}};
    PG8_VOA(voA, 0, cur);
    const char* cA = (const char*)g.A + (size_t)cur.pm * tstep;
    const char* cB = (const char*)g.Bt + (size_t)cur.pn * tstep;
    PG8_STAGE(PG8_SB(0, 0), cB, voffB); PG8_STAGEA(PG8_SA(0, 0), 0, voA, cA, 0); PG8_STAGE(PG8_SB(0, 1), cB + bstep, voffB); PG8_STAGEA(PG8_SA(0, 1), 0, voA, cA, 1);
    if (wr == 1) PG8_BAR;
    PG8_WAIT_V(4); PG8_BAR;
    PG8_STAGE(PG8_SB(1, 0), cB + kstep, voffB); PG8_STAGEA(PG8_SA(1, 0), kstep, voA, cA, 0); PG8_STAGE(PG8_SB(1, 1), cB + bstep + kstep, voffB);
    PG8_WAIT_V(6); PG8_BAR;
    for (;;) {
        const bool has_next = S.next(ui + 1, nxt);
        if (has_next) { PG8_VOA(voN, ui + 1, nxt); }
        else if (GATHER) {
#pragma unroll
            for (int _h = 0; _h < 2; ++_h)
#pragma unroll
                for (int _i = 0; _i < 2; ++_i) voN[_h][_i] = voA[_h][_i]; }
        const char* nA = has_next ? (const char*)g.A + (size_t)nxt.pm * tstep : cA;
        const char* nB = has_next ? (const char*)g.Bt + (size_t)nxt.pn * tstep : cB;
        for (int t = 0; t < nt; t += 2) {
            const bool last = (t == nt - 2);
            const size_t k1 = (size_t)(t + 1) * kstep;
            const size_t k2 = last ? 0 : (size_t)(t + 2) * kstep, k3 = k2 + kstep;
            const char* b2 = last ? nB : cB + (size_t)(t + 2) * kstep; const char* b3 = b2 + kstep;
            unsigned vo2[2][2] = {{0u, 0u}, {0u, 0u}};
            if (GATHER) {
#pragma unroll
                for (int _h = 0; _h < 2; ++_h)
#pragma unroll
                    for (int _i = 0; _i < 2; ++_i) vo2[_h][_i] = last ? voN[_h][_i] : voA[_h][_i]; }
            const char* a2 = last ? nA : cA;
            const bool pre = (ui > 0) && (t == 0);
            PG8_LDB(B0, 0, 0); PG8_SCHED; PG8_LDA(At, 0, 0); if (!pre) PG8_STAGEA(PG8_SA(1, 1), k1, voA, cA, 1);
            PG8_WAIT_L(8); PG8_BAR; PG8_WAIT_L(0); PG8_MMA(0, 0, At, B0); PG8_BAR; PG8_SCHED;
            PG8_LDB(B1, 0, 1); PG8_STAGE(PG8_SB(0, 0), b2, voffB);
            PG8_BAR; PG8_WAIT_L(0); PG8_MMA(0, 1, At, B1); PG8_BAR;
            PG8_LDA(At, 0, 1); PG8_STAGEA(PG8_SA(0, 0), k2, vo2, a2, 0);
            PG8_BAR; PG8_WAIT_L(0); PG8_MMA(1, 0, At, B0); PG8_BAR; PG8_SCHED;
            PG8_STAGE(PG8_SB(0, 1), b2 + bstep, voffB);
            if (pre) asm volatile("s_waitcnt vmcnt(%0)" :: "n"(6 + Epi::NS) : "memory");
            else PG8_WAIT_V(6);
            PG8_BAR; PG8_MMA(1, 1, At, B1); PG8_BAR;
            PG8_LDB(B0, 1, 0); PG8_SCHED; PG8_LDA(At, 1, 0); PG8_STAGEA(PG8_SA(0, 1), k2, vo2, a2, 1);
            PG8_WAIT_L(8); PG8_BAR; PG8_WAIT_L(0); PG8_MMA(0, 0, At, B0); PG8_BAR; PG8_SCHED;
            PG8_LDB(B1, 1, 1); PG8_STAGE(PG8_SB(1, 0), b3, voffB);
            PG8_BAR; PG8_WAIT_L(0); PG8_MMA(0, 1, At, B1); PG8_BAR;
            PG8_LDA(At, 1, 1); PG8_STAGEA(PG8_SA(1, 0), k3, vo2, a2, 0);
            PG8_BAR; PG8_WAIT_L(0); PG8_MMA(1, 0, At, B0); PG8_BAR; PG8_SCHED;
            PG8_STAGE(PG8_SB(1, 1), b3 + bstep, voffB);
            PG8_WAIT_V(6); PG8_BAR; PG8_MMA(1, 1, At, B1); PG8_BAR;
        }
        if (has_next) PG8_STAGEA(PG8_SA(1, 1), kstep, voN, nA, 1);
        if (FP8) asm volatile("s_nop 15\n\ts_nop 15" ::: "memory");
        E(acc, cur, wr, wc, fr, fq);
        if (!has_next) break;
#pragma unroll
        for (int a = 0; a < 2; ++a)
#pragma unroll
            for (int b = 0; b < 2; ++b)
#pragma unroll
                for (int m = 0; m < 4; ++m)
#pragma unroll
                    for (int n = 0; n < 2; ++n) acc[a][b][m][n] = (f32x4){0.f, 0.f, 0.f, 0.f};
        cur = nxt; cA = nA; cB = nB; ++ui;
        if (GATHER) {
#pragma unroll
            for (int _h = 0; _h < 2; ++_h)
#pragma unroll
                for (int _i = 0; _i < 2; ++_i) voA[_h][_i] = voN[_h][_i]; }
    }
    PG8_WAIT_V(0);
    if (wr == 0) PG8_BAR;
    PG8_BAR;
#undef PG8_SA
#undef PG8_SB
#undef PG8_STAGE
#undef PG8_STAGEA
#undef PG8_LDA
#undef PG8_LDB
#undef PG8_MMA
#undef PG8_WAIT_V
#undef PG8_WAIT_L
#undef PG8_BAR
#undef PG8_SCHED
#undef PG8_VOA
}
}
struct Params {
    const GAS float* in[26];
    GAS float* out;
    GAS unsigned char* ws;
    int ph_lo, ph_hi;
};
typedef const Params __attribute__((address_space(4))) CParams;
constexpr int NPH = 13;
constexpr int WAVE_LDS = 19968;
constexpr int LDS_MISC = 8 * WAVE_LDS;
constexpr int LDS_BYTES = LDS_MISC + 1024;

struct Ctx {
    LAS unsigned char* lds; int tid, lane, wave, gw, ngw, L, bid, nblk;
    CParams* p;
    unsigned char* ws;
};
DI unsigned char* fresh(GAS unsigned char* q) { asm volatile("" : "+s"(q)); return (unsigned char*)q; }
#define inp(c, k) ((const float*)(c).p->in[k])
#define outp(c) ((float*)(c).p->out)

DI void transpose_item(const float* W, int K, int N, bf16* WT, int drow0, LAS float* scr, int kb, int nb, int lane, bool lo_part, float qs = 0.f) {
    const int k0 = 64 * kb, n0 = 32 * nb;
#pragma unroll 8
    for (int i = 0; i < 32; ++i) { const int kk = 2 * i + (lane >> 5); scr[kk * 33 + (lane & 31)] = W[(size_t)(k0 + kk) * N + n0 + (lane & 31)]; }
    asm volatile("s_waitcnt lgkmcnt(0)" ::: "memory");
    const int c = lane & 7;
#pragma unroll
    for (int j = 0; j < 4; ++j) { const int n = (lane >> 3) + 8 * j; const LAS float* s = scr + (8 * c) * 33 + n;
        float v[8];
#pragma unroll
        for (int q = 0; q < 8; ++q) { v[q] = s[q * 33]; if (lo_part) v[q] = v[q] - bf2f(f2bf(v[q])); if (EMU_FP8 && qs != 0.f) v[q] = q8(v[q] * qs) / qs; }
        u32x4 o; o.x = pk2(v[0], v[1]); o.y = pk2(v[2], v[3]); o.z = pk2(v[4], v[5]); o.w = pk2(v[6], v[7]);
        *(u32x4*)(WT + (size_t)(drow0 + n) * K + k0 + 8 * c) = o; }
    asm volatile("s_waitcnt lgkmcnt(0)" ::: "memory");
}

DI void transpose_item8(const float* W, int K, int N, unsigned char* WT, int drow0, LAS float* scr, int kb, int nb, int lane) {
    const int k0 = 64 * kb, n0 = 64 * nb;
    f32x4 v[16];
    const int ncol = min(n0 + 4 * (lane & 15), N - 4);
#pragma unroll
    for (int i = 0; i < 16; ++i) v[i] = *(const f32x4*)(W + (size_t)(k0 + 4 * i + (lane >> 4)) * N + ncol);
#pragma unroll
    for (int i = 0; i < 16; ++i) { LAS float* d = scr + (4 * i + (lane >> 4)) * 65 + 4 * (lane & 15); d[0] = v[i].x; d[1] = v[i].y; d[2] = v[i].z; d[3] = v[i].w; }
    asm volatile("s_waitcnt lgkmcnt(0)" ::: "memory");
    const int c = lane & 7;
#pragma unroll
    for (int j = 0; j < 8; ++j) { const int n = (lane >> 3) + 8 * j; const LAS float* s = scr + (8 * c) * 65 + n;
        float q[8];
#pragma unroll
        for (int e = 0; e < 8; ++e) q[e] = s[e * 65] * 64.f;
        int p0 = __builtin_amdgcn_cvt_pk_fp8_f32(q[0], q[1], 0, false); p0 = __builtin_amdgcn_cvt_pk_fp8_f32(q[2], q[3], p0, true);
        int p1 = __builtin_amdgcn_cvt_pk_fp8_f32(q[4], q[5], 0, false); p1 = __builtin_amdgcn_cvt_pk_fp8_f32(q[6], q[7], p1, true);
        u32x2 o; o.x = (unsigned)p0; o.y = (unsigned)p1;
        *(u32x2*)(WT + (size_t)(drow0 + n) * K + k0 + 8 * c) = o; }
    asm volatile("s_waitcnt lgkmcnt(0)" ::: "memory");
}

struct CvItem { const float* src; unsigned char* dst; int K, N; };
DI bool cv_decode(const Ctx& c, int L, int r, CvItem& it) {
    constexpr int I_E = 768;
    if (r >= 65 * I_E) return false;
    unsigned char* ws = c.ws; const size_t wgu_off = L == 0 ? WS_WGU : WS_WGU1, wd_off = L == 0 ? WS_WD : WS_WD1;
    const int e = r / I_E, q = r % I_E, which = q / 256, idx = q % 256;
    if (which < 2) {
        const float* W = e < 64 ? inp(c, which == 0 ? 18 : 19) + ((size_t)(L * 64 + e)) * D * DEXP : inp(c, which == 0 ? 21 : 22) + (size_t)L * D * DEXP;
        const int kb = idx / 8, nb = idx % 8, n0 = 64 * nb, k0 = 64 * kb;
        it.K = D; it.N = DEXP; it.src = W + (size_t)k0 * DEXP + n0;
        it.dst = (unsigned char*)(ws + wgu_off) + (size_t)(e * 1024 + (n0 / 128) * 256 + which * 128 + (n0 % 128)) * D + k0;
    } else {
        const float* W = e < 64 ? inp(c, 20) + ((size_t)(L * 64 + e)) * DEXP * D : inp(c, 23) + (size_t)L * DEXP * D;
        const int kb = idx / 32, nb = idx % 32, n0 = 64 * nb, k0 = 64 * kb;
        it.K = DEXP; it.N = D; it.src = W + (size_t)k0 * D + n0;
        it.dst = (unsigned char*)(ws + wd_off) + (size_t)(e * 2048 + n0) * DEXP + k0;
    }
    return true;
}
DI void cv_load(const CvItem& it, f32x4 (&v)[16], int lane) {
#pragma unroll
    for (int i = 0; i < 16; ++i) v[i] = __builtin_nontemporal_load((const f32x4*)(it.src + (size_t)(4 * i + (lane >> 4)) * it.N + 4 * (lane & 15)));
}
DI void cv_store(const CvItem& it, const f32x4 (&v)[16], LAS float* scr, int lane) {
#pragma unroll
    for (int i = 0; i < 16; ++i) { LAS float* d = scr + (4 * i + (lane >> 4)) * 65 + 4 * (lane & 15); d[0] = v[i].x; d[1] = v[i].y; d[2] = v[i].z; d[3] = v[i].w; }
    asm volatile("s_waitcnt lgkmcnt(0)" ::: "memory");
    const int c8 = lane & 7;
#pragma unroll
    for (int j = 0; j < 8; ++j) { const int n = (lane >> 3) + 8 * j; const LAS float* s = scr + (8 * c8) * 65 + n;
        float q[8];
#pragma unroll
        for (int e = 0; e < 8; ++e) q[e] = s[e * 65] * 64.f;
        u32x2 o; o.x = pk4_fp8(q[0], q[1], q[2], q[3]); o.y = pk4_fp8(q[4], q[5], q[6], q[7]);
        *(u32x2*)(it.dst + (size_t)n * it.K + 8 * c8) = o; }
    asm volatile("s_waitcnt lgkmcnt(0)" ::: "memory");
}
DI void convert_experts(const Ctx& c, int L, int it0, int step) {
    LAS float* scr = (LAS float*)(c.lds + c.wave * WAVE_LDS);
    CvItem ia, ib; f32x4 va[16], vb[16];
    int r = it0;
    bool ha = cv_decode(c, L, r, ia); if (ha) cv_load(ia, va, c.lane);
    while (ha) {
        const bool hb = cv_decode(c, L, r + step, ib); if (hb) cv_load(ib, vb, c.lane);
        cv_store(ia, va, scr, c.lane);
        if (!hb) break;
        ha = cv_decode(c, L, r + 2 * step, ia); if (ha) cv_load(ia, va, c.lane);
        cv_store(ib, vb, scr, c.lane);
        r += 2 * step;
    }
}
DI void cv_steal(const Ctx& c, int npairs) {
    LAS float* scr = (LAS float*)(c.lds + c.wave * WAVE_LDS);
    unsigned* ctr = (unsigned*)(c.ws + WS_CTL) + CW_CV;
    for (int i = 0; i < npairs; ++i) {
        unsigned idx = 0u;
        if (c.lane == 0) idx = __hip_atomic_fetch_add(ctr, 2u, __ATOMIC_RELAXED, __HIP_MEMORY_SCOPE_AGENT);
        const int r = __builtin_amdgcn_readfirstlane((int)idx);
        CvItem ia, ib; f32x4 va[16], vb[16];
        const bool ha = cv_decode(c, 1, r, ia); if (!ha) break;
        cv_load(ia, va, c.lane);
        const bool hb = cv_decode(c, 1, r + 1, ib); if (hb) cv_load(ib, vb, c.lane);
        cv_store(ia, va, scr, c.lane);
        if (hb) cv_store(ib, vb, scr, c.lane);
    }
}

DI void phase0(const Ctx& c) {
    const int L = c.L;
    unsigned char* ws = c.ws;
    if (L == 0) {
        LAS float* sc = (LAS float*)c.lds;
        LAS float* part = (LAS float*)(c.lds + 32768);
        for (int i = c.tid; i < 3 * D; i += 512) { const int r = i / D, k = i % D; const float v = r < 2 ? inp(c, 1)[r * D + k] : inp(c, 3)[k]; sc[i] = v / (1.f + __expf(-v)); }
        __syncthreads();
        for (int cb = c.bid; cb < 512; cb += c.nblk) {
            const int Lm = cb >> 8, n0 = (cb & 255) * 48;
            const float* wa = inp(c, 4) + (size_t)Lm * D * 6 * D; const float* ba = inp(c, 5) + (size_t)Lm * 6 * D;
            float* mod = (float*)(ws + WS_MOD) + (size_t)Lm * 3 * 6 * D;
            float a0 = 0.f, a1 = 0.f, a2 = 0.f;
            if (c.lane < 48) {
                const float* wp = wa + (size_t)(c.wave * 256) * (6 * D) + n0 + c.lane;
                for (int k0 = 0; k0 < 256; k0 += 32) {
                    float wv[32];
#pragma unroll
                    for (int k = 0; k < 32; ++k) wv[k] = wp[(size_t)(k0 + k) * (6 * D)];
#pragma unroll
                    for (int k = 0; k < 32; ++k) { const int kk = c.wave * 256 + k0 + k; a0 += sc[kk] * wv[k]; a1 += sc[D + kk] * wv[k]; a2 += sc[2 * D + kk] * wv[k]; }
                }
                part[(c.wave * 3 + 0) * 48 + c.lane] = a0; part[(c.wave * 3 + 1) * 48 + c.lane] = a1; part[(c.wave * 3 + 2) * 48 + c.lane] = a2;
            }
            __syncthreads();
            if (c.tid < 144) { const int r = c.tid / 48, j = c.tid % 48; float s = 0.f;
#pragma unroll
                for (int w = 0; w < 8; ++w) s += part[(w * 3 + r) * 48 + j];
                mod[r * 6 * D + n0 + j] = s + ba[n0 + j]; }
            __syncthreads();
        }
    }
    __syncthreads();
    {
        LAS float* scr = (LAS float*)(c.lds + c.wave * WAVE_LDS);
        constexpr int I_IN = 32 * ((PW + 63) / 64), I_OUT = 32 * 32, I_R = 64;
        constexpr int NIT = I_IN + I_OUT + 2 * I_R;
        bf16* win = (bf16*)(ws + WS_WIN); bf16* wout = (bf16*)(ws + WS_WOUT); bf16* rw = (bf16*)(ws + WS_ROUTW);
        for (int it = c.gw; it < NIT; it += c.ngw) {
            int r = it;
            if (r < I_IN) { const int nblk = (PW + 63) / 64; transpose_item8(inp(c, 6) + (size_t)L * D * PW, D, PW, (unsigned char*)win, 64 * (r % nblk), scr, r / nblk, r % nblk, c.lane); continue; } r -= I_IN;
            if (r < I_OUT) { transpose_item8(inp(c, 13) + (size_t)L * D * D, D, D, (unsigned char*)wout, 64 * (r % 32), scr, r / 32, r % 32, c.lane); continue; } r -= I_OUT;
            { const int lo = r / I_R, idx = r % I_R, kb = idx / 2, nb = idx % 2;
              transpose_item(inp(c, 16) + (size_t)L * D * NEXP, D, NEXP, rw, lo * 64 + 32 * nb, scr, kb, nb, c.lane, lo != 0); }
        }
    }
    if (L == 0) convert_experts(c, 0, c.gw, c.ngw);
    else { const int r0 = (int)__hip_atomic_load((unsigned*)(c.ws + WS_CTL) + CW_CV, __ATOMIC_RELAXED, __HIP_MEMORY_SCOPE_AGENT);
           convert_experts(c, 1, r0 + c.gw, c.ngw); }
    if (L == 0) {
        float* rope = (float*)(ws + WS_ROPE);
        for (int i = c.bid * 512 + c.tid; i < 128 * 16; i += c.nblk * 512) {
            const int pos = i / 16, f = i % 16;
            const float inv = exp2f(-(float)f * (13.287712379549449f / 16.f));
            const float ang = (float)pos * inv;
            const float n = rintf(ang * 0.15915494309189535f);
            float rr = fmaf(-n, 6.28125f, ang); rr = fmaf(-n, 1.9353071795864769e-3f, rr);
            rope[2 * i] = __cosf(rr); rope[2 * i + 1] = __sinf(rr);
        }
    }
}

DI void row_stats(const f32x4 (&v)[8], float& mean, float& rstd) {
    float s = 0.f;
#pragma unroll
    for (int j = 0; j < 8; ++j) s += (v[j].x + v[j].y) + (v[j].z + v[j].w);
    mean = wave_sum(s) * (1.f / D);
    float q = 0.f;
#pragma unroll
    for (int j = 0; j < 8; ++j) { const f32x4 d = v[j] - mean; q += (d.x * d.x + d.y * d.y) + (d.z * d.z + d.w * d.w); }
    rstd = 1.f / sqrtf(wave_sum(q) * (1.f / D) + LN_EPS);
}
DI const float* mod_row_l(const Ctx& c, int row, int l) { return (const float*)(c.ws + WS_MOD) + (size_t)(l * 3 + (row < NLAT ? row / SEQ : 2)) * 6 * D; }
DI const float* mod_row(const Ctx& c, int row) { return mod_row_l(c, row, c.L); }
DI const float* x_in_row(const Ctx& c, int row) {

    if (row < NLAT) return inp(c, 0) + (size_t)row * D;
    return inp(c, 2) + (size_t)(row - NLAT) * D;
}

DI void phase1(const Ctx& c) {
    unsigned char* xn = (unsigned char*)(c.ws + WS_XN);
    LAS float* cl = (LAS float*)c.lds;
    for (int i = c.tid; i < 12288 / 4; i += 512) { const int e = 4 * i, seg = e >> 11, col = e & 2047;
        *(LAS f32x4*)(cl + e) = *(const f32x4*)((const float*)(c.ws + WS_MOD) + (size_t)(seg % 3) * 6 * D + (size_t)(seg / 3) * D + col); }
    __syncthreads();
    auto load_pair = [&](int r2, f32x4 (&t)[2][8]) {
#pragma unroll
        for (int u = 0; u < 2; ++u) { const float* xr = x_in_row(c, 2 * r2 + u);
#pragma unroll
            for (int j = 0; j < 8; ++j) t[u][j] = *(const f32x4*)(xr + 4 * c.lane + 256 * j); } };
    f32x4 v[2][8];
    if (c.gw < NTOK / 2) load_pair(c.gw, v);
    for (int r2 = c.gw; r2 < NTOK / 2; r2 += c.ngw) {
        f32x4 vn[2][8]; float mean[2], rstd[2];
        { const int n2 = r2 + c.ngw; if (n2 < NTOK / 2) load_pair(n2, vn); }
#pragma unroll
        for (int u = 0; u < 2; ++u) row_stats(v[u], mean[u], rstd[u]);
        const int mset = 2 * r2 < NLAT ? (2 * r2) / SEQ : 2;
#pragma unroll
        for (int j = 0; j < 8; ++j) { const int col = 4 * c.lane + 256 * j;
            const f32x4 sh = *(const LAS f32x4*)(cl + 2048 * mset + col), sc = *(const LAS f32x4*)(cl + 6144 + 2048 * mset + col);
#pragma unroll
            for (int u = 0; u < 2; ++u) { const f32x4 y = (v[u][j] - mean[u]) * rstd[u] * (sc + 1.f) + sh;
                *(unsigned*)(xn + (size_t)(2 * r2 + u) * D + col) = pk4_fp8(y.x, y.y, y.z, y.w); } }
#pragma unroll
        for (int u = 0; u < 2; ++u)
#pragma unroll
            for (int j = 0; j < 8; ++j) v[u][j] = vn[u][j];
    }
}

DI void phase7(const Ctx& c) {
    const int L = c.L;
    bf16* xl = (bf16*)(c.ws + WS_XL); const bf16* T = (const bf16*)(c.ws + WS_T); bf16* x1 = (bf16*)(c.ws + WS_X1);
    const bf16* xb = (const bf16*)(c.ws + WS_XB);
    const float* lg = inp(c, 14) + (size_t)L * D; const float* lb = inp(c, 15) + (size_t)L * D;
    const int nrows = L == 0 ? NTOK : NLAT;
    LAS float* cl = (LAS float*)c.lds;
    for (int i = c.tid; i < 22528 / 4; i += 512) { const int e = 4 * i, seg = e >> 11, col = e & 2047; const float* src;
        if (seg == 0) src = lg + col; else if (seg == 1) src = lb + col;
        else src = (const float*)(c.ws + WS_MOD) + (size_t)(L * 3 + (seg - 2) % 3) * 6 * D + (size_t)(2 + (seg - 2) / 3) * D + col;
        *(LAS f32x4*)(cl + e) = *(const f32x4*)src; }
    __syncthreads();
    auto finish = [&](f32x4 (&v)[2][8], int r2, int mset) {
        float mean[2], rstd[2];
#pragma unroll
        for (int u = 0; u < 2; ++u) row_stats(v[u], mean[u], rstd[u]);
#pragma unroll
        for (int j = 0; j < 8; ++j) { const int col = 4 * c.lane + 256 * j; const f32x4 gg = *(const LAS f32x4*)(cl + col), bb = *(const LAS f32x4*)(cl + 2048 + col);
#pragma unroll
            for (int u = 0; u < 2; ++u) { v[u][j] = (v[u][j] - mean[u]) * rstd[u] * gg + bb; u32x2 o; o.x = pk2(v[u][j].x, v[u][j].y); o.y = pk2(v[u][j].z, v[u][j].w); *(u32x2*)(x1 + (size_t)(2 * r2 + u) * D + col) = o; } }
#pragma unroll
        for (int u = 0; u < 2; ++u) row_stats(v[u], mean[u], rstd[u]);
#pragma unroll
        for (int j = 0; j < 8; ++j) { const int col = 4 * c.lane + 256 * j;
            const f32x4 sh = *(const LAS f32x4*)(cl + 10240 + 2048 * mset + col), sc = *(const LAS f32x4*)(cl + 16384 + 2048 * mset + col);
#pragma unroll
            for (int u = 0; u < 2; ++u) { const f32x4 y = (v[u][j] - mean[u]) * rstd[u] * (sc + 1.f) + sh;
                int pq = __builtin_amdgcn_cvt_pk_fp8_f32(y.x, y.y, 0, false); pq = __builtin_amdgcn_cvt_pk_fp8_f32(y.z, y.w, pq, true);
                const f32x2 qa = __builtin_amdgcn_cvt_pk_f32_fp8(pq, false), qb = __builtin_amdgcn_cvt_pk_f32_fp8(pq, true);
                u32x2 ol; ol.x = pk2(y.x - qa.x, y.y - qa.y); ol.y = pk2(y.z - qb.x, y.w - qb.y);
                *(u32x2*)(xl + (size_t)(2 * r2 + u) * D + col) = ol;
                *(int*)((unsigned char*)(c.ws + WS_XQ) + (size_t)(2 * r2 + u) * D + col) = pq; } } };
    if (L == 0) {
        f32x4 xc[2][8]; u32x2 tc[2][8];
        auto ldp = [&](int r2) {
#pragma unroll
            for (int u = 0; u < 2; ++u) { const float* xr = x_in_row(c, 2 * r2 + u);
#pragma unroll
                for (int j = 0; j < 8; ++j) { xc[u][j] = *(const f32x4*)(xr + 4 * c.lane + 256 * j); tc[u][j] = *(const u32x2*)(T + (size_t)(2 * r2 + u) * D + 4 * c.lane + 256 * j); } } };
        if (c.gw < nrows / 2) ldp(c.gw);
        for (int r2 = c.gw; r2 < nrows / 2; r2 += c.ngw) {
            const int mset = 2 * r2 < NLAT ? (2 * r2) / SEQ : 2;
            f32x4 v[2][8];
#pragma unroll
            for (int u = 0; u < 2; ++u)
#pragma unroll
                for (int j = 0; j < 8; ++j) { const int col = 4 * c.lane + 256 * j; const u32x2 t = tc[u][j];
                    v[u][j] = xc[u][j] * DN_ALPHA + *(const LAS f32x4*)(cl + 4096 + 2048 * mset + col) * (f32x4){lo16(t.x), hi16(t.x), lo16(t.y), hi16(t.y)}; }
            { const int n2 = r2 + c.ngw; if (n2 < nrows / 2) ldp(n2); }
            finish(v, r2, mset);
        }
    } else {
        u32x2 xc[2][8], tc[2][8];
        auto ldp = [&](int r2) {
#pragma unroll
            for (int u = 0; u < 2; ++u)
#pragma unroll
                for (int j = 0; j < 8; ++j) { const size_t o = (size_t)(2 * r2 + u) * D + 4 * c.lane + 256 * j; xc[u][j] = *(const u32x2*)(xb + o); tc[u][j] = *(const u32x2*)(T + o); } };
        if (c.gw < nrows / 2) ldp(c.gw);
        for (int r2 = c.gw; r2 < nrows / 2; r2 += c.ngw) {
            const int mset = (2 * r2) / SEQ;
            f32x4 v[2][8];
#pragma unroll
            for (int u = 0; u < 2; ++u)
#pragma unroll
                for (int j = 0; j < 8; ++j) { const int col = 4 * c.lane + 256 * j; const u32x2 x = xc[u][j], t = tc[u][j];
                    v[u][j] = (f32x4){lo16(x.x), hi16(x.x), lo16(x.y), hi16(x.y)} * DN_ALPHA + *(const LAS f32x4*)(cl + 4096 + 2048 * mset + col) * (f32x4){lo16(t.x), hi16(t.x), lo16(t.y), hi16(t.y)}; }
            { const int n2 = r2 + c.ngw; if (n2 < nrows / 2) ldp(n2); }
            finish(v, r2, mset);
        }
    }
}
constexpr float QK_SCALE_L2 = 0.125f * 1.4426950408889634f, LOG2E = 1.4426950408889634f;
constexpr int VSTR = 144;
struct AttnAcc { f32x16 o0, o1; float m, l; };
DI void attn_init(AttnAcc& a) { a.o0 = zero16(); a.o1 = zero16(); a.m = -INFINITY; a.l = 0.f; }

constexpr int KLOFF = 12288;
struct KV { u32x4 k[4]; u32x4 v[4]; };
template <class RowF>
DI void attn_load(KV& t, const bf16* P, RowF rowf, int kcol, int vcol, int lane) {
#pragma unroll
    for (int i = 0; i < 4; ++i) { const bf16* rp = P + (size_t)rowf((lane >> 3) + 8 * i) * PWP + (lane & 7) * 8; t.k[i] = *(const u32x4*)(rp + kcol); t.v[i] = *(const u32x4*)(rp + vcol); }
}
template <class ScoreF>
DI void attn_tile(AttnAcc& a, const bf16x8 (&qf)[4], const u32x4 (&kr)[4], const u32x4 (&vr)[4], LAS unsigned char* vl, int lane, ScoreF sf) {
    const int half = lane >> 5;
    bf16x8 kf[4];
    {
        LAS unsigned char* d = vl + (lane >> 3) * VSTR + (lane & 7) * 16;
#pragma unroll
        for (int i = 0; i < 4; ++i) { *(LAS u32x4*)(d + KLOFF + 8 * i * VSTR) = kr[i]; *(LAS u32x4*)(d + 8 * i * VSTR) = vr[i]; }
        const LAS unsigned char* ks = vl + KLOFF + (lane & 31) * VSTR + 16 * half;
#pragma unroll
        for (int s = 0; s < 4; ++s) kf[s] = *(const LAS bf16x8*)(ks + 32 * s);
    }
    f32x16 st = zero16();
#pragma unroll
    for (int s = 0; s < 4; ++s) st = MFMA32(kf[s], qf[s], st);
    float sc[16]; float mx = -INFINITY;
#pragma unroll
    for (int r = 0; r < 16; ++r) { sc[r] = sf(r, crow(r, half), st[r]); mx = fmaxf(mx, sc[r]); }
    mx = fmaxf(mx, bperm_f(lane ^ 32, mx));
    const float mnew = fmaxf(a.m, mx);
    const float muse = (mnew == -INFINITY) ? 0.f : mnew;
    float ps = 0.f;
#pragma unroll
    for (int r = 0; r < 16; ++r) { sc[r] = __builtin_amdgcn_exp2f(sc[r] - muse); ps += sc[r]; }
    ps += bperm_f(lane ^ 32, ps);
    if (__any(mnew != a.m)) {
        const float corr = __builtin_amdgcn_exp2f(a.m - muse);
        a.l *= corr;
#pragma unroll
        for (int r = 0; r < 16; ++r) { a.o0[r] *= corr; a.o1[r] *= corr; }
    }
    a.l += ps; a.m = mnew;
    const bf16x8 pb0 = pack8(sc[0], sc[1], sc[2], sc[3], sc[4], sc[5], sc[6], sc[7]);
    const bf16x8 pb1 = pack8(sc[8], sc[9], sc[10], sc[11], sc[12], sc[13], sc[14], sc[15]);
    const int q = (lane & 15) >> 2, pp = lane & 3, blk = (lane >> 4) & 1;
    LAS unsigned char* vb = vl + (4 * half + q) * VSTR + (16 * blk + 4 * pp) * 2;
    { const bf16x8 A = cat4(tr_read(vb), tr_read(vb + 8 * VSTR)); a.o0 = MFMA32(A, pb0, a.o0); }
    { const bf16x8 A = cat4(tr_read(vb + 64), tr_read(vb + 8 * VSTR + 64)); a.o1 = MFMA32(A, pb0, a.o1); }
    { const bf16x8 A = cat4(tr_read(vb + 16 * VSTR), tr_read(vb + 24 * VSTR)); a.o0 = MFMA32(A, pb1, a.o0); }
    { const bf16x8 A = cat4(tr_read(vb + 16 * VSTR + 64), tr_read(vb + 24 * VSTR + 64)); a.o1 = MFMA32(A, pb1, a.o1); }
}
DI void attn_store(const AttnAcc& a, unsigned char* y0, LAS unsigned char* ol, int lane) {
    const int half = lane >> 5; const float inv = 1.f / a.l;
    LAS unsigned char* d = ol + (lane & 31) * 80 + 4 * half;
#pragma unroll
    for (int g = 0; g < 4; ++g) {
        *(LAS unsigned*)(d + 8 * g) = pk4_fp8(a.o0[4 * g] * inv, a.o0[4 * g + 1] * inv, a.o0[4 * g + 2] * inv, a.o0[4 * g + 3] * inv);
        *(LAS unsigned*)(d + 32 + 8 * g) = pk4_fp8(a.o1[4 * g] * inv, a.o1[4 * g + 1] * inv, a.o1[4 * g + 2] * inv, a.o1[4 * g + 3] * inv); }
#pragma unroll
    for (int i = 0; i < 2; ++i) { const int row = 16 * i + (lane >> 2);
        *(u32x4*)(y0 + (size_t)row * D + (lane & 3) * 16) = *(const LAS u32x4*)(ol + row * 80 + (lane & 3) * 16); }
}
DI void load_frags(bf16x8 (&f)[4], const bf16* row, int half) {
#pragma unroll
    for (int s = 0; s < 4; ++s) f[s] = *(const bf16x8*)(row + 16 * s + 8 * half);
}
DI void rope_frags(bf16x8 (&f)[4], int posr, int posc, int half, const float* rope) {
#pragma unroll
    for (int pr = 0; pr < 2; ++pr) {
        const int pos = pr == 0 ? posr : posc;
        const f32x4* t = (const f32x4*)(rope + (size_t)(pos * 16 + 8 * half) * 2);
        const f32x4 t0 = t[0], t1 = t[1], t2 = t[2], t3 = t[3];
        const float cs[16] = {t0.x, t0.y, t0.z, t0.w, t1.x, t1.y, t1.z, t1.w, t2.x, t2.y, t2.z, t2.w, t3.x, t3.y, t3.z, t3.w};
        float x1[8], x2[8]; unpack8(f[2 * pr], x1); unpack8(f[2 * pr + 1], x2);
        float y1[8], y2[8];
#pragma unroll
        for (int e = 0; e < 8; ++e) { const float co = cs[2 * e], si = cs[2 * e + 1]; y1[e] = x1[e] * co - x2[e] * si; y2[e] = x2[e] * co + x1[e] * si; }
        f[2 * pr] = pack8(y1[0], y1[1], y1[2], y1[3], y1[4], y1[5], y1[6], y1[7]);
        f[2 * pr + 1] = pack8(y2[0], y2[1], y2[2], y2[3], y2[4], y2[5], y2[6], y2[7]);
    }
}

DI void na_item(const Ctx& c, int item) {
    const bf16* P = (const bf16*)(c.ws + WS_P); unsigned char* Y = (unsigned char*)(c.ws + WS_YMIX);
    const int lane = c.lane, half = lane >> 5, j = lane & 31;
    const int cc = item & 1, g_ = item >> 3, h = (g_ >> 3) & 7, r = (((g_ & 7) | (((g_ >> 6) & 3) << 3)) << 2) | ((item >> 1) & 3), b = g_ >> 8;
    const float* rpb = inp(c, 7) + (size_t)(c.L * 8 + h) * 15 * 31;
    LAS unsigned char* vl = c.lds + c.wave * WAVE_LDS; LAS float* tbl = (LAS float*)(vl + 32 * VSTR);
#pragma unroll
    for (int i = 0; i < 8; ++i) { const int e = lane + 64 * i; if (e < 15 * 31) tbl[(e / 31) * 128 + 48 + (e % 31)] = rpb[e] * LOG2E; }
    const int qrow = b * SEQ + r * 64 + 32 * cc + j;
    bf16x8 qf[4]; load_frags(qf, P + (size_t)qrow * PWP + NA_Q + h * 64, half);
    const int qc = 32 * cc + j, cstart = min(max(qc - 8, 0), 48);
    const int rs = min(max(r - 4, 0), 120);
    const int cb8 = cc ? 24 : 32;
    unsigned okf = 0u, okp = 0u;
#pragma unroll
    for (int rr = 0; rr < 16; ++rr) { const int kf = 32 * cc + crow(rr, half), kp = cb8 + (rr & 3) + 4 * half;
        okf |= ((kf >= cstart) && (kf < cstart + 16)) ? (1u << rr) : 0u; okp |= ((kp >= cstart) && (kp < cstart + 16)) ? (1u << rr) : 0u; }
    AttnAcc a; attn_init(a);
    auto key_row = [&](int t, int i) {
        if (t < 8) return b * SEQ + (rs + t) * 64 + 32 * cc + i;
        if (t < 10) return b * SEQ + (rs + 4 * (t - 8) + (i >> 3)) * 64 + cb8 + (i & 7);
        return NLAT + b * CTXL + 32 * (t - 10) + i; };
    auto load = [&](KV& kv, int t) { attn_load(kv, P, [&](int i) { return key_row(t, i); }, NA_K + h * 64, NA_V + h * 64, lane); };
    auto full = [&](KV& kv, int t) {
        const LAS float* bp = tbl + (rs + t - r + 7) * 128 + 32 * cc - qc + 63 + 4 * half;
        attn_tile(a, qf, kv.k, kv.v, vl, lane, [&](int rr, int, float raw) { const float sb = raw * QK_SCALE_L2 + bp[crow(rr, 0)]; return ((okf >> rr) & 1u) ? sb : -INFINITY; }); };
    auto packed = [&](KV& kv, int t) {
        const LAS float* bp = tbl + (rs + 4 * (t - 8) - r + 7) * 128 + cb8 - qc + 63 + 4 * half;
        attn_tile(a, qf, kv.k, kv.v, vl, lane, [&](int rr, int, float raw) { const float sb = raw * QK_SCALE_L2 + bp[(rr >> 2) * 128 + (rr & 3)]; return ((okp >> rr) & 1u) ? sb : -INFINITY; }); };
    auto ctx = [&](KV& kv) { attn_tile(a, qf, kv.k, kv.v, vl, lane, [&](int, int, float raw) { return raw * QK_SCALE_L2; }); };
    KV A, B; load(A, 0);
    for (int t = 0; t < 8; t += 2) { load(B, t + 1); full(A, t); load(A, t + 2); full(B, t + 1); }
    { load(B, 9); packed(A, 8); load(A, 10); packed(B, 9); }
    for (int t = 10; t < 18; t += 2) { load(B, t + 1); ctx(A); if (t + 2 < 18) load(A, t + 2); ctx(B); }
    attn_store(a, Y + (size_t)(qrow - j) * D + h * 64, vl, lane);
}

DI void rope_prepass(const Ctx& c) {
    bf16* P = (bf16*)(c.ws + WS_P); const float* rope = (const float*)(c.ws + WS_ROPE);
    for (int r0 = c.gw * 8; r0 < NLAT; r0 += c.ngw * 8) {
        u32x4 xa[5], xb[5]; f32x4 cs[5][4]; bf16* bp[5];
#pragma unroll
        for (int i = 0; i < 5; ++i) {
            const int q = c.lane + 64 * i, rk = q / 40, u = q - 40 * rk, row = r0 + rk, t = row % SEQ, pr = t >> 6, pc = t & 63;
            const int head = u >> 2, hs = (u >> 1) & 1, g = u & 1;
            bp[i] = P + (size_t)row * PWP + SW_Q + head * 64 + 32 * hs + 8 * g;
            xa[i] = *(const u32x4*)bp[i]; xb[i] = *(const u32x4*)(bp[i] + 16);
            const f32x4* tp = (const f32x4*)(rope + (size_t)((hs ? pc : pr) * 16 + 8 * g) * 2);
            cs[i][0] = tp[0]; cs[i][1] = tp[1]; cs[i][2] = tp[2]; cs[i][3] = tp[3];
        }
#pragma unroll
        for (int i = 0; i < 5; ++i) {
            float x1[8], x2[8], y1[8], y2[8]; unpack8(__builtin_bit_cast(bf16x8, xa[i]), x1); unpack8(__builtin_bit_cast(bf16x8, xb[i]), x2);
#pragma unroll
            for (int e = 0; e < 8; ++e) { const float co = cs[i][e >> 1][2 * (e & 1)], si = cs[i][e >> 1][2 * (e & 1) + 1]; y1[e] = x1[e] * co - x2[e] * si; y2[e] = x2[e] * co + x1[e] * si; }
            *(bf16x8*)bp[i] = pack8(y1[0], y1[1], y1[2], y1[3], y1[4], y1[5], y1[6], y1[7]);
            *(bf16x8*)(bp[i] + 16) = pack8(y2[0], y2[1], y2[2], y2[3], y2[4], y2[5], y2[6], y2[7]);
        }
    }
}

DI void swa_item(const Ctx& c, int item) {
    const bf16* P = (const bf16*)(c.ws + WS_P); unsigned char* Y = (unsigned char*)(c.ws + WS_YMIX);
    const int lane = c.lane, half = lane >> 5, j = lane & 31;
    const int hq = item & 7, qb = (item >> 3) & 255, b = item >> 11, kvh = hq >> 2;
    LAS unsigned char* vl = c.lds + c.wave * WAVE_LDS;
    const int i0 = 32 * qb, qi = i0 + j, qrow = b * SEQ + qi;
    bf16x8 qf[4]; load_frags(qf, P + (size_t)qrow * PWP + SW_Q + hq * 64, half);
    AttnAcc a; attn_init(a);
    const int m_lo = max(0, 4 - qb), m_hi = min(9, 260 - qb), nw = m_hi - m_lo, nt = nw + 8;
    auto load = [&](KV& kv, int t) {
        const int base = t < nw ? b * SEQ + i0 - 128 + 32 * (m_lo + t) : NLAT + b * CTXL + 32 * (t - nw);
        attn_load(kv, P, [&](int i) { return base + i; }, SW_K + kvh * 64, SW_V + kvh * 64, lane); };
    auto compute = [&](KV& kv, int t) {
        const int m = m_lo + t; const bool edge = t < nw && (m == 0 || m == 8);
        if (edge) { const int j0 = i0 - 128 + 32 * m;
            attn_tile(a, qf, kv.k, kv.v, vl, lane, [&](int, int i, float raw) { const int dlt = j0 + i - qi; return ((dlt >= -128) && (dlt <= 128)) ? raw * QK_SCALE_L2 : -INFINITY; }); }
        else attn_tile(a, qf, kv.k, kv.v, vl, lane, [&](int, int, float raw) { return raw * QK_SCALE_L2; }); };
    KV A, B; load(A, 0);
    for (int t = 0; t < nt; t += 2) {
        if (t + 1 < nt) load(B, t + 1);
        compute(A, t);
        if (t + 1 < nt) { if (t + 2 < nt) load(A, t + 2); compute(B, t + 1); }
    }
    const float sink = inp(c, 12)[c.L * 8 + hq];
    a.l += __builtin_amdgcn_exp2f(sink * LOG2E - a.m);
    attn_store(a, Y + (size_t)(qrow - j) * D + 1536 + hq * 64, vl, lane);
}

DI void ctx_attn_item(const Ctx& c, int item) {
    const bf16* P = (const bf16*)(c.ws + WS_P); unsigned char* Y = (unsigned char*)(c.ws + WS_YMIX);
    const int lane = c.lane, half = lane >> 5, j = lane & 31;
    const int h = item & 7, qb = (item >> 3) & 7, b = (item >> 6) & 1, kind = item >> 7;
    LAS unsigned char* vl = c.lds + c.wave * WAVE_LDS;
    const int qcol = kind == 0 ? NA_Q + h * 64 : SW_Q + h * 64;
    const int kcol = kind == 0 ? NA_K + h * 64 : SW_K + (h >> 2) * 64;
    const int vcol = kind == 0 ? NA_V + h * 64 : SW_V + (h >> 2) * 64;
    const int qrow = NLAT + b * CTXL + 32 * qb + j;
    bf16x8 qf[4]; load_frags(qf, P + (size_t)qrow * PWP + qcol, half);
    AttnAcc a; attn_init(a);
    auto load = [&](KV& kv, int t) { const int base = NLAT + b * CTXL + 32 * t;
        attn_load(kv, P, [&](int i) { return base + i; }, kcol, vcol, lane); };
    KV A, B; load(A, 0);
    for (int t = 0; t < 8; t += 2) {
        load(B, t + 1);
        attn_tile(a, qf, A.k, A.v, vl, lane, [&](int, int, float raw) { return raw * QK_SCALE_L2; });
        if (t + 2 < 8) load(A, t + 2);
        attn_tile(a, qf, B.k, B.v, vl, lane, [&](int, int, float raw) { return raw * QK_SCALE_L2; });
    }
    if (kind == 1) a.l += __builtin_amdgcn_exp2f(inp(c, 12)[c.L * 8 + h] * LOG2E - a.m);
    attn_store(a, Y + (size_t)(qrow - j) * D + (kind == 0 ? 0 : 1536) + h * 64, vl, lane);
}

DI void conv_rows4(const Ctx& c, int row0, int stride, int nrows) {
    const bf16* P = (const bf16*)(c.ws + WS_P); unsigned char* Y = (unsigned char*)(c.ws + WS_YMIX);
    const int lane = c.lane, ch = 8 * lane;
    const float* w = inp(c, 8) + (size_t)c.L * 3 * 512;
    f32x4 wv[3][2];
#pragma unroll
    for (int t = 0; t < 3; ++t) { wv[t][0] = *(const f32x4*)(w + t * 512 + ch); wv[t][1] = *(const f32x4*)(w + t * 512 + ch + 4); }
    bf16x8 u[4][3], g[4][3], gb[4]; bool ok[4][3]; int rows[4];
#pragma unroll
    for (int r = 0; r < 4; ++r) {
        const int row = row0 + r * stride; rows[r] = row;
        const bool live = row < nrows; const int rr = live ? row : 0;
        int pos, len; if (rr < NLAT) { pos = rr % SEQ; len = SEQ; } else { pos = (rr - NLAT) % CTXL; len = CTXL; }
#pragma unroll
        for (int t = 0; t < 3; ++t) { const int q = pos + t - 1; ok[r][t] = live && q >= 0 && q < len; const bf16* pr = P + (size_t)(ok[r][t] ? rr + t - 1 : rr) * PWP;
            u[r][t] = *(const bf16x8*)(pr + SC_U + ch); g[r][t] = *(const bf16x8*)(pr + SC_C + ch); }
        gb[r] = *(const bf16x8*)(P + (size_t)rr * PWP + SC_B + ch);
    }
#pragma unroll
    for (int r = 0; r < 4; ++r) {
        if (rows[r] >= nrows) continue;
        float acc[8];
#pragma unroll
        for (int e = 0; e < 8; ++e) acc[e] = 0.f;
#pragma unroll
        for (int t = 0; t < 3; ++t) { float uf[8], gf[8]; unpack8(u[r][t], uf); unpack8(g[r][t], gf);
            const float wf[8] = {wv[t][0].x, wv[t][0].y, wv[t][0].z, wv[t][0].w, wv[t][1].x, wv[t][1].y, wv[t][1].z, wv[t][1].w};
            const float m = ok[r][t] ? 1.f : 0.f;
#pragma unroll
            for (int e = 0; e < 8; ++e) acc[e] += m * wf[e] * (gf[e] * uf[e]); }
        float bf_[8]; unpack8(gb[r], bf_);
        u32x2 o; o.x = pk4_fp8(bf_[0] * acc[0], bf_[1] * acc[1], bf_[2] * acc[2], bf_[3] * acc[3]); o.y = pk4_fp8(bf_[4] * acc[4], bf_[5] * acc[5], bf_[6] * acc[6], bf_[7] * acc[7]);
        *(u32x2*)(Y + (size_t)rows[r] * D + 512 + ch) = o;
    }
}
constexpr int KSTR = 144, V2STR = 272;
DI int gla_row0(int b, int ck) { return ck < 8 ? NLAT + b * CTXL + 32 * ck : b * SEQ + 32 * (ck - 8); }
DI int gla_chain_pos(int dir, int ck) { return ck < 8 ? (dir == 0 ? ck : 7 - ck) : (dir == 0 ? ck : 8 + 255 - (ck - 8)); }

struct GlaGate { float w[16]; float bias; };
template <int DIR>
DI void gla_gate_load(const Ctx& c, int h, GlaGate& g) {
    const float* w2 = inp(c, 9) + (size_t)((c.L * 2 + DIR) * 16) * 256 + h * 64 + c.lane;
#pragma unroll
    for (int i = 0; i < 16; ++i) g.w[i] = w2[i * 256];
    g.bias = inp(c, 10)[(c.L * 2 + DIR) * 256 + h * 64 + c.lane];
}
DI void gla_stage_z(const bf16* P, int row0, LAS unsigned char* zl, int lane) {
    const u32x4 v0 = *(const u32x4*)(P + (size_t)(row0 + (lane >> 2)) * PWP + GL_Z + (lane & 3) * 8);
    const u32x4 v1 = *(const u32x4*)(P + (size_t)(row0 + 16 + (lane >> 2)) * PWP + GL_Z + (lane & 3) * 8);
    *(LAS u32x4*)(zl + (lane >> 2) * 64 + (lane & 3) * 16) = v0; *(LAS u32x4*)(zl + (16 + (lane >> 2)) * 64 + (lane & 3) * 16) = v1;
}
template <int DIR>
DI float gla_la(const GlaGate& g, const LAS unsigned char* zl, int t) {
    const LAS unsigned char* zr = zl + t * 64 + DIR * 32;
    float a[8], bq[8]; unpack8(*(const LAS bf16x8*)zr, a); unpack8(*(const LAS bf16x8*)(zr + 16), bq);
    float x = g.bias;
#pragma unroll
    for (int i = 0; i < 8; ++i) x += a[i] * g.w[i];
#pragma unroll
    for (int i = 0; i < 8; ++i) x += bq[i] * g.w[8 + i];
    return (fminf(x, 0.f) - __logf(1.f + __expf(-fabsf(x)))) * (1.f / 16.f);
}
DI void gla_stage_v(const bf16* P, int row0, int h, LAS unsigned char* vl, int lane) {
#pragma unroll
    for (int i = 0; i < 8; ++i) { const int idx = lane + 64 * i, t = idx >> 4, ch = idx & 15;
        *(LAS u32x4*)(vl + t * V2STR + ch * 16) = *(const u32x4*)(P + (size_t)(row0 + t) * PWP + GL_V + h * 128 + ch * 8); }
}
DI void gla_load_qk(u32x4 (&r)[4], const bf16* P, int row0, int col, int lane) {
#pragma unroll
    for (int i = 0; i < 4; ++i) r[i] = *(const u32x4*)(P + (size_t)(row0 + 8 * i + (lane >> 3)) * PWP + col + (lane & 7) * 8);
}
DI void gla_put_qk(const u32x4 (&r)[4], LAS unsigned char* l, int lane) {
    LAS unsigned char* d = l + (lane >> 3) * KSTR + (lane & 7) * 16;
#pragma unroll
    for (int i = 0; i < 4; ++i) *(LAS u32x4*)(d + 8 * i * KSTR) = r[i];
}

template <int DIR>
DI void gla_g1(const Ctx& c, int b, int h, int ck) {
    const bf16* P = (const bf16*)(c.ws + WS_P);
    const int lane = c.lane, half = lane >> 5;
    LAS unsigned char* kl = c.lds + c.wave * WAVE_LDS; LAS unsigned char* vl = kl + 32 * KSTR; LAS unsigned char* zl = vl + 32 * V2STR;
    const int row0 = gla_row0(b, ck), n = gla_chain_pos(DIR, ck);
    const size_t chain = (size_t)((b * 2 + DIR) * 4 + h) * NCH + n;
    u32x4 kr[4]; gla_load_qk(kr, P, row0, GL_K + h * 64, lane);
    GlaGate gate; gla_gate_load<DIR>(c, h, gate);
    gla_stage_z(P, row0, zl, lane);
    gla_stage_v(P, row0, h, vl, lane);
    gla_put_qk(kr, kl, lane);
    bf16* erp = (bf16*)(c.ws + WS_ER) + chain * 2048;
    float rev = 0.f;
#pragma unroll
    for (int tt = 31; tt >= 0; --tt) {
        const int t = DIR ? 31 - tt : tt;
        LAS bf16* kp = (LAS bf16*)(kl + t * KSTR + 2 * lane);
        const float er = __expf(rev);
        *kp = f2bf(bf2f(*kp) * er);
        erp[t * 64 + lane] = f2bf(er);
        rev += gla_la<DIR>(gate, zl, t);
    }
    ((float*)(c.ws + WS_GDEC))[chain * 64 + lane] = __expf(rev);
    const int q = (lane & 15) >> 2, pp = lane & 3, blk = (lane >> 4) & 1;
    bf16* ut = (bf16*)(c.ws + WS_UT) + chain * 8192;
    bf16x8 Kf[2][2];
#pragma unroll
    for (int nt = 0; nt < 2; ++nt)
#pragma unroll
        for (int s = 0; s < 2; ++s) { LAS unsigned char* a = kl + (16 * s + 8 * half + q) * KSTR + (32 * nt + 16 * blk + 4 * pp) * 2; Kf[nt][s] = cat4(tr_read(a), tr_read(a + 4 * KSTR)); }
#pragma unroll
    for (int mt = 0; mt < 4; ++mt) {
        bf16x8 Vf[2];
#pragma unroll
        for (int s = 0; s < 2; ++s) { LAS unsigned char* a = vl + (16 * s + 8 * half + q) * V2STR + (32 * mt + 16 * blk + 4 * pp) * 2; Vf[s] = cat4(tr_read(a), tr_read(a + 4 * V2STR)); }
#pragma unroll
        for (int nt = 0; nt < 2; ++nt) {
            f32x16 acc = zero16();
            acc = MFMA32(Kf[nt][0], Vf[0], acc); acc = MFMA32(Kf[nt][1], Vf[1], acc);
            LAS unsigned char* ud = kl + (lane & 31) * KSTR + 64 * nt + 8 * half;
#pragma unroll
            for (int g4 = 0; g4 < 4; ++g4) { u32x2 w; w.x = pk2(acc[4 * g4], acc[4 * g4 + 1]); w.y = pk2(acc[4 * g4 + 2], acc[4 * g4 + 3]); *(LAS u32x2*)(ud + 16 * g4) = w; }
        }
#pragma unroll
        for (int i = 0; i < 4; ++i) { const int vr = 8 * i + (lane >> 3);
            *(u32x4*)(ut + (size_t)(32 * mt + vr) * 64 + (lane & 7) * 8) = *(const LAS u32x4*)(kl + vr * KSTR + (lane & 7) * 16); }
    }
}

DI void gla_scan(const Ctx& c) {

    const bf16* ut = (const bf16*)(c.ws + WS_UT); bf16* sin = (bf16*)(c.ws + WS_SIN); const float* gd = (const float*)(c.ws + WS_GDEC);
    for (int e = c.bid * 512 + c.tid; e < 16 * 8192; e += c.nblk * 512) {
        const int chain = e >> 13, el = e & 8191, k = el & 63;
        const size_t base = (size_t)chain * NCH * 8192 + el;
        const float* g = gd + (size_t)chain * NCH * 64 + k;
        float st = 0.f;
        for (int n0 = 0; n0 < NCH; n0 += 88) {
            float u[88], gg[88];
#pragma unroll
            for (int i = 0; i < 88; ++i) { u[i] = bf2f(ut[base + (size_t)(n0 + i) * 8192]); gg[i] = g[(n0 + i) * 64]; }
#pragma unroll
            for (int i = 0; i < 88; ++i) { sin[base + (size_t)(n0 + i) * 8192] = f2bf(st); st = gg[i] * st + u[i]; }
        }
    }
}

template <int DIR>
DI void gla_g3_dir(const Ctx& c, int b, int h, int ck, const unsigned (&qc)[16], const unsigned (&kc)[16], LAS unsigned char* ql, LAS unsigned char* kl, LAS unsigned char* vl, LAS unsigned char* zl, f32x16 (&o)[4]) {
    const int lane = c.lane, half = lane >> 5, j = lane & 31;
    const size_t chain = (size_t)((b * 2 + DIR) * 4 + h) * NCH + gla_chain_pos(DIR, ck);
    const bf16* sin = (const bf16*)(c.ws + WS_SIN) + chain * 8192;
    bf16x8 sf[2][4], sg[2][4];
#pragma unroll
    for (int mt = 0; mt < 2; ++mt)
#pragma unroll
        for (int s = 0; s < 4; ++s) sf[mt][s] = *(const bf16x8*)(sin + (size_t)(32 * mt + j) * 64 + 16 * s + 8 * half);
    { const float gd = ((const float*)(c.ws + WS_GDEC))[chain * 64 + lane];
      const bf16* erp = (const bf16*)(c.ws + WS_ER) + chain * 2048;
      bf16 er[32];
#pragma unroll
      for (int t = 0; t < 32; ++t) er[t] = erp[t * 64 + lane];
#pragma unroll
      for (int t = 0; t < 32; ++t) {
        const float e1 = gd * __builtin_amdgcn_rcpf(bf2f(er[t]));
        const float qv = (t & 1) ? hi16(qc[t >> 1]) : lo16(qc[t >> 1]), kv = (t & 1) ? hi16(kc[t >> 1]) : lo16(kc[t >> 1]);
        *(LAS bf16*)(ql + t * KSTR + 2 * lane) = f2bf(qv * e1 * 0.125f);
        *(LAS bf16*)(kl + t * KSTR + 2 * lane) = f2bf(kv * __builtin_amdgcn_rcpf(e1));
      } }
#pragma unroll
    for (int mt = 0; mt < 2; ++mt)
#pragma unroll
        for (int s = 0; s < 4; ++s) sg[mt][s] = *(const bf16x8*)(sin + (size_t)(32 * (mt + 2) + j) * 64 + 16 * s + 8 * half);
    bf16x8 qf[4], kf[4];
#pragma unroll
    for (int s = 0; s < 4; ++s) { qf[s] = *(const LAS bf16x8*)(ql + j * KSTR + (16 * s + 8 * half) * 2); kf[s] = *(const LAS bf16x8*)(kl + j * KSTR + (16 * s + 8 * half) * 2); }
    f32x16 at = zero16();
#pragma unroll
    for (int s = 0; s < 4; ++s) at = MFMA32(kf[s], qf[s], at);
    float a[16];
#pragma unroll
    for (int r = 0; r < 16; ++r) { const int s = crow(r, half); const bool ok = DIR ? (s >= j) : (s <= j); a[r] = ok ? at[r] : 0.f; }
    const bf16x8 pb0 = pack8(a[0], a[1], a[2], a[3], a[4], a[5], a[6], a[7]), pb1 = pack8(a[8], a[9], a[10], a[11], a[12], a[13], a[14], a[15]);
    const int q = (lane & 15) >> 2, pp = lane & 3, blk = (lane >> 4) & 1;
#pragma unroll
    for (int mt = 0; mt < 4; ++mt) {
        LAS unsigned char* vb = vl + (4 * half + q) * V2STR + (32 * mt + 16 * blk + 4 * pp) * 2;
        o[mt] = MFMA32(cat4(tr_read(vb), tr_read(vb + 8 * V2STR)), pb0, o[mt]);
        o[mt] = MFMA32(cat4(tr_read(vb + 16 * V2STR), tr_read(vb + 24 * V2STR)), pb1, o[mt]);
#pragma unroll
        for (int s = 0; s < 4; ++s) o[mt] = MFMA32(mt < 2 ? sf[mt & 1][s] : sg[mt & 1][s], qf[s], o[mt]);
    }
}
DI void gla_g3(const Ctx& c, int b, int h, int ck) {
    const bf16* P = (const bf16*)(c.ws + WS_P); unsigned char* Y = (unsigned char*)(c.ws + WS_YMIX);
    const int lane = c.lane, half = lane >> 5, j = lane & 31;
    LAS unsigned char* ql = c.lds + c.wave * WAVE_LDS; LAS unsigned char* kl = ql + 32 * KSTR; LAS unsigned char* vl = kl + 32 * KSTR; LAS unsigned char* zl = vl + 32 * V2STR;
    const int row0 = gla_row0(b, ck);
    { u32x4 qr[4], kr[4]; gla_load_qk(qr, P, row0, GL_Q + h * 64, lane); gla_load_qk(kr, P, row0, GL_K + h * 64, lane);
      gla_stage_v(P, row0, h, vl, lane);
      gla_put_qk(qr, ql, lane); gla_put_qk(kr, kl, lane); }
    unsigned qc[16], kc[16];
#pragma unroll
    for (int i = 0; i < 16; ++i) {
        qc[i] = (unsigned)*(const LAS bf16*)(ql + (2 * i) * KSTR + 2 * lane) | ((unsigned)*(const LAS bf16*)(ql + (2 * i + 1) * KSTR + 2 * lane) << 16);
        kc[i] = (unsigned)*(const LAS bf16*)(kl + (2 * i) * KSTR + 2 * lane) | ((unsigned)*(const LAS bf16*)(kl + (2 * i + 1) * KSTR + 2 * lane) << 16); }
    u32x2 grp[16];
#pragma unroll
    for (int mt = 0; mt < 4; ++mt)
#pragma unroll
        for (int g4 = 0; g4 < 4; ++g4) grp[4 * mt + g4] = *(const u32x2*)(P + (size_t)(row0 + j) * PWP + GL_G + h * 128 + 32 * mt + 8 * g4 + 4 * half);
    f32x16 o[4];
#pragma unroll
    for (int mt = 0; mt < 4; ++mt) o[mt] = zero16();
    gla_g3_dir<0>(c, b, h, ck, qc, kc, ql, kl, vl, zl, o);
    gla_g3_dir<1>(c, b, h, ck, qc, kc, ql, kl, vl, zl, o);
    float ss = 0.f;
#pragma unroll
    for (int mt = 0; mt < 4; ++mt)
#pragma unroll
        for (int r = 0; r < 16; ++r) ss += o[mt][r] * o[mt][r];
    ss += bperm_f(lane ^ 32, ss);
    const float rstd = 1.f / sqrtf(ss * (1.f / 128.f) + LN_EPS);
    const float* gain = inp(c, 11) + (size_t)c.L * 128;
    const int row = row0 + j;
#pragma unroll
    for (int mt = 0; mt < 4; ++mt)
#pragma unroll
        for (int g4 = 0; g4 < 4; ++g4) {
            const int v0 = 32 * mt + 8 * g4 + 4 * half;
            const u32x2 gr = grp[4 * mt + g4];
            const float gv[4] = {lo16(gr.x), hi16(gr.x), lo16(gr.y), hi16(gr.y)};
            const f32x4 gn = *(const f32x4*)(gain + v0);
            float y[4];
#pragma unroll
            for (int e = 0; e < 4; ++e) { const float on = o[mt][4 * g4 + e] * rstd * gn[e]; y[e] = on * (gv[e] / (1.f + __expf(-gv[e]))); }
            *(unsigned*)(Y + (size_t)row * D + 1024 + h * 128 + v0) = pk4_fp8(y[0], y[1], y[2], y[3]); }
}
template <int NT>
DI void router_phase(const Ctx& c, int rows_per_chunk, int nchunks) {
    const int L = c.L, lane = c.lane, r16 = lane & 15, q = lane >> 4, w = c.wave;
    const unsigned char* xq = (const unsigned char*)(c.ws + WS_XQ); const bf16* xl = (const bf16*)(c.ws + WS_XL); const bf16* rw = (const bf16*)(c.ws + WS_ROUTW);
    const float* rb = inp(c, 17) + (size_t)L * NEXP;
    int* eidx = (int*)(c.ws + WS_EIDX); int* rank = (int*)(c.ws + WS_RANK); float* wts = (float*)(c.ws + WS_WTS);
    unsigned* cnt = (unsigned*)(c.ws + WS_CTL) + CW_CNT + L * 64;
    LAS float* part = (LAS float*)c.lds;
    LAS float* sc = (LAS float*)(c.lds + 98304);
    LAS float* sl = sc + 5 * 16 * 65;
    LAS unsigned* lcnt = (LAS unsigned*)(c.lds + LDS_MISC + 256);
    LAS unsigned* lbase = lcnt + 64;
    for (int chunk = c.bid; chunk < nchunks; chunk += c.nblk) {
        const int row0 = chunk * rows_per_chunk, rowlast = row0 + rows_per_chunk - 1;
        if (c.tid < 64) lcnt[c.tid] = 0u;
        f32x4 acc[NT][4];
#pragma unroll
        for (int t = 0; t < NT; ++t)
#pragma unroll
            for (int nt = 0; nt < 4; ++nt) acc[t][nt] = (f32x4){0.f, 0.f, 0.f, 0.f};
#pragma unroll 2
        for (int ks = 0; ks < 8; ++ks) {
            const int k0 = 256 * w + 32 * ks + 8 * q;
            bf16x8 bh[4], bl[4];
#pragma unroll
            for (int nt = 0; nt < 4; ++nt) { bh[nt] = *(const bf16x8*)(rw + (size_t)(16 * nt + r16) * D + k0); bl[nt] = *(const bf16x8*)(rw + (size_t)(64 + 16 * nt + r16) * D + k0); }
#pragma unroll
            for (int t = 0; t < NT; ++t) {
                const int row = min(row0 + 16 * t + r16, rowlast);
                const u32x2 aq = *(const u32x2*)(xq + (size_t)row * D + k0); const bf16x8 al = *(const bf16x8*)(xl + (size_t)row * D + k0);
                const f32x2 q0 = __builtin_amdgcn_cvt_pk_f32_fp8((int)aq.x, false), q1 = __builtin_amdgcn_cvt_pk_f32_fp8((int)aq.x, true), q2 = __builtin_amdgcn_cvt_pk_f32_fp8((int)aq.y, false), q3 = __builtin_amdgcn_cvt_pk_f32_fp8((int)aq.y, true);
                const bf16x8 ah = pack8(q0.x, q0.y, q1.x, q1.y, q2.x, q2.y, q3.x, q3.y);
#pragma unroll
                for (int nt = 0; nt < 4; ++nt) { acc[t][nt] = MFMA16(ah, bh[nt], acc[t][nt]); acc[t][nt] = MFMA16(al, bh[nt], acc[t][nt]); acc[t][nt] = MFMA16(ah, bl[nt], acc[t][nt]); }
            }
        }
#pragma unroll
        for (int g = 0; g < 2; ++g) {
            const int t0 = 3 * g, tn = (g == 0) ? (NT < 3 ? NT : 3) : NT - 3;
            __syncthreads();
#pragma unroll
            for (int tt = 0; tt < 3; ++tt) if (tt < tn)
#pragma unroll
                for (int nt = 0; nt < 4; ++nt)
#pragma unroll
                    for (int r = 0; r < 4; ++r) part[(w * 3 + tt) * 1024 + (4 * q + r) * 64 + 16 * nt + r16] = acc[t0 + tt][nt][r];
            __syncthreads();
            for (int e = c.tid; e < tn * 1024; e += 512) {
                const int tt = e >> 10, el = e & 1023, tok = el >> 6, ex = el & 63;
                float sum = 0.f;
#pragma unroll
                for (int ww = 0; ww < 8; ++ww) sum += part[(ww * 3 + tt) * 1024 + el];
                const float sg = 1.f / (1.f + __expf(-sum));
                sc[((t0 + tt) * 16 + tok) * 65 + ex] = sg; sl[((t0 + tt) * 16 + tok) * 65 + ex] = sg + rb[ex];
            }
        }
        __syncthreads();
        int e0 = 0, e1 = 0, li0 = 0, li1 = 0; float w0 = 0.f, w1 = 0.f;
        const int tk = lane >> 2, s4 = lane & 3;
        const int tokrow = row0 + 16 * w + tk;
        const bool act = (w < NT) && (tokrow <= rowlast);
        if (act) {
            const LAS float* slt = sl + (w * 16 + tk) * 65; const LAS float* sct = sc + (w * 16 + tk) * 65;
            float v[16];
#pragma unroll
            for (int i = 0; i < 16; ++i) v[i] = slt[16 * s4 + i];
            float ga, gb;
            { float m1 = -INFINITY, m2 = -INFINITY;
#pragma unroll
              for (int i = 0; i < 8; ++i) { if (v[i] > m1) { m2 = m1; m1 = v[i]; } else if (v[i] > m2) m2 = v[i]; }
              ga = m1 + m2; m1 = -INFINITY; m2 = -INFINITY;
#pragma unroll
              for (int i = 8; i < 16; ++i) { if (v[i] > m1) { m2 = m1; m1 = v[i]; } else if (v[i] > m2) m2 = v[i]; }
              gb = m1 + m2; }
            float gs[8];
#pragma unroll
            for (int s2 = 0; s2 < 4; ++s2) { gs[2 * s2] = bperm_f((lane & ~3) | s2, ga); gs[2 * s2 + 1] = bperm_f((lane & ~3) | s2, gb); }
            unsigned gmask = 0u;
#pragma unroll
            for (int it = 0; it < 4; ++it) { float best = -INFINITY; int bi = 0;
#pragma unroll
                for (int g = 0; g < 8; ++g) { const bool fr = ((gmask >> g) & 1u) == 0u; if (fr && gs[g] > best) { best = gs[g]; bi = g; } }
                gmask |= 1u << bi; }
            const bool oka = (gmask >> (2 * s4)) & 1u, okb = (gmask >> (2 * s4 + 1)) & 1u;
#pragma unroll
            for (int i = 0; i < 16; ++i) v[i] = ((i < 8) ? oka : okb) ? v[i] : -INFINITY;
            float wsum = 0.f;
#pragma unroll
            for (int rd = 0; rd < 8; ++rd) {
                float best = -INFINITY; int bi = 16 * s4;
#pragma unroll
                for (int i = 0; i < 16; ++i) if (v[i] > best) { best = v[i]; bi = 16 * s4 + i; }
#pragma unroll
                for (int o = 1; o < 4; o <<= 1) { const float ob = bperm_f(lane ^ o, best); const int oi = bperm_i(lane ^ o, bi); if (ob > best || (ob == best && oi < bi)) { best = ob; bi = oi; } }
                const float wv = sct[bi]; wsum += wv;
                if ((bi >> 4) == s4) {
#pragma unroll
                    for (int i = 0; i < 16; ++i) v[i] = (i == (bi & 15)) ? -INFINITY : v[i]; }
                if ((rd & 3) == s4) { if (rd < 4) { e0 = bi; w0 = wv; } else { e1 = bi; w1 = wv; } }
            }
            const float sc25 = 2.5f / wsum; w0 *= sc25; w1 *= sc25;
            li0 = (int)__hip_atomic_fetch_add((unsigned*)(lcnt + e0), 1u, __ATOMIC_RELAXED, __HIP_MEMORY_SCOPE_WORKGROUP); li1 = (int)__hip_atomic_fetch_add((unsigned*)(lcnt + e1), 1u, __ATOMIC_RELAXED, __HIP_MEMORY_SCOPE_WORKGROUP);
        }
        __syncthreads();
        if (c.tid < 64) { const unsigned n = lcnt[c.tid]; lbase[c.tid] = n ? atomicAdd(cnt + c.tid, n) : 0u; }
        __syncthreads();
        if (act) {
            eidx[tokrow * 8 + s4] = e0; wts[tokrow * 8 + s4] = w0; rank[tokrow * 8 + s4] = (int)lbase[e0] + li0;
            eidx[tokrow * 8 + s4 + 4] = e1; wts[tokrow * 8 + s4 + 4] = w1; rank[tokrow * 8 + s4 + 4] = (int)lbase[e1] + li1;
        }
        __syncthreads();
    }
}

DI void phase9(const Ctx& c) {
    const int L = c.L;
    const int nmoe = L == 0 ? NTOK : NLAT;
    LAS int* ts = (LAS int*)c.lds;
    const unsigned* cnt = (const unsigned*)(c.ws + WS_CTL) + CW_CNT + L * 64;
    if (c.tid == 0) { int acc = 0; for (int e = 0; e < 64; ++e) { ts[e] = acc; acc += ((int)cnt[e] + 255) >> 8; } ts[64] = acc; ts[65] = acc + nmoe / 256; }
    __syncthreads();
    int* toks = (int*)(c.ws + WS_TOKS); int* pos = (int*)(c.ws + WS_POS); int* tile_e = (int*)(c.ws + WS_TILEE);
    const int* eidx = (const int*)(c.ws + WS_EIDX); const int* rank = (const int*)(c.ws + WS_RANK);
    const int gt = c.bid * 512 + c.tid, ngt = c.nblk * 512;
    for (int i = gt; i < nmoe * 8; i += ngt) { const int e = eidx[i]; const int slot = ts[e] * 256 + rank[i]; toks[slot] = i >> 3; pos[i] = slot; }
    for (int i = gt; i < nmoe; i += ngt) toks[ts[64] * 256 + i] = i;
    for (int e = c.bid; e < 65; e += c.nblk) {
        for (int t = ts[e] + c.tid; t < ts[e + 1]; t += 512) tile_e[t] = e;
        if (e < 64) { const int n = (int)cnt[e]; for (int s = n + c.tid; s < (ts[e + 1] - ts[e]) * 256; s += 512) toks[ts[e] * 256 + s] = 0; }
    }
    if (c.bid == 0 && c.tid == 0) { int* nt = (int*)(c.ws + WS_CTL) + CW_NT + L * 64; nt[0] = ts[65]; nt[1] = ts[64]; }
    __syncthreads();
}

DI void phase12(const Ctx& c) {
    const int L = c.L;
    const int nmoe = L == 0 ? NTOK : NLAT;
    const unsigned char* Yb = (const unsigned char*)(c.ws + WS_Y); const bf16* x1 = (const bf16*)(c.ws + WS_X1);
    const int* pos = (const int*)(c.ws + WS_POS); const float* wts = (const float*)(c.ws + WS_WTS);
    const int sh_tile0 = ((const int*)(c.ws + WS_CTL))[CW_NT + L * 64 + 1];
    const float* lg = inp(c, 24) + (size_t)L * D; const float* lb = inp(c, 25) + (size_t)L * D;
    LAS float* cl = (LAS float*)c.lds;
    { const int nch = (L == 0 ? 22528 : 10240) / 4;
      for (int i = c.tid; i < nch; i += 512) { const int e = 4 * i, seg = e >> 11, col = e & 2047; const float* src;
          if (seg == 0) src = lg + col; else if (seg == 1) src = lb + col;
          else if (seg < 5) src = (const float*)(c.ws + WS_MOD) + (size_t)(L * 3 + (seg - 2)) * 6 * D + 5 * D + col;
          else if (seg < 8) src = (const float*)(c.ws + WS_MOD) + (size_t)(3 + (seg - 5)) * 6 * D + col;
          else src = (const float*)(c.ws + WS_MOD) + (size_t)(3 + (seg - 8)) * 6 * D + D + col;
          *(LAS f32x4*)(cl + e) = *(const f32x4*)src; }
      __syncthreads(); }
    auto load_ids = [&](int r, int4& a, int4& b, f32x4& qa, f32x4& qb) { a = *(const int4*)(pos + r * 8); b = *(const int4*)(pos + r * 8 + 4); qa = *(const f32x4*)(wts + r * 8); qb = *(const f32x4*)(wts + r * 8 + 4); };
    auto load_rows = [&](int r, const int4& s0, const int4& s1, u32x4 (&y)[9][2], u32x4 (&x)[2][2]) {
        const int slot[9] = {s0.x, s0.y, s0.z, s0.w, s1.x, s1.y, s1.z, s1.w, sh_tile0 * 256 + r};
#pragma unroll
        for (int k = 0; k < 9; ++k) { const unsigned char* yr = Yb + (size_t)slot[k] * D + 16 * c.lane; y[k][0] = *(const u32x4*)yr; y[k][1] = *(const u32x4*)(yr + 1024); }
#pragma unroll
        for (int j = 0; j < 2; ++j) { const bf16* xr = x1 + (size_t)r * D + 1024 * j + 16 * c.lane; x[j][0] = *(const u32x4*)xr; x[j][1] = *(const u32x4*)(xr + 8); } };
    u32x4 yc[9][2], xc[2][2]; f32x4 cq0 = {0.f, 0.f, 0.f, 0.f}, cq1 = {0.f, 0.f, 0.f, 0.f};
    int4 ns0 = {0, 0, 0, 0}, ns1 = {0, 0, 0, 0}; f32x4 nq0 = {0.f, 0.f, 0.f, 0.f}, nq1 = {0.f, 0.f, 0.f, 0.f};
    if (c.gw < nmoe) { int4 a, b; load_ids(c.gw, a, b, cq0, cq1); load_rows(c.gw, a, b, yc, xc); if (c.gw + c.ngw < nmoe) load_ids(c.gw + c.ngw, ns0, ns1, nq0, nq1); }
    for (int row = c.gw; row < nmoe; row += c.ngw) {
        const int mset = row < NLAT ? row / SEQ : 2;
        const int nr = row + c.ngw;
        u32x4 yn[9][2], xn[2][2]; const f32x4 tq0 = nq0, tq1 = nq1;
        if (nr < nmoe) { const int4 t0 = ns0, t1 = ns1; load_rows(nr, t0, t1, yn, xn); if (nr + c.ngw < nmoe) load_ids(nr + c.ngw, ns0, ns1, nq0, nq1); }
        f32x4 f[8];
        const float w[8] = {cq0.x, cq0.y, cq0.z, cq0.w, cq1.x, cq1.y, cq1.z, cq1.w};
#pragma unroll
        for (int j = 0; j < 2; ++j)
#pragma unroll
            for (int q = 0; q < 4; ++q) {
                { const int d = (int)yc[8][j][q]; const f32x2 a = __builtin_amdgcn_cvt_pk_f32_fp8(d, false), b2 = __builtin_amdgcn_cvt_pk_f32_fp8(d, true); f[4 * j + q] = (f32x4){a.x, a.y, b2.x, b2.y}; }
#pragma unroll
                for (int k = 0; k < 8; ++k) { const int d = (int)yc[k][j][q]; const f32x2 a = __builtin_amdgcn_cvt_pk_f32_fp8(d, false), b2 = __builtin_amdgcn_cvt_pk_f32_fp8(d, true); f[4 * j + q] += (f32x4){a.x, a.y, b2.x, b2.y} * w[k]; }
                f[4 * j + q] = f[4 * j + q] * 0.125f; }
        f32x4 v[8];
#pragma unroll
        for (int j = 0; j < 2; ++j) { const int cb = 1024 * j + 16 * c.lane;
            const u32x4 ta = xc[j][0], tb = xc[j][1];
            const f32x4 xa[4] = {(f32x4){lo16(ta.x), hi16(ta.x), lo16(ta.y), hi16(ta.y)}, (f32x4){lo16(ta.z), hi16(ta.z), lo16(ta.w), hi16(ta.w)},
                                 (f32x4){lo16(tb.x), hi16(tb.x), lo16(tb.y), hi16(tb.y)}, (f32x4){lo16(tb.z), hi16(tb.z), lo16(tb.w), hi16(tb.w)}};
#pragma unroll
            for (int q = 0; q < 4; ++q) v[4 * j + q] = xa[q] * DN_ALPHA + *(const LAS f32x4*)(cl + 4096 + 2048 * mset + cb + 4 * q) * f[4 * j + q]; }
        float mean, rstd; row_stats(v, mean, rstd);
#pragma unroll
        for (int j = 0; j < 2; ++j)
#pragma unroll
            for (int q = 0; q < 4; ++q) { const int col = 1024 * j + 16 * c.lane + 4 * q; v[4 * j + q] = (v[4 * j + q] - mean) * rstd * *(const LAS f32x4*)(cl + col) + *(const LAS f32x4*)(cl + 2048 + col); }
        if (L == 1) {
            float* orow = outp(c) + (size_t)row * D;
#pragma unroll
            for (int j = 0; j < 2; ++j)
#pragma unroll
                for (int q = 0; q < 4; ++q) *(f32x4*)(orow + 1024 * j + 16 * c.lane + 4 * q) = v[4 * j + q];
        } else if (row < NLAT) {
            bf16* xb = (bf16*)(c.ws + WS_XB);
#pragma unroll
            for (int j = 0; j < 2; ++j) { u32x4 oa, ob;
                oa.x = pk2(v[4 * j][0], v[4 * j][1]); oa.y = pk2(v[4 * j][2], v[4 * j][3]); oa.z = pk2(v[4 * j + 1][0], v[4 * j + 1][1]); oa.w = pk2(v[4 * j + 1][2], v[4 * j + 1][3]);
                ob.x = pk2(v[4 * j + 2][0], v[4 * j + 2][1]); ob.y = pk2(v[4 * j + 2][2], v[4 * j + 2][3]); ob.z = pk2(v[4 * j + 3][0], v[4 * j + 3][1]); ob.w = pk2(v[4 * j + 3][2], v[4 * j + 3][3]);
                *(u32x4*)(xb + (size_t)row * D + 1024 * j + 16 * c.lane) = oa; *(u32x4*)(xb + (size_t)row * D + 1024 * j + 16 * c.lane + 8) = ob; }
        }
        if (L == 0) {
            unsigned char* xn = (unsigned char*)(c.ws + WS_XN);
            row_stats(v, mean, rstd);
#pragma unroll
            for (int j = 0; j < 2; ++j) { const int cb = 1024 * j + 16 * c.lane; u32x4 o;
#pragma unroll
                for (int q = 0; q < 4; ++q) { const f32x4 sh = *(const LAS f32x4*)(cl + 10240 + 2048 * mset + cb + 4 * q), sc = *(const LAS f32x4*)(cl + 16384 + 2048 * mset + cb + 4 * q);
                    const f32x4 yv = (v[4 * j + q] - mean) * rstd * (sc + 1.f) + sh; o[q] = pk4_fp8(yv.x, yv.y, yv.z, yv.w); }
                *(u32x4*)(xn + (size_t)row * D + cb) = o; }
        }
#pragma unroll
        for (int k = 0; k < 9; ++k) { yc[k][0] = yn[k][0]; yc[k][1] = yn[k][1]; }
        xc[0][0] = xn[0][0]; xc[0][1] = xn[0][1]; xc[1][0] = xn[1][0]; xc[1][1] = xn[1][1]; cq0 = tq0; cq1 = tq1;
    }
    __syncthreads();
}

DI int xcd_vid(int G, int bx) { return (G % 8 == 0) ? (bx % 8) * (G / 8) + bx / 8 : bx; }
__global__ void __launch_bounds__(512, 2) fwd(Params prm) {
    extern __shared__ __attribute__((aligned(16))) unsigned char lds_raw[];
    const int wave_s = __builtin_amdgcn_readfirstlane(threadIdx.x >> 6);
    Ctx c; c.lds = (LAS unsigned char*)lds_raw; c.tid = threadIdx.x; c.lane = c.tid & 63; c.wave = __builtin_amdgcn_readfirstlane(c.tid >> 6);
    c.gw = blockIdx.x * 8 + c.wave; c.ngw = gridDim.x * 8; c.bid = blockIdx.x; c.nblk = gridDim.x; c.p = (CParams*)__builtin_amdgcn_kernarg_segment_ptr(); c.L = 0;
    volatile LAS unsigned* misc = (volatile LAS unsigned*)(c.lds + LDS_MISC);
    if (c.tid < 64) misc[c.tid] = 0u;
    __syncthreads();
    unsigned char* ws = (unsigned char*)prm.ws; c.ws = ws;
    XcdBarrier bar = xcd_barrier_post((unsigned*)(ws + WS_CTL) + CW_BAR, misc + 8);
    const int lo = prm.ph_lo, hi = prm.ph_hi;
    int gdim = gridDim.x, bidx = blockIdx.x;
#ifndef ONLY_PH
#define ONLY_PH -1
#endif
#ifndef STAGGER_US
#define STAGGER_US 0
#endif
#ifndef CVQ_P2
#define CVQ_P2 3
#define CVQ_P6 3
#define CVQ_P10 2
#define CVQ_P11 1
#define CVQ_P5 2
#endif
#ifndef PROBE_BARRIERS
#define PROBE_BARRIERS 0
#endif
#ifndef DUPMASK
#define DUPMASK 0
#endif
#ifndef PHMASK
#define PHMASK 0x1fff
#endif
#define IN(k) (lo <= (k) && (k) < hi && (ONLY_PH < 0 || ((k) % NPH) == ONLY_PH) && ((PHMASK >> ((k) % NPH)) & 1))
#define REFRESH() do { { CParams* kp_ = (CParams*)__builtin_amdgcn_kernarg_segment_ptr(); asm volatile("" : "+s"(kp_)); c.p = kp_; } ws = fresh(c.p->ws); c.ws = ws; int w_ = wave_s; asm volatile("" : "+s"(w_)); const int t_ = w_ * 64 + lane_id_fresh(); c.tid = t_; c.lane = t_ & 63; c.wave = w_; gdim = gridDim.x; bidx = blockIdx.x; asm volatile("" : "+s"(gdim), "+s"(bidx)); c.gw = bidx * 8 + c.wave; c.ngw = gdim * 8; c.bid = bidx; c.nblk = gdim; } while (0)
#define SEAM(k) do { if (IN(k) && IN((k) + 1)) xcd_barrier(bar); } while (0)
    for (int L = 0; L < 2; ++L) {
        c.L = L; const int pb = L * NPH;
        if (IN(pb + 0)) { for (int rep_ = 0; rep_ <= ((DUPMASK >> 0) & 1); ++rep_) { if (rep_) xcd_barrier(bar); REFRESH(); phase0(c); __syncthreads(); } } SEAM(pb + 0);
        if (IN(pb + 1)) { for (int rep_ = 0; rep_ <= ((DUPMASK >> 1) & 1); ++rep_) { if (rep_) xcd_barrier(bar); REFRESH(); if (L == 0) phase1(c); } } if (L == 0) SEAM(pb + 1);
        if (IN(pb + 2)) { for (int rep_ = 0; rep_ <= ((DUPMASK >> 2) & 1); ++rep_) { if (rep_) xcd_barrier(bar); REFRESH();
            pg8::Gemm g{(const bf16*)(ws + WS_XN), (const bf16*)(ws + WS_WIN), D / 2}; pg8::StaticOrder S; S.init(NTOK, PWP, gdim, bidx);
            pg8::EpiBf16 E{(bf16*)(ws + WS_P), PWP, 1.f / 64.f, rep_};
            pg8::gemm_phase<pg8::EpiBf16, pg8::StaticOrder, false, true>(c.lds, g, S, E, nullptr, c.tid);
            if (L == 0 && S.short_deal()) { REFRESH(); cv_steal(c, CVQ_P2); }
        } } SEAM(pb + 2);
        if (IN(pb + 2) && IN(pb + 3)) { REFRESH(); rope_prepass(c); xcd_barrier(bar); }
        if (IN(pb + 3)) { for (int rep_ = 0; rep_ <= ((DUPMASK >> 3) & 1); ++rep_) { if (rep_) xcd_barrier(bar); REFRESH();
            const int gw1 = (c.gw + c.ngw / 2) % c.ngw, gw2 = (c.gw + 3 * (c.ngw / 4)) % c.ngw, gw3 = (c.gw + c.ngw / 4) % c.ngw;
            for (int it = c.gw; it < 4096; it += c.ngw) na_item(c, it);
            for (int it = c.gw; it < 4096; it += c.ngw) swa_item(c, it);
            for (int it = gw1; it < 16 * NCH; it += c.ngw) { const int ck = it % NCH, h = (it / NCH) & 3, dir = (it / (NCH * 4)) & 1, b = it / (NCH * 8);
                if (dir == 0) gla_g1<0>(c, b, h, ck); else gla_g1<1>(c, b, h, ck); }
            if (L == 0) for (int it = gw2; it < 256; it += c.ngw) ctx_attn_item(c, it);
            for (int row = gw3; row < (L == 0 ? NTOK : NLAT); row += 4 * c.ngw) conv_rows4(c, row, c.ngw, L == 0 ? NTOK : NLAT);
        } } SEAM(pb + 3);
        if (PROBE_BARRIERS && IN(pb + 4)) { for (int i_ = 0; i_ < PROBE_BARRIERS; ++i_) xcd_barrier(bar); }
        if (IN(pb + 4)) { for (int rep_ = 0; rep_ <= ((DUPMASK >> 4) & 1); ++rep_) { if (rep_) xcd_barrier(bar); REFRESH(); gla_scan(c); } } SEAM(pb + 4);
        if (IN(pb + 5)) { for (int rep_ = 0; rep_ <= ((DUPMASK >> 5) & 1); ++rep_) { if (rep_) xcd_barrier(bar); REFRESH();
            for (int it = c.gw; it < 8 * NCH; it += c.ngw) { const int ck = it % NCH, h = (it / NCH) & 3, b = it / (NCH * 4);
                if (ck < 8 && L != 0) continue;
                gla_g3(c, b, h, ck); }
            if (L == 0 && c.gw + c.ngw >= 8 * NCH) cv_steal(c, CVQ_P5);
        } } SEAM(pb + 5);
        if (IN(pb + 6)) { for (int rep_ = 0; rep_ <= ((DUPMASK >> 6) & 1); ++rep_) { if (rep_) xcd_barrier(bar); REFRESH();
            pg8::Gemm g{(const bf16*)(ws + WS_YMIX), (const bf16*)(ws + WS_WOUT), D / 2};
            pg8::StaticOrder S; S.init(L == 0 ? NTOK : NLAT, D, gdim, bidx);
            pg8::EpiBf16 E{(bf16*)(ws + WS_T), D, 1.f / 64.f, rep_};
            pg8::gemm_phase<pg8::EpiBf16, pg8::StaticOrder, false, true>(c.lds, g, S, E, nullptr, c.tid);
            if (L == 0 && S.short_deal()) { REFRESH(); cv_steal(c, CVQ_P6); }
        } } SEAM(pb + 6);
        if (IN(pb + 7)) { for (int rep_ = 0; rep_ <= ((DUPMASK >> 7) & 1); ++rep_) { if (rep_) xcd_barrier(bar); REFRESH(); phase7(c); } } SEAM(pb + 7);
        if (IN(pb + 8)) { for (int rep_ = 0; rep_ <= ((DUPMASK >> 8) & 1); ++rep_) { if (rep_) { xcd_barrier(bar); if (blockIdx.x == 0 && c.tid < 64) ((unsigned*)(ws + WS_CTL))[CW_CNT + L * 64 + c.tid] = 0u; xcd_barrier(bar); } REFRESH(); if (L == 0) router_phase<5>(c, 66, 256); else router_phase<4>(c, 64, 256); } } SEAM(pb + 8);
        if (IN(pb + 9)) { for (int rep_ = 0; rep_ <= ((DUPMASK >> 9) & 1); ++rep_) { if (rep_) xcd_barrier(bar); REFRESH(); phase9(c); } } SEAM(pb + 9);
        if (IN(pb + 10)) { for (int rep_ = 0; rep_ <= ((DUPMASK >> 10) & 1); ++rep_) { if (rep_) xcd_barrier(bar); REFRESH();
            const int* ntp = (const int*)(ws + WS_CTL) + CW_NT + L * 64;
            pg8::Gemm g{(const bf16*)(ws + WS_XQ), (const bf16*)(ws + (L == 0 ? WS_WGU : WS_WGU1)), D / 2};
            int nu_ = __builtin_amdgcn_readfirstlane(ntp[0]) * 4; asm volatile("" : "+s"(nu_)); pg8::GroupOrder S{(const int*)(ws + WS_TILEE), nu_, 4, gdim, xcd_vid(gdim, bidx), (LAS int*)(c.lds + pg8::STAGE_BYTES + 24 * pg8::BM * 4)};
            pg8::EpiSwiglu8 E{(unsigned char*)(ws + WS_H)};
            pg8::gemm_phase<pg8::EpiSwiglu8, pg8::GroupOrder, true, true>(c.lds, g, S, E, (const int*)(ws + WS_TOKS), c.tid);
            if (L == 0 && S.short_deal()) { REFRESH(); cv_steal(c, CVQ_P10); }
        } } SEAM(pb + 10);
        if (IN(pb + 11)) { for (int rep_ = 0; rep_ <= ((DUPMASK >> 11) & 1); ++rep_) { if (rep_) xcd_barrier(bar); REFRESH();
            const int* ntp = (const int*)(ws + WS_CTL) + CW_NT + L * 64;
            if (STAGGER_US > 0 && (bidx & 1)) { const unsigned long long t0 = __builtin_amdgcn_s_memrealtime(); while (__builtin_amdgcn_s_memrealtime() - t0 < (unsigned long long)(STAGGER_US * 100)) __builtin_amdgcn_s_sleep(8); }
            pg8::Gemm g{(const bf16*)(ws + WS_H), (const bf16*)(ws + (L == 0 ? WS_WD : WS_WD1)), DEXP / 2};
            int nu_ = __builtin_amdgcn_readfirstlane(ntp[0]) * 8; asm volatile("" : "+s"(nu_)); pg8::GroupOrder S{(const int*)(ws + WS_TILEE), nu_, 8, gdim, xcd_vid(gdim, bidx), (LAS int*)(c.lds + pg8::STAGE_BYTES + 24 * pg8::BM * 4)};
            pg8::EpiFp8 E{(unsigned char*)(ws + WS_Y), D, 8.f / 64.f, rep_};
            pg8::gemm_phase<pg8::EpiFp8, pg8::GroupOrder, false, true>(c.lds, g, S, E, nullptr, c.tid);
            if (L == 0 && S.short_deal()) { REFRESH(); cv_steal(c, CVQ_P11); }
        } } SEAM(pb + 11);
        if (IN(pb + 12)) { for (int rep_ = 0; rep_ <= ((DUPMASK >> 12) & 1); ++rep_) { if (rep_) xcd_barrier(bar); REFRESH(); phase12(c); } }
    }
#undef IN
#undef SEAM
}

#ifndef MK_ONE_LAUNCH
#define MK_ONE_LAUNCH 1
#endif
extern "C" void kernel_launch(void* const* d_in, const int* in_sizes, int n_in, void* d_out, int out_size, void* d_ws, size_t ws_size, hipStream_t stream) {
    static int grid = 0;
    if (grid == 0) {
        if (n_in != 26 || out_size != NLAT * D || ws_size < WS_END) { fprintf(stderr, "kernel_launch: unexpected shapes (n_in %d out %d ws %zu)\n", n_in, out_size, ws_size); grid = -1; return; }
        int dev = 0, cus = 0;
        if (hipGetDevice(&dev) != hipSuccess || hipDeviceGetAttribute(&cus, hipDeviceAttributeMultiprocessorCount, dev) != hipSuccess) { grid = -1; return; }
        if (hipFuncSetAttribute((const void*)fwd, hipFuncAttributeMaxDynamicSharedMemorySize, LDS_BYTES) != hipSuccess) { fprintf(stderr, "kernel_launch: hipFuncSetAttribute failed\n"); grid = -1; return; }
        int per_cu = 0;
        if (hipOccupancyMaxActiveBlocksPerMultiprocessor(&per_cu, (const void*)fwd, 512, LDS_BYTES) != hipSuccess || per_cu < 1) fprintf(stderr, "kernel_launch: occupancy query reports %d\n", per_cu);
        (void)hipGetLastError();
        grid = cus;
    }
    if (grid < 0) return;
    hipMemsetAsync((char*)d_ws + WS_CTL, 0, (size_t)(CW_BAR + XCD_BAR_WORDS) * 4, stream);
    Params prm{};
    for (int i = 0; i < 26; ++i) prm.in[i] = (const GAS float*)d_in[i];
    prm.out = (GAS float*)d_out; prm.ws = (GAS unsigned char*)d_ws;
#if MK_ONE_LAUNCH
    prm.ph_lo = 0; prm.ph_hi = 2 * NPH;
    hipLaunchKernelGGL(fwd, dim3(grid), dim3(512), LDS_BYTES, stream, prm);
#else
    for (int ph = 0; ph < 2 * NPH; ++ph) { prm.ph_lo = ph; prm.ph_hi = ph + 1; hipLaunchKernelGGL(fwd, dim3(grid), dim3(512), LDS_BYTES, stream, prm); }
#endif
}
```
